# Optimizing an MI355X kernel written in HIP

```python
import jax, jax.numpy as jnp
from jax import lax
import numpy as np

D_MODEL = 1024
BATCH = 8
SEQ = 2048
DEPTH = 2

N_EVEN = (DEPTH + 1) // 2
N_ODD = DEPTH // 2
MIX_DIM = D_MODEL
HEAD_DIM = 64
ROPE_THETA = 10000.0
NORM_EPS = 1e-6
NEG_INF = -1e30
BIG = 1e9
NSA_DIM = D_MODEL // 2
N_Q_HEADS = NSA_DIM // HEAD_DIM
GQA = 4
N_KV_HEADS = N_Q_HEADS // GQA
KV_DIM = N_KV_HEADS * HEAD_DIM
CMP_BLOCK = 32
CMP_STRIDE = 16
CMP_HIDDEN = 256
SEL_BLOCK = 64
N_SEL = 8
N_LOCAL = 2
WINDOW = 512
Q_BLOCK = 128
ATTN_SCALE = HEAD_DIM ** -0.5
CONV_DIM = D_MODEL // 2
CONV_WIDTH = 3
EVEN_SIZES = (NSA_DIM,) + (KV_DIM,) * 6 + (N_Q_HEADS * 3,) + (CONV_DIM,) * 3
EVEN_COLS = sum(EVEN_SIZES)
RWKV_DIM = D_MODEL // 2
N_RWKV_HEADS = RWKV_DIM // HEAD_DIM
DECAY_LORA = 64
AAA_LORA = 64
GATE_LORA = 128
RWKV_SIZES = (RWKV_DIM,) * 3 + (DECAY_LORA, AAA_LORA, GATE_LORA)
RWKV_COLS = sum(RWKV_SIZES)
LNX_EPS = 64e-5
POOL_DIM = D_MODEL // 2
POOL_WINDOWS = (2, 4, 8, 16)
POOL_GROUP = POOL_DIM // len(POOL_WINDOWS)
ODD_COLS = RWKV_COLS + POOL_DIM
N_EXPERTS = 16
N_EXPERT_GROUPS = 4
EXPERTS_PER_GROUP = N_EXPERTS // N_EXPERT_GROUPS
GROUP_SCORE_TOPK = 2
TOP_K = 2
D_EXPERT = D_MODEL // 2

kernel_name = 'hybrid_nsa_conv_rwkv7_pool_moe'


def rms_norm(x, g):
    xf = x.astype(jnp.float32)
    y = xf * lax.rsqrt(jnp.mean(xf * xf, axis=-1, keepdims=True) + NORM_EPS)
    return (y * g.astype(jnp.float32)).astype(x.dtype)


def modulate(h, shift, scale):
    return h * (1 + scale[:, None, :]) + shift[:, None, :]


def split_cols(t, sizes):
    bounds = [int(b) for b in np.cumsum(sizes)[:-1]]
    return jnp.split(t, bounds, axis=-1)


def to_heads(t):
    b, s, _ = t.shape
    return t.reshape(b, s, -1, HEAD_DIM)


def rope(t):
    s = t.shape[1]
    half = HEAD_DIM // 2
    inv = ROPE_THETA ** (-jnp.arange(half, dtype=jnp.float32) / half)
    ang = jnp.arange(s, dtype=jnp.float32)[:, None] * inv[None, :]
    cos = jnp.cos(ang)[None, :, None, :]
    sin = jnp.sin(ang)[None, :, None, :]
    tf = t.astype(jnp.float32)
    t1, t2 = tf[..., :half], tf[..., half:]
    return jnp.concatenate([t1 * cos - t2 * sin, t2 * cos + t1 * sin], axis=-1).astype(t.dtype)


def masked_softmax(s, mask):
    p = jax.nn.softmax(jnp.where(mask, s.astype(jnp.float32), NEG_INF), axis=-1)
    return p * mask


def nsa_compressed(q, k_tok, v_tok, cmp_pos, cmp_w1, cmp_w2):
    b, s = q.shape[:2]
    n_cmp = (s - CMP_BLOCK) // CMP_STRIDE + 1
    idx = jnp.arange(n_cmp)[:, None] * CMP_STRIDE + jnp.arange(CMP_BLOCK)[None, :]

    def compress(tok, j):
        blocks = tok[:, idx] + cmp_pos[j][None, None, :, None, :]
        flat = blocks.transpose(0, 1, 3, 2, 4).reshape(b, n_cmp, N_KV_HEADS, CMP_BLOCK * HEAD_DIM)
        return jax.nn.gelu(flat @ cmp_w1[j]) @ cmp_w2[j]

    kc = compress(k_tok, 0)
    vc = compress(v_tok, 1)
    t = jnp.arange(s)
    mask = (jnp.arange(n_cmp) * CMP_STRIDE + CMP_BLOCK - 1)[None, :] <= t[:, None]
    sc = jnp.einsum('bshgd,bchd->bhgsc', q, kc) * ATTN_SCALE
    p = masked_softmax(sc, mask)
    out = jnp.einsum('bhgsc,bchd->bshgd', p.astype(vc.dtype), vc)
    return out, p.sum(axis=2)


def nsa_select(imp):
    s, n_cmp = imp.shape[2], imp.shape[3]
    n_blk = s // SEL_BLOCK
    r = SEL_BLOCK // CMP_STRIDE
    c = CMP_BLOCK // CMP_STRIDE
    need = r * n_blk + c - 1
    imp = jnp.pad(imp, ((0, 0), (0, 0), (0, 0), (0, need - n_cmp)))
    p_slc = jnp.zeros(imp.shape[:3] + (n_blk,), jnp.float32)
    for m in range(r):
        for n in range(c):
            p_slc = p_slc + imp[..., m + n: m + n + r * n_blk: r]
    t = jnp.arange(s)[:, None]
    j = jnp.arange(n_blk)[None, :]
    cur = t // SEL_BLOCK
    valid = j * SEL_BLOCK <= t
    forced = (j == 0) | ((cur - j >= 0) & (cur - j < N_LOCAL))
    score = jnp.where(forced, BIG, jnp.where(valid, p_slc, -BIG))
    top, idx = lax.top_k(score, min(N_SEL, n_blk))
    return idx, top > -0.5 * BIG


def nsa_selected(q, k, v, sel_idx, sel_ok):
    b, s = q.shape[:2]
    n_blk = s // SEL_BLOCK
    n_qb = s // Q_BLOCK
    n_sel = sel_idx.shape[-1]
    kb = k.reshape(b, n_blk, SEL_BLOCK, N_KV_HEADS, HEAD_DIM).transpose(0, 3, 1, 2, 4)
    vb = v.reshape(b, n_blk, SEL_BLOCK, N_KV_HEADS, HEAD_DIM).transpose(0, 3, 1, 2, 4)
    qs = jnp.moveaxis(q.reshape(b, n_qb, Q_BLOCK, N_KV_HEADS, GQA, HEAD_DIM), 1, 0)
    ids = jnp.moveaxis(sel_idx.reshape(b, N_KV_HEADS, n_qb, Q_BLOCK, n_sel), 2, 0)
    oks = jnp.moveaxis(sel_ok.reshape(b, N_KV_HEADS, n_qb, Q_BLOCK, n_sel), 2, 0)
    bi = jnp.arange(b)[:, None, None, None]
    hi = jnp.arange(N_KV_HEADS)[None, :, None, None]

    def one_block(args):
        blk, qb, ib, ok = args
        kg = kb[bi, hi, ib]
        vg = vb[bi, hi, ib]
        t = blk * Q_BLOCK + jnp.arange(Q_BLOCK)
        kpos = ib[..., None] * SEL_BLOCK + jnp.arange(SEL_BLOCK)
        mask = ok[..., None] & (kpos <= t[:, None, None])
        mask = mask.reshape(b, N_KV_HEADS, 1, Q_BLOCK, n_sel * SEL_BLOCK)
        sc = jnp.einsum('bqhgd,bhqnkd->bhgqnk', qb, kg).reshape(
            b, N_KV_HEADS, GQA, Q_BLOCK, n_sel * SEL_BLOCK) * ATTN_SCALE
        p = masked_softmax(sc, mask).reshape(b, N_KV_HEADS, GQA, Q_BLOCK, n_sel, SEL_BLOCK)
        return jnp.einsum('bhgqnk,bhqnkd->bqhgd', p.astype(vg.dtype), vg)

    out = lax.map(one_block, (jnp.arange(n_qb), qs, ids, oks))
    return jnp.moveaxis(out, 0, 1).reshape(b, s, N_KV_HEADS, GQA, HEAD_DIM)


def nsa_window(q, k, v):
    b, s = q.shape[:2]
    kp = jnp.pad(k, ((0, 0), (WINDOW, 0), (0, 0), (0, 0)))
    vp = jnp.pad(v, ((0, 0), (WINDOW, 0), (0, 0), (0, 0)))
    span = WINDOW + Q_BLOCK

    def one_block(blk):
        start = blk * Q_BLOCK
        qb = lax.dynamic_slice_in_dim(q, start, Q_BLOCK, axis=1)
        kw = lax.dynamic_slice_in_dim(kp, start, span, axis=1)
        vw = lax.dynamic_slice_in_dim(vp, start, span, axis=1)
        t = start + jnp.arange(Q_BLOCK)
        s_pos = start - WINDOW + jnp.arange(span)
        diff = t[:, None] - s_pos[None, :]
        mask = (diff >= 0) & (diff < WINDOW) & (s_pos[None, :] >= 0)
        sc = jnp.einsum('bqhgd,bkhd->bhgqk', qb, kw) * ATTN_SCALE
        p = masked_softmax(sc, mask)
        return jnp.einsum('bhgqk,bkhd->bqhgd', p.astype(vw.dtype), vw)

    out = lax.map(one_block, jnp.arange(s // Q_BLOCK))
    return jnp.moveaxis(out, 0, 1).reshape(b, s, N_KV_HEADS, GQA, HEAD_DIM)


def short_conv(xb, b_gate, c_gate, conv_w):
    s = xb.shape[1]
    u = jnp.pad(c_gate * xb, ((0, 0), (CONV_WIDTH - 1, 0), (0, 0)))
    y = conv_w[CONV_WIDTH - 1] * u[:, CONV_WIDTH - 1: CONV_WIDTH - 1 + s]
    for kk in range(CONV_WIDTH - 1):
        y = y + conv_w[kk] * u[:, kk: kk + s]
    return b_gate * y


def nsa_conv_mixer(h, w_in, cmp_pos, cmp_w1, cmp_w2, conv_w, w_out):
    b, s, _ = h.shape
    q, kc, vc, ks, vs, kw, vw, gl, xb, bg, cg = split_cols(h @ w_in, EVEN_SIZES)
    q_h = to_heads(q)
    q_nope = q_h.reshape(b, s, N_KV_HEADS, GQA, HEAD_DIM)
    q_rot = rope(q_h).reshape(b, s, N_KV_HEADS, GQA, HEAD_DIM)
    o_cmp, imp = nsa_compressed(q_nope, to_heads(kc), to_heads(vc), cmp_pos, cmp_w1, cmp_w2)
    sel_idx, sel_ok = nsa_select(imp)
    o_slc = nsa_selected(q_rot, rope(to_heads(ks)), to_heads(vs), sel_idx, sel_ok)
    o_win = nsa_window(q_rot, rope(to_heads(kw)), to_heads(vw))
    g = jax.nn.sigmoid(gl).reshape(b, s, N_KV_HEADS, GQA, 3)
    o_nsa = (g[..., 0:1] * o_cmp + g[..., 1:2] * o_slc + g[..., 2:3] * o_win).reshape(b, s, NSA_DIM)
    y_conv = short_conv(xb, bg, cg, conv_w)
    return jnp.concatenate([o_nsa.astype(h.dtype), y_conv.astype(h.dtype)], axis=-1) @ w_out


def rwkv7_scan(r, w, k, v, a, bb):
    b, s, h, n = r.shape

    def step(state, inp):
        r_t, w_t, k_t, v_t, a_t, b_t = inp
        sa = jnp.einsum('bhij,bhj->bhi', state, a_t)
        state = (state * w_t[:, :, None, :] + sa[..., None] * b_t[:, :, None, :]
                 + v_t[..., None] * k_t[:, :, None, :])
        return state, jnp.einsum('bhij,bhj->bhi', state, r_t)

    xs = tuple(jnp.moveaxis(t, 1, 0) for t in (r, w, k, v, a, bb))
    _, ys = lax.scan(step, jnp.zeros((b, h, n, n), jnp.float32), xs)
    return jnp.moveaxis(ys, 0, 1)


def multiscale_pool(u, pool_w, pool_scale):
    b, s, _ = u.shape
    ug = u.reshape(b, s, len(POOL_WINDOWS), POOL_GROUP).astype(jnp.float32)
    cs = jnp.pad(jnp.cumsum(ug, axis=1), ((0, 0), (1, 0), (0, 0), (0, 0)))
    end = jnp.arange(1, s + 1)
    outs = []
    for gi, win in enumerate(POOL_WINDOWS):
        start = jnp.maximum(end - win, 0)
        mean = (cs[:, end, gi] - cs[:, start, gi]) / (end - start).astype(jnp.float32)[None, :, None]
        outs.append(mean - ug[:, :, gi])
    pooled = jnp.stack(outs, axis=2).astype(u.dtype)
    mixed = jnp.einsum('bsgc,gcd->bsgd', pooled, pool_w).reshape(b, s, POOL_DIM)
    return mixed * pool_scale


def rwkv_pool_mixer(h, w_in, mu, w0, w2, a0, a2, g2, k_k, k_a, r_k, lnx_w, lnx_b,
                    pool_w, pool_scale, w_out):
    b, s, _ = h.shape
    f32 = jnp.float32
    proj = h @ w_in
    rw, u = proj[..., :RWKV_COLS], proj[..., RWKV_COLS:]
    rw_prev = jnp.pad(rw, ((0, 0), (1, 0), (0, 0)))[:, :s]
    rw = rw + (rw_prev - rw) * mu
    r, k, v, wl, al, gl = split_cols(rw, RWKV_SIZES)
    w_log = -jax.nn.softplus(-(w0 + jnp.tanh(wl) @ w2).astype(f32)) - 0.5
    decay = jnp.exp(-jnp.exp(w_log))
    a = jax.nn.sigmoid((a0 + al @ a2).astype(f32))
    g = jax.nn.sigmoid(gl) @ g2
    k_mod = k.astype(f32) * (1 + (a - 1) * k_a.astype(f32))

    def hd(t):
        return t.astype(f32).reshape(b, s, N_RWKV_HEADS, HEAD_DIM)

    kk = hd(k * k_k)
    kk = kk / jnp.maximum(jnp.sqrt(jnp.sum(kk * kk, axis=-1, keepdims=True)), 1e-12)
    r_h, k_h, v_h = hd(r), hd(k_mod), hd(v)
    y = rwkv7_scan(r_h, hd(decay), k_h, v_h, -kk, kk * hd(a))
    mean = jnp.mean(y, axis=-1, keepdims=True)
    var = jnp.mean(jnp.square(y - mean), axis=-1, keepdims=True)
    y = ((y - mean) * lax.rsqrt(var + LNX_EPS)).reshape(b, s, RWKV_DIM) * lnx_w + lnx_b
    bonus = jnp.sum(r_h * k_h * r_k, axis=-1, keepdims=True) * v_h
    o_rwkv = ((y + bonus.reshape(b, s, RWKV_DIM)) * g).astype(h.dtype)
    o_pool = multiscale_pool(u, pool_w, pool_scale).astype(h.dtype)
    return jnp.concatenate([o_rwkv, o_pool], axis=-1) @ w_out


def grouped_moe(h, router_w, router_b, w_gate, w_up, w_down):
    b, s, d = h.shape
    t = h.reshape(b * s, d)
    scores = jax.nn.sigmoid((t @ router_w).astype(jnp.float32))
    biased = scores + router_b.astype(jnp.float32)
    grp = biased.reshape(-1, N_EXPERT_GROUPS, EXPERTS_PER_GROUP)
    grp_score = lax.top_k(grp, GROUP_SCORE_TOPK)[0].sum(axis=-1)
    top_grp = jnp.argmax(grp_score, axis=-1)
    in_group = (jnp.arange(N_EXPERTS) // EXPERTS_PER_GROUP)[None, :] == top_grp[:, None]
    _, idx = lax.top_k(jnp.where(in_group, biased, NEG_INF), TOP_K)
    w_sel = jnp.take_along_axis(scores, idx, axis=-1)
    w_sel = w_sel / jnp.sum(w_sel, axis=-1, keepdims=True)
    gates = jnp.sum(jax.nn.one_hot(idx, N_EXPERTS, dtype=jnp.float32) * w_sel[..., None], axis=1)
    gates = gates.astype(t.dtype)
    out = jnp.zeros_like(t)
    for e in range(N_EXPERTS):
        he = jax.nn.silu(t @ w_gate[e]) * (t @ w_up[e])
        out = out + gates[:, e:e + 1] * (he @ w_down[e])
    return out.reshape(b, s, d)


def setup_inputs(seed: int = 0) -> dict:
    key = jax.random.key(seed)
    ks = iter(jax.random.split(key, 48))
    f32 = jnp.float32

    def nrm(shape, scale):
        return scale * jax.random.normal(next(ks), shape, f32)

    def uni(shape, lo, hi):
        return jax.random.uniform(next(ks), shape, f32, lo, hi)

    D = D_MODEL
    return {
        'x': nrm((BATCH, SEQ, D), 1.0),
        'c': nrm((BATCH, D), 1.0),
        'ada_w': nrm((DEPTH, D, 6 * D), 0.5 * D ** -0.5),
        'ada_b': nrm((DEPTH, 6 * D), 0.02),
        'norm_mix': 1.0 + nrm((DEPTH, D), 0.05),
        'norm_ffn': 1.0 + nrm((DEPTH, D), 0.05),
        'even_w_in': nrm((N_EVEN, D, EVEN_COLS), D ** -0.5),
        'even_cmp_pos': nrm((N_EVEN, 2, CMP_BLOCK, HEAD_DIM), 0.02),
        'even_cmp_w1': nrm((N_EVEN, 2, CMP_BLOCK * HEAD_DIM, CMP_HIDDEN), (CMP_BLOCK * HEAD_DIM) ** -0.5),
        'even_cmp_w2': nrm((N_EVEN, 2, CMP_HIDDEN, HEAD_DIM), CMP_HIDDEN ** -0.5),
        'even_conv_w': nrm((N_EVEN, CONV_WIDTH, CONV_DIM), CONV_WIDTH ** -0.5),
        'even_w_out': nrm((N_EVEN, MIX_DIM, D), MIX_DIM ** -0.5),
        'odd_w_in': nrm((N_ODD, D, ODD_COLS), D ** -0.5),
        'odd_mu': uni((N_ODD, RWKV_COLS), 0.0, 1.0),
        'odd_w0': uni((N_ODD, RWKV_DIM), -6.0, -1.0),
        'odd_w2': nrm((N_ODD, DECAY_LORA, RWKV_DIM), 0.1),
        'odd_a0': nrm((N_ODD, RWKV_DIM), 0.1),
        'odd_a2': nrm((N_ODD, AAA_LORA, RWKV_DIM), AAA_LORA ** -0.5),
        'odd_g2': nrm((N_ODD, GATE_LORA, RWKV_DIM), GATE_LORA ** -0.5),
        'odd_k_k': 0.85 + nrm((N_ODD, RWKV_DIM), 0.05),
        'odd_k_a': 1.0 + nrm((N_ODD, RWKV_DIM), 0.05),
        'odd_r_k': nrm((N_ODD, N_RWKV_HEADS, HEAD_DIM), 0.1),
        'odd_lnx_w': 1.0 + nrm((N_ODD, RWKV_DIM), 0.05),
        'odd_lnx_b': nrm((N_ODD, RWKV_DIM), 0.02),
        'odd_pool_w': nrm((N_ODD, len(POOL_WINDOWS), POOL_GROUP, POOL_GROUP), POOL_GROUP ** -0.5),
        'odd_pool_scale': 1.0 + nrm((N_ODD, POOL_DIM), 0.1),
        'odd_w_out': nrm((N_ODD, MIX_DIM, D), MIX_DIM ** -0.5),
        'router_w': nrm((D, N_EXPERTS), D ** -0.5),
        'router_b': nrm((N_EXPERTS,), 0.01),
        'moe_w_gate': nrm((DEPTH, N_EXPERTS, D, D_EXPERT), D ** -0.5),
        'moe_w_up': nrm((DEPTH, N_EXPERTS, D, D_EXPERT), D ** -0.5),
        'moe_w_down': nrm((DEPTH, N_EXPERTS, D_EXPERT, D), D_EXPERT ** -0.5),
        'final_norm': 1.0 + nrm((D,), 0.05),
    }


def reference(x, c, ada_w, ada_b, norm_mix, norm_ffn,
              even_w_in, even_cmp_pos, even_cmp_w1, even_cmp_w2, even_conv_w, even_w_out,
              odd_w_in, odd_mu, odd_w0, odd_w2, odd_a0, odd_a2, odd_g2, odd_k_k, odd_k_a, odd_r_k,
              odd_lnx_w, odd_lnx_b, odd_pool_w, odd_pool_scale, odd_w_out,
              router_w, router_b, moe_w_gate, moe_w_up, moe_w_down, final_norm):
    cond = jax.nn.silu(c)
    for layer in range(DEPTH):
        mod = cond @ ada_w[layer] + ada_b[layer]
        sh1, sc1, g1, sh2, sc2, g2 = jnp.split(mod, 6, axis=-1)
        h = modulate(rms_norm(x, norm_mix[layer]), sh1, sc1)
        i = layer // 2
        if layer % 2 == 0:
            y = nsa_conv_mixer(h, even_w_in[i], even_cmp_pos[i], even_cmp_w1[i], even_cmp_w2[i],
                               even_conv_w[i], even_w_out[i])
        else:
            y = rwkv_pool_mixer(h, odd_w_in[i], odd_mu[i], odd_w0[i], odd_w2[i], odd_a0[i], odd_a2[i],
                                odd_g2[i], odd_k_k[i], odd_k_a[i], odd_r_k[i], odd_lnx_w[i], odd_lnx_b[i],
                                odd_pool_w[i], odd_pool_scale[i], odd_w_out[i])
        x = x + g1[:, None, :] * y
        h = modulate(rms_norm(x, norm_ffn[layer]), sh2, sc2)
        x = x + g2[:, None, :] * grouped_moe(h, router_w, router_b, moe_w_gate[layer],
                                             moe_w_up[layer], moe_w_down[layer])
    return rms_norm(x, final_norm)
```

```cpp
#include <hip/hip_runtime.h>
#include <hip/hip_cooperative_groups.h>
#include <cstdio>
namespace cg = cooperative_groups;

typedef unsigned short bfr;
using bf16x8 = __attribute__((ext_vector_type(8))) short;
using f32x4 = __attribute__((ext_vector_type(4))) float;
typedef __attribute__((ext_vector_type(2))) __bf16 bf2v;
#define DI __device__ __forceinline__

constexpr int NT = 16384;
constexpr int SEQ = 2048;
constexpr int DM = 1024;
constexpr int PW0 = 2944;
constexpr int PW1 = 2304;
constexpr int C_Q = 0, C_KC = 512, C_VC = 640, C_KS = 768, C_VS = 896, C_KW = 1024, C_VW = 1152;
constexpr int C_XB = 1280, C_BG = 1792, C_CG = 2304, C_GL = 2816;

constexpr size_t al256(size_t x) { return (x + 255) & ~size_t(255); }
constexpr size_t MB = 1024 * 1024;
constexpr size_t O_MOD = 0;
constexpr size_t O_ROPE = O_MOD + al256(2 * 8 * 6144 * 4);
constexpr size_t O_BIAS1 = O_ROPE + al256(2048 * 32 * 2 * 4);
constexpr size_t O_CNT = O_BIAS1 + al256(2 * 256 * 4);
constexpr size_t O_TOPW = O_CNT + al256(2 * 16 * 64 * 4);
constexpr size_t O_LIST = O_TOPW + al256((size_t)NT * 2 * 4);
constexpr size_t O_SEL = O_LIST + al256((size_t)16 * NT * 4);
constexpr size_t O_KCVC = O_SEL + al256((size_t)NT * 2 * 4);
constexpr size_t O_RK = O_KCVC + al256(2 * 2048 * 64 * 4);
constexpr size_t O_CH = O_RK + al256((size_t)NT * 8 * 4);
constexpr size_t O_WEIN = O_CH + al256(2 * 2048 * 256 * 2);
constexpr size_t O_WEOUT = O_WEIN + al256((size_t)PW0 * 1024 * 2);
constexpr size_t O_WOIN = O_WEOUT + al256(1024 * 1024 * 2);
constexpr size_t O_WOOUT = O_WOIN + al256((size_t)PW1 * 1024 * 2);
constexpr size_t O_WC1 = O_WOOUT + al256(1024 * 1024 * 2);
constexpr size_t O_WC2 = O_WC1 + al256(2 * 256 * 2048 * 2);
constexpr size_t O_WGU = O_WC2 + al256(2 * 128 * 256 * 2);
constexpr size_t O_WDN = O_WGU + 64 * MB;
constexpr size_t O_HB = O_WDN + 32 * MB;
constexpr size_t O_MIX = O_HB + 32 * MB;
constexpr size_t O_E = O_MIX + 32 * MB;
constexpr size_t SZ_E = al256((size_t)NT * PW0 * 2);
constexpr size_t O_F = O_E + SZ_E;
constexpr size_t WS_NEED = O_F + 48 * MB;
constexpr size_t O_HMID = O_MIX;
constexpr size_t O_PROJ = O_E;
constexpr size_t O_MOEOUT = O_E;
constexpr size_t O_CHP = O_E;
constexpr size_t O_CHL = O_E + 32 * MB;
constexpr size_t O_QR = O_F;
constexpr size_t O_KSR = O_F + 16 * MB;
constexpr size_t O_KWR = O_F + 20 * MB;
constexpr size_t O_OCMP = O_F + 24 * MB;
constexpr size_t O_RW_W = O_HB;
constexpr size_t O_RW_R = O_F;
constexpr size_t O_RW_K = O_F + 16 * MB;
constexpr size_t O_RW_V = O_F + 32 * MB;
constexpr size_t O_RW_A = O_WGU;
constexpr size_t O_RW_B = O_WGU + 16 * MB;
constexpr size_t O_RW_G = O_WDN;

struct Params {
  const float* in[33];
  float* out;
  char* ws;
  unsigned long long ws_size;
};

enum { I_X = 0, I_C, I_ADAW, I_ADAB, I_NMIX, I_NFFN, I_EWIN, I_CPOS, I_CW1, I_CW2, I_CONVW, I_EWOUT, I_OWIN, I_MU, I_W0, I_W2,
       I_A0, I_A2, I_G2, I_KK, I_KA, I_RKP, I_LNW, I_LNB, I_POOLW, I_POOLS, I_OWOUT, I_RTW, I_RTB, I_MG, I_MU_, I_MD, I_FN };

DI float bf2f(bfr u) { return __uint_as_float(((unsigned)u) << 16); }
DI bfr f2bf(float x) { unsigned u = __float_as_uint(x); u += 0x7fffu + ((u >> 16) & 1u); return (bfr)(u >> 16); }
DI unsigned pack2(float a, float b) { return (unsigned)f2bf(a) | ((unsigned)f2bf(b) << 16); }
DI float lo2f(unsigned u) { return __uint_as_float(u << 16); }
DI float hi2f(unsigned u) { return __uint_as_float(u & 0xffff0000u); }
DI float wave_sum(float v) {
#pragma unroll
  for (int o = 32; o > 0; o >>= 1) v += __shfl_xor(v, o);
  return v;
}
DI float sigmoidf_(float x) { return 1.f / (1.f + __expf(-x)); }
DI float dot2(unsigned a, unsigned b, float c) {
  return __builtin_amdgcn_fdot2_f32_bf16(__builtin_bit_cast(bf2v, a), __builtin_bit_cast(bf2v, b), c, false);
}

struct GemmLds { bfr a[2][128][40]; bfr b[2][128][40]; };
static_assert(sizeof(GemmLds) == 40960, "lds");

template <class AF, class BF, class Epi>
DI void gemm_tile(char* smem, int nk, const AF& af, const BF& bfn, Epi&& epi) {
  GemmLds& L = *(GemmLds*)smem;
  const int tid = threadIdx.x, lane = tid & 63, wid = tid >> 6, wr = wid >> 1, wc = wid & 1, fr = lane & 15, fq = lane >> 4;
  const int lr = tid >> 2, lk = (tid & 3) * 8;
  const bfr* a0 = af.row(lr);
  const bfr* a1 = af.row(lr + 64);
  const bfr* b0 = bfn.row(lr);
  const bfr* b1 = bfn.row(lr + 64);
  f32x4 acc[4][4];
#pragma unroll
  for (int m = 0; m < 4; ++m)
#pragma unroll
    for (int n = 0; n < 4; ++n) acc[m][n] = f32x4{0.f, 0.f, 0.f, 0.f};
  uint4 ra0, ra1, rb0, rb1;
  {
    const int ka = af.koff(lk), kb = bfn.koff(lk);
    ra0 = *(const uint4*)(a0 + ka); ra1 = *(const uint4*)(a1 + ka);
    rb0 = *(const uint4*)(b0 + kb); rb1 = *(const uint4*)(b1 + kb);
  }
  *(uint4*)&L.a[0][lr][lk] = ra0; *(uint4*)&L.a[0][lr + 64][lk] = ra1;
  *(uint4*)&L.b[0][lr][lk] = rb0; *(uint4*)&L.b[0][lr + 64][lk] = rb1;
  __syncthreads();
  for (int kt = 0; kt < nk; ++kt) {
    const int cur = kt & 1;
    if (kt + 1 < nk) {
      const int k = (kt + 1) * 32 + lk;
      const int ka = af.koff(k), kb = bfn.koff(k);
      ra0 = *(const uint4*)(a0 + ka); ra1 = *(const uint4*)(a1 + ka);
      rb0 = *(const uint4*)(b0 + kb); rb1 = *(const uint4*)(b1 + kb);
    }
    bf16x8 fa[4], fb[4];
#pragma unroll
    for (int m = 0; m < 4; ++m) fa[m] = *(const bf16x8*)&L.a[cur][wr * 64 + m * 16 + fr][fq * 8];
#pragma unroll
    for (int n = 0; n < 4; ++n) fb[n] = *(const bf16x8*)&L.b[cur][wc * 64 + n * 16 + fr][fq * 8];
#pragma unroll
    for (int m = 0; m < 4; ++m)
#pragma unroll
      for (int n = 0; n < 4; ++n) acc[m][n] = __builtin_amdgcn_mfma_f32_16x16x32_bf16(fa[m], fb[n], acc[m][n], 0, 0, 0);
    if (kt + 1 < nk) {
      *(uint4*)&L.a[cur ^ 1][lr][lk] = ra0; *(uint4*)&L.a[cur ^ 1][lr + 64][lk] = ra1;
      *(uint4*)&L.b[cur ^ 1][lr][lk] = rb0; *(uint4*)&L.b[cur ^ 1][lr + 64][lk] = rb1;
    }
    __syncthreads();
  }
  epi(acc, wr, wc, fr, fq);
}

struct RowsContig {
  const bfr* base; int ld; int maxrow;
  DI const bfr* row(int r) const { return base + (size_t)(r < maxrow ? r : maxrow) * ld; }
  DI int koff(int k) const { return k; }
};

DI int remap_col(int mode, int n) {
  if (mode == 1) return n < 1280 ? n : (n < 1304 ? C_GL + (n - 1280) : n - 24);
  if (mode == 2) return ((n >> 4) << 5) + (n & 15);
  if (mode == 3) return ((n >> 4) << 5) + 16 + (n & 15);
  return n;
}

DI void conv_tile(char* smem, const float* __restrict__ src, int ldsrc, int Ndim, int k0, int n0, bfr* dst, int ldd, int mode) {
  float(*t)[65] = (float(*)[65])smem;
  const int tid = threadIdx.x;
  {
    const int n = tid & 63, kq = tid >> 6;
    const int nn = n0 + n;
#pragma unroll
    for (int i = 0; i < 16; ++i) {
      const int k = i * 4 + kq;
      t[k][n] = (nn < Ndim) ? src[(size_t)(k0 + k) * ldsrc + nn] : 0.f;
    }
  }
  __syncthreads();
  {
    const int nl = tid >> 2, kc = (tid & 3) * 16;
    const int nn = n0 + nl;
    if (nn < Ndim) {
      const int dr = remap_col(mode, nn);
      unsigned w[8];
#pragma unroll
      for (int i = 0; i < 8; ++i) w[i] = pack2(t[kc + 2 * i][nl], t[kc + 2 * i + 1][nl]);
      uint4* d = (uint4*)(dst + (size_t)dr * ldd + k0 + kc);
      d[0] = make_uint4(w[0], w[1], w[2], w[3]);
      d[1] = make_uint4(w[4], w[5], w[6], w[7]);
    }
  }
  __syncthreads();
}

constexpr int PREP_MOD = 192, PREP_ROPE = 256, PREP_MISC = 3;
constexpr int T_EIN = 16 * 45, T_SQ = 256, T_OIN = 16 * 36, T_C1 = 128, T_C2 = 4, T_G = 128, T_D = 128;
constexpr int PREP_CONV0 = PREP_MOD + PREP_ROPE + PREP_MISC;
constexpr int PREP_TOTAL = PREP_CONV0 + T_EIN + T_SQ + T_OIN + T_SQ + 2 * T_C1 + 2 * T_C2 + 32 * (2 * T_G + T_D);

DI void prep_item(const Params& p, char* smem, int item) {
  const int tid = threadIdx.x;
  char* ws = p.ws;
  if (item < PREP_MOD) {
    const int layer = item / 96, cch = item % 96;
    float* cond = (float*)smem;
    float* red = (float*)(smem + 32768);
    const float* c = p.in[I_C];
    for (int i = tid; i < 8192; i += 256) {
      const int b = i >> 10, k = i & 1023;
      const float v = c[i];
      cond[k * 8 + b] = v / (1.f + __expf(-v));
    }
    __syncthreads();
    const int col = cch * 64 + (tid & 63), kg = tid >> 6;
    const float* w = p.in[I_ADAW] + (size_t)layer * 1024 * 6144 + col;
    float acc[8] = {0, 0, 0, 0, 0, 0, 0, 0};
#pragma unroll 8
    for (int k = kg * 256; k < kg * 256 + 256; ++k) {
      const float wv = w[(size_t)k * 6144];
      const float4 c0 = *(const float4*)&cond[k * 8], c1 = *(const float4*)&cond[k * 8 + 4];
      acc[0] += c0.x * wv; acc[1] += c0.y * wv; acc[2] += c0.z * wv; acc[3] += c0.w * wv;
      acc[4] += c1.x * wv; acc[5] += c1.y * wv; acc[6] += c1.z * wv; acc[7] += c1.w * wv;
    }
#pragma unroll
    for (int b = 0; b < 8; ++b) red[(kg * 8 + b) * 64 + (tid & 63)] = acc[b];
    __syncthreads();
    for (int i = tid; i < 512; i += 256) {
      const int b = i >> 6, cc = i & 63;
      const float s = red[(0 * 8 + b) * 64 + cc] + red[(1 * 8 + b) * 64 + cc] + red[(2 * 8 + b) * 64 + cc] + red[(3 * 8 + b) * 64 + cc];
      const int cg_ = cch * 64 + cc;
      ((float*)(ws + O_MOD))[(layer * 8 + b) * 6144 + cg_] = s + p.in[I_ADAB][layer * 6144 + cg_];
    }
    __syncthreads();
    return;
  }
  item -= PREP_MOD;
  if (item < PREP_ROPE) {
    const int e = item * 256 + tid;
    const int t = e >> 5, i = e & 31;
    const float inv = powf(10000.f, -(float)i / 32.f);
    const float ang = (float)t * inv;
    float* rp = (float*)(ws + O_ROPE);
    rp[e] = cosf(ang);
    rp[65536 + e] = sinf(ang);
    return;
  }
  item -= PREP_ROPE;
  if (item < PREP_MISC) {
    if (item < 2) {
      const int j = item, n = tid;
      const float* pos = p.in[I_CPOS] + j * 2048;
      const float* w1 = p.in[I_CW1] + (size_t)j * 2048 * 256 + n;
      float s = 0.f;
      for (int k = 0; k < 2048; ++k) s += pos[k] * w1[(size_t)k * 256];
      ((float*)(ws + O_BIAS1))[j * 256 + n] = s;
    } else {
      int* cnt = (int*)(ws + O_CNT);
      for (int i = tid; i < 2 * 16 * 64; i += 256) cnt[i] = 0;
      uint4 z = make_uint4(0, 0, 0, 0);
      uint4* wpad = (uint4*)(ws + O_WEIN + (size_t)2840 * 1024 * 2);
      for (int i = tid; i < 104 * 1024 * 2 / 16; i += 256) wpad[i] = z;
      for (int j = 0; j < 2; ++j) {
        uint4* cp = (uint4*)(ws + O_WC2 + ((size_t)j * 128 + 64) * 256 * 2);
        for (int i = tid; i < 64 * 256 * 2 / 16; i += 256) cp[i] = z;
      }
    }
    return;
  }
  item -= PREP_MISC;
  if (item < T_EIN) { conv_tile(smem, p.in[I_EWIN], 2840, 2840, (item / 45) * 64, (item % 45) * 64, (bfr*)(ws + O_WEIN), 1024, 1); return; }
  item -= T_EIN;
  if (item < T_SQ) { conv_tile(smem, p.in[I_EWOUT], 1024, 1024, (item / 16) * 64, (item % 16) * 64, (bfr*)(ws + O_WEOUT), 1024, 0); return; }
  item -= T_SQ;
  if (item < T_OIN) { conv_tile(smem, p.in[I_OWIN], 2304, 2304, (item / 36) * 64, (item % 36) * 64, (bfr*)(ws + O_WOIN), 1024, 0); return; }
  item -= T_OIN;
  if (item < T_SQ) { conv_tile(smem, p.in[I_OWOUT], 1024, 1024, (item / 16) * 64, (item % 16) * 64, (bfr*)(ws + O_WOOUT), 1024, 0); return; }
  item -= T_SQ;
  if (item < 2 * T_C1) {
    const int j = item / T_C1, tt = item % T_C1;
    conv_tile(smem, p.in[I_CW1] + (size_t)j * 2048 * 256, 256, 256, (tt / 4) * 64, (tt % 4) * 64, (bfr*)(ws + O_WC1) + (size_t)j * 256 * 2048, 2048, 0);
    return;
  }
  item -= 2 * T_C1;
  if (item < 2 * T_C2) {
    const int j = item / T_C2, tt = item % T_C2;
    conv_tile(smem, p.in[I_CW2] + (size_t)j * 256 * 64, 64, 64, tt * 64, 0, (bfr*)(ws + O_WC2) + (size_t)j * 128 * 256, 256, 0);
    return;
  }
  item -= 2 * T_C2;
  {
    const int le = item / (2 * T_G + T_D), tt = item % (2 * T_G + T_D);
    if (tt < T_G) {
      conv_tile(smem, p.in[I_MG] + (size_t)le * 1024 * 512, 512, 512, (tt / 8) * 64, (tt % 8) * 64, (bfr*)(ws + O_WGU) + (size_t)le * 1024 * 1024, 1024, 2);
    } else if (tt < 2 * T_G) {
      const int t2 = tt - T_G;
      conv_tile(smem, p.in[I_MU_] + (size_t)le * 1024 * 512, 512, 512, (t2 / 8) * 64, (t2 % 8) * 64, (bfr*)(ws + O_WGU) + (size_t)le * 1024 * 1024, 1024, 3);
    } else {
      const int t2 = tt - 2 * T_G;
      conv_tile(smem, p.in[I_MD] + (size_t)le * 512 * 1024, 1024, 1024, (t2 / 16) * 64, (t2 % 16) * 64, (bfr*)(ws + O_WDN) + (size_t)le * 1024 * 512, 512, 0);
    }
  }
}

template <int MODE, bool ROUTER>
DI void norm_phase(const Params& p, char* smem, const float* xin, float* xout, const float* nw, const float* modl,
                   int sh_off, int sc_off, int g_off, int layer) {
  char* ws = p.ws;
  const int tid = threadIdx.x, lane = tid & 63, wid = tid >> 6;
  bfr* HB = (bfr*)(ws + O_HB);
  const bfr* MO0 = (const bfr*)(ws + O_MOEOUT);
  const bfr* MO1 = MO0 + (size_t)NT * 1024;
  int* lcnt = (int*)smem;
  int* lbase = lcnt + 16;
  int* lexp = lbase + 16;
  int* lrank = lexp + 64;
  for (int chunk = blockIdx.x; chunk < NT / 32; chunk += gridDim.x) {
    if (ROUTER) {
      if (tid < 16) lcnt[tid] = 0;
      __syncthreads();
    }
    for (int it = 0; it < 8; ++it) {
      const int row = chunk * 32 + it * 4 + wid;
      const int b = row >> 11;
      float v[16];
      float ss = 0.f;
#pragma unroll
      for (int i = 0; i < 4; ++i) {
        const int c = (i * 64 + lane) * 4;
        float4 x = *(const float4*)(xin + (size_t)row * 1024 + c);
        if (MODE >= 1) {
          const float4 g = *(const float4*)(modl + b * 6144 + g_off + c);
          const uint2 m0 = *(const uint2*)(MO0 + (size_t)row * 1024 + c);
          const uint2 m1 = *(const uint2*)(MO1 + (size_t)row * 1024 + c);
          x.x += g.x * (lo2f(m0.x) + lo2f(m1.x));
          x.y += g.y * (hi2f(m0.x) + hi2f(m1.x));
          x.z += g.z * (lo2f(m0.y) + lo2f(m1.y));
          x.w += g.w * (hi2f(m0.y) + hi2f(m1.y));
          if (MODE == 1) *(float4*)(xout + (size_t)row * 1024 + c) = x;
        }
        v[i * 4 + 0] = x.x; v[i * 4 + 1] = x.y; v[i * 4 + 2] = x.z; v[i * 4 + 3] = x.w;
        ss += x.x * x.x + x.y * x.y + x.z * x.z + x.w * x.w;
      }
      ss = wave_sum(ss);
      const float rstd = rsqrtf(ss * (1.f / 1024.f) + 1e-6f);
#pragma unroll
      for (int i = 0; i < 4; ++i) {
        const int c = (i * 64 + lane) * 4;
        const float4 w = *(const float4*)(nw + c);
        if (MODE == 2) {
          float4 o;
          o.x = v[i * 4 + 0] * rstd * w.x; o.y = v[i * 4 + 1] * rstd * w.y; o.z = v[i * 4 + 2] * rstd * w.z; o.w = v[i * 4 + 3] * rstd * w.w;
          *(float4*)(xout + (size_t)row * 1024 + c) = o;
        } else {
          const float4 sc = *(const float4*)(modl + b * 6144 + sc_off + c);
          const float4 sh = *(const float4*)(modl + b * 6144 + sh_off + c);
          v[i * 4 + 0] = v[i * 4 + 0] * rstd * w.x * (1.f + sc.x) + sh.x;
          v[i * 4 + 1] = v[i * 4 + 1] * rstd * w.y * (1.f + sc.y) + sh.y;
          v[i * 4 + 2] = v[i * 4 + 2] * rstd * w.z * (1.f + sc.z) + sh.z;
          v[i * 4 + 3] = v[i * 4 + 3] * rstd * w.w * (1.f + sc.w) + sh.w;
          uint2 o;
          o.x = pack2(v[i * 4 + 0], v[i * 4 + 1]);
          o.y = pack2(v[i * 4 + 2], v[i * 4 + 3]);
          *(uint2*)(HB + (size_t)row * 1024 + c) = o;
        }
      }
      if (ROUTER) {
        float lg[16];
#pragma unroll
        for (int e = 0; e < 16; ++e) lg[e] = 0.f;
        const float* rw = p.in[I_RTW];
#pragma unroll
        for (int i = 0; i < 16; ++i) {
          const int c = ((i >> 2) * 64 + lane) * 4 + (i & 3);
          const float4 w0 = *(const float4*)(rw + c * 16), w1 = *(const float4*)(rw + c * 16 + 4);
          const float4 w2 = *(const float4*)(rw + c * 16 + 8), w3 = *(const float4*)(rw + c * 16 + 12);
          const float h = v[i];
          lg[0] += h * w0.x; lg[1] += h * w0.y; lg[2] += h * w0.z; lg[3] += h * w0.w;
          lg[4] += h * w1.x; lg[5] += h * w1.y; lg[6] += h * w1.z; lg[7] += h * w1.w;
          lg[8] += h * w2.x; lg[9] += h * w2.y; lg[10] += h * w2.z; lg[11] += h * w2.w;
          lg[12] += h * w3.x; lg[13] += h * w3.y; lg[14] += h * w3.z; lg[15] += h * w3.w;
        }
        float sc[16], bi[16];
#pragma unroll
        for (int e = 0; e < 16; ++e) {
          lg[e] = wave_sum(lg[e]);
          sc[e] = 1.f / (1.f + expf(-lg[e]));
          bi[e] = sc[e] + p.in[I_RTB][e];
        }
        int tg = 0; float best = -3.0e38f;
#pragma unroll
        for (int g = 0; g < 4; ++g) {
          float m1 = -3.0e38f, m2 = -3.0e38f;
#pragma unroll
          for (int j = 0; j < 4; ++j) {
            const float x = bi[g * 4 + j];
            if (x > m1) { m2 = m1; m1 = x; } else if (x > m2) { m2 = x; }
          }
          const float gs = m1 + m2;
          if (gs > best) { best = gs; tg = g; }
        }
        int i0 = -1, i1 = -1; float b0 = -3.0e38f, b1 = -3.0e38f, s0 = 0.f, s1 = 0.f;
#pragma unroll
        for (int e = 0; e < 16; ++e) {
          if ((e >> 2) == tg) {
            const float x = bi[e];
            if (x > b0) { b1 = b0; i1 = i0; s1 = s0; b0 = x; i0 = e; s0 = sc[e]; }
            else if (x > b1) { b1 = x; i1 = e; s1 = sc[e]; }
          }
        }
        if (lane == 0) {
          const float inv = 1.f / (s0 + s1);
          float* topw = (float*)(ws + O_TOPW);
          topw[row * 2 + 0] = s0 * inv;
          topw[row * 2 + 1] = s1 * inv;
          const int a = (it * 4 + wid) * 2;
          lexp[a] = i0; lrank[a] = atomicAdd(&lcnt[i0], 1);
          lexp[a + 1] = i1; lrank[a + 1] = atomicAdd(&lcnt[i1], 1);
        }
      }
    }
    if (ROUTER) {
      __syncthreads();
      int* cnt = (int*)(ws + O_CNT) + layer * 16 * 64;
      if (tid < 16) lbase[tid] = atomicAdd(&cnt[tid * 64], lcnt[tid]);
      __syncthreads();
      if (tid < 64) {
        const int e = lexp[tid];
        const int slot = lbase[e] + lrank[tid];
        ((int*)(ws + O_LIST))[(size_t)e * NT + slot] = (chunk * 32 + (tid >> 1)) * 2 + (tid & 1);
      }
      __syncthreads();
    }
  }
}

DI void gemm_proj_phase(const Params& p, char* smem, const bfr* Wt, int ncols_pad, bfr* out) {
  const bfr* HB = (const bfr*)(p.ws + O_HB);
  const int n_nt = ncols_pad / 128;
  const int ntiles = (NT / 128) * n_nt;
  for (int tile = blockIdx.x; tile < ntiles; tile += gridDim.x) {
    const int mt = tile / n_nt, nt = tile % n_nt;
    RowsContig A{HB + (size_t)mt * 128 * 1024, 1024, 127};
    RowsContig B{Wt + (size_t)nt * 128 * 1024, 1024, 127};
    gemm_tile(smem, 32, A, B, [&](f32x4(&acc)[4][4], int wr, int wc, int fr, int fq) {
#pragma unroll
      for (int m = 0; m < 4; ++m)
#pragma unroll
        for (int n = 0; n < 4; ++n)
#pragma unroll
          for (int j = 0; j < 4; ++j) {
            const int row = mt * 128 + wr * 64 + m * 16 + fq * 4 + j, col = nt * 128 + wc * 64 + n * 16 + fr;
            out[(size_t)row * ncols_pad + col] = f2bf(acc[m][n][j]);
          }
    });
  }
}

DI void gemm_out_phase(const Params& p, char* smem, const bfr* Wt, const float* xin, float* xout, const float* gate  ) {
  const bfr* MIX = (const bfr*)(p.ws + O_MIX);
  const int ntiles = (NT / 128) * 8;
  for (int tile = blockIdx.x; tile < ntiles; tile += gridDim.x) {
    const int mt = tile / 8, nt = tile % 8;
    RowsContig A{MIX + (size_t)mt * 128 * 1024, 1024, 127};
    RowsContig B{Wt + (size_t)nt * 128 * 1024, 1024, 127};
    const int b = (mt * 128) >> 11;
    gemm_tile(smem, 32, A, B, [&](f32x4(&acc)[4][4], int wr, int wc, int fr, int fq) {
#pragma unroll
      for (int m = 0; m < 4; ++m)
#pragma unroll
        for (int n = 0; n < 4; ++n) {
          const int col = nt * 128 + wc * 64 + n * 16 + fr;
          const float g = gate[b * 6144 + col];
#pragma unroll
          for (int j = 0; j < 4; ++j) {
            const int row = mt * 128 + wr * 64 + m * 16 + fq * 4 + j;
            xout[(size_t)row * 1024 + col] = xin[(size_t)row * 1024 + col] + g * acc[m][n][j];
          }
        }
    });
  }
}

struct RowsCmp {
  const bfr* proj; int colbase; int mt;
  DI const bfr* row(int r) const {
    int rr = mt * 128 + r; if (rr > 2031) rr = 2031;
    const int h = rr & 1, bn = rr >> 1, b = bn / 127, nc = bn % 127;
    return proj + (size_t)(b * SEQ + nc * 16) * PW0 + colbase + h * 64;
  }
  DI int koff(int k) const { return (k >> 6) * PW0 + (k & 63); }
};

DI float gelu_tanh(float x) {
  const float u = 0.7978845608028654f * (x + 0.044715f * x * x * x);
  return 0.5f * x * (1.f + tanhf(u));
}

DI void post0_phase(const Params& p, char* smem) {
  char* ws = p.ws;
  const bfr* PROJ = (const bfr*)(ws + O_PROJ);
  const int tid = threadIdx.x;
  for (int tile = blockIdx.x; tile < 64; tile += gridDim.x) {
    const int j = tile >> 5, mt = (tile >> 1) & 15, nt = tile & 1;
    RowsCmp A{PROJ, j ? C_VC : C_KC, mt};
    RowsContig B{(const bfr*)(ws + O_WC1) + ((size_t)j * 256 + nt * 128) * 2048, 2048, 127};
    bfr* CH = (bfr*)(ws + O_CH) + (size_t)j * 2048 * 256;
    const float* bias = (const float*)(ws + O_BIAS1) + j * 256;
    gemm_tile(smem, 64, A, B, [&](f32x4(&acc)[4][4], int wr, int wc, int fr, int fq) {
#pragma unroll
      for (int m = 0; m < 4; ++m)
#pragma unroll
        for (int n = 0; n < 4; ++n) {
          const int col = nt * 128 + wc * 64 + n * 16 + fr;
          const float bb = bias[col];
#pragma unroll
          for (int jj = 0; jj < 4; ++jj) {
            const int row = mt * 128 + wr * 64 + m * 16 + fq * 4 + jj;
            CH[(size_t)row * 256 + col] = f2bf(gelu_tanh(acc[m][n][jj] + bb));
          }
        }
    });
  }
  const float* ropec = (const float*)(ws + O_ROPE);
  const float* ropes = ropec + 65536;
  bfr* QR = (bfr*)(ws + O_QR);
  bfr* KSR = (bfr*)(ws + O_KSR);
  bfr* KWR = (bfr*)(ws + O_KWR);
  bfr* MIX = (bfr*)(ws + O_MIX);
  const float* cw = p.in[I_CONVW];
  for (int item = blockIdx.x; item < NT / 8; item += gridDim.x) {
    for (int tt = 0; tt < 8; ++tt) {
      const int tok = item * 8 + tt, t = tok & (SEQ - 1);
      const bfr* pr = PROJ + (size_t)tok * PW0;
      {
        const int head = tid >> 5, i = tid & 31;
        const float c = ropec[t * 32 + i], s = ropes[t * 32 + i];
        const float t1 = bf2f(pr[C_Q + head * 64 + i]), t2 = bf2f(pr[C_Q + head * 64 + 32 + i]);
        QR[(size_t)tok * 512 + head * 64 + i] = f2bf(t1 * c - t2 * s);
        QR[(size_t)tok * 512 + head * 64 + 32 + i] = f2bf(t2 * c + t1 * s);
        if (tid < 128) {
          const int which = tid >> 6, hh = (tid >> 5) & 1;
          const int cb = (which ? C_KW : C_KS) + hh * 64;
          const float k1 = bf2f(pr[cb + i]), k2 = bf2f(pr[cb + 32 + i]);
          bfr* dst = (which ? KWR : KSR) + (size_t)tok * 128 + hh * 64;
          dst[i] = f2bf(k1 * c - k2 * s);
          dst[32 + i] = f2bf(k2 * c + k1 * s);
        }
      }
#pragma unroll
      for (int h2 = 0; h2 < 2; ++h2) {
        const int ch = tid + h2 * 256;
        const float u0 = bf2f(pr[C_CG + ch]) * bf2f(pr[C_XB + ch]);
        float u1 = 0.f, u2 = 0.f;
        if (t >= 1) u1 = bf2f(pr[C_CG + ch - PW0]) * bf2f(pr[C_XB + ch - PW0]);
        if (t >= 2) u2 = bf2f(pr[C_CG + ch - 2 * PW0]) * bf2f(pr[C_XB + ch - 2 * PW0]);
        const float y = cw[2 * 512 + ch] * u0 + cw[1 * 512 + ch] * u1 + cw[0 * 512 + ch] * u2;
        MIX[(size_t)tok * 1024 + 512 + ch] = f2bf(bf2f(pr[C_BG + ch]) * y);
      }
    }
  }
}

DI void cmp2_phase(const Params& p, char* smem) {
  char* ws = p.ws;
  for (int tile = blockIdx.x; tile < 32; tile += gridDim.x) {
    const int j = tile >> 4, mt = tile & 15;
    RowsContig A{(const bfr*)(ws + O_CH) + ((size_t)j * 2048 + mt * 128) * 256, 256, 127};
    RowsContig B{(const bfr*)(ws + O_WC2) + (size_t)j * 128 * 256, 256, 127};
    bfr* KC = (bfr*)(ws + O_KCVC) + (size_t)j * 2048 * 64;
    gemm_tile(smem, 8, A, B, [&](f32x4(&acc)[4][4], int wr, int wc, int fr, int fq) {
      if (wc == 0) {
#pragma unroll
        for (int m = 0; m < 4; ++m)
#pragma unroll
          for (int n = 0; n < 4; ++n)
#pragma unroll
            for (int jj = 0; jj < 4; ++jj) {
              const int row = mt * 128 + wr * 64 + m * 16 + fq * 4 + jj, col = n * 16 + fr;
              KC[(size_t)row * 64 + col] = f2bf(acc[m][n][jj]);
            }
      }
    });
  }
}

DI void cmp_attn_phase(const Params& p, char* smem) {
  char* ws = p.ws;
  const bfr* PROJ = (const bfr*)(ws + O_PROJ);
  const bfr* KC = (const bfr*)(ws + O_KCVC);
  const bfr* VC = KC + 2048 * 64;
  bfr* OCMP = (bfr*)(ws + O_OCMP);
  unsigned* SEL = (unsigned*)(ws + O_SEL);
  const int tid = threadIdx.x;
  for (int item = blockIdx.x; item < NT / 32; item += gridDim.x) {
    const int tok = item * 32 + (tid >> 3), head = tid & 7, hkv = head >> 2;
    const int b = tok >> 11, t = tok & (SEQ - 1);
    const int nv = t >= 31 ? ((t - 31) >> 4) + 1 : 0;
    unsigned q[32];
    {
      const uint4* qp = (const uint4*)(PROJ + (size_t)tok * PW0 + C_Q + head * 64);
#pragma unroll
      for (int i = 0; i < 8; ++i) { const uint4 u = qp[i]; q[i * 4] = u.x; q[i * 4 + 1] = u.y; q[i * 4 + 2] = u.z; q[i * 4 + 3] = u.w; }
    }
    const bfr* kb = KC + ((size_t)(b * 127) * 2 + hkv) * 64;
    const bfr* vb = VC + ((size_t)(b * 127) * 2 + hkv) * 64;
    auto dotk = [&](int c) {
      const uint4* kp = (const uint4*)(kb + (size_t)c * 128);
      float a = 0.f;
#pragma unroll
      for (int i = 0; i < 8; ++i) {
        const uint4 u = kp[i];
        a = dot2(q[i * 4], u.x, a); a = dot2(q[i * 4 + 1], u.y, a); a = dot2(q[i * 4 + 2], u.z, a); a = dot2(q[i * 4 + 3], u.w, a);
      }
      return a * 0.125f;
    };
    float mx = -1e30f;
    for (int c = 0; c < nv; ++c) mx = fmaxf(mx, dotk(c));
    float o[64];
#pragma unroll
    for (int i = 0; i < 64; ++i) o[i] = 0.f;
    float l = 0.f;
    for (int c = 0; c < nv; ++c) {
      const float pe = __expf(dotk(c) - mx);
      l += pe;
      const uint4* vp = (const uint4*)(vb + (size_t)c * 128);
#pragma unroll
      for (int i = 0; i < 8; ++i) {
        const uint4 u = vp[i];
        o[i * 8 + 0] += pe * lo2f(u.x); o[i * 8 + 1] += pe * hi2f(u.x);
        o[i * 8 + 2] += pe * lo2f(u.y); o[i * 8 + 3] += pe * hi2f(u.y);
        o[i * 8 + 4] += pe * lo2f(u.z); o[i * 8 + 5] += pe * hi2f(u.z);
        o[i * 8 + 6] += pe * lo2f(u.w); o[i * 8 + 7] += pe * hi2f(u.w);
      }
    }
    const float invl = nv > 0 ? 1.f / l : 0.f;
    {
      const float gl = bf2f(PROJ[(size_t)tok * PW0 + C_GL + head * 3 + 0]);
      const float g0 = sigmoidf_(gl) * invl;
      uint4* op = (uint4*)(OCMP + (size_t)tok * 512 + head * 64);
#pragma unroll
      for (int i = 0; i < 8; ++i) {
        uint4 u;
        u.x = pack2(o[i * 8 + 0] * g0, o[i * 8 + 1] * g0); u.y = pack2(o[i * 8 + 2] * g0, o[i * 8 + 3] * g0);
        u.z = pack2(o[i * 8 + 4] * g0, o[i * 8 + 5] * g0); u.w = pack2(o[i * 8 + 6] * g0, o[i * 8 + 7] * g0);
        op[i] = u;
      }
    }
    const int cur = t >> 6;
    float tv0 = -1.f, tv1 = -1.f, tv2 = -1.f, tv3 = -1.f, tv4 = -1.f;
    int ti0 = -1, ti1 = -1, ti2 = -1, ti3 = -1, ti4 = -1;
    float part = 0.f;
    int curmax = cur;
#pragma unroll
    for (int o2 = 32; o2 > 0; o2 >>= 1) curmax = max(curmax, __shfl_xor(curmax, o2));
#pragma unroll 1
    for (int j = 0; j <= curmax + 1 && j <= 32; ++j) {
      float e[4];
#pragma unroll
      for (int oo = 0; oo < 4; ++oo) {
        const int c = j * 4 + oo;
        float pe = 0.f;
        if (c < nv) pe = __expf(dotk(c) - mx) * invl;
        pe += __shfl_xor(pe, 1);
        pe += __shfl_xor(pe, 2);
        e[oo] = pe;
      }
      if (j >= 1) {
        const float val = part + e[0];
        const int jb = j - 1;
        if (jb >= 1 && jb <= cur - 2) {
          if (val > tv4) {
            tv4 = val; ti4 = jb;
            if (tv4 > tv3) { float tf = tv3; tv3 = tv4; tv4 = tf; int tii = ti3; ti3 = ti4; ti4 = tii; }
            if (tv3 > tv2) { float tf = tv2; tv2 = tv3; tv3 = tf; int tii = ti2; ti2 = ti3; ti3 = tii; }
            if (tv2 > tv1) { float tf = tv1; tv1 = tv2; tv2 = tf; int tii = ti1; ti1 = ti2; ti2 = tii; }
            if (tv1 > tv0) { float tf = tv0; tv0 = tv1; tv1 = tf; int tii = ti0; ti0 = ti1; ti1 = tii; }
          }
        }
      }
      part = e[0] + 2.f * (e[1] + e[2] + e[3]);
    }
    unsigned mask = 1u | (1u << cur);
    if (cur >= 1) mask |= 1u << (cur - 1);
    if (ti0 >= 0) mask |= 1u << ti0;
    if (ti1 >= 0) mask |= 1u << ti1;
    if (ti2 >= 0) mask |= 1u << ti2;
    if (ti3 >= 0) mask |= 1u << ti3;
    if (ti4 >= 0) mask |= 1u << ti4;
    if ((head & 3) == 0) SEL[tok * 2 + hkv] = mask;
  }
}

DI void slcwin_phase(const Params& p, char* smem) {
  char* ws = p.ws;
  const bfr* PROJ = (const bfr*)(ws + O_PROJ);
  const bfr* QR = (const bfr*)(ws + O_QR);
  const bfr* KSR = (const bfr*)(ws + O_KSR);
  const bfr* KWR = (const bfr*)(ws + O_KWR);
  const bfr* OCMP = (const bfr*)(ws + O_OCMP);
  const unsigned* SEL = (const unsigned*)(ws + O_SEL);
  bfr* MIX = (bfr*)(ws + O_MIX);
  const int tid = threadIdx.x, lane = tid & 63, wid = tid >> 6;
  for (int item = blockIdx.x; item < 512; item += gridDim.x) {
    const int tile = 31 - (item >> 4), bh = item & 15, b = bh >> 1, hkv = bh & 1;
    const int t = tile * 64 + lane, tok = b * SEQ + t, head = hkv * 4 + wid;
    unsigned q[32];
    {
      const uint4* qp = (const uint4*)(QR + (size_t)tok * 512 + head * 64);
#pragma unroll
      for (int i = 0; i < 8; ++i) { const uint4 u = qp[i]; q[i * 4] = u.x; q[i * 4 + 1] = u.y; q[i * 4 + 2] = u.z; q[i * 4 + 3] = u.w; }
    }
    const unsigned sel = SEL[tok * 2 + hkv];
#pragma unroll 1
    for (int pass = 0; pass < 2; ++pass) {
      const bfr* Kb = (pass == 0 ? KSR : KWR) + (size_t)b * SEQ * 128 + hkv * 64;
      const bfr* Vb = PROJ + (size_t)b * SEQ * PW0 + (pass == 0 ? C_VS : C_VW) + hkv * 64;
      float o[64];
#pragma unroll
      for (int i = 0; i < 64; ++i) o[i] = 0.f;
      float m = -1e30f, l = 0.f;
      const int jlo = pass == 0 ? 0 : (tile >= 8 ? tile - 8 : 0);
#pragma unroll 1
      for (int j = jlo; j <= tile; ++j) {
        const bool lane_ok = pass == 0 ? ((sel >> j) & 1u) != 0 : true;
        if (pass == 0 && !__any(lane_ok)) continue;
#pragma unroll 1
        for (int kb = 0; kb < 64; kb += 4) {
          float s[4];
#pragma unroll
          for (int kk = 0; kk < 4; ++kk) {
            const int key = j * 64 + kb + kk;
            const uint4* kp = (const uint4*)(Kb + (size_t)key * 128);
            float a = 0.f;
#pragma unroll
            for (int i = 0; i < 8; ++i) {
              const uint4 u = kp[i];
              a = dot2(q[i * 4], u.x, a); a = dot2(q[i * 4 + 1], u.y, a); a = dot2(q[i * 4 + 2], u.z, a); a = dot2(q[i * 4 + 3], u.w, a);
            }
            bool ok = lane_ok && key <= t;
            if (pass == 1) ok = ok && (t - key < 512);
            s[kk] = ok ? a * 0.125f : -1e30f;
          }
          const float cm = fmaxf(fmaxf(s[0], s[1]), fmaxf(s[2], s[3]));
          const float mn = fmaxf(m, cm);
          const float corr = __expf(m - mn);
          m = mn;
          float pe[4];
#pragma unroll
          for (int kk = 0; kk < 4; ++kk) pe[kk] = s[kk] > -1e29f ? __expf(s[kk] - mn) : 0.f;
          l = l * corr + (pe[0] + pe[1] + pe[2] + pe[3]);
#pragma unroll
          for (int i = 0; i < 64; ++i) o[i] *= corr;
#pragma unroll
          for (int kk = 0; kk < 4; ++kk) {
            const int key = j * 64 + kb + kk;
            const uint4* vp = (const uint4*)(Vb + (size_t)key * PW0);
#pragma unroll
            for (int i = 0; i < 8; ++i) {
              const uint4 u = vp[i];
              o[i * 8 + 0] += pe[kk] * lo2f(u.x); o[i * 8 + 1] += pe[kk] * hi2f(u.x);
              o[i * 8 + 2] += pe[kk] * lo2f(u.y); o[i * 8 + 3] += pe[kk] * hi2f(u.y);
              o[i * 8 + 4] += pe[kk] * lo2f(u.z); o[i * 8 + 5] += pe[kk] * hi2f(u.z);
              o[i * 8 + 6] += pe[kk] * lo2f(u.w); o[i * 8 + 7] += pe[kk] * hi2f(u.w);
            }
          }
        }
      }
      const float gate = sigmoidf_(bf2f(PROJ[(size_t)tok * PW0 + C_GL + head * 3 + 1 + pass]));
      const float gsc = gate * (l > 0.f ? 1.f / l : 0.f);
      uint4* op = (uint4*)(MIX + (size_t)tok * 1024 + head * 64);
      const uint4* cp = pass == 0 ? (const uint4*)(OCMP + (size_t)tok * 512 + head * 64) : (const uint4*)op;
#pragma unroll
      for (int i = 0; i < 8; ++i) {
        const uint4 c = cp[i];
        uint4 u;
        u.x = pack2(o[i * 8 + 0] * gsc + lo2f(c.x), o[i * 8 + 1] * gsc + hi2f(c.x));
        u.y = pack2(o[i * 8 + 2] * gsc + lo2f(c.y), o[i * 8 + 3] * gsc + hi2f(c.y));
        u.z = pack2(o[i * 8 + 4] * gsc + lo2f(c.z), o[i * 8 + 5] * gsc + hi2f(c.z));
        u.w = pack2(o[i * 8 + 6] * gsc + lo2f(c.w), o[i * 8 + 7] * gsc + hi2f(c.w));
        op[i] = u;
      }
    }
  }
}

struct RowsGather {
  const bfr* base; const int* list; int i0; int cnt; int ld; bool viaTok;
  DI const bfr* row(int r) const {
    int i = i0 + r; if (i > cnt - 1) i = cnt - 1;
    const int e = list[i];
    return base + (size_t)(viaTok ? (e >> 1) : 0) * ld;
  }
  DI int koff(int k) const { return k; }
};

DI void moe1_phase(const Params& p, char* smem, int layer) {
  char* ws = p.ws;
  const int* cnt = (const int*)(ws + O_CNT) + layer * 16 * 64;
  const int* LIST = (const int*)(ws + O_LIST);
  const bfr* HB = (const bfr*)(ws + O_HB);
  bfr* HMID = (bfr*)(ws + O_HMID);
  int c[16], mtiles = 0;
#pragma unroll
  for (int e = 0; e < 16; ++e) { c[e] = cnt[e * 64]; mtiles += (c[e] + 127) >> 7; }
  const int ntiles = mtiles * 8;
  for (int tile = blockIdx.x; tile < ntiles; tile += gridDim.x) {
    int mg = tile >> 3; const int nt = tile & 7;
    int e = 0, off = 0, ce = 0;
#pragma unroll
    for (int k = 0; k < 16; ++k) {
      const int mk = (c[k] + 127) >> 7;
      if (k == e && mg >= mk) { mg -= mk; off += c[k]; e = k + 1; }
    }
#pragma unroll
    for (int k = 0; k < 16; ++k) if (k == e) ce = c[k];
    const int mt = mg;
    RowsGather A{HB, LIST + (size_t)e * NT, mt * 128, ce, 1024, true};
    RowsContig B{(const bfr*)(ws + O_WGU) + ((size_t)(layer * 16 + e) * 1024 + nt * 128) * 1024, 1024, 127};
    gemm_tile(smem, 32, A, B, [&](f32x4(&acc)[4][4], int wr, int wc, int fr, int fq) {
#pragma unroll
      for (int m = 0; m < 4; ++m)
#pragma unroll
        for (int n2 = 0; n2 < 2; ++n2) {
          const int col = nt * 64 + wc * 32 + n2 * 16 + fr;
#pragma unroll
          for (int j = 0; j < 4; ++j) {
            const int i = mt * 128 + wr * 64 + m * 16 + fq * 4 + j;
            if (i < ce) {
              const float g = acc[m][n2 * 2][j], u = acc[m][n2 * 2 + 1][j];
              HMID[(size_t)(off + i) * 512 + col] = f2bf(g / (1.f + __expf(-g)) * u);
            }
          }
        }
    });
  }
}

DI void moe2_phase(const Params& p, char* smem, int layer) {
  char* ws = p.ws;
  const int* cnt = (const int*)(ws + O_CNT) + layer * 16 * 64;
  const int* LIST = (const int*)(ws + O_LIST);
  const float* TOPW = (const float*)(ws + O_TOPW);
  const bfr* HMID = (const bfr*)(ws + O_HMID);
  bfr* MO = (bfr*)(ws + O_MOEOUT);
  int c[16], mtiles = 0;
#pragma unroll
  for (int e = 0; e < 16; ++e) { c[e] = cnt[e * 64]; mtiles += (c[e] + 127) >> 7; }
  const int ntiles = mtiles * 8;
  for (int tile = blockIdx.x; tile < ntiles; tile += gridDim.x) {
    int mg = tile >> 3; const int nt = tile & 7;
    int e = 0, off = 0, ce = 0;
#pragma unroll
    for (int k = 0; k < 16; ++k) {
      const int mk = (c[k] + 127) >> 7;
      if (k == e && mg >= mk) { mg -= mk; off += c[k]; e = k + 1; }
    }
#pragma unroll
    for (int k = 0; k < 16; ++k) if (k == e) ce = c[k];
    const int mt = mg;
    const int rows_here = ce - mt * 128;
    RowsContig A{HMID + (size_t)(off + mt * 128) * 512, 512, (rows_here < 128 ? rows_here : 128) - 1};
    RowsContig B{(const bfr*)(ws + O_WDN) + ((size_t)(layer * 16 + e) * 1024 + nt * 128) * 512, 512, 127};
    const int* lst = LIST + (size_t)e * NT;
    gemm_tile(smem, 16, A, B, [&](f32x4(&acc)[4][4], int wr, int wc, int fr, int fq) {
#pragma unroll
      for (int m = 0; m < 4; ++m)
#pragma unroll
        for (int j = 0; j < 4; ++j) {
          const int i = mt * 128 + wr * 64 + m * 16 + fq * 4 + j;
          if (i < ce) {
            const int en = lst[i];
            const float w = TOPW[en];
            bfr* dst = MO + ((size_t)(en & 1) * NT + (en >> 1)) * 1024 + nt * 128 + wc * 64 + fr;
#pragma unroll
            for (int n = 0; n < 4; ++n) dst[n * 16] = f2bf(acc[m][n][j] * w);
          }
        }
    });
  }
}

DI void rwkv_prep_phase(const Params& p, char* smem) {
  char* ws = p.ws;
  const bfr* PROJ = (const bfr*)(ws + O_PROJ);
  const int tid = threadIdx.x;
  float* lw = (float*)smem;
  float* la = lw + 16 * 64;
  float* lg = la + 16 * 64;
  float* pl = (float*)smem;
  const float* mu = p.in[I_MU];
  float* W = (float*)(ws + O_RW_W);
  bfr* R = (bfr*)(ws + O_RW_R); bfr* K = (bfr*)(ws + O_RW_K); bfr* V = (bfr*)(ws + O_RW_V);
  bfr* A = (bfr*)(ws + O_RW_A); bfr* Bb = (bfr*)(ws + O_RW_B); bfr* G = (bfr*)(ws + O_RW_G);
  float* RK = (float*)(ws + O_RK);
  bfr* MIX = (bfr*)(ws + O_MIX);
  for (int item = blockIdx.x; item < 2 * (NT / 16); item += gridDim.x) {
    const int tok0 = (item >> 1) * 16;
    if ((item & 1) == 0) {
      for (int i = tid; i < 16 * 256; i += 256) {
        const int tt = i >> 8, cc = i & 255;
        const int tok = tok0 + tt, t = tok & (SEQ - 1);
        const int col = 1536 + cc;
        const float cur = bf2f(PROJ[(size_t)tok * PW1 + col]);
        const float prev = t > 0 ? bf2f(PROJ[(size_t)(tok - 1) * PW1 + col]) : 0.f;
        const float v = cur + (prev - cur) * mu[col];
        if (cc < 64) lw[tt * 64 + cc] = tanhf(v);
        else if (cc < 128) la[tt * 64 + cc - 64] = v;
        else lg[tt * 128 + cc - 128] = sigmoidf_(v);
      }
      __syncthreads();
      const int c0 = tid * 2;
      float ad[16][2], aa[16][2], ag[16][2];
#pragma unroll
      for (int tt = 0; tt < 16; ++tt) { ad[tt][0] = ad[tt][1] = aa[tt][0] = aa[tt][1] = ag[tt][0] = ag[tt][1] = 0.f; }
      const float* w2 = p.in[I_W2] + c0;
      const float* a2 = p.in[I_A2] + c0;
      const float* g2 = p.in[I_G2] + c0;
      for (int k = 0; k < 64; ++k) {
        const float2 ww = *(const float2*)(w2 + k * 512);
        const float2 wa = *(const float2*)(a2 + k * 512);
#pragma unroll
        for (int tt = 0; tt < 16; ++tt) {
          const float x = lw[tt * 64 + k], y = la[tt * 64 + k];
          ad[tt][0] += x * ww.x; ad[tt][1] += x * ww.y;
          aa[tt][0] += y * wa.x; aa[tt][1] += y * wa.y;
        }
      }
      for (int k = 0; k < 128; ++k) {
        const float2 wg = *(const float2*)(g2 + k * 512);
#pragma unroll
        for (int tt = 0; tt < 16; ++tt) {
          const float x = lg[tt * 128 + k];
          ag[tt][0] += x * wg.x; ag[tt][1] += x * wg.y;
        }
      }
      const float2 w0 = *(const float2*)(p.in[I_W0] + c0), a0 = *(const float2*)(p.in[I_A0] + c0);
      const float2 kkp = *(const float2*)(p.in[I_KK] + c0), kap = *(const float2*)(p.in[I_KA] + c0);
      const float2 rkp = *(const float2*)(p.in[I_RKP] + c0);
      const float2 mur = *(const float2*)(mu + c0), muk = *(const float2*)(mu + 512 + c0), muv = *(const float2*)(mu + 1024 + c0);
#pragma unroll
      for (int tt = 0; tt < 16; ++tt) {
        const int tok = tok0 + tt, t = tok & (SEQ - 1);
        const bfr* pr = PROJ + (size_t)tok * PW1;
        const unsigned ur = *(const unsigned*)(pr + c0), uk = *(const unsigned*)(pr + 512 + c0), uv = *(const unsigned*)(pr + 1024 + c0);
        unsigned pr_ = 0, pk_ = 0, pv_ = 0;
        if (t > 0) { pr_ = *(const unsigned*)(pr - PW1 + c0); pk_ = *(const unsigned*)(pr - PW1 + 512 + c0); pv_ = *(const unsigned*)(pr - PW1 + 1024 + c0); }
        float r[2], k[2], v[2];
        r[0] = lo2f(ur) + (lo2f(pr_) - lo2f(ur)) * mur.x; r[1] = hi2f(ur) + (hi2f(pr_) - hi2f(ur)) * mur.y;
        k[0] = lo2f(uk) + (lo2f(pk_) - lo2f(uk)) * muk.x; k[1] = hi2f(uk) + (hi2f(pk_) - hi2f(uk)) * muk.y;
        v[0] = lo2f(uv) + (lo2f(pv_) - lo2f(uv)) * muv.x; v[1] = hi2f(uv) + (hi2f(pv_) - hi2f(uv)) * muv.y;
        float dec[2], av[2], km[2], kk[2];
        const float w0v[2] = {w0.x, w0.y}, a0v[2] = {a0.x, a0.y}, kkv[2] = {kkp.x, kkp.y}, kav[2] = {kap.x, kap.y}, rkv[2] = {rkp.x, rkp.y};
        float nrm = 0.f, rk = 0.f;
#pragma unroll
        for (int u = 0; u < 2; ++u) {
          const float z = -(w0v[u] + ad[tt][u]);
          const float sp = fmaxf(z, 0.f) + log1pf(__expf(-fabsf(z)));
          const float wlog = -sp - 0.5f;
          dec[u] = __expf(-__expf(wlog));
          av[u] = sigmoidf_(a0v[u] + aa[tt][u]);
          km[u] = k[u] * (1.f + (av[u] - 1.f) * kav[u]);
          kk[u] = k[u] * kkv[u];
          nrm += kk[u] * kk[u];
          rk += r[u] * km[u] * rkv[u];
        }
#pragma unroll
        for (int o2 = 16; o2 > 0; o2 >>= 1) { nrm += __shfl_xor(nrm, o2); rk += __shfl_xor(rk, o2); }
        const float inv = 1.f / fmaxf(sqrtf(nrm), 1e-12f);
        kk[0] *= inv; kk[1] *= inv;
        const size_t o = (size_t)tok * 512 + c0;
        *(float2*)(W + o) = make_float2(dec[0], dec[1]);
        *(unsigned*)(R + o) = pack2(r[0], r[1]);
        *(unsigned*)(K + o) = pack2(km[0], km[1]);
        *(unsigned*)(V + o) = pack2(v[0], v[1]);
        *(unsigned*)(A + o) = pack2(-kk[0], -kk[1]);
        *(unsigned*)(Bb + o) = pack2(kk[0] * av[0], kk[1] * av[1]);
        *(unsigned*)(G + o) = pack2(ag[tt][0], ag[tt][1]);
        if ((tid & 31) == 0) RK[tok * 8 + (tid >> 5)] = rk;
      }
      __syncthreads();
    } else {
      {
        const int c0 = tid * 2, gi = c0 >> 7, win = 2 << gi;
        for (int tt = 0; tt < 16; ++tt) {
          const int tok = tok0 + tt, t = tok & (SEQ - 1);
          const int n = (t + 1 < win) ? t + 1 : win;
          float s0 = 0.f, s1 = 0.f;
          for (int d = 0; d < n; ++d) {
            const unsigned u = *(const unsigned*)(PROJ + (size_t)(tok - d) * PW1 + 1792 + c0);
            s0 += lo2f(u); s1 += hi2f(u);
          }
          const unsigned u = *(const unsigned*)(PROJ + (size_t)tok * PW1 + 1792 + c0);
          const float invn = 1.f / (float)n;
          pl[tt * 512 + c0] = s0 * invn - lo2f(u);
          pl[tt * 512 + c0 + 1] = s1 * invn - hi2f(u);
        }
      }
      __syncthreads();
      {
        const int d0 = tid * 2, gi = d0 >> 7, dl = d0 & 127;
        const float* pw = p.in[I_POOLW] + (size_t)gi * 128 * 128 + dl;
        float acc[16][2];
#pragma unroll
        for (int tt = 0; tt < 16; ++tt) acc[tt][0] = acc[tt][1] = 0.f;
        for (int c = 0; c < 128; ++c) {
          const float2 w = *(const float2*)(pw + c * 128);
#pragma unroll
          for (int tt = 0; tt < 16; ++tt) {
            const float x = pl[tt * 512 + gi * 128 + c];
            acc[tt][0] += x * w.x; acc[tt][1] += x * w.y;
          }
        }
        const float2 ps = *(const float2*)(p.in[I_POOLS] + d0);
#pragma unroll
        for (int tt = 0; tt < 16; ++tt)
          *(unsigned*)(MIX + (size_t)(tok0 + tt) * 1024 + 512 + d0) = pack2(acc[tt][0] * ps.x, acc[tt][1] * ps.y);
      }
      __syncthreads();
    }
  }
}

DI void scanA_phase(const Params& p, char* smem) {
  char* ws = p.ws;
  const int tid = threadIdx.x, lane = tid & 63, wid = tid >> 6;
  const int ul = wid >> 1, isP = wid & 1;
  float* stb = (float*)smem;
  const float* W = (const float*)(ws + O_RW_W);
  bfr* R = (bfr*)(ws + O_RW_R); bfr* K = (bfr*)(ws + O_RW_K); const bfr* V = (const bfr*)(ws + O_RW_V);
  const bfr* A = (const bfr*)(ws + O_RW_A); const bfr* Bb = (const bfr*)(ws + O_RW_B);
  float* CHP = (float*)(ws + O_CHP); float* CHL = (float*)(ws + O_CHL);
  for (int item = blockIdx.x; item < 1024; item += gridDim.x) {
    const int unit = item * 2 + ul;
    const int chain = unit >> 5, chunk = unit & 31, b = chain >> 3, h = chain & 7;
    const size_t base = ((size_t)b * SEQ + chunk * 64) * 512 + h * 64;
    float S[64];
#pragma unroll
    for (int j = 0; j < 64; ++j) S[j] = (isP && j == lane) ? 1.f : 0.f;
#pragma unroll 1
    for (int sub = 0; sub < 4; ++sub) {
      __syncthreads();
      {
        float* d0 = stb + ul * (16 * 384);
#pragma unroll 4
        for (int s = 0; s < 16; ++s) {
          const size_t o = base + (size_t)(sub * 16 + s) * 512 + lane;
          float* d = d0 + s * 384;
          if (isP == 0) {
            d[lane] = bf2f(R[o]);
            d[64 + lane] = W[o];
            d[128 + lane] = bf2f(K[o]);
          } else {
            d[192 + lane] = bf2f(V[o]);
            d[256 + lane] = bf2f(A[o]);
            d[320 + lane] = bf2f(Bb[o]);
          }
        }
      }
      __syncthreads();
#pragma unroll 1
      for (int s = 0; s < 16; ++s) {
        const float* d = stb + ul * (16 * 384) + s * 384;
        float sa = 0.f;
#pragma unroll
        for (int j4 = 0; j4 < 16; ++j4) {
          const float4 a4 = *(const float4*)(d + 256 + j4 * 4);
          sa += S[j4 * 4] * a4.x + S[j4 * 4 + 1] * a4.y + S[j4 * 4 + 2] * a4.z + S[j4 * 4 + 3] * a4.w;
        }
        const float vi = isP ? 0.f : d[192 + lane];
        float y = 0.f;
#pragma unroll
        for (int j4 = 0; j4 < 16; ++j4) {
          const float4 w4 = *(const float4*)(d + 64 + j4 * 4);
          const float4 b4 = *(const float4*)(d + 320 + j4 * 4);
          const float4 k4 = *(const float4*)(d + 128 + j4 * 4);
          const float4 r4 = *(const float4*)(d + j4 * 4);
          S[j4 * 4 + 0] = S[j4 * 4 + 0] * w4.x + (sa * b4.x + vi * k4.x);
          S[j4 * 4 + 1] = S[j4 * 4 + 1] * w4.y + (sa * b4.y + vi * k4.y);
          S[j4 * 4 + 2] = S[j4 * 4 + 2] * w4.z + (sa * b4.z + vi * k4.z);
          S[j4 * 4 + 3] = S[j4 * 4 + 3] * w4.w + (sa * b4.w + vi * k4.w);
          y += S[j4 * 4] * r4.x + S[j4 * 4 + 1] * r4.y + S[j4 * 4 + 2] * r4.z + S[j4 * 4 + 3] * r4.w;
        }
        const size_t o = base + (size_t)(sub * 16 + s) * 512 + lane;
        if (isP) R[o] = f2bf(y);
        else K[o] = f2bf(y);
      }
    }
    float4* dp = (float4*)((isP ? CHP : CHL) + ((size_t)unit * 64 + lane) * 64);
#pragma unroll
    for (int j4 = 0; j4 < 16; ++j4) dp[j4] = make_float4(S[j4 * 4], S[j4 * 4 + 1], S[j4 * 4 + 2], S[j4 * 4 + 3]);
  }
}

DI void scanB_phase(const Params& p, char* smem) {
  char* ws = p.ws;
  const int tid = threadIdx.x;
  float* Ss = (float*)smem;
  float* Ps = Ss + 64 * 65;
  const float* CHP = (const float*)(ws + O_CHP);
  float* CHL = (float*)(ws + O_CHL);
  const int i = tid >> 2, qd = tid & 3;
  for (int chain = blockIdx.x; chain < 64; chain += gridDim.x) {
    for (int e = tid; e < 64 * 65; e += 256) Ss[e] = 0.f;
    __syncthreads();
    for (int c = 0; c < 31; ++c) {
      const size_t ub = ((size_t)(chain * 32 + c)) * 4096;
      for (int e = tid; e < 1024; e += 256) ((float4*)Ps)[e] = ((const float4*)(CHP + ub))[e];
      float acc[16];
      {
        const float4* lp = (const float4*)(CHL + ub + i * 64 + qd * 16);
#pragma unroll
        for (int u = 0; u < 4; ++u) { const float4 v = lp[u]; acc[u * 4] = v.x; acc[u * 4 + 1] = v.y; acc[u * 4 + 2] = v.z; acc[u * 4 + 3] = v.w; }
      }
      __syncthreads();
      if (c > 0) {
        for (int k = 0; k < 64; ++k) {
          const float s = Ss[i * 65 + k];
          const float4* pr = (const float4*)(Ps + k * 64 + qd * 16);
#pragma unroll
          for (int u = 0; u < 4; ++u) {
            const float4 v = pr[u];
            acc[u * 4] += s * v.x; acc[u * 4 + 1] += s * v.y; acc[u * 4 + 2] += s * v.z; acc[u * 4 + 3] += s * v.w;
          }
        }
      }
      __syncthreads();
#pragma unroll
      for (int u = 0; u < 16; ++u) Ss[i * 65 + qd * 16 + u] = acc[u];
      {
        float4* lp = (float4*)(CHL + ub + i * 64 + qd * 16);
#pragma unroll
        for (int u = 0; u < 4; ++u) lp[u] = make_float4(acc[u * 4], acc[u * 4 + 1], acc[u * 4 + 2], acc[u * 4 + 3]);
      }
      __syncthreads();
    }
  }
}

DI void scanC_phase(const Params& p, char* smem) {
  char* ws = p.ws;
  const int tid = threadIdx.x, lane = tid & 63, wid = tid >> 6;
  float* st = (float*)smem + wid * (8 * 64);
  const bfr* Q = (const bfr*)(ws + O_RW_R); const bfr* YL = (const bfr*)(ws + O_RW_K); const bfr* V = (const bfr*)(ws + O_RW_V);
  const bfr* G = (const bfr*)(ws + O_RW_G);
  const float* RK = (const float*)(ws + O_RK);
  const float* CHL = (const float*)(ws + O_CHL);
  bfr* MIX = (bfr*)(ws + O_MIX);
  for (int item = blockIdx.x; item < 512; item += gridDim.x) {
    const int unit = item * 4 + wid;
    const int chain = unit >> 5, chunk = unit & 31, b = chain >> 3, h = chain & 7;
    const size_t base = ((size_t)b * SEQ + chunk * 64) * 512 + h * 64;
    float S[64];
    if (chunk > 0) {
      const float4* sp = (const float4*)(CHL + ((size_t)(unit - 1) * 64 + lane) * 64);
#pragma unroll
      for (int j4 = 0; j4 < 16; ++j4) { const float4 v = sp[j4]; S[j4 * 4] = v.x; S[j4 * 4 + 1] = v.y; S[j4 * 4 + 2] = v.z; S[j4 * 4 + 3] = v.w; }
    } else {
#pragma unroll
      for (int j = 0; j < 64; ++j) S[j] = 0.f;
    }
    const float lnw = p.in[I_LNW][h * 64 + lane], lnb = p.in[I_LNB][h * 64 + lane];
#pragma unroll 1
    for (int sub = 0; sub < 8; ++sub) {
#pragma unroll
      for (int s = 0; s < 8; ++s) st[s * 64 + lane] = bf2f(Q[base + (size_t)(sub * 8 + s) * 512 + lane]);
      __builtin_amdgcn_fence(__ATOMIC_RELEASE, "wavefront");
      __builtin_amdgcn_wave_barrier();
#pragma unroll 1
      for (int s = 0; s < 8; ++s) {
        const size_t o = base + (size_t)(sub * 8 + s) * 512 + lane;
        float y = bf2f(YL[o]);
        const float* d = st + s * 64;
#pragma unroll
        for (int j4 = 0; j4 < 16; ++j4) {
          const float4 q4 = *(const float4*)(d + j4 * 4);
          y += S[j4 * 4] * q4.x + S[j4 * 4 + 1] * q4.y + S[j4 * 4 + 2] * q4.z + S[j4 * 4 + 3] * q4.w;
        }
        const float mean = wave_sum(y) * (1.f / 64.f);
        const float dlt = y - mean;
        const float var = wave_sum(dlt * dlt) * (1.f / 64.f);
        const float yn = dlt * rsqrtf(var + 64e-5f) * lnw + lnb;
        const int tok = b * SEQ + chunk * 64 + sub * 8 + s;
        const float outv = (yn + RK[tok * 8 + h] * bf2f(V[o])) * bf2f(G[o]);
        MIX[(size_t)tok * 1024 + h * 64 + lane] = f2bf(outv);
      }
      __builtin_amdgcn_fence(__ATOMIC_RELEASE, "wavefront");
      __builtin_amdgcn_wave_barrier();
    }
  }
}

__global__ void __launch_bounds__(256, 2) fwd_megakernel(Params p) {
  cg::grid_group grid = cg::this_grid();
  __shared__ __attribute__((aligned(16))) char smem[49152];
  char* ws = p.ws;
  const float* MOD = (const float*)(ws + O_MOD);
  const float* MOD1 = MOD + 8 * 6144;
  float* X = p.out;

  for (int item = blockIdx.x; item < PREP_TOTAL; item += gridDim.x) prep_item(p, smem, item);
  grid.sync();
  norm_phase<0, false>(p, smem, p.in[I_X], nullptr, p.in[I_NMIX], MOD, 0, 1024, 0, 0);
  grid.sync();
  gemm_proj_phase(p, smem, (const bfr*)(ws + O_WEIN), PW0, (bfr*)(ws + O_PROJ));
  grid.sync();
  post0_phase(p, smem);
  grid.sync();
  cmp2_phase(p, smem);
  grid.sync();
  cmp_attn_phase(p, smem);
  grid.sync();
  slcwin_phase(p, smem);
  grid.sync();
  gemm_out_phase(p, smem, (const bfr*)(ws + O_WEOUT), p.in[I_X], X, MOD + 2048);
  grid.sync();
  norm_phase<0, true>(p, smem, X, nullptr, p.in[I_NFFN], MOD, 3072, 4096, 0, 0);
  grid.sync();
  moe1_phase(p, smem, 0);
  grid.sync();
  moe2_phase(p, smem, 0);
  grid.sync();
  norm_phase<1, false>(p, smem, X, X, p.in[I_NMIX] + 1024, MOD1, 0, 1024, 5120 - 6144 * 8, 1);
  grid.sync();
  gemm_proj_phase(p, smem, (const bfr*)(ws + O_WOIN), PW1, (bfr*)(ws + O_PROJ));
  grid.sync();
  rwkv_prep_phase(p, smem);
  grid.sync();
  scanA_phase(p, smem);
  grid.sync();
  scanB_phase(p, smem);
  grid.sync();
  scanC_phase(p, smem);
  grid.sync();
  gemm_out_phase(p, smem, (const bfr*)(ws + O_WOOUT), X, X, MOD1 + 2048);
  grid.sync();
  norm_phase<0, true>(p, smem, X, nullptr, p.in[I_NFFN] + 1024, MOD1, 3072, 4096, 0, 1);
  grid.sync();
  moe1_phase(p, smem, 1);
  grid.sync();
  moe2_phase(p, smem, 1);
  grid.sync();
  norm_phase<2, false>(p, smem, X, X, p.in[I_FN], MOD1, 0, 0, 5120, 1);
}

extern "C" void kernel_launch(void* const* d_in, const int* in_sizes, int n_in,
                              void* d_out, int out_size, void* d_ws, size_t ws_size,
                              hipStream_t stream) {
  static int grid_blocks = 0;
  if (!grid_blocks) {
    int dev = 0, cus = 0, per_cu = 0;
    (void)hipGetDevice(&dev);
    (void)hipDeviceGetAttribute(&cus, hipDeviceAttributeMultiprocessorCount, dev);
    (void)hipOccupancyMaxActiveBlocksPerMultiprocessor(&per_cu, fwd_megakernel, 256, 0);
    if (per_cu > 2) per_cu = 2;
    if (per_cu < 1) per_cu = 1;
    grid_blocks = cus * per_cu;
    fprintf(stderr, "cus=%d per_cu=%d grid=%d ws=%zu need=%zu\n", cus, per_cu, grid_blocks, ws_size, (size_t)WS_NEED);
  }
  if (ws_size < WS_NEED || n_in < 33) { fprintf(stderr, "workspace too small\n"); return; }
  Params p{};
  for (int i = 0; i < 33; ++i) p.in[i] = (const float*)d_in[i];
  p.out = (float*)d_out;
  p.ws = (char*)d_ws;
  p.ws_size = (unsigned long long)ws_size;
  void* args[] = {&p};
  hipError_t e = hipLaunchCooperativeKernel((void*)fwd_megakernel, dim3(grid_blocks), dim3(256), args, 0, stream);
  if (e != hipSuccess) fprintf(stderr, "cooperative launch failed: %s (grid %d)\n", hipGetErrorString(e), grid_blocks);
}
```

```cpp
#include <hip/hip_runtime.h>
#include <hip/hip_cooperative_groups.h>
#include <cstdio>
namespace cg = cooperative_groups;

typedef unsigned short bfr;
using bf16x8 = __attribute__((ext_vector_type(8))) short;
using f32x4 = __attribute__((ext_vector_type(4))) float;
typedef __attribute__((ext_vector_type(2))) __bf16 bf2v;
#define DI __device__ __forceinline__

constexpr int NT = 16384;
constexpr int SEQ = 2048;
constexpr int DM = 1024;
constexpr int PW0 = 2944;
constexpr int PW1 = 2304;
constexpr int C_Q = 0, C_KC = 512, C_VC = 640, C_KS = 768, C_VS = 896, C_KW = 1024, C_VW = 1152;
constexpr int C_XB = 1280, C_BG = 1792, C_CG = 2304, C_GL = 2816;

constexpr size_t al256(size_t x) { return (x + 255) & ~size_t(255); }
constexpr size_t MB = 1024 * 1024;
constexpr size_t O_MOD = 0;
constexpr size_t O_ROPE = O_MOD + al256(2 * 8 * 6144 * 4);
constexpr size_t O_BIAS1 = O_ROPE + al256(2048 * 32 * 2 * 4);
constexpr size_t O_BAR = O_BIAS1 + al256(2 * 256 * 4);
constexpr size_t O_CNT = O_BAR + al256(3456 * 4);
constexpr size_t O_TOPW = O_CNT + al256(2 * 16 * 64 * 4);
constexpr size_t O_LIST = O_TOPW + al256((size_t)NT * 2 * 4);
constexpr size_t O_SEL = O_LIST + al256((size_t)16 * NT * 4);
constexpr size_t O_KCVC = O_SEL + al256((size_t)NT * 2 * 4);
constexpr size_t O_RK = O_KCVC + al256(2 * 2048 * 64 * 4);
constexpr size_t O_CH = O_RK + al256((size_t)NT * 8 * 4);
constexpr size_t O_WEIN = O_CH + al256(2 * 2048 * 256 * 2);
constexpr size_t O_WEOUT = O_WEIN + al256((size_t)PW0 * 1024 * 2);
constexpr size_t O_WOIN = O_WEOUT + al256(1024 * 1024 * 2);
constexpr size_t O_WOOUT = O_WOIN + al256((size_t)PW1 * 1024 * 2);
constexpr size_t O_WC1 = O_WOOUT + al256(1024 * 1024 * 2);
constexpr size_t O_WC2 = O_WC1 + al256(2 * 256 * 2048 * 2);
constexpr size_t O_WGU = O_WC2 + al256(2 * 128 * 256 * 2);
constexpr size_t O_WDN = O_WGU + 64 * MB;
constexpr size_t O_HB = O_WDN + 32 * MB;
constexpr size_t O_MIX = O_HB + 32 * MB;
constexpr size_t O_E = O_MIX + 32 * MB;
constexpr size_t SZ_E = al256((size_t)NT * PW0 * 2);
constexpr size_t O_F = O_E + SZ_E;
constexpr size_t WS_NEED = O_F + 48 * MB;
constexpr size_t O_HMID = O_MIX;
constexpr size_t O_PROJ = O_E;
constexpr size_t O_MOEOUT = O_E;
constexpr size_t O_CHP = O_E;
constexpr size_t O_CHL = O_E + 32 * MB;
constexpr size_t O_QR = O_F;
constexpr size_t O_KSR = O_F + 16 * MB;
constexpr size_t O_KWR = O_F + 20 * MB;
constexpr size_t O_OCMP = O_F + 24 * MB;
constexpr size_t O_VST = O_F + 40 * MB;
constexpr size_t O_VWT = O_F + 44 * MB;
constexpr size_t O_RW_W = O_HB;
constexpr size_t O_RW_R = O_F;
constexpr size_t O_RW_K = O_F + 16 * MB;
constexpr size_t O_RW_V = O_F + 32 * MB;
constexpr size_t O_RW_A = O_WGU;
constexpr size_t O_RW_B = O_WGU + 16 * MB;
constexpr size_t O_RW_G = O_WDN;

struct Params {
  const float* in[33];
  float* out;
  char* ws;
  unsigned long long ws_size;
};

enum { I_X = 0, I_C, I_ADAW, I_ADAB, I_NMIX, I_NFFN, I_EWIN, I_CPOS, I_CW1, I_CW2, I_CONVW, I_EWOUT, I_OWIN, I_MU, I_W0, I_W2,
       I_A0, I_A2, I_G2, I_KK, I_KA, I_RKP, I_LNW, I_LNB, I_POOLW, I_POOLS, I_OWOUT, I_RTW, I_RTB, I_MG, I_MU_, I_MD, I_FN };

DI float bf2f(bfr u) { return __uint_as_float(((unsigned)u) << 16); }
DI bfr f2bf(float x) { unsigned u = __float_as_uint(x); u += 0x7fffu + ((u >> 16) & 1u); return (bfr)(u >> 16); }
typedef __attribute__((ext_vector_type(2))) float f32x2_;
DI unsigned pack2(float a, float b) { f32x2_ x = {a, b}; return __builtin_bit_cast(unsigned, __builtin_convertvector(x, bf2v)); }
DI float lo2f(unsigned u) { return __uint_as_float(u << 16); }
DI float hi2f(unsigned u) { return __uint_as_float(u & 0xffff0000u); }
DI float wave_sum(float v) {
#pragma unroll
  for (int o = 32; o > 0; o >>= 1) v += __shfl_xor(v, o);
  return v;
}
DI float sigmoidf_(float x) { return 1.f / (1.f + __expf(-x)); }
DI float dot2(unsigned a, unsigned b, float c) {
  return __builtin_amdgcn_fdot2_f32_bf16(__builtin_bit_cast(bf2v, a), __builtin_bit_cast(bf2v, b), c, false);
}

#define XB_TMO      128
#define XB_XCNT(j)  (256  + 64 * (j))
#define XB_XSUB(j)  (1280 + 64 * (j))
#define XB_XGEN(j)  (2304 + 64 * (j))
#define XB_TOP      3328
#define XB_TOPGEN   3392
#define XCD_BAR_WORDS 3456
#define XB_SPIN_CAP (1u << 22)
#define LAS __attribute__((address_space(3)))
DI unsigned xb_ld(unsigned* p) { return __hip_atomic_load(p, __ATOMIC_RELAXED, __HIP_MEMORY_SCOPE_AGENT); }
DI unsigned xb_add(unsigned* p, unsigned v) { return __hip_atomic_fetch_add(p, v, __ATOMIC_RELAXED, __HIP_MEMORY_SCOPE_AGENT); }
DI unsigned xb_xcc_id() { return (unsigned)__builtin_amdgcn_s_getreg((3 << 11) | 20) & 0xFu; }
#define XB_SPIN(cond, bar) do { unsigned _sp = 0; while (cond) { __builtin_amdgcn_s_sleep(1); \
    if ((++_sp & 255u) == 0u) { if (xb_ld(&(bar)[XB_TMO])) break; if (_sp > XB_SPIN_CAP) { atomicAdd(&(bar)[XB_TMO], 1u); break; } } } } while (0)
struct XcdBarrier { unsigned* bar; unsigned x; volatile LAS unsigned* st; };
DI XcdBarrier xcd_barrier_post(unsigned* bar, volatile LAS unsigned* st) {
  XcdBarrier b; b.bar = bar; b.x = xb_xcc_id(); b.st = st;
  if (threadIdx.x == 0) (void)xb_add(&bar[XB_XCNT(b.x)], 1u);
  return b;
}
DI void xcd_barrier_complete(unsigned* bar, unsigned x, unsigned& nloc, unsigned& nx) {
  const unsigned G = gridDim.x * gridDim.y * gridDim.z;
  unsigned sum, cnt, mine, sp = 0u;
  for (;;) {
    sum = 0u; cnt = 0u; mine = 0u;
#pragma unroll
    for (unsigned j = 0; j < 16; ++j) { const unsigned c = xb_ld(&bar[XB_XCNT(j)]); sum += c; cnt += (c > 0u) ? 1u : 0u; mine = (j == x) ? c : mine; }
    if (sum == G) break;
    __builtin_amdgcn_s_sleep(1);
    if ((++sp & 255u) == 0u) { if (xb_ld(&bar[XB_TMO])) break; if (sp > XB_SPIN_CAP) { atomicAdd(&bar[XB_TMO], 1u); break; } }
  }
  nloc = mine > 0u ? mine : 1u; nx = cnt > 0u ? cnt : 1u;
}
DI void xcd_barrier(const XcdBarrier& b) {
  asm volatile("s_waitcnt vmcnt(0)" ::: "memory");
  __syncthreads();
  if (threadIdx.x == 0) {
    unsigned* bar = b.bar;
    __builtin_amdgcn_s_waitcnt(0);
    unsigned nloc = b.st[0], nx = b.st[1];
    if (nloc == 0u) { xcd_barrier_complete(bar, b.x, nloc, nx); b.st[0] = nloc; b.st[1] = nx; }
    const unsigned old = xb_add(&bar[XB_XSUB(b.x)], 1u);
    const unsigned gen = old / nloc;
    if (old + 1u == (gen + 1u) * nloc) {
      __builtin_amdgcn_fence(__ATOMIC_RELEASE, "agent");
      asm volatile("s_waitcnt vmcnt(0)" ::: "memory");
      const unsigned og = xb_add(&bar[XB_TOP], 1u);
      const unsigned tg = og / nx;
      if (og + 1u == (tg + 1u) * nx) xb_add(&bar[XB_TOPGEN], 1u);
      else XB_SPIN(xb_ld(&bar[XB_TOPGEN]) == tg, bar);
      __builtin_amdgcn_fence(__ATOMIC_ACQUIRE, "agent");
      xb_add(&bar[XB_XGEN(b.x)], 1u);
      asm volatile("s_waitcnt vmcnt(0)" ::: "memory");
    } else {
      XB_SPIN(xb_ld(&bar[XB_XGEN(b.x)]) == gen, bar);
      __builtin_amdgcn_fence(__ATOMIC_ACQUIRE, "agent");
      asm volatile("s_waitcnt vmcnt(0)" ::: "memory");
    }
  }
  __syncthreads();
}

struct GemmLds { bfr a[2][128][40]; bfr b[2][128][40]; };
static_assert(sizeof(GemmLds) == 40960, "lds");

template <class AF, class BF, class Epi>
DI void gemm_tile(char* smem, int nk, const AF& af, const BF& bfn, Epi&& epi) {
  GemmLds& L = *(GemmLds*)smem;
  const int tid = threadIdx.x, lane = tid & 63, wid = tid >> 6, wr = wid >> 1, wc = wid & 1, fr = lane & 15, fq = lane >> 4;
  const int lr = tid >> 2, lk = (tid & 3) * 8;
  const bfr* a0 = af.row(lr);
  const bfr* a1 = af.row(lr + 64);
  const bfr* b0 = bfn.row(lr);
  const bfr* b1 = bfn.row(lr + 64);
  f32x4 acc[4][4];
#pragma unroll
  for (int m = 0; m < 4; ++m)
#pragma unroll
    for (int n = 0; n < 4; ++n) acc[m][n] = f32x4{0.f, 0.f, 0.f, 0.f};
  uint4 ra0, ra1, rb0, rb1;
  {
    const int ka = af.koff(lk), kb = bfn.koff(lk);
    ra0 = *(const uint4*)(a0 + ka); ra1 = *(const uint4*)(a1 + ka);
    rb0 = *(const uint4*)(b0 + kb); rb1 = *(const uint4*)(b1 + kb);
  }
  *(uint4*)&L.a[0][lr][lk] = ra0; *(uint4*)&L.a[0][lr + 64][lk] = ra1;
  *(uint4*)&L.b[0][lr][lk] = rb0; *(uint4*)&L.b[0][lr + 64][lk] = rb1;
  __syncthreads();
  for (int kt = 0; kt < nk; ++kt) {
    const int cur = kt & 1;
    if (kt + 1 < nk) {
      const int k = (kt + 1) * 32 + lk;
      const int ka = af.koff(k), kb = bfn.koff(k);
      ra0 = *(const uint4*)(a0 + ka); ra1 = *(const uint4*)(a1 + ka);
      rb0 = *(const uint4*)(b0 + kb); rb1 = *(const uint4*)(b1 + kb);
    }
    bf16x8 fa[4], fb[4];
#pragma unroll
    for (int m = 0; m < 4; ++m) fa[m] = *(const bf16x8*)&L.a[cur][wr * 64 + m * 16 + fr][fq * 8];
#pragma unroll
    for (int n = 0; n < 4; ++n) fb[n] = *(const bf16x8*)&L.b[cur][wc * 64 + n * 16 + fr][fq * 8];
#pragma unroll
    for (int m = 0; m < 4; ++m)
#pragma unroll
      for (int n = 0; n < 4; ++n) acc[m][n] = __builtin_amdgcn_mfma_f32_16x16x32_bf16(fa[m], fb[n], acc[m][n], 0, 0, 0);
    if (kt + 1 < nk) {
      *(uint4*)&L.a[cur ^ 1][lr][lk] = ra0; *(uint4*)&L.a[cur ^ 1][lr + 64][lk] = ra1;
      *(uint4*)&L.b[cur ^ 1][lr][lk] = rb0; *(uint4*)&L.b[cur ^ 1][lr + 64][lk] = rb1;
    }
    __syncthreads();
  }
  epi(acc, wr, wc, fr, fq);
}

struct RowsContig {
  const bfr* base; int ld; int maxrow;
  DI const bfr* row(int r) const { return base + (size_t)(r < maxrow ? r : maxrow) * ld; }
  DI int koff(int k) const { return k; }
};

DI int remap_col(int mode, int n) {
  if (mode == 1) return n < 1280 ? n : (n < 1304 ? C_GL + (n - 1280) : n - 24);
  if (mode == 2) return ((n >> 4) << 5) + (n & 15);
  if (mode == 3) return ((n >> 4) << 5) + 16 + (n & 15);
  return n;
}

DI void conv_tile(char* smem, const float* __restrict__ src, int ldsrc, int Ndim, int k0, int n0, bfr* dst, int ldd, int mode) {
  float(*t)[65] = (float(*)[65])smem;
  const int tid = threadIdx.x;
  {
    const int n = tid & 63, kq = tid >> 6;
    const int nn = n0 + n;
#pragma unroll
    for (int i = 0; i < 16; ++i) {
      const int k = i * 4 + kq;
      t[k][n] = (nn < Ndim) ? src[(size_t)(k0 + k) * ldsrc + nn] : 0.f;
    }
  }
  __syncthreads();
  {
    const int nl = tid >> 2, kc = (tid & 3) * 16;
    const int nn = n0 + nl;
    if (nn < Ndim) {
      const int dr = remap_col(mode, nn);
      unsigned w[8];
#pragma unroll
      for (int i = 0; i < 8; ++i) w[i] = pack2(t[kc + 2 * i][nl], t[kc + 2 * i + 1][nl]);
      uint4* d = (uint4*)(dst + (size_t)dr * ldd + k0 + kc);
      d[0] = make_uint4(w[0], w[1], w[2], w[3]);
      d[1] = make_uint4(w[4], w[5], w[6], w[7]);
    }
  }
  __syncthreads();
}

constexpr int PREP_MOD = 192, PREP_ROPE = 256, PREP_MISC = 3;
constexpr int T_EIN = 16 * 45, T_SQ = 256, T_OIN = 16 * 36, T_C1 = 128, T_C2 = 4, T_G = 128, T_D = 128;
constexpr int PREP_CONV0 = PREP_MOD + PREP_ROPE + PREP_MISC;
constexpr int PREP_TOTAL = PREP_CONV0 + T_EIN + T_SQ + T_OIN + T_SQ + 2 * T_C1 + 2 * T_C2 + 32 * (2 * T_G + T_D);

DI void prep_item(const Params& p, char* smem, int item) {
  const int tid = threadIdx.x;
  char* ws = p.ws;
  if (item < PREP_MOD) {
    const int layer = item / 96, cch = item % 96;
    float* cond = (float*)smem;
    float* red = (float*)(smem + 32768);
    const float* c = p.in[I_C];
    for (int i = tid; i < 8192; i += 256) {
      const int b = i >> 10, k = i & 1023;
      const float v = c[i];
      cond[k * 8 + b] = v / (1.f + __expf(-v));
    }
    __syncthreads();
    const int col = cch * 64 + (tid & 63), kg = tid >> 6;
    const float* w = p.in[I_ADAW] + (size_t)layer * 1024 * 6144 + col;
    float acc[8] = {0, 0, 0, 0, 0, 0, 0, 0};
#pragma unroll 8
    for (int k = kg * 256; k < kg * 256 + 256; ++k) {
      const float wv = w[(size_t)k * 6144];
      const float4 c0 = *(const float4*)&cond[k * 8], c1 = *(const float4*)&cond[k * 8 + 4];
      acc[0] += c0.x * wv; acc[1] += c0.y * wv; acc[2] += c0.z * wv; acc[3] += c0.w * wv;
      acc[4] += c1.x * wv; acc[5] += c1.y * wv; acc[6] += c1.z * wv; acc[7] += c1.w * wv;
    }
#pragma unroll
    for (int b = 0; b < 8; ++b) red[(kg * 8 + b) * 64 + (tid & 63)] = acc[b];
    __syncthreads();
    for (int i = tid; i < 512; i += 256) {
      const int b = i >> 6, cc = i & 63;
      const float s = red[(0 * 8 + b) * 64 + cc] + red[(1 * 8 + b) * 64 + cc] + red[(2 * 8 + b) * 64 + cc] + red[(3 * 8 + b) * 64 + cc];
      const int cg_ = cch * 64 + cc;
      ((float*)(ws + O_MOD))[(layer * 8 + b) * 6144 + cg_] = s + p.in[I_ADAB][layer * 6144 + cg_];
    }
    __syncthreads();
    return;
  }
  item -= PREP_MOD;
  if (item < PREP_ROPE) {
    const int e = item * 256 + tid;
    const int t = e >> 5, i = e & 31;
    const float inv = powf(10000.f, -(float)i / 32.f);
    const float ang = (float)t * inv;
    float* rp = (float*)(ws + O_ROPE);
    rp[e] = cosf(ang);
    rp[65536 + e] = sinf(ang);
    return;
  }
  item -= PREP_ROPE;
  if (item < PREP_MISC) {
    if (item < 2) {
      const int j = item, n = tid;
      const float* pos = p.in[I_CPOS] + j * 2048;
      const float* w1 = p.in[I_CW1] + (size_t)j * 2048 * 256 + n;
      float s = 0.f;
      for (int k = 0; k < 2048; ++k) s += pos[k] * w1[(size_t)k * 256];
      ((float*)(ws + O_BIAS1))[j * 256 + n] = s;
    } else {
      int* cnt = (int*)(ws + O_CNT);
      for (int i = tid; i < 2 * 16 * 64; i += 256) cnt[i] = 0;
      unsigned* barw = (unsigned*)(ws + O_BAR);
      for (int i = tid; i < XCD_BAR_WORDS; i += 256) barw[i] = 0u;
      uint4 z = make_uint4(0, 0, 0, 0);
      uint4* wpad = (uint4*)(ws + O_WEIN + (size_t)2840 * 1024 * 2);
      for (int i = tid; i < 104 * 1024 * 2 / 16; i += 256) wpad[i] = z;
      for (int j = 0; j < 2; ++j) {
        uint4* cp = (uint4*)(ws + O_WC2 + ((size_t)j * 128 + 64) * 256 * 2);
        for (int i = tid; i < 64 * 256 * 2 / 16; i += 256) cp[i] = z;
      }
    }
    return;
  }
  item -= PREP_MISC;
  if (item < T_EIN) { conv_tile(smem, p.in[I_EWIN], 2840, 2840, (item / 45) * 64, (item % 45) * 64, (bfr*)(ws + O_WEIN), 1024, 1); return; }
  item -= T_EIN;
  if (item < T_SQ) { conv_tile(smem, p.in[I_EWOUT], 1024, 1024, (item / 16) * 64, (item % 16) * 64, (bfr*)(ws + O_WEOUT), 1024, 0); return; }
  item -= T_SQ;
  if (item < T_OIN) { conv_tile(smem, p.in[I_OWIN], 2304, 2304, (item / 36) * 64, (item % 36) * 64, (bfr*)(ws + O_WOIN), 1024, 0); return; }
  item -= T_OIN;
  if (item < T_SQ) { conv_tile(smem, p.in[I_OWOUT], 1024, 1024, (item / 16) * 64, (item % 16) * 64, (bfr*)(ws + O_WOOUT), 1024, 0); return; }
  item -= T_SQ;
  if (item < 2 * T_C1) {
    const int j = item / T_C1, tt = item % T_C1;
    conv_tile(smem, p.in[I_CW1] + (size_t)j * 2048 * 256, 256, 256, (tt / 4) * 64, (tt % 4) * 64, (bfr*)(ws + O_WC1) + (size_t)j * 256 * 2048, 2048, 0);
    return;
  }
  item -= 2 * T_C1;
  if (item < 2 * T_C2) {
    const int j = item / T_C2, tt = item % T_C2;
    conv_tile(smem, p.in[I_CW2] + (size_t)j * 256 * 64, 64, 64, tt * 64, 0, (bfr*)(ws + O_WC2) + (size_t)j * 128 * 256, 256, 0);
    return;
  }
  item -= 2 * T_C2;
  {
    const int le = item / (2 * T_G + T_D), tt = item % (2 * T_G + T_D);
    if (tt < T_G) {
      conv_tile(smem, p.in[I_MG] + (size_t)le * 1024 * 512, 512, 512, (tt / 8) * 64, (tt % 8) * 64, (bfr*)(ws + O_WGU) + (size_t)le * 1024 * 1024, 1024, 2);
    } else if (tt < 2 * T_G) {
      const int t2 = tt - T_G;
      conv_tile(smem, p.in[I_MU_] + (size_t)le * 1024 * 512, 512, 512, (t2 / 8) * 64, (t2 % 8) * 64, (bfr*)(ws + O_WGU) + (size_t)le * 1024 * 1024, 1024, 3);
    } else {
      const int t2 = tt - 2 * T_G;
      conv_tile(smem, p.in[I_MD] + (size_t)le * 512 * 1024, 1024, 1024, (t2 / 16) * 64, (t2 % 16) * 64, (bfr*)(ws + O_WDN) + (size_t)le * 1024 * 512, 512, 0);
    }
  }
}

template <int MODE, bool ROUTER>
DI void norm_phase(const Params& p, char* smem, const float* xin, float* xout, const float* nw, const float* modl,
                   int sh_off, int sc_off, int g_off, int layer) {
  char* ws = p.ws;
  const int tid = threadIdx.x, lane = tid & 63, wid = tid >> 6;
  bfr* HB = (bfr*)(ws + O_HB);
  const bfr* MO0 = (const bfr*)(ws + O_MOEOUT);
  const bfr* MO1 = MO0 + (size_t)NT * 1024;
  int* lcnt = (int*)smem;
  int* lbase = lcnt + 16;
  int* lexp = lbase + 16;
  int* lrank = lexp + 64;
  for (int chunk = blockIdx.x; chunk < NT / 32; chunk += gridDim.x) {
    if (ROUTER) {
      if (tid < 16) lcnt[tid] = 0;
      __syncthreads();
    }
    for (int it = 0; it < 8; ++it) {
      const int row = chunk * 32 + it * 4 + wid;
      const int b = row >> 11;
      float v[16];
      float ss = 0.f;
#pragma unroll
      for (int i = 0; i < 4; ++i) {
        const int c = (i * 64 + lane) * 4;
        float4 x = *(const float4*)(xin + (size_t)row * 1024 + c);
        if (MODE >= 1) {
          const float4 g = *(const float4*)(modl + b * 6144 + g_off + c);
          const uint2 m0 = *(const uint2*)(MO0 + (size_t)row * 1024 + c);
          const uint2 m1 = *(const uint2*)(MO1 + (size_t)row * 1024 + c);
          x.x += g.x * (lo2f(m0.x) + lo2f(m1.x));
          x.y += g.y * (hi2f(m0.x) + hi2f(m1.x));
          x.z += g.z * (lo2f(m0.y) + lo2f(m1.y));
          x.w += g.w * (hi2f(m0.y) + hi2f(m1.y));
          if (MODE == 1) *(float4*)(xout + (size_t)row * 1024 + c) = x;
        }
        v[i * 4 + 0] = x.x; v[i * 4 + 1] = x.y; v[i * 4 + 2] = x.z; v[i * 4 + 3] = x.w;
        ss += x.x * x.x + x.y * x.y + x.z * x.z + x.w * x.w;
      }
      ss = wave_sum(ss);
      const float rstd = rsqrtf(ss * (1.f / 1024.f) + 1e-6f);
#pragma unroll
      for (int i = 0; i < 4; ++i) {
        const int c = (i * 64 + lane) * 4;
        const float4 w = *(const float4*)(nw + c);
        if (MODE == 2) {
          float4 o;
          o.x = v[i * 4 + 0] * rstd * w.x; o.y = v[i * 4 + 1] * rstd * w.y; o.z = v[i * 4 + 2] * rstd * w.z; o.w = v[i * 4 + 3] * rstd * w.w;
          *(float4*)(xout + (size_t)row * 1024 + c) = o;
        } else {
          const float4 sc = *(const float4*)(modl + b * 6144 + sc_off + c);
          const float4 sh = *(const float4*)(modl + b * 6144 + sh_off + c);
          v[i * 4 + 0] = v[i * 4 + 0] * rstd * w.x * (1.f + sc.x) + sh.x;
          v[i * 4 + 1] = v[i * 4 + 1] * rstd * w.y * (1.f + sc.y) + sh.y;
          v[i * 4 + 2] = v[i * 4 + 2] * rstd * w.z * (1.f + sc.z) + sh.z;
          v[i * 4 + 3] = v[i * 4 + 3] * rstd * w.w * (1.f + sc.w) + sh.w;
          uint2 o;
          o.x = pack2(v[i * 4 + 0], v[i * 4 + 1]);
          o.y = pack2(v[i * 4 + 2], v[i * 4 + 3]);
          *(uint2*)(HB + (size_t)row * 1024 + c) = o;
        }
      }
      if (ROUTER) {
        float* hrow = (float*)(smem + 1024) + wid * 1024;
#pragma unroll
        for (int i = 0; i < 4; ++i) {
          const int c = (i * 64 + lane) * 4;
          *(float4*)(hrow + c) = make_float4(v[i * 4], v[i * 4 + 1], v[i * 4 + 2], v[i * 4 + 3]);
        }
        __builtin_amdgcn_fence(__ATOMIC_RELEASE, "wavefront");
        __builtin_amdgcn_wave_barrier();
        const float* rw = p.in[I_RTW];
        const int ee = lane & 15, kq = lane >> 4;
        float part = 0.f;
#pragma unroll 8
        for (int k = kq * 256; k < kq * 256 + 256; ++k) part += hrow[k] * rw[k * 16 + ee];
        part += __shfl_xor(part, 16);
        part += __shfl_xor(part, 32);
        __builtin_amdgcn_wave_barrier();
        float sc[16], bi[16];
#pragma unroll
        for (int e = 0; e < 16; ++e) {
          const float lgv = __shfl(part, e);
          sc[e] = 1.f / (1.f + expf(-lgv));
          bi[e] = sc[e] + p.in[I_RTB][e];
        }
        int tg = 0; float best = -3.0e38f;
#pragma unroll
        for (int g = 0; g < 4; ++g) {
          float m1 = -3.0e38f, m2 = -3.0e38f;
#pragma unroll
          for (int j = 0; j < 4; ++j) {
            const float x = bi[g * 4 + j];
            if (x > m1) { m2 = m1; m1 = x; } else if (x > m2) { m2 = x; }
          }
          const float gs = m1 + m2;
          if (gs > best) { best = gs; tg = g; }
        }
        int i0 = -1, i1 = -1; float b0 = -3.0e38f, b1 = -3.0e38f, s0 = 0.f, s1 = 0.f;
#pragma unroll
        for (int e = 0; e < 16; ++e) {
          if ((e >> 2) == tg) {
            const float x = bi[e];
            if (x > b0) { b1 = b0; i1 = i0; s1 = s0; b0 = x; i0 = e; s0 = sc[e]; }
            else if (x > b1) { b1 = x; i1 = e; s1 = sc[e]; }
          }
        }
        if (lane == 0) {
          const float inv = 1.f / (s0 + s1);
          float* topw = (float*)(ws + O_TOPW);
          topw[row * 2 + 0] = s0 * inv;
          topw[row * 2 + 1] = s1 * inv;
          const int a = (it * 4 + wid) * 2;
          lexp[a] = i0; lrank[a] = atomicAdd(&lcnt[i0], 1);
          lexp[a + 1] = i1; lrank[a + 1] = atomicAdd(&lcnt[i1], 1);
        }
      }
    }
    if (ROUTER) {
      __syncthreads();
      int* cnt = (int*)(ws + O_CNT) + layer * 16 * 64;
      if (tid < 16) lbase[tid] = atomicAdd(&cnt[tid * 64], lcnt[tid]);
      __syncthreads();
      if (tid < 64) {
        const int e = lexp[tid];
        const int slot = lbase[e] + lrank[tid];
        ((int*)(ws + O_LIST))[(size_t)e * NT + slot] = (chunk * 32 + (tid >> 1)) * 2 + (tid & 1);
      }
      __syncthreads();
    }
  }
}

DI void gemm_proj_phase(const Params& p, char* smem, const bfr* Wt, int ncols_pad, bfr* out) {
  const bfr* HB = (const bfr*)(p.ws + O_HB);
  const int n_nt = ncols_pad / 128;
  const int ntiles = (NT / 128) * n_nt;
  for (int tile = blockIdx.x; tile < ntiles; tile += gridDim.x) {
    const int mt = tile / n_nt, nt = tile % n_nt;
    RowsContig A{HB + (size_t)mt * 128 * 1024, 1024, 127};
    RowsContig B{Wt + (size_t)nt * 128 * 1024, 1024, 127};
    gemm_tile(smem, 32, A, B, [&](f32x4(&acc)[4][4], int wr, int wc, int fr, int fq) {
#pragma unroll
      for (int m = 0; m < 4; ++m)
#pragma unroll
        for (int n = 0; n < 4; ++n)
#pragma unroll
          for (int j = 0; j < 4; ++j) {
            const int row = mt * 128 + wr * 64 + m * 16 + fq * 4 + j, col = nt * 128 + wc * 64 + n * 16 + fr;
            out[(size_t)row * ncols_pad + col] = f2bf(acc[m][n][j]);
          }
    });
  }
}

DI void gemm_out_phase(const Params& p, char* smem, const bfr* Wt, const float* xin, float* xout, const float* gate  ) {
  const bfr* MIX = (const bfr*)(p.ws + O_MIX);
  const int ntiles = (NT / 128) * 8;
  for (int tile = blockIdx.x; tile < ntiles; tile += gridDim.x) {
    const int mt = tile / 8, nt = tile % 8;
    RowsContig A{MIX + (size_t)mt * 128 * 1024, 1024, 127};
    RowsContig B{Wt + (size_t)nt * 128 * 1024, 1024, 127};
    const int b = (mt * 128) >> 11;
    gemm_tile(smem, 32, A, B, [&](f32x4(&acc)[4][4], int wr, int wc, int fr, int fq) {
#pragma unroll
      for (int m = 0; m < 4; ++m)
#pragma unroll
        for (int n = 0; n < 4; ++n) {
          const int col = nt * 128 + wc * 64 + n * 16 + fr;
          const float g = gate[b * 6144 + col];
#pragma unroll
          for (int j = 0; j < 4; ++j) {
            const int row = mt * 128 + wr * 64 + m * 16 + fq * 4 + j;
            xout[(size_t)row * 1024 + col] = xin[(size_t)row * 1024 + col] + g * acc[m][n][j];
          }
        }
    });
  }
}

struct RowsCmp {
  const bfr* proj; int colbase; int mt;
  DI const bfr* row(int r) const {
    int rr = mt * 128 + r; if (rr > 2031) rr = 2031;
    const int h = rr & 1, bn = rr >> 1, b = bn / 127, nc = bn % 127;
    return proj + (size_t)(b * SEQ + nc * 16) * PW0 + colbase + h * 64;
  }
  DI int koff(int k) const { return (k >> 6) * PW0 + (k & 63); }
};

DI float gelu_tanh(float x) {
  const float u = 0.7978845608028654f * (x + 0.044715f * x * x * x);
  return 0.5f * x * (1.f + tanhf(u));
}

DI void post0_phase(const Params& p, char* smem) {
  char* ws = p.ws;
  const bfr* PROJ = (const bfr*)(ws + O_PROJ);
  const int tid = threadIdx.x;
  for (int tile = blockIdx.x; tile < 64; tile += gridDim.x) {
    const int j = tile >> 5, mt = (tile >> 1) & 15, nt = tile & 1;
    RowsCmp A{PROJ, j ? C_VC : C_KC, mt};
    RowsContig B{(const bfr*)(ws + O_WC1) + ((size_t)j * 256 + nt * 128) * 2048, 2048, 127};
    bfr* CH = (bfr*)(ws + O_CH) + (size_t)j * 2048 * 256;
    const float* bias = (const float*)(ws + O_BIAS1) + j * 256;
    gemm_tile(smem, 64, A, B, [&](f32x4(&acc)[4][4], int wr, int wc, int fr, int fq) {
#pragma unroll
      for (int m = 0; m < 4; ++m)
#pragma unroll
        for (int n = 0; n < 4; ++n) {
          const int col = nt * 128 + wc * 64 + n * 16 + fr;
          const float bb = bias[col];
#pragma unroll
          for (int jj = 0; jj < 4; ++jj) {
            const int row = mt * 128 + wr * 64 + m * 16 + fq * 4 + jj;
            CH[(size_t)row * 256 + col] = f2bf(gelu_tanh(acc[m][n][jj] + bb));
          }
        }
    });
  }
  {
    bfr(*tt)[66] = (bfr(*)[66])smem;
    for (int item = blockIdx.x; item < 1024; item += gridDim.x) {
      const int tl = item & 31, hk = (item >> 5) & 1, which = (item >> 6) & 1, b = item >> 7;
      const bfr* src = PROJ + (size_t)(b * SEQ + tl * 64) * PW0 + (which ? C_VW : C_VS) + hk * 64;
      bfr* dst = (bfr*)(ws + (which ? O_VWT : O_VST)) + (size_t)((b * 2 + hk) * 64) * SEQ + tl * 64;
      for (int e = tid; e < 64 * 32; e += 256) {
        const int row = e >> 5, c2 = (e & 31) * 2;
        const unsigned u = *(const unsigned*)(src + (size_t)row * PW0 + c2);
        tt[row][c2] = (bfr)(u & 0xffffu); tt[row][c2 + 1] = (bfr)(u >> 16);
      }
      __syncthreads();
      for (int e = tid; e < 64 * 32; e += 256) {
        const int d = e >> 5, t2 = (e & 31) * 2;
        const unsigned u = (unsigned)tt[t2][d] | ((unsigned)tt[t2 + 1][d] << 16);
        *(unsigned*)(dst + (size_t)d * SEQ + t2) = u;
      }
      __syncthreads();
    }
  }
  const float* ropec = (const float*)(ws + O_ROPE);
  const float* ropes = ropec + 65536;
  bfr* QR = (bfr*)(ws + O_QR);
  bfr* KSR = (bfr*)(ws + O_KSR);
  bfr* KWR = (bfr*)(ws + O_KWR);
  bfr* MIX = (bfr*)(ws + O_MIX);
  const float* cw = p.in[I_CONVW];
  for (int item = blockIdx.x; item < NT / 8; item += gridDim.x) {
    for (int tt = 0; tt < 8; ++tt) {
      const int tok = item * 8 + tt, t = tok & (SEQ - 1);
      const bfr* pr = PROJ + (size_t)tok * PW0;
      {
        const int head = tid >> 5, i = tid & 31;
        const float c = ropec[t * 32 + i], s = ropes[t * 32 + i];
        const float t1 = bf2f(pr[C_Q + head * 64 + i]), t2 = bf2f(pr[C_Q + head * 64 + 32 + i]);
        QR[(size_t)tok * 512 + head * 64 + i] = f2bf(t1 * c - t2 * s);
        QR[(size_t)tok * 512 + head * 64 + 32 + i] = f2bf(t2 * c + t1 * s);
        if (tid < 128) {
          const int which = tid >> 6, hh = (tid >> 5) & 1;
          const int cb = (which ? C_KW : C_KS) + hh * 64;
          const float k1 = bf2f(pr[cb + i]), k2 = bf2f(pr[cb + 32 + i]);
          bfr* dst = (which ? KWR : KSR) + (size_t)tok * 128 + hh * 64;
          dst[i] = f2bf(k1 * c - k2 * s);
          dst[32 + i] = f2bf(k2 * c + k1 * s);
        }
      }
#pragma unroll
      for (int h2 = 0; h2 < 2; ++h2) {
        const int ch = tid + h2 * 256;
        const float u0 = bf2f(pr[C_CG + ch]) * bf2f(pr[C_XB + ch]);
        float u1 = 0.f, u2 = 0.f;
        if (t >= 1) u1 = bf2f(pr[C_CG + ch - PW0]) * bf2f(pr[C_XB + ch - PW0]);
        if (t >= 2) u2 = bf2f(pr[C_CG + ch - 2 * PW0]) * bf2f(pr[C_XB + ch - 2 * PW0]);
        const float y = cw[2 * 512 + ch] * u0 + cw[1 * 512 + ch] * u1 + cw[0 * 512 + ch] * u2;
        MIX[(size_t)tok * 1024 + 512 + ch] = f2bf(bf2f(pr[C_BG + ch]) * y);
      }
    }
  }
}

DI void cmp2_phase(const Params& p, char* smem) {
  char* ws = p.ws;
  for (int tile = blockIdx.x; tile < 32; tile += gridDim.x) {
    const int j = tile >> 4, mt = tile & 15;
    RowsContig A{(const bfr*)(ws + O_CH) + ((size_t)j * 2048 + mt * 128) * 256, 256, 127};
    RowsContig B{(const bfr*)(ws + O_WC2) + (size_t)j * 128 * 256, 256, 127};
    bfr* KC = (bfr*)(ws + O_KCVC) + (size_t)j * 2048 * 64;
    gemm_tile(smem, 8, A, B, [&](f32x4(&acc)[4][4], int wr, int wc, int fr, int fq) {
      if (wc == 0) {
#pragma unroll
        for (int m = 0; m < 4; ++m)
#pragma unroll
          for (int n = 0; n < 4; ++n)
#pragma unroll
            for (int jj = 0; jj < 4; ++jj) {
              const int row = mt * 128 + wr * 64 + m * 16 + fq * 4 + jj, col = n * 16 + fr;
              KC[(size_t)row * 64 + col] = f2bf(acc[m][n][jj]);
            }
      }
    });
  }
}

DI void cmp_attn_phase(const Params& p, char* smem) {
  char* ws = p.ws;
  const bfr* PROJ = (const bfr*)(ws + O_PROJ);
  const bfr* KC = (const bfr*)(ws + O_KCVC);
  const bfr* VC = KC + 2048 * 64;
  bfr* OCMP = (bfr*)(ws + O_OCMP);
  unsigned* SEL = (unsigned*)(ws + O_SEL);
  const int tid = threadIdx.x;
  for (int item = blockIdx.x; item < NT / 32; item += gridDim.x) {
    const int tok = item * 32 + (tid >> 3), head = tid & 7, hkv = head >> 2;
    const int b = tok >> 11, t = tok & (SEQ - 1);
    const int nv = t >= 31 ? ((t - 31) >> 4) + 1 : 0;
    unsigned q[32];
    {
      const uint4* qp = (const uint4*)(PROJ + (size_t)tok * PW0 + C_Q + head * 64);
#pragma unroll
      for (int i = 0; i < 8; ++i) { const uint4 u = qp[i]; q[i * 4] = u.x; q[i * 4 + 1] = u.y; q[i * 4 + 2] = u.z; q[i * 4 + 3] = u.w; }
    }
    const bfr* kb = KC + ((size_t)(b * 127) * 2 + hkv) * 64;
    const bfr* vb = VC + ((size_t)(b * 127) * 2 + hkv) * 64;
    auto dotk = [&](int c) {
      const uint4* kp = (const uint4*)(kb + (size_t)c * 128);
      float a = 0.f;
#pragma unroll
      for (int i = 0; i < 8; ++i) {
        const uint4 u = kp[i];
        a = dot2(q[i * 4], u.x, a); a = dot2(q[i * 4 + 1], u.y, a); a = dot2(q[i * 4 + 2], u.z, a); a = dot2(q[i * 4 + 3], u.w, a);
      }
      return a * 0.125f;
    };
    float mx = -1e30f;
    for (int c = 0; c < nv; ++c) mx = fmaxf(mx, dotk(c));
    float o[64];
#pragma unroll
    for (int i = 0; i < 64; ++i) o[i] = 0.f;
    float l = 0.f;
    for (int c = 0; c < nv; ++c) {
      const float pe = __expf(dotk(c) - mx);
      l += pe;
      const uint4* vp = (const uint4*)(vb + (size_t)c * 128);
#pragma unroll
      for (int i = 0; i < 8; ++i) {
        const uint4 u = vp[i];
        o[i * 8 + 0] += pe * lo2f(u.x); o[i * 8 + 1] += pe * hi2f(u.x);
        o[i * 8 + 2] += pe * lo2f(u.y); o[i * 8 + 3] += pe * hi2f(u.y);
        o[i * 8 + 4] += pe * lo2f(u.z); o[i * 8 + 5] += pe * hi2f(u.z);
        o[i * 8 + 6] += pe * lo2f(u.w); o[i * 8 + 7] += pe * hi2f(u.w);
      }
    }
    const float invl = nv > 0 ? 1.f / l : 0.f;
    {
      const float gl = bf2f(PROJ[(size_t)tok * PW0 + C_GL + head * 3 + 0]);
      const float g0 = sigmoidf_(gl) * invl;
      uint4* op = (uint4*)(OCMP + (size_t)tok * 512 + head * 64);
#pragma unroll
      for (int i = 0; i < 8; ++i) {
        uint4 u;
        u.x = pack2(o[i * 8 + 0] * g0, o[i * 8 + 1] * g0); u.y = pack2(o[i * 8 + 2] * g0, o[i * 8 + 3] * g0);
        u.z = pack2(o[i * 8 + 4] * g0, o[i * 8 + 5] * g0); u.w = pack2(o[i * 8 + 6] * g0, o[i * 8 + 7] * g0);
        op[i] = u;
      }
    }
    const int cur = t >> 6;
    float tv0 = -1.f, tv1 = -1.f, tv2 = -1.f, tv3 = -1.f, tv4 = -1.f;
    int ti0 = -1, ti1 = -1, ti2 = -1, ti3 = -1, ti4 = -1;
    float part = 0.f;
    int curmax = cur;
#pragma unroll
    for (int o2 = 32; o2 > 0; o2 >>= 1) curmax = max(curmax, __shfl_xor(curmax, o2));
#pragma unroll 1
    for (int j = 0; j <= curmax + 1 && j <= 32; ++j) {
      float e[4];
#pragma unroll
      for (int oo = 0; oo < 4; ++oo) {
        const int c = j * 4 + oo;
        float pe = 0.f;
        if (c < nv) pe = __expf(dotk(c) - mx) * invl;
        pe += __shfl_xor(pe, 1);
        pe += __shfl_xor(pe, 2);
        e[oo] = pe;
      }
      if (j >= 1) {
        const float val = part + e[0];
        const int jb = j - 1;
        if (jb >= 1 && jb <= cur - 2) {
          if (val > tv4) {
            tv4 = val; ti4 = jb;
            if (tv4 > tv3) { float tf = tv3; tv3 = tv4; tv4 = tf; int tii = ti3; ti3 = ti4; ti4 = tii; }
            if (tv3 > tv2) { float tf = tv2; tv2 = tv3; tv3 = tf; int tii = ti2; ti2 = ti3; ti3 = tii; }
            if (tv2 > tv1) { float tf = tv1; tv1 = tv2; tv2 = tf; int tii = ti1; ti1 = ti2; ti2 = tii; }
            if (tv1 > tv0) { float tf = tv0; tv0 = tv1; tv1 = tf; int tii = ti0; ti0 = ti1; ti1 = tii; }
          }
        }
      }
      part = e[0] + 2.f * (e[1] + e[2] + e[3]);
    }
    unsigned mask = 1u | (1u << cur);
    if (cur >= 1) mask |= 1u << (cur - 1);
    if (ti0 >= 0) mask |= 1u << ti0;
    if (ti1 >= 0) mask |= 1u << ti1;
    if (ti2 >= 0) mask |= 1u << ti2;
    if (ti3 >= 0) mask |= 1u << ti3;
    if (ti4 >= 0) mask |= 1u << ti4;
    if ((head & 3) == 0) SEL[tok * 2 + hkv] = mask;
  }
}

DI void slcwin_phase(const Params& p, char* smem) {
  char* ws = p.ws;
  const bfr* PROJ = (const bfr*)(ws + O_PROJ);
  const bfr* QR = (const bfr*)(ws + O_QR);
  const bfr* KSR = (const bfr*)(ws + O_KSR);
  const bfr* KWR = (const bfr*)(ws + O_KWR);
  const bfr* OCMP = (const bfr*)(ws + O_OCMP);
  const unsigned* SEL = (const unsigned*)(ws + O_SEL);
  bfr* MIX = (bfr*)(ws + O_MIX);
  const int tid = threadIdx.x, lane = tid & 63, wid = tid >> 6;
  for (int item = blockIdx.x; item < 512; item += gridDim.x) {
    const int tile = 31 - (item >> 4), bh = item & 15, b = bh >> 1, hkv = bh & 1;
    const int t = tile * 64 + lane, tok = b * SEQ + t, head = hkv * 4 + wid;
    unsigned q[32];
    {
      const uint4* qp = (const uint4*)(QR + (size_t)tok * 512 + head * 64);
#pragma unroll
      for (int i = 0; i < 8; ++i) { const uint4 u = qp[i]; q[i * 4] = u.x; q[i * 4 + 1] = u.y; q[i * 4 + 2] = u.z; q[i * 4 + 3] = u.w; }
    }
    const unsigned sel = SEL[tok * 2 + hkv];
#pragma unroll 1
    for (int pass = 0; pass < 2; ++pass) {
      const bfr* Kb = (pass == 0 ? KSR : KWR) + (size_t)b * SEQ * 128 + hkv * 64;
      const bfr* Vb = PROJ + (size_t)b * SEQ * PW0 + (pass == 0 ? C_VS : C_VW) + hkv * 64;
      float o[64];
#pragma unroll
      for (int i = 0; i < 64; ++i) o[i] = 0.f;
      float m = -1e30f, l = 0.f;
      const int jlo = pass == 0 ? 0 : (tile >= 8 ? tile - 8 : 0);
#pragma unroll 1
      for (int j = jlo; j <= tile; ++j) {
        const bool lane_ok = pass == 0 ? ((sel >> j) & 1u) != 0 : true;
        if (pass == 0 && !__any(lane_ok)) continue;
#pragma unroll 1
        for (int kb = 0; kb < 64; kb += 4) {
          float s[4];
#pragma unroll
          for (int kk = 0; kk < 4; ++kk) {
            const int key = j * 64 + kb + kk;
            const uint4* kp = (const uint4*)(Kb + (size_t)key * 128);
            float a = 0.f;
#pragma unroll
            for (int i = 0; i < 8; ++i) {
              const uint4 u = kp[i];
              a = dot2(q[i * 4], u.x, a); a = dot2(q[i * 4 + 1], u.y, a); a = dot2(q[i * 4 + 2], u.z, a); a = dot2(q[i * 4 + 3], u.w, a);
            }
            bool ok = lane_ok && key <= t;
            if (pass == 1) ok = ok && (t - key < 512);
            s[kk] = ok ? a * 0.125f : -1e30f;
          }
          const float cm = fmaxf(fmaxf(s[0], s[1]), fmaxf(s[2], s[3]));
          const float mn = fmaxf(m, cm);
          const float corr = __expf(m - mn);
          m = mn;
          float pe[4];
#pragma unroll
          for (int kk = 0; kk < 4; ++kk) pe[kk] = s[kk] > -1e29f ? __expf(s[kk] - mn) : 0.f;
          l = l * corr + (pe[0] + pe[1] + pe[2] + pe[3]);
#pragma unroll
          for (int i = 0; i < 64; ++i) o[i] *= corr;
#pragma unroll
          for (int kk = 0; kk < 4; ++kk) {
            const int key = j * 64 + kb + kk;
            const uint4* vp = (const uint4*)(Vb + (size_t)key * PW0);
#pragma unroll
            for (int i = 0; i < 8; ++i) {
              const uint4 u = vp[i];
              o[i * 8 + 0] += pe[kk] * lo2f(u.x); o[i * 8 + 1] += pe[kk] * hi2f(u.x);
              o[i * 8 + 2] += pe[kk] * lo2f(u.y); o[i * 8 + 3] += pe[kk] * hi2f(u.y);
              o[i * 8 + 4] += pe[kk] * lo2f(u.z); o[i * 8 + 5] += pe[kk] * hi2f(u.z);
              o[i * 8 + 6] += pe[kk] * lo2f(u.w); o[i * 8 + 7] += pe[kk] * hi2f(u.w);
            }
          }
        }
      }
      const float gate = sigmoidf_(bf2f(PROJ[(size_t)tok * PW0 + C_GL + head * 3 + 1 + pass]));
      const float gsc = gate * (l > 0.f ? 1.f / l : 0.f);
      uint4* op = (uint4*)(MIX + (size_t)tok * 1024 + head * 64);
      const uint4* cp = pass == 0 ? (const uint4*)(OCMP + (size_t)tok * 512 + head * 64) : (const uint4*)op;
#pragma unroll
      for (int i = 0; i < 8; ++i) {
        const uint4 c = cp[i];
        uint4 u;
        u.x = pack2(o[i * 8 + 0] * gsc + lo2f(c.x), o[i * 8 + 1] * gsc + hi2f(c.x));
        u.y = pack2(o[i * 8 + 2] * gsc + lo2f(c.y), o[i * 8 + 3] * gsc + hi2f(c.y));
        u.z = pack2(o[i * 8 + 4] * gsc + lo2f(c.z), o[i * 8 + 5] * gsc + hi2f(c.z));
        u.w = pack2(o[i * 8 + 6] * gsc + lo2f(c.w), o[i * 8 + 7] * gsc + hi2f(c.w));
        op[i] = u;
      }
    }
  }
}

using f32x16 = __attribute__((ext_vector_type(16))) float;
#define MFMA32(a, b, c) __builtin_amdgcn_mfma_f32_32x32x16_bf16((a), (b), (c), 0, 0, 0)
struct AttnLds { bfr k[2][64][72]; bfr vt[2][64][68]; };
static_assert(sizeof(AttnLds) <= 49152, "attn lds");
DI int crow16(int i, int h2) { return (i & 3) + 8 * (i >> 2) + 4 * h2; }

DI void attn_sw_phase(const Params& p, char* smem) {
  char* ws = p.ws;
  AttnLds& L = *(AttnLds*)smem;
  const bfr* PROJ = (const bfr*)(ws + O_PROJ);
  const bfr* QR = (const bfr*)(ws + O_QR);
  const bfr* OCMP = (const bfr*)(ws + O_OCMP);
  const unsigned* SEL = (const unsigned*)(ws + O_SEL);
  bfr* MIX = (bfr*)(ws + O_MIX);
  const int tid = threadIdx.x, lane = tid & 63, wid = tid >> 6, r = lane & 31, h2 = lane >> 5;
  const float CS = 0.125f * 1.4426950408889634f;
  const int lrow = tid >> 3, lc8 = (tid & 7) * 8;
  for (int item = blockIdx.x; item < 1024; item += gridDim.x) {
    const int qt = item < 512 ? 63 - (item >> 4) : ((item - 512) >> 4);
    const int bh = item & 15, b = bh >> 1, hkv = bh & 1;
    const int cur = qt >> 1;
    const int tokl = qt * 32 + wid * 8 + (r >> 2), g = r & 3, head = hkv * 4 + g, tok = b * SEQ + tokl;
    bf16x8 qf[4];
#pragma unroll
    for (int s = 0; s < 4; ++s) qf[s] = *(const bf16x8*)(QR + (size_t)tok * 512 + head * 64 + 16 * s + 8 * h2);
    const unsigned sel = SEL[tok * 2 + hkv];
    const int nslc = cur + 1, wlo = cur > 8 ? cur - 8 : 0, T = nslc + (cur - wlo + 1);
    const bfr* KS = (const bfr*)(ws + O_KSR) + (size_t)b * SEQ * 128 + hkv * 64;
    const bfr* KW = (const bfr*)(ws + O_KWR) + (size_t)b * SEQ * 128 + hkv * 64;
    const bfr* VS = (const bfr*)(ws + O_VST) + (size_t)((b * 2 + hkv) * 64) * SEQ;
    const bfr* VW = (const bfr*)(ws + O_VWT) + (size_t)((b * 2 + hkv) * 64) * SEQ;
    uint4 rk0, rk1, rv0, rv1;
    auto gload = [&](int tt) {
      const int pass = tt >= nslc, j = pass ? wlo + tt - nslc : tt;
      const bfr* kb = (pass ? KW : KS) + (size_t)(j * 64) * 128 + lc8;
      const bfr* vb = (pass ? VW : VS) + j * 64 + lc8;
      rk0 = *(const uint4*)(kb + (size_t)lrow * 128); rk1 = *(const uint4*)(kb + (size_t)(lrow + 32) * 128);
      rv0 = *(const uint4*)(vb + (size_t)lrow * SEQ); rv1 = *(const uint4*)(vb + (size_t)(lrow + 32) * SEQ);
    };
    auto lstore = [&](int buf) {
      *(uint4*)&L.k[buf][lrow][lc8] = rk0; *(uint4*)&L.k[buf][lrow + 32][lc8] = rk1;
      *(uint2*)&L.vt[buf][lrow][lc8] = make_uint2(rv0.x, rv0.y); *(uint2*)&L.vt[buf][lrow][lc8 + 4] = make_uint2(rv0.z, rv0.w);
      *(uint2*)&L.vt[buf][lrow + 32][lc8] = make_uint2(rv1.x, rv1.y); *(uint2*)&L.vt[buf][lrow + 32][lc8 + 4] = make_uint2(rv1.z, rv1.w);
    };
    gload(0); lstore(0);
    __syncthreads();
    float m = -1e30f, l = 0.f;
    f32x16 o0, o1;
#pragma unroll
    for (int i = 0; i < 16; ++i) { o0[i] = 0.f; o1[i] = 0.f; }
#pragma unroll 1
    for (int tt = 0; tt < T; ++tt) {
      const int buf = tt & 1;
      if (tt + 1 < T) gload(tt + 1);
      const int pass = tt >= nslc, j = pass ? wlo + tt - nslc : tt;
      const bool rowok = pass ? true : ((sel >> j) & 1u) != 0u;
      if (__any(rowok)) {
        f32x16 s0, s1;
#pragma unroll
        for (int i = 0; i < 16; ++i) { s0[i] = 0.f; s1[i] = 0.f; }
#pragma unroll
        for (int s = 0; s < 4; ++s) {
          const bf16x8 k0 = *(const bf16x8*)&L.k[buf][r][16 * s + 8 * h2];
          const bf16x8 k1 = *(const bf16x8*)&L.k[buf][32 + r][16 * s + 8 * h2];
          s0 = MFMA32(k0, qf[s], s0);
          s1 = MFMA32(k1, qf[s], s1);
        }
        if (!rowok) {
#pragma unroll
          for (int i = 0; i < 16; ++i) { s0[i] = -1e30f; s1[i] = -1e30f; }
        }
        if (j == cur) {
          const int lim = tokl - j * 64;
#pragma unroll
          for (int i = 0; i < 16; ++i) {
            if (crow16(i, h2) > lim) s0[i] = -1e30f;
            if (32 + crow16(i, h2) > lim) s1[i] = -1e30f;
          }
        }
        if (pass && cur >= 8 && j == cur - 8) {
          const int lo = tokl - 512 - j * 64;
#pragma unroll
          for (int i = 0; i < 16; ++i) {
            if (crow16(i, h2) <= lo) s0[i] = -1e30f;
            if (32 + crow16(i, h2) <= lo) s1[i] = -1e30f;
          }
        }
        float mx = -1e30f;
#pragma unroll
        for (int i = 0; i < 16; ++i) mx = fmaxf(mx, fmaxf(s0[i], s1[i]));
        mx = fmaxf(mx, __shfl_xor(mx, 32));
        const float mnew = fmaxf(m, mx);
        const float mu = fmaxf(mnew, -1e20f);
        const float corr = __builtin_amdgcn_exp2f((m - mu) * CS);
        m = mnew;
        const float muc = mu * CS;
        float ps = 0.f;
#pragma unroll
        for (int i = 0; i < 16; ++i) {
          s0[i] = __builtin_amdgcn_exp2f(fmaf(s0[i], CS, -muc));
          s1[i] = __builtin_amdgcn_exp2f(fmaf(s1[i], CS, -muc));
          ps += s0[i] + s1[i];
        }
        l = l * corr + ps;
#pragma unroll
        for (int i = 0; i < 16; ++i) { o0[i] *= corr; o1[i] *= corr; }
#pragma unroll
        for (int kb = 0; kb < 2; ++kb) {
#pragma unroll
          for (int s = 0; s < 2; ++s) {
            uint4 pk;
            if (kb == 0) {
              pk.x = pack2(s0[8 * s + 0], s0[8 * s + 1]); pk.y = pack2(s0[8 * s + 2], s0[8 * s + 3]);
              pk.z = pack2(s0[8 * s + 4], s0[8 * s + 5]); pk.w = pack2(s0[8 * s + 6], s0[8 * s + 7]);
            } else {
              pk.x = pack2(s1[8 * s + 0], s1[8 * s + 1]); pk.y = pack2(s1[8 * s + 2], s1[8 * s + 3]);
              pk.z = pack2(s1[8 * s + 4], s1[8 * s + 5]); pk.w = pack2(s1[8 * s + 6], s1[8 * s + 7]);
            }
            const bf16x8 pf = __builtin_bit_cast(bf16x8, pk);
            const int kc = kb * 32 + 16 * s + 4 * h2;
            const uint2 a0 = *(const uint2*)&L.vt[buf][r][kc];
            const uint2 a1 = *(const uint2*)&L.vt[buf][r][kc + 8];
            const uint2 c0 = *(const uint2*)&L.vt[buf][32 + r][kc];
            const uint2 c1 = *(const uint2*)&L.vt[buf][32 + r][kc + 8];
            const bf16x8 v0 = __builtin_bit_cast(bf16x8, make_uint4(a0.x, a0.y, a1.x, a1.y));
            const bf16x8 v1 = __builtin_bit_cast(bf16x8, make_uint4(c0.x, c0.y, c1.x, c1.y));
            o0 = MFMA32(v0, pf, o0);
            o1 = MFMA32(v1, pf, o1);
          }
        }
      }
      if (tt == nslc - 1 || tt == T - 1) {
        const float lt = l + __shfl_xor(l, 32);
        const float gate = sigmoidf_(bf2f(PROJ[(size_t)tok * PW0 + C_GL + head * 3 + 1 + pass]));
        const float sc = lt > 0.f ? gate / lt : 0.f;
        bfr* mixp = MIX + (size_t)tok * 1024 + head * 64;
        const bfr* addp = pass ? (const bfr*)mixp : OCMP + (size_t)tok * 512 + head * 64;
#pragma unroll
        for (int q4 = 0; q4 < 4; ++q4) {
          const int d0 = 8 * q4 + 4 * h2;
          const uint2 c = *(const uint2*)(addp + d0);
          uint2 u;
          u.x = pack2(o0[q4 * 4 + 0] * sc + lo2f(c.x), o0[q4 * 4 + 1] * sc + hi2f(c.x));
          u.y = pack2(o0[q4 * 4 + 2] * sc + lo2f(c.y), o0[q4 * 4 + 3] * sc + hi2f(c.y));
          *(uint2*)(mixp + d0) = u;
          const uint2 c2 = *(const uint2*)(addp + 32 + d0);
          u.x = pack2(o1[q4 * 4 + 0] * sc + lo2f(c2.x), o1[q4 * 4 + 1] * sc + hi2f(c2.x));
          u.y = pack2(o1[q4 * 4 + 2] * sc + lo2f(c2.y), o1[q4 * 4 + 3] * sc + hi2f(c2.y));
          *(uint2*)(mixp + 32 + d0) = u;
        }
#pragma unroll
        for (int i = 0; i < 16; ++i) { o0[i] = 0.f; o1[i] = 0.f; }
        m = -1e30f; l = 0.f;
      }
      if (tt + 1 < T) lstore(buf ^ 1);
      __syncthreads();
    }
  }
}

struct RowsGather {
  const bfr* base; const int* list; int i0; int cnt; int ld; bool viaTok;
  DI const bfr* row(int r) const {
    int i = i0 + r; if (i > cnt - 1) i = cnt - 1;
    const int e = list[i];
    return base + (size_t)(viaTok ? (e >> 1) : 0) * ld;
  }
  DI int koff(int k) const { return k; }
};

DI void moe1_phase(const Params& p, char* smem, int layer) {
  char* ws = p.ws;
  const int* cnt = (const int*)(ws + O_CNT) + layer * 16 * 64;
  const int* LIST = (const int*)(ws + O_LIST);
  const bfr* HB = (const bfr*)(ws + O_HB);
  bfr* HMID = (bfr*)(ws + O_HMID);
  int c[16], mtiles = 0;
#pragma unroll
  for (int e = 0; e < 16; ++e) { c[e] = cnt[e * 64]; mtiles += (c[e] + 127) >> 7; }
  const int ntiles = mtiles * 8;
  for (int tile = blockIdx.x; tile < ntiles; tile += gridDim.x) {
    int mg = tile >> 3; const int nt = tile & 7;
    int e = 0, off = 0, ce = 0;
#pragma unroll
    for (int k = 0; k < 16; ++k) {
      const int mk = (c[k] + 127) >> 7;
      if (k == e && mg >= mk) { mg -= mk; off += c[k]; e = k + 1; }
    }
#pragma unroll
    for (int k = 0; k < 16; ++k) if (k == e) ce = c[k];
    const int mt = mg;
    RowsGather A{HB, LIST + (size_t)e * NT, mt * 128, ce, 1024, true};
    RowsContig B{(const bfr*)(ws + O_WGU) + ((size_t)(layer * 16 + e) * 1024 + nt * 128) * 1024, 1024, 127};
    gemm_tile(smem, 32, A, B, [&](f32x4(&acc)[4][4], int wr, int wc, int fr, int fq) {
#pragma unroll
      for (int m = 0; m < 4; ++m)
#pragma unroll
        for (int n2 = 0; n2 < 2; ++n2) {
          const int col = nt * 64 + wc * 32 + n2 * 16 + fr;
#pragma unroll
          for (int j = 0; j < 4; ++j) {
            const int i = mt * 128 + wr * 64 + m * 16 + fq * 4 + j;
            if (i < ce) {
              const float g = acc[m][n2 * 2][j], u = acc[m][n2 * 2 + 1][j];
              HMID[(size_t)(off + i) * 512 + col] = f2bf(g / (1.f + __expf(-g)) * u);
            }
          }
        }
    });
  }
}

DI void moe2_phase(const Params& p, char* smem, int layer) {
  char* ws = p.ws;
  const int* cnt = (const int*)(ws + O_CNT) + layer * 16 * 64;
  const int* LIST = (const int*)(ws + O_LIST);
  const float* TOPW = (const float*)(ws + O_TOPW);
  const bfr* HMID = (const bfr*)(ws + O_HMID);
  bfr* MO = (bfr*)(ws + O_MOEOUT);
  int c[16], mtiles = 0;
#pragma unroll
  for (int e = 0; e < 16; ++e) { c[e] = cnt[e * 64]; mtiles += (c[e] + 127) >> 7; }
  const int ntiles = mtiles * 8;
  for (int tile = blockIdx.x; tile < ntiles; tile += gridDim.x) {
    int mg = tile >> 3; const int nt = tile & 7;
    int e = 0, off = 0, ce = 0;
#pragma unroll
    for (int k = 0; k < 16; ++k) {
      const int mk = (c[k] + 127) >> 7;
      if (k == e && mg >= mk) { mg -= mk; off += c[k]; e = k + 1; }
    }
#pragma unroll
    for (int k = 0; k < 16; ++k) if (k == e) ce = c[k];
    const int mt = mg;
    const int rows_here = ce - mt * 128;
    RowsContig A{HMID + (size_t)(off + mt * 128) * 512, 512, (rows_here < 128 ? rows_here : 128) - 1};
    RowsContig B{(const bfr*)(ws + O_WDN) + ((size_t)(layer * 16 + e) * 1024 + nt * 128) * 512, 512, 127};
    const int* lst = LIST + (size_t)e * NT;
    gemm_tile(smem, 16, A, B, [&](f32x4(&acc)[4][4], int wr, int wc, int fr, int fq) {
#pragma unroll
      for (int m = 0; m < 4; ++m)
#pragma unroll
        for (int j = 0; j < 4; ++j) {
          const int i = mt * 128 + wr * 64 + m * 16 + fq * 4 + j;
          if (i < ce) {
            const int en = lst[i];
            const float w = TOPW[en];
            bfr* dst = MO + ((size_t)(en & 1) * NT + (en >> 1)) * 1024 + nt * 128 + wc * 64 + fr;
#pragma unroll
            for (int n = 0; n < 4; ++n) dst[n * 16] = f2bf(acc[m][n][j] * w);
          }
        }
    });
  }
}

DI void rwkv_prep_phase(const Params& p, char* smem) {
  char* ws = p.ws;
  const bfr* PROJ = (const bfr*)(ws + O_PROJ);
  const int tid = threadIdx.x;
  float* lw = (float*)smem;
  float* la = lw + 16 * 64;
  float* lg = la + 16 * 64;
  float* pl = (float*)smem;
  const float* mu = p.in[I_MU];
  float* W = (float*)(ws + O_RW_W);
  bfr* R = (bfr*)(ws + O_RW_R); bfr* K = (bfr*)(ws + O_RW_K); bfr* V = (bfr*)(ws + O_RW_V);
  bfr* A = (bfr*)(ws + O_RW_A); bfr* Bb = (bfr*)(ws + O_RW_B); bfr* G = (bfr*)(ws + O_RW_G);
  float* RK = (float*)(ws + O_RK);
  bfr* MIX = (bfr*)(ws + O_MIX);
  for (int item = blockIdx.x; item < 2 * (NT / 16); item += gridDim.x) {
    const int tok0 = (item >> 1) * 16;
    if ((item & 1) == 0) {
      for (int i = tid; i < 16 * 256; i += 256) {
        const int tt = i >> 8, cc = i & 255;
        const int tok = tok0 + tt, t = tok & (SEQ - 1);
        const int col = 1536 + cc;
        const float cur = bf2f(PROJ[(size_t)tok * PW1 + col]);
        const float prev = t > 0 ? bf2f(PROJ[(size_t)(tok - 1) * PW1 + col]) : 0.f;
        const float v = cur + (prev - cur) * mu[col];
        if (cc < 64) lw[tt * 64 + cc] = tanhf(v);
        else if (cc < 128) la[tt * 64 + cc - 64] = v;
        else lg[tt * 128 + cc - 128] = sigmoidf_(v);
      }
      __syncthreads();
      const int c0 = tid * 2;
      float ad[16][2], aa[16][2], ag[16][2];
#pragma unroll
      for (int tt = 0; tt < 16; ++tt) { ad[tt][0] = ad[tt][1] = aa[tt][0] = aa[tt][1] = ag[tt][0] = ag[tt][1] = 0.f; }
      const float* w2 = p.in[I_W2] + c0;
      const float* a2 = p.in[I_A2] + c0;
      const float* g2 = p.in[I_G2] + c0;
      for (int k = 0; k < 64; ++k) {
        const float2 ww = *(const float2*)(w2 + k * 512);
        const float2 wa = *(const float2*)(a2 + k * 512);
#pragma unroll
        for (int tt = 0; tt < 16; ++tt) {
          const float x = lw[tt * 64 + k], y = la[tt * 64 + k];
          ad[tt][0] += x * ww.x; ad[tt][1] += x * ww.y;
          aa[tt][0] += y * wa.x; aa[tt][1] += y * wa.y;
        }
      }
      for (int k = 0; k < 128; ++k) {
        const float2 wg = *(const float2*)(g2 + k * 512);
#pragma unroll
        for (int tt = 0; tt < 16; ++tt) {
          const float x = lg[tt * 128 + k];
          ag[tt][0] += x * wg.x; ag[tt][1] += x * wg.y;
        }
      }
      const float2 w0 = *(const float2*)(p.in[I_W0] + c0), a0 = *(const float2*)(p.in[I_A0] + c0);
      const float2 kkp = *(const float2*)(p.in[I_KK] + c0), kap = *(const float2*)(p.in[I_KA] + c0);
      const float2 rkp = *(const float2*)(p.in[I_RKP] + c0);
      const float2 mur = *(const float2*)(mu + c0), muk = *(const float2*)(mu + 512 + c0), muv = *(const float2*)(mu + 1024 + c0);
#pragma unroll
      for (int tt = 0; tt < 16; ++tt) {
        const int tok = tok0 + tt, t = tok & (SEQ - 1);
        const bfr* pr = PROJ + (size_t)tok * PW1;
        const unsigned ur = *(const unsigned*)(pr + c0), uk = *(const unsigned*)(pr + 512 + c0), uv = *(const unsigned*)(pr + 1024 + c0);
        unsigned pr_ = 0, pk_ = 0, pv_ = 0;
        if (t > 0) { pr_ = *(const unsigned*)(pr - PW1 + c0); pk_ = *(const unsigned*)(pr - PW1 + 512 + c0); pv_ = *(const unsigned*)(pr - PW1 + 1024 + c0); }
        float r[2], k[2], v[2];
        r[0] = lo2f(ur) + (lo2f(pr_) - lo2f(ur)) * mur.x; r[1] = hi2f(ur) + (hi2f(pr_) - hi2f(ur)) * mur.y;
        k[0] = lo2f(uk) + (lo2f(pk_) - lo2f(uk)) * muk.x; k[1] = hi2f(uk) + (hi2f(pk_) - hi2f(uk)) * muk.y;
        v[0] = lo2f(uv) + (lo2f(pv_) - lo2f(uv)) * muv.x; v[1] = hi2f(uv) + (hi2f(pv_) - hi2f(uv)) * muv.y;
        float dec[2], av[2], km[2], kk[2];
        const float w0v[2] = {w0.x, w0.y}, a0v[2] = {a0.x, a0.y}, kkv[2] = {kkp.x, kkp.y}, kav[2] = {kap.x, kap.y}, rkv[2] = {rkp.x, rkp.y};
        float nrm = 0.f, rk = 0.f;
#pragma unroll
        for (int u = 0; u < 2; ++u) {
          const float z = -(w0v[u] + ad[tt][u]);
          const float sp = fmaxf(z, 0.f) + log1pf(__expf(-fabsf(z)));
          const float wlog = -sp - 0.5f;
          dec[u] = __expf(-__expf(wlog));
          av[u] = sigmoidf_(a0v[u] + aa[tt][u]);
          km[u] = k[u] * (1.f + (av[u] - 1.f) * kav[u]);
          kk[u] = k[u] * kkv[u];
          nrm += kk[u] * kk[u];
          rk += r[u] * km[u] * rkv[u];
        }
#pragma unroll
        for (int o2 = 16; o2 > 0; o2 >>= 1) { nrm += __shfl_xor(nrm, o2); rk += __shfl_xor(rk, o2); }
        const float inv = 1.f / fmaxf(sqrtf(nrm), 1e-12f);
        kk[0] *= inv; kk[1] *= inv;
        const size_t o = (size_t)tok * 512 + c0;
        *(float2*)(W + o) = make_float2(dec[0], dec[1]);
        *(unsigned*)(R + o) = pack2(r[0], r[1]);
        *(unsigned*)(K + o) = pack2(km[0], km[1]);
        *(unsigned*)(V + o) = pack2(v[0], v[1]);
        *(unsigned*)(A + o) = pack2(-kk[0], -kk[1]);
        *(unsigned*)(Bb + o) = pack2(kk[0] * av[0], kk[1] * av[1]);
        *(unsigned*)(G + o) = pack2(ag[tt][0], ag[tt][1]);
        if ((tid & 31) == 0) RK[tok * 8 + (tid >> 5)] = rk;
      }
      __syncthreads();
    } else {
      {
        const int c0 = tid * 2, gi = c0 >> 7, win = 2 << gi;
        for (int tt = 0; tt < 16; ++tt) {
          const int tok = tok0 + tt, t = tok & (SEQ - 1);
          const int n = (t + 1 < win) ? t + 1 : win;
          float s0 = 0.f, s1 = 0.f;
          for (int d = 0; d < n; ++d) {
            const unsigned u = *(const unsigned*)(PROJ + (size_t)(tok - d) * PW1 + 1792 + c0);
            s0 += lo2f(u); s1 += hi2f(u);
          }
          const unsigned u = *(const unsigned*)(PROJ + (size_t)tok * PW1 + 1792 + c0);
          const float invn = 1.f / (float)n;
          pl[tt * 512 + c0] = s0 * invn - lo2f(u);
          pl[tt * 512 + c0 + 1] = s1 * invn - hi2f(u);
        }
      }
      __syncthreads();
      {
        const int d0 = tid * 2, gi = d0 >> 7, dl = d0 & 127;
        const float* pw = p.in[I_POOLW] + (size_t)gi * 128 * 128 + dl;
        float acc[16][2];
#pragma unroll
        for (int tt = 0; tt < 16; ++tt) acc[tt][0] = acc[tt][1] = 0.f;
        for (int c = 0; c < 128; ++c) {
          const float2 w = *(const float2*)(pw + c * 128);
#pragma unroll
          for (int tt = 0; tt < 16; ++tt) {
            const float x = pl[tt * 512 + gi * 128 + c];
            acc[tt][0] += x * w.x; acc[tt][1] += x * w.y;
          }
        }
        const float2 ps = *(const float2*)(p.in[I_POOLS] + d0);
#pragma unroll
        for (int tt = 0; tt < 16; ++tt)
          *(unsigned*)(MIX + (size_t)(tok0 + tt) * 1024 + 512 + d0) = pack2(acc[tt][0] * ps.x, acc[tt][1] * ps.y);
      }
      __syncthreads();
    }
  }
}

DI void scanA_phase(const Params& p, char* smem) {
  char* ws = p.ws;
  const int tid = threadIdx.x, lane = tid & 63, wid = tid >> 6;
  const int ul = wid >> 1, isP = wid & 1;
  float* stb = (float*)smem;
  const float* W = (const float*)(ws + O_RW_W);
  bfr* R = (bfr*)(ws + O_RW_R); bfr* K = (bfr*)(ws + O_RW_K); const bfr* V = (const bfr*)(ws + O_RW_V);
  const bfr* A = (const bfr*)(ws + O_RW_A); const bfr* Bb = (const bfr*)(ws + O_RW_B);
  float* CHP = (float*)(ws + O_CHP); float* CHL = (float*)(ws + O_CHL);
  for (int item = blockIdx.x; item < 1024; item += gridDim.x) {
    const int unit = item * 2 + ul;
    const int chain = unit >> 5, chunk = unit & 31, b = chain >> 3, h = chain & 7;
    const size_t base = ((size_t)b * SEQ + chunk * 64) * 512 + h * 64;
    float S[64];
    int diag = isP ? lane : -1;
    asm volatile("" : "+v"(diag));
#pragma unroll
    for (int j = 0; j < 64; ++j) S[j] = (j == diag) ? 1.f : 0.f;
#pragma unroll 1
    for (int sub = 0; sub < 4; ++sub) {
      __syncthreads();
      {
        float* d0 = stb + ul * (16 * 384);
#pragma unroll 4
        for (int s = 0; s < 16; ++s) {
          const size_t o = base + (size_t)(sub * 16 + s) * 512 + lane;
          float* d = d0 + s * 384;
          if (isP == 0) {
            d[lane] = bf2f(R[o]);
            d[64 + lane] = W[o];
            d[128 + lane] = bf2f(K[o]);
          } else {
            d[192 + lane] = bf2f(V[o]);
            d[256 + lane] = bf2f(A[o]);
            d[320 + lane] = bf2f(Bb[o]);
          }
        }
      }
      __syncthreads();
#pragma unroll 1
      for (int s = 0; s < 16; ++s) {
        const float* d = stb + ul * (16 * 384) + s * 384;
        float sa = 0.f;
#pragma unroll
        for (int j4 = 0; j4 < 16; ++j4) {
          const float4 a4 = *(const float4*)(d + 256 + j4 * 4);
          sa += S[j4 * 4] * a4.x + S[j4 * 4 + 1] * a4.y + S[j4 * 4 + 2] * a4.z + S[j4 * 4 + 3] * a4.w;
        }
        const float vi = isP ? 0.f : d[192 + lane];
        float y = 0.f;
#pragma unroll
        for (int j4 = 0; j4 < 16; ++j4) {
          if ((j4 & 3) == 0) asm volatile("" ::: "memory");
          const float4 w4 = *(const float4*)(d + 64 + j4 * 4);
          const float4 b4 = *(const float4*)(d + 320 + j4 * 4);
          const float4 k4 = *(const float4*)(d + 128 + j4 * 4);
          const float4 r4 = *(const float4*)(d + j4 * 4);
          S[j4 * 4 + 0] = S[j4 * 4 + 0] * w4.x + (sa * b4.x + vi * k4.x);
          S[j4 * 4 + 1] = S[j4 * 4 + 1] * w4.y + (sa * b4.y + vi * k4.y);
          S[j4 * 4 + 2] = S[j4 * 4 + 2] * w4.z + (sa * b4.z + vi * k4.z);
          S[j4 * 4 + 3] = S[j4 * 4 + 3] * w4.w + (sa * b4.w + vi * k4.w);
          y += S[j4 * 4] * r4.x + S[j4 * 4 + 1] * r4.y + S[j4 * 4 + 2] * r4.z + S[j4 * 4 + 3] * r4.w;
        }
        const size_t o = base + (size_t)(sub * 16 + s) * 512 + lane;
        if (isP) R[o] = f2bf(y);
        else K[o] = f2bf(y);
      }
    }
    float4* dp = (float4*)((isP ? CHP : CHL) + ((size_t)unit * 64 + lane) * 64);
#pragma unroll
    for (int j4 = 0; j4 < 16; ++j4) dp[j4] = make_float4(S[j4 * 4], S[j4 * 4 + 1], S[j4 * 4 + 2], S[j4 * 4 + 3]);
  }
}

DI void scanB_phase(const Params& p, char* smem) {
  char* ws = p.ws;
  const int tid = threadIdx.x;
  float* Ss = (float*)smem;
  float* Ps = Ss + 64 * 65;
  const float* CHP = (const float*)(ws + O_CHP);
  float* CHL = (float*)(ws + O_CHL);
  const int i = tid >> 2, qd = tid & 3;
  for (int chain = blockIdx.x; chain < 64; chain += gridDim.x) {
    for (int e = tid; e < 64 * 65; e += 256) Ss[e] = 0.f;
    __syncthreads();
    for (int c = 0; c < 31; ++c) {
      const size_t ub = ((size_t)(chain * 32 + c)) * 4096;
      for (int e = tid; e < 1024; e += 256) ((float4*)Ps)[e] = ((const float4*)(CHP + ub))[e];
      float acc[16];
      {
        const float4* lp = (const float4*)(CHL + ub + i * 64 + qd * 16);
#pragma unroll
        for (int u = 0; u < 4; ++u) { const float4 v = lp[u]; acc[u * 4] = v.x; acc[u * 4 + 1] = v.y; acc[u * 4 + 2] = v.z; acc[u * 4 + 3] = v.w; }
      }
      __syncthreads();
      if (c > 0) {
        for (int k = 0; k < 64; ++k) {
          const float s = Ss[i * 65 + k];
          const float4* pr = (const float4*)(Ps + k * 64 + qd * 16);
#pragma unroll
          for (int u = 0; u < 4; ++u) {
            const float4 v = pr[u];
            acc[u * 4] += s * v.x; acc[u * 4 + 1] += s * v.y; acc[u * 4 + 2] += s * v.z; acc[u * 4 + 3] += s * v.w;
          }
        }
      }
      __syncthreads();
#pragma unroll
      for (int u = 0; u < 16; ++u) Ss[i * 65 + qd * 16 + u] = acc[u];
      {
        float4* lp = (float4*)(CHL + ub + i * 64 + qd * 16);
#pragma unroll
        for (int u = 0; u < 4; ++u) lp[u] = make_float4(acc[u * 4], acc[u * 4 + 1], acc[u * 4 + 2], acc[u * 4 + 3]);
      }
      __syncthreads();
    }
  }
}

DI void scanC_phase(const Params& p, char* smem) {
  char* ws = p.ws;
  const int tid = threadIdx.x, lane = tid & 63, wid = tid >> 6;
  float* st = (float*)smem + wid * (8 * 64);
  const bfr* Q = (const bfr*)(ws + O_RW_R); const bfr* YL = (const bfr*)(ws + O_RW_K); const bfr* V = (const bfr*)(ws + O_RW_V);
  const bfr* G = (const bfr*)(ws + O_RW_G);
  const float* RK = (const float*)(ws + O_RK);
  const float* CHL = (const float*)(ws + O_CHL);
  bfr* MIX = (bfr*)(ws + O_MIX);
  for (int item = blockIdx.x; item < 512; item += gridDim.x) {
    const int unit = item * 4 + wid;
    const int chain = unit >> 5, chunk = unit & 31, b = chain >> 3, h = chain & 7;
    const size_t base = ((size_t)b * SEQ + chunk * 64) * 512 + h * 64;
    float S[64];
    if (chunk > 0) {
      const float4* sp = (const float4*)(CHL + ((size_t)(unit - 1) * 64 + lane) * 64);
#pragma unroll
      for (int j4 = 0; j4 < 16; ++j4) { const float4 v = sp[j4]; S[j4 * 4] = v.x; S[j4 * 4 + 1] = v.y; S[j4 * 4 + 2] = v.z; S[j4 * 4 + 3] = v.w; }
    } else {
#pragma unroll
      for (int j = 0; j < 64; ++j) S[j] = 0.f;
    }
    const float lnw = p.in[I_LNW][h * 64 + lane], lnb = p.in[I_LNB][h * 64 + lane];
#pragma unroll 1
    for (int sub = 0; sub < 8; ++sub) {
#pragma unroll
      for (int s = 0; s < 8; ++s) st[s * 64 + lane] = bf2f(Q[base + (size_t)(sub * 8 + s) * 512 + lane]);
      __builtin_amdgcn_fence(__ATOMIC_RELEASE, "wavefront");
      __builtin_amdgcn_wave_barrier();
#pragma unroll 1
      for (int s = 0; s < 8; ++s) {
        const size_t o = base + (size_t)(sub * 8 + s) * 512 + lane;
        float y = bf2f(YL[o]);
        const float* d = st + s * 64;
#pragma unroll
        for (int j4 = 0; j4 < 16; ++j4) {
          const float4 q4 = *(const float4*)(d + j4 * 4);
          y += S[j4 * 4] * q4.x + S[j4 * 4 + 1] * q4.y + S[j4 * 4 + 2] * q4.z + S[j4 * 4 + 3] * q4.w;
        }
        const float mean = wave_sum(y) * (1.f / 64.f);
        const float dlt = y - mean;
        const float var = wave_sum(dlt * dlt) * (1.f / 64.f);
        const float yn = dlt * rsqrtf(var + 64e-5f) * lnw + lnb;
        const int tok = b * SEQ + chunk * 64 + sub * 8 + s;
        const float outv = (yn + RK[tok * 8 + h] * bf2f(V[o])) * bf2f(G[o]);
        MIX[(size_t)tok * 1024 + h * 64 + lane] = f2bf(outv);
      }
      __builtin_amdgcn_fence(__ATOMIC_RELEASE, "wavefront");
      __builtin_amdgcn_wave_barrier();
    }
  }
}

#ifndef REP_PREP
#define REP_PREP 1
#endif
#ifndef REP_PROJ0
#define REP_PROJ0 1
#endif
#ifndef REP_CMPA
#define REP_CMPA 1
#endif
#ifndef REP_SLC
#define REP_SLC 1
#endif
#ifndef REP_MOE1
#define REP_MOE1 1
#endif
#ifndef REP_MOE2
#define REP_MOE2 1
#endif
#ifndef REP_POST0
#define REP_POST0 1
#endif
#ifndef REP_RPREP
#define REP_RPREP 1
#endif
#ifndef REP_SCANB
#define REP_SCANB 1
#endif
#ifndef REP_SCANC
#define REP_SCANC 1
#endif
#ifndef REP_SYNC
#define REP_SYNC 1
#endif
__global__ void __launch_bounds__(256, 2) fwd_megakernel(Params p) {
  cg::grid_group grid = cg::this_grid();
  __shared__ __attribute__((aligned(16))) char smem[49152];
  __shared__ uint4 xb_words;
  char* ws = p.ws;
  const float* MOD = (const float*)(ws + O_MOD);
  const float* MOD1 = MOD + 8 * 6144;
  float* X = p.out;
  if (threadIdx.x == 0) xb_words = make_uint4(0u, 0u, 0u, 0u);

  for (int rep = 0; rep < REP_PREP; ++rep)
  for (int item = blockIdx.x; item < PREP_TOTAL; item += gridDim.x) prep_item(p, smem, item);
  grid.sync();
  const XcdBarrier xb = xcd_barrier_post((unsigned*)(ws + O_BAR), (volatile LAS unsigned*)&xb_words);
#define GSYNC() xcd_barrier(xb)
  for (int rep = 1; rep < REP_SYNC; ++rep) GSYNC();
  norm_phase<0, false>(p, smem, p.in[I_X], nullptr, p.in[I_NMIX], MOD, 0, 1024, 0, 0);
  GSYNC();
  for (int rep = 0; rep < REP_PROJ0; ++rep) gemm_proj_phase(p, smem, (const bfr*)(ws + O_WEIN), PW0, (bfr*)(ws + O_PROJ));
  GSYNC();
  for (int rep = 0; rep < REP_POST0; ++rep) post0_phase(p, smem);
  GSYNC();
  cmp2_phase(p, smem);
  GSYNC();
  for (int rep = 0; rep < REP_CMPA; ++rep) cmp_attn_phase(p, smem);
  GSYNC();
  for (int rep = 0; rep < REP_SLC; ++rep) attn_sw_phase(p, smem);
  GSYNC();
  gemm_out_phase(p, smem, (const bfr*)(ws + O_WEOUT), p.in[I_X], X, MOD + 2048);
  GSYNC();
  norm_phase<0, true>(p, smem, X, nullptr, p.in[I_NFFN], MOD, 3072, 4096, 0, 0);
  GSYNC();
  for (int rep = 0; rep < REP_MOE1; ++rep) moe1_phase(p, smem, 0);
  GSYNC();
  for (int rep = 0; rep < REP_MOE2; ++rep) moe2_phase(p, smem, 0);
  GSYNC();
  norm_phase<1, false>(p, smem, X, X, p.in[I_NMIX] + 1024, MOD1, 0, 1024, 5120 - 6144 * 8, 1);
  GSYNC();
  gemm_proj_phase(p, smem, (const bfr*)(ws + O_WOIN), PW1, (bfr*)(ws + O_PROJ));
  GSYNC();
  for (int rep = 0; rep < REP_RPREP; ++rep) rwkv_prep_phase(p, smem);
  GSYNC();
  scanA_phase(p, smem);
  GSYNC();
  scanB_phase(p, smem);
  GSYNC();
  for (int rep = 0; rep < REP_SCANC; ++rep) scanC_phase(p, smem);
  GSYNC();
  gemm_out_phase(p, smem, (const bfr*)(ws + O_WOOUT), X, X, MOD1 + 2048);
  GSYNC();
  norm_phase<0, true>(p, smem, X, nullptr, p.in[I_NFFN] + 1024, MOD1, 3072, 4096, 0, 1);
  GSYNC();
  moe1_phase(p, smem, 1);
  GSYNC();
  moe2_phase(p, smem, 1);
  GSYNC();
  norm_phase<2, false>(p, smem, X, X, p.in[I_FN], MOD1, 0, 0, 5120, 1);
}

extern "C" void kernel_launch(void* const* d_in, const int* in_sizes, int n_in,
                              void* d_out, int out_size, void* d_ws, size_t ws_size,
                              hipStream_t stream) {
  static int grid_blocks = 0;
  if (!grid_blocks) {
    int dev = 0, cus = 0, per_cu = 0;
    (void)hipGetDevice(&dev);
    (void)hipDeviceGetAttribute(&cus, hipDeviceAttributeMultiprocessorCount, dev);
    (void)hipOccupancyMaxActiveBlocksPerMultiprocessor(&per_cu, fwd_megakernel, 256, 0);
    if (per_cu > 2) per_cu = 2;
    if (per_cu < 1) per_cu = 1;
    grid_blocks = cus * per_cu;
    fprintf(stderr, "cus=%d per_cu=%d grid=%d ws=%zu need=%zu\n", cus, per_cu, grid_blocks, ws_size, (size_t)WS_NEED);
  }
  if (ws_size < WS_NEED || n_in < 33) { fprintf(stderr, "workspace too small\n"); return; }
  Params p{};
  for (int i = 0; i < 33; ++i) p.in[i] = (const float*)d_in[i];
  p.out = (float*)d_out;
  p.ws = (char*)d_ws;
  p.ws_size = (unsigned long long)ws_size;
  void* args[] = {&p};
  hipError_t e = hipLaunchCooperativeKernel((void*)fwd_megakernel, dim3(grid_blocks), dim3(256), args, 0, stream);
  if (e != hipSuccess) fprintf(stderr, "cooperative launch failed: %s (grid %d)\n", hipGetErrorString(e), grid_blocks);
}
```

```cpp
#include <hip/hip_runtime.h>
#include <hip/hip_cooperative_groups.h>
#include <cstdio>
namespace cg = cooperative_groups;

typedef unsigned short bfr;
using bf16x8 = __attribute__((ext_vector_type(8))) short;
using f32x4 = __attribute__((ext_vector_type(4))) float;
typedef __attribute__((ext_vector_type(2))) __bf16 bf2v;
#define DI __device__ __forceinline__

constexpr int NT = 16384;
constexpr int SEQ = 2048;
constexpr int DM = 1024;
constexpr int PW0 = 2944;
constexpr int PW1 = 2304;
constexpr int C_Q = 0, C_KC = 512, C_VC = 640, C_KS = 768, C_VS = 896, C_KW = 1024, C_VW = 1152;
constexpr int C_XB = 1280, C_BG = 1792, C_CG = 2304, C_GL = 2816;

constexpr size_t al256(size_t x) { return (x + 255) & ~size_t(255); }
constexpr size_t MB = 1024 * 1024;
constexpr size_t O_MOD = 0;
constexpr size_t O_ROPE = O_MOD + al256(2 * 8 * 6144 * 4);
constexpr size_t O_BIAS1 = O_ROPE + al256(2048 * 32 * 2 * 4);
constexpr size_t O_BAR = O_BIAS1 + al256(2 * 256 * 4);
constexpr size_t O_CNT = O_BAR + al256(3456 * 4);
constexpr size_t O_TOPW = O_CNT + al256(2 * 16 * 64 * 4);
constexpr size_t O_LIST = O_TOPW + al256((size_t)NT * 2 * 4);
constexpr size_t O_SEL = O_LIST + al256((size_t)16 * NT * 4);
constexpr size_t O_KCVC = O_SEL + al256((size_t)NT * 2 * 4);
constexpr size_t O_RK = O_KCVC + al256(2 * 2048 * 64 * 4);
constexpr size_t O_VCT = O_RK + al256((size_t)NT * 8 * 4);
constexpr size_t O_CH = O_VCT + al256(8 * 2 * 64 * 128 * 2);
constexpr size_t O_WEIN = O_CH + al256(2 * 2048 * 256 * 2);
constexpr size_t O_WEOUT = O_WEIN + al256((size_t)PW0 * 1024 * 2);
constexpr size_t O_WOIN = O_WEOUT + al256(1024 * 1024 * 2);
constexpr size_t O_WOOUT = O_WOIN + al256((size_t)PW1 * 1024 * 2);
constexpr size_t O_WC1 = O_WOOUT + al256(1024 * 1024 * 2);
constexpr size_t O_WC2 = O_WC1 + al256(2 * 256 * 2048 * 2);
constexpr size_t O_WGU = O_WC2 + al256(2 * 128 * 256 * 2);
constexpr size_t O_WDN = O_WGU + 64 * MB;
constexpr size_t O_HB = O_WDN + 32 * MB;
constexpr size_t O_MIX = O_HB + 32 * MB;
constexpr size_t O_E = O_MIX + 32 * MB;
constexpr size_t SZ_E = al256((size_t)NT * PW0 * 2);
constexpr size_t O_F = O_E + SZ_E;
constexpr size_t WS_NEED = O_F + 48 * MB;
constexpr size_t O_HMID = O_MIX;
constexpr size_t O_PROJ = O_E;
constexpr size_t O_MOEOUT = O_E;
constexpr size_t O_CHP = O_E;
constexpr size_t O_CHL = O_E + 32 * MB;
constexpr size_t O_QR = O_F;
constexpr size_t O_KSR = O_F + 16 * MB;
constexpr size_t O_KWR = O_F + 20 * MB;
constexpr size_t O_OCMP = O_F + 24 * MB;
constexpr size_t O_VST = O_F + 40 * MB;
constexpr size_t O_VWT = O_F + 44 * MB;
constexpr size_t O_RW_W = O_HB;
constexpr size_t O_RW_R = O_F;
constexpr size_t O_RW_K = O_F + 16 * MB;
constexpr size_t O_RW_V = O_F + 32 * MB;
constexpr size_t O_RW_A = O_WGU;
constexpr size_t O_RW_B = O_WGU + 16 * MB;
constexpr size_t O_RW_G = O_WDN;

struct Params {
  const float* in[33];
  float* out;
  char* ws;
  unsigned long long ws_size;
};

enum { I_X = 0, I_C, I_ADAW, I_ADAB, I_NMIX, I_NFFN, I_EWIN, I_CPOS, I_CW1, I_CW2, I_CONVW, I_EWOUT, I_OWIN, I_MU, I_W0, I_W2,
       I_A0, I_A2, I_G2, I_KK, I_KA, I_RKP, I_LNW, I_LNB, I_POOLW, I_POOLS, I_OWOUT, I_RTW, I_RTB, I_MG, I_MU_, I_MD, I_FN };

DI int tid_opaque() { int t = threadIdx.x; asm volatile("" : "+v"(t)); return t; }
DI float bf2f(bfr u) { return __uint_as_float(((unsigned)u) << 16); }
DI bfr f2bf(float x) { unsigned u = __float_as_uint(x); u += 0x7fffu + ((u >> 16) & 1u); return (bfr)(u >> 16); }
typedef __attribute__((ext_vector_type(2))) float f32x2_;
DI unsigned pack2(float a, float b) { f32x2_ x = {a, b}; return __builtin_bit_cast(unsigned, __builtin_convertvector(x, bf2v)); }
DI float lo2f(unsigned u) { return __uint_as_float(u << 16); }
DI float hi2f(unsigned u) { return __uint_as_float(u & 0xffff0000u); }
DI float wave_sum(float v) {
#pragma unroll
  for (int o = 32; o > 0; o >>= 1) v += __shfl_xor(v, o);
  return v;
}
DI float sigmoidf_(float x) { return 1.f / (1.f + __expf(-x)); }
DI float dot2(unsigned a, unsigned b, float c) {
  return __builtin_amdgcn_fdot2_f32_bf16(__builtin_bit_cast(bf2v, a), __builtin_bit_cast(bf2v, b), c, false);
}

#define XB_TMO      128
#define XB_XCNT(j)  (256  + 64 * (j))
#define XB_XSUB(j)  (1280 + 64 * (j))
#define XB_XGEN(j)  (2304 + 64 * (j))
#define XB_TOP      3328
#define XB_TOPGEN   3392
#define XCD_BAR_WORDS 3456
#define XB_SPIN_CAP (1u << 22)
#define LAS __attribute__((address_space(3)))
DI unsigned xb_ld(unsigned* p) { return __hip_atomic_load(p, __ATOMIC_RELAXED, __HIP_MEMORY_SCOPE_AGENT); }
DI unsigned xb_add(unsigned* p, unsigned v) { return __hip_atomic_fetch_add(p, v, __ATOMIC_RELAXED, __HIP_MEMORY_SCOPE_AGENT); }
DI unsigned xb_xcc_id() { return (unsigned)__builtin_amdgcn_s_getreg((3 << 11) | 20) & 0xFu; }
#define XB_SPIN(cond, bar) do { unsigned _sp = 0; while (cond) { __builtin_amdgcn_s_sleep(1); \
    if ((++_sp & 255u) == 0u) { if (xb_ld(&(bar)[XB_TMO])) break; if (_sp > XB_SPIN_CAP) { atomicAdd(&(bar)[XB_TMO], 1u); break; } } } } while (0)
struct XcdBarrier { unsigned* bar; unsigned x; volatile LAS unsigned* st; };
DI XcdBarrier xcd_barrier_post(unsigned* bar, volatile LAS unsigned* st) {
  XcdBarrier b; b.bar = bar; b.x = xb_xcc_id(); b.st = st;
  if (threadIdx.x == 0) (void)xb_add(&bar[XB_XCNT(b.x)], 1u);
  return b;
}
DI void xcd_barrier_complete(unsigned* bar, unsigned x, unsigned& nloc, unsigned& nx) {
  const unsigned G = gridDim.x * gridDim.y * gridDim.z;
  unsigned sum, cnt, mine, sp = 0u;
  for (;;) {
    sum = 0u; cnt = 0u; mine = 0u;
#pragma unroll
    for (unsigned j = 0; j < 16; ++j) { const unsigned c = xb_ld(&bar[XB_XCNT(j)]); sum += c; cnt += (c > 0u) ? 1u : 0u; mine = (j == x) ? c : mine; }
    if (sum == G) break;
    __builtin_amdgcn_s_sleep(1);
    if ((++sp & 255u) == 0u) { if (xb_ld(&bar[XB_TMO])) break; if (sp > XB_SPIN_CAP) { atomicAdd(&bar[XB_TMO], 1u); break; } }
  }
  nloc = mine > 0u ? mine : 1u; nx = cnt > 0u ? cnt : 1u;
}
template <bool REL = true, bool ACQ = true>
DI void xcd_barrier(const XcdBarrier& b) {
  asm volatile("s_waitcnt vmcnt(0)" ::: "memory");
  __syncthreads();
  if (threadIdx.x == 0) {
    unsigned* bar = b.bar;
    __builtin_amdgcn_s_waitcnt(0);
    unsigned nloc = b.st[0], nx = b.st[1];
    if (nloc == 0u) { xcd_barrier_complete(bar, b.x, nloc, nx); b.st[0] = nloc; b.st[1] = nx; }
    const unsigned old = xb_add(&bar[XB_XSUB(b.x)], 1u);
    const unsigned gen = old / nloc;
    if (old + 1u == (gen + 1u) * nloc) {
      if (REL) __builtin_amdgcn_fence(__ATOMIC_RELEASE, "agent");
      asm volatile("s_waitcnt vmcnt(0)" ::: "memory");
      const unsigned og = xb_add(&bar[XB_TOP], 1u);
      const unsigned tg = og / nx;
      if (og + 1u == (tg + 1u) * nx) xb_add(&bar[XB_TOPGEN], 1u);
      else XB_SPIN(xb_ld(&bar[XB_TOPGEN]) == tg, bar);
      if (ACQ) __builtin_amdgcn_fence(__ATOMIC_ACQUIRE, "agent");
      xb_add(&bar[XB_XGEN(b.x)], 1u);
      asm volatile("s_waitcnt vmcnt(0)" ::: "memory");
    } else {
      XB_SPIN(xb_ld(&bar[XB_XGEN(b.x)]) == gen, bar);
      if (ACQ) __builtin_amdgcn_fence(__ATOMIC_ACQUIRE, "agent");
      asm volatile("s_waitcnt vmcnt(0)" ::: "memory");
    }
  }
  __syncthreads();
}

struct GemmLds { bfr a[2][128][40]; bfr b[2][128][40]; };
static_assert(sizeof(GemmLds) == 40960, "lds");

template <class AF, class BF, class Epi>
DI void gemm_tile(char* smem, int nk, const AF& af, const BF& bfn, Epi&& epi) {
  GemmLds& L = *(GemmLds*)smem;
  const int tid = tid_opaque(), lane = tid & 63, wid = tid >> 6, wr = wid >> 1, wc = wid & 1, fr = lane & 15, fq = lane >> 4;
  const int lr = tid >> 2, lk = (tid & 3) * 8;
  const bfr* a0 = af.row(lr);
  const bfr* a1 = af.row(lr + 64);
  const bfr* b0 = bfn.row(lr);
  const bfr* b1 = bfn.row(lr + 64);
  f32x4 acc[4][4];
#pragma unroll
  for (int m = 0; m < 4; ++m)
#pragma unroll
    for (int n = 0; n < 4; ++n) acc[m][n] = f32x4{0.f, 0.f, 0.f, 0.f};
  uint4 ra0, ra1, rb0, rb1;
  {
    const int ka = af.koff(lk), kb = bfn.koff(lk);
    ra0 = *(const uint4*)(a0 + ka); ra1 = *(const uint4*)(a1 + ka);
    rb0 = *(const uint4*)(b0 + kb); rb1 = *(const uint4*)(b1 + kb);
  }
  *(uint4*)&L.a[0][lr][lk] = ra0; *(uint4*)&L.a[0][lr + 64][lk] = ra1;
  *(uint4*)&L.b[0][lr][lk] = rb0; *(uint4*)&L.b[0][lr + 64][lk] = rb1;
  __syncthreads();
  for (int kt = 0; kt < nk; ++kt) {
    const int cur = kt & 1;
    if (kt + 1 < nk) {
      const int k = (kt + 1) * 32 + lk;
      const int ka = af.koff(k), kb = bfn.koff(k);
      ra0 = *(const uint4*)(a0 + ka); ra1 = *(const uint4*)(a1 + ka);
      rb0 = *(const uint4*)(b0 + kb); rb1 = *(const uint4*)(b1 + kb);
    }
    bf16x8 fa[4], fb[4];
#pragma unroll
    for (int m = 0; m < 4; ++m) fa[m] = *(const bf16x8*)&L.a[cur][wr * 64 + m * 16 + fr][fq * 8];
#pragma unroll
    for (int n = 0; n < 4; ++n) fb[n] = *(const bf16x8*)&L.b[cur][wc * 64 + n * 16 + fr][fq * 8];
#pragma unroll
    for (int m = 0; m < 4; ++m)
#pragma unroll
      for (int n = 0; n < 4; ++n) acc[m][n] = __builtin_amdgcn_mfma_f32_16x16x32_bf16(fa[m], fb[n], acc[m][n], 0, 0, 0);
    if (kt + 1 < nk) {
      *(uint4*)&L.a[cur ^ 1][lr][lk] = ra0; *(uint4*)&L.a[cur ^ 1][lr + 64][lk] = ra1;
      *(uint4*)&L.b[cur ^ 1][lr][lk] = rb0; *(uint4*)&L.b[cur ^ 1][lr + 64][lk] = rb1;
    }
    __syncthreads();
  }
  epi(acc, wr, wc, fr, fq);
}

struct RowsContig {
  const bfr* base; int ld; int maxrow;
  DI const bfr* row(int r) const { return base + (size_t)(r < maxrow ? r : maxrow) * ld; }
  DI int koff(int k) const { return k; }
};

DI int remap_col(int mode, int n) {
  if (mode == 1) return n < 1280 ? n : (n < 1304 ? C_GL + (n - 1280) : n - 24);
  if (mode == 2) return ((n >> 4) << 5) + (n & 15);
  if (mode == 3) return ((n >> 4) << 5) + 16 + (n & 15);
  return n;
}

DI void conv_tile(char* smem, const float* __restrict__ src, int ldsrc, int Ndim, int k0, int n0, bfr* dst, int ldd, int mode) {
  float(*t)[65] = (float(*)[65])smem;
  const int tid = tid_opaque();
  {
    const int n = tid & 63, kq = tid >> 6;
    const int nn = n0 + n;
#pragma unroll
    for (int i = 0; i < 16; ++i) {
      const int k = i * 4 + kq;
      t[k][n] = (nn < Ndim) ? src[(size_t)(k0 + k) * ldsrc + nn] : 0.f;
    }
  }
  __syncthreads();
  {
    const int nl = tid >> 2, kc = (tid & 3) * 16;
    const int nn = n0 + nl;
    if (nn < Ndim) {
      const int dr = remap_col(mode, nn);
      unsigned w[8];
#pragma unroll
      for (int i = 0; i < 8; ++i) w[i] = pack2(t[kc + 2 * i][nl], t[kc + 2 * i + 1][nl]);
      uint4* d = (uint4*)(dst + (size_t)dr * ldd + k0 + kc);
      d[0] = make_uint4(w[0], w[1], w[2], w[3]);
      d[1] = make_uint4(w[4], w[5], w[6], w[7]);
    }
  }
  __syncthreads();
}

constexpr int PREP_MOD = 192, PREP_ROPE = 256, PREP_MISC = 3;
constexpr int T_EIN = 16 * 45, T_SQ = 256, T_OIN = 16 * 36, T_C1 = 128, T_C2 = 4, T_G = 128, T_D = 128;
constexpr int PREP_CONV0 = PREP_MOD + PREP_ROPE + PREP_MISC;
constexpr int PREP_TOTAL = PREP_CONV0 + T_EIN + T_SQ + T_OIN + T_SQ + 2 * T_C1 + 2 * T_C2 + 32 * (2 * T_G + T_D);

DI void prep_item(const Params& p, char* smem, int item) {
  const int tid = tid_opaque();
  char* ws = p.ws;
  if (item < PREP_MOD) {
    const int layer = item / 96, cch = item % 96;
    float* cond = (float*)smem;
    float* red = (float*)(smem + 32768);
    const float* c = p.in[I_C];
    for (int i = tid; i < 8192; i += 256) {
      const int b = i >> 10, k = i & 1023;
      const float v = c[i];
      cond[k * 8 + b] = v / (1.f + __expf(-v));
    }
    __syncthreads();
    const int col = cch * 64 + (tid & 63), kg = tid >> 6;
    const float* w = p.in[I_ADAW] + (size_t)layer * 1024 * 6144 + col;
    float acc[8] = {0, 0, 0, 0, 0, 0, 0, 0};
#pragma unroll 8
    for (int k = kg * 256; k < kg * 256 + 256; ++k) {
      const float wv = w[(size_t)k * 6144];
      const float4 c0 = *(const float4*)&cond[k * 8], c1 = *(const float4*)&cond[k * 8 + 4];
      acc[0] += c0.x * wv; acc[1] += c0.y * wv; acc[2] += c0.z * wv; acc[3] += c0.w * wv;
      acc[4] += c1.x * wv; acc[5] += c1.y * wv; acc[6] += c1.z * wv; acc[7] += c1.w * wv;
    }
#pragma unroll
    for (int b = 0; b < 8; ++b) red[(kg * 8 + b) * 64 + (tid & 63)] = acc[b];
    __syncthreads();
    for (int i = tid; i < 512; i += 256) {
      const int b = i >> 6, cc = i & 63;
      const float s = red[(0 * 8 + b) * 64 + cc] + red[(1 * 8 + b) * 64 + cc] + red[(2 * 8 + b) * 64 + cc] + red[(3 * 8 + b) * 64 + cc];
      const int cg_ = cch * 64 + cc;
      ((float*)(ws + O_MOD))[(layer * 8 + b) * 6144 + cg_] = s + p.in[I_ADAB][layer * 6144 + cg_];
    }
    __syncthreads();
    return;
  }
  item -= PREP_MOD;
  if (item < PREP_ROPE) {
    const int e = item * 256 + tid;
    const int t = e >> 5, i = e & 31;
    const float inv = powf(10000.f, -(float)i / 32.f);
    const float ang = (float)t * inv;
    float* rp = (float*)(ws + O_ROPE);
    rp[e] = cosf(ang);
    rp[65536 + e] = sinf(ang);
    return;
  }
  item -= PREP_ROPE;
  if (item < PREP_MISC) {
    if (item < 2) {
      const int j = item, n = tid;
      const float* pos = p.in[I_CPOS] + j * 2048;
      const float* w1 = p.in[I_CW1] + (size_t)j * 2048 * 256 + n;
      float s = 0.f;
      for (int k = 0; k < 2048; ++k) s += pos[k] * w1[(size_t)k * 256];
      ((float*)(ws + O_BIAS1))[j * 256 + n] = s;
    } else {
      int* cnt = (int*)(ws + O_CNT);
      for (int i = tid; i < 2 * 16 * 64; i += 256) cnt[i] = 0;
      uint4* vct = (uint4*)(ws + O_VCT);
      for (int i = tid; i < 8 * 2 * 64 * 128 * 2 / 16; i += 256) vct[i] = make_uint4(0, 0, 0, 0);
      unsigned* barw = (unsigned*)(ws + O_BAR);
      for (int i = tid; i < XCD_BAR_WORDS; i += 256) barw[i] = 0u;
      uint4 z = make_uint4(0, 0, 0, 0);
      uint4* wpad = (uint4*)(ws + O_WEIN + (size_t)2840 * 1024 * 2);
      for (int i = tid; i < 104 * 1024 * 2 / 16; i += 256) wpad[i] = z;
      for (int j = 0; j < 2; ++j) {
        uint4* cp = (uint4*)(ws + O_WC2 + ((size_t)j * 128 + 64) * 256 * 2);
        for (int i = tid; i < 64 * 256 * 2 / 16; i += 256) cp[i] = z;
      }
    }
    return;
  }
  item -= PREP_MISC;
  if (item < T_EIN) { conv_tile(smem, p.in[I_EWIN], 2840, 2840, (item / 45) * 64, (item % 45) * 64, (bfr*)(ws + O_WEIN), 1024, 1); return; }
  item -= T_EIN;
  if (item < T_SQ) { conv_tile(smem, p.in[I_EWOUT], 1024, 1024, (item / 16) * 64, (item % 16) * 64, (bfr*)(ws + O_WEOUT), 1024, 0); return; }
  item -= T_SQ;
  if (item < T_OIN) { conv_tile(smem, p.in[I_OWIN], 2304, 2304, (item / 36) * 64, (item % 36) * 64, (bfr*)(ws + O_WOIN), 1024, 0); return; }
  item -= T_OIN;
  if (item < T_SQ) { conv_tile(smem, p.in[I_OWOUT], 1024, 1024, (item / 16) * 64, (item % 16) * 64, (bfr*)(ws + O_WOOUT), 1024, 0); return; }
  item -= T_SQ;
  if (item < 2 * T_C1) {
    const int j = item / T_C1, tt = item % T_C1;
    conv_tile(smem, p.in[I_CW1] + (size_t)j * 2048 * 256, 256, 256, (tt / 4) * 64, (tt % 4) * 64, (bfr*)(ws + O_WC1) + (size_t)j * 256 * 2048, 2048, 0);
    return;
  }
  item -= 2 * T_C1;
  if (item < 2 * T_C2) {
    const int j = item / T_C2, tt = item % T_C2;
    conv_tile(smem, p.in[I_CW2] + (size_t)j * 256 * 64, 64, 64, tt * 64, 0, (bfr*)(ws + O_WC2) + (size_t)j * 128 * 256, 256, 0);
    return;
  }
  item -= 2 * T_C2;
  {
    const int le = item / (2 * T_G + T_D), tt = item % (2 * T_G + T_D);
    if (tt < T_G) {
      conv_tile(smem, p.in[I_MG] + (size_t)le * 1024 * 512, 512, 512, (tt / 8) * 64, (tt % 8) * 64, (bfr*)(ws + O_WGU) + (size_t)le * 1024 * 1024, 1024, 2);
    } else if (tt < 2 * T_G) {
      const int t2 = tt - T_G;
      conv_tile(smem, p.in[I_MU_] + (size_t)le * 1024 * 512, 512, 512, (t2 / 8) * 64, (t2 % 8) * 64, (bfr*)(ws + O_WGU) + (size_t)le * 1024 * 1024, 1024, 3);
    } else {
      const int t2 = tt - 2 * T_G;
      conv_tile(smem, p.in[I_MD] + (size_t)le * 512 * 1024, 1024, 1024, (t2 / 16) * 64, (t2 % 16) * 64, (bfr*)(ws + O_WDN) + (size_t)le * 1024 * 512, 512, 0);
    }
  }
}

template <int MODE, bool ROUTER>
DI void norm_phase(const Params& p, char* smem, const float* xin, float* xout, const float* nw, const float* modl,
                   int sh_off, int sc_off, int g_off, int layer) {
  char* ws = p.ws;
  const int tid = tid_opaque(), lane = tid & 63, wid = tid >> 6;
  bfr* HB = (bfr*)(ws + O_HB);
  const bfr* MO0 = (const bfr*)(ws + O_MOEOUT);
  const bfr* MO1 = MO0 + (size_t)NT * 1024;
  int* lcnt = (int*)smem;
  int* lbase = lcnt + 16;
  int* lexp = lbase + 16;
  int* lrank = lexp + 64;
  for (int chunk = blockIdx.x; chunk < NT / 32; chunk += gridDim.x) {
    if (ROUTER) {
      if (tid < 16) lcnt[tid] = 0;
      __syncthreads();
    }
    for (int it = 0; it < 8; ++it) {
      const int row = chunk * 32 + it * 4 + wid;
      const int b = row >> 11;
      float v[16];
      float ss = 0.f;
#pragma unroll
      for (int i = 0; i < 4; ++i) {
        const int c = (i * 64 + lane) * 4;
        float4 x = *(const float4*)(xin + (size_t)row * 1024 + c);
        if (MODE >= 1) {
          const float4 g = *(const float4*)(modl + b * 6144 + g_off + c);
          const uint2 m0 = *(const uint2*)(MO0 + (size_t)row * 1024 + c);
          const uint2 m1 = *(const uint2*)(MO1 + (size_t)row * 1024 + c);
          x.x += g.x * (lo2f(m0.x) + lo2f(m1.x));
          x.y += g.y * (hi2f(m0.x) + hi2f(m1.x));
          x.z += g.z * (lo2f(m0.y) + lo2f(m1.y));
          x.w += g.w * (hi2f(m0.y) + hi2f(m1.y));
          if (MODE == 1) *(float4*)(xout + (size_t)row * 1024 + c) = x;
        }
        v[i * 4 + 0] = x.x; v[i * 4 + 1] = x.y; v[i * 4 + 2] = x.z; v[i * 4 + 3] = x.w;
        ss += x.x * x.x + x.y * x.y + x.z * x.z + x.w * x.w;
      }
      ss = wave_sum(ss);
      const float rstd = rsqrtf(ss * (1.f / 1024.f) + 1e-6f);
#pragma unroll
      for (int i = 0; i < 4; ++i) {
        const int c = (i * 64 + lane) * 4;
        const float4 w = *(const float4*)(nw + c);
        if (MODE == 2) {
          float4 o;
          o.x = v[i * 4 + 0] * rstd * w.x; o.y = v[i * 4 + 1] * rstd * w.y; o.z = v[i * 4 + 2] * rstd * w.z; o.w = v[i * 4 + 3] * rstd * w.w;
          *(float4*)(xout + (size_t)row * 1024 + c) = o;
        } else {
          const float4 sc = *(const float4*)(modl + b * 6144 + sc_off + c);
          const float4 sh = *(const float4*)(modl + b * 6144 + sh_off + c);
          v[i * 4 + 0] = v[i * 4 + 0] * rstd * w.x * (1.f + sc.x) + sh.x;
          v[i * 4 + 1] = v[i * 4 + 1] * rstd * w.y * (1.f + sc.y) + sh.y;
          v[i * 4 + 2] = v[i * 4 + 2] * rstd * w.z * (1.f + sc.z) + sh.z;
          v[i * 4 + 3] = v[i * 4 + 3] * rstd * w.w * (1.f + sc.w) + sh.w;
          uint2 o;
          o.x = pack2(v[i * 4 + 0], v[i * 4 + 1]);
          o.y = pack2(v[i * 4 + 2], v[i * 4 + 3]);
          *(uint2*)(HB + (size_t)row * 1024 + c) = o;
        }
      }
      if (ROUTER) {
        float* hrow = (float*)(smem + 1024) + wid * 1024;
#pragma unroll
        for (int i = 0; i < 4; ++i) {
          const int c = (i * 64 + lane) * 4;
          *(float4*)(hrow + c) = make_float4(v[i * 4], v[i * 4 + 1], v[i * 4 + 2], v[i * 4 + 3]);
        }
        __builtin_amdgcn_fence(__ATOMIC_RELEASE, "wavefront");
        __builtin_amdgcn_wave_barrier();
        const float* rw = p.in[I_RTW];
        const int ee = lane & 15, kq = lane >> 4;
        float part = 0.f;
#pragma unroll 8
        for (int k = kq * 256; k < kq * 256 + 256; ++k) part += hrow[k] * rw[k * 16 + ee];
        part += __shfl_xor(part, 16);
        part += __shfl_xor(part, 32);
        __builtin_amdgcn_wave_barrier();
        float sc[16], bi[16];
#pragma unroll
        for (int e = 0; e < 16; ++e) {
          const float lgv = __shfl(part, e);
          sc[e] = 1.f / (1.f + expf(-lgv));
          bi[e] = sc[e] + p.in[I_RTB][e];
        }
        int tg = 0; float best = -3.0e38f;
#pragma unroll
        for (int g = 0; g < 4; ++g) {
          float m1 = -3.0e38f, m2 = -3.0e38f;
#pragma unroll
          for (int j = 0; j < 4; ++j) {
            const float x = bi[g * 4 + j];
            if (x > m1) { m2 = m1; m1 = x; } else if (x > m2) { m2 = x; }
          }
          const float gs = m1 + m2;
          if (gs > best) { best = gs; tg = g; }
        }
        int i0 = -1, i1 = -1; float b0 = -3.0e38f, b1 = -3.0e38f, s0 = 0.f, s1 = 0.f;
#pragma unroll
        for (int e = 0; e < 16; ++e) {
          if ((e >> 2) == tg) {
            const float x = bi[e];
            if (x > b0) { b1 = b0; i1 = i0; s1 = s0; b0 = x; i0 = e; s0 = sc[e]; }
            else if (x > b1) { b1 = x; i1 = e; s1 = sc[e]; }
          }
        }
        if (lane == 0) {
          const float inv = 1.f / (s0 + s1);
          float* topw = (float*)(ws + O_TOPW);
          topw[row * 2 + 0] = s0 * inv;
          topw[row * 2 + 1] = s1 * inv;
          const int a = (it * 4 + wid) * 2;
          lexp[a] = i0; lrank[a] = atomicAdd(&lcnt[i0], 1);
          lexp[a + 1] = i1; lrank[a + 1] = atomicAdd(&lcnt[i1], 1);
        }
      }
    }
    if (ROUTER) {
      __syncthreads();
      int* cnt = (int*)(ws + O_CNT) + layer * 16 * 64;
      if (tid < 16) lbase[tid] = atomicAdd(&cnt[tid * 64], lcnt[tid]);
      __syncthreads();
      if (tid < 64) {
        const int e = lexp[tid];
        const int slot = lbase[e] + lrank[tid];
        ((int*)(ws + O_LIST))[(size_t)e * NT + slot] = (chunk * 32 + (tid >> 1)) * 2 + (tid & 1);
      }
      __syncthreads();
    }
  }
}

DI void gemm_proj_phase(const Params& p, char* smem, const bfr* Wt, int ncols_pad, bfr* out) {
  const bfr* HB = (const bfr*)(p.ws + O_HB);
  const int n_nt = ncols_pad / 128;
  const int ntiles = (NT / 128) * n_nt;
  for (int tile = blockIdx.x; tile < ntiles; tile += gridDim.x) {
    const int mt = tile / n_nt, nt = tile % n_nt;
    RowsContig A{HB + (size_t)mt * 128 * 1024, 1024, 127};
    RowsContig B{Wt + (size_t)nt * 128 * 1024, 1024, 127};
    gemm_tile(smem, 32, A, B, [&](f32x4(&acc)[4][4], int wr, int wc, int fr, int fq) {
#pragma unroll
      for (int m = 0; m < 4; ++m)
#pragma unroll
        for (int n = 0; n < 4; ++n)
#pragma unroll
          for (int j = 0; j < 4; ++j) {
            const int row = mt * 128 + wr * 64 + m * 16 + fq * 4 + j, col = nt * 128 + wc * 64 + n * 16 + fr;
            out[(size_t)row * ncols_pad + col] = f2bf(acc[m][n][j]);
          }
    });
  }
}

DI void gemm_out_phase(const Params& p, char* smem, const bfr* Wt, const float* xin, float* xout, const float* gate  ) {
  const bfr* MIX = (const bfr*)(p.ws + O_MIX);
  const int ntiles = (NT / 128) * 8;
  for (int tile = blockIdx.x; tile < ntiles; tile += gridDim.x) {
    const int mt = tile / 8, nt = tile % 8;
    RowsContig A{MIX + (size_t)mt * 128 * 1024, 1024, 127};
    RowsContig B{Wt + (size_t)nt * 128 * 1024, 1024, 127};
    const int b = (mt * 128) >> 11;
    gemm_tile(smem, 32, A, B, [&](f32x4(&acc)[4][4], int wr, int wc, int fr, int fq) {
#pragma unroll
      for (int m = 0; m < 4; ++m)
#pragma unroll
        for (int n = 0; n < 4; ++n) {
          const int col = nt * 128 + wc * 64 + n * 16 + fr;
          const float g = gate[b * 6144 + col];
#pragma unroll
          for (int j = 0; j < 4; ++j) {
            const int row = mt * 128 + wr * 64 + m * 16 + fq * 4 + j;
            xout[(size_t)row * 1024 + col] = xin[(size_t)row * 1024 + col] + g * acc[m][n][j];
          }
        }
    });
  }
}

struct RowsCmp {
  const bfr* proj; int colbase; int mt;
  DI const bfr* row(int r) const {
    int rr = mt * 128 + r; if (rr > 2031) rr = 2031;
    const int h = rr & 1, bn = rr >> 1, b = bn / 127, nc = bn % 127;
    return proj + (size_t)(b * SEQ + nc * 16) * PW0 + colbase + h * 64;
  }
  DI int koff(int k) const { return (k >> 6) * PW0 + (k & 63); }
};

DI float gelu_tanh(float x) {
  const float u = 0.7978845608028654f * (x + 0.044715f * x * x * x);
  return 0.5f * x * (1.f + tanhf(u));
}

DI void post0_phase(const Params& p, char* smem) {
  char* ws = p.ws;
  const bfr* PROJ = (const bfr*)(ws + O_PROJ);
  const int tid = tid_opaque();
  for (int tile = blockIdx.x; tile < 64; tile += gridDim.x) {
    const int j = tile >> 5, mt = (tile >> 1) & 15, nt = tile & 1;
    RowsCmp A{PROJ, j ? C_VC : C_KC, mt};
    RowsContig B{(const bfr*)(ws + O_WC1) + ((size_t)j * 256 + nt * 128) * 2048, 2048, 127};
    bfr* CH = (bfr*)(ws + O_CH) + (size_t)j * 2048 * 256;
    const float* bias = (const float*)(ws + O_BIAS1) + j * 256;
    gemm_tile(smem, 64, A, B, [&](f32x4(&acc)[4][4], int wr, int wc, int fr, int fq) {
#pragma unroll
      for (int m = 0; m < 4; ++m)
#pragma unroll
        for (int n = 0; n < 4; ++n) {
          const int col = nt * 128 + wc * 64 + n * 16 + fr;
          const float bb = bias[col];
#pragma unroll
          for (int jj = 0; jj < 4; ++jj) {
            const int row = mt * 128 + wr * 64 + m * 16 + fq * 4 + jj;
            CH[(size_t)row * 256 + col] = f2bf(gelu_tanh(acc[m][n][jj] + bb));
          }
        }
    });
  }
  {
    bfr(*tt)[66] = (bfr(*)[66])smem;
    for (int item = blockIdx.x; item < 1024; item += gridDim.x) {
      const int tl = item & 31, hk = (item >> 5) & 1, which = (item >> 6) & 1, b = item >> 7;
      const bfr* src = PROJ + (size_t)(b * SEQ + tl * 64) * PW0 + (which ? C_VW : C_VS) + hk * 64;
      bfr* dst = (bfr*)(ws + (which ? O_VWT : O_VST)) + (size_t)((b * 2 + hk) * 64) * SEQ + tl * 64;
      for (int e = tid; e < 64 * 32; e += 256) {
        const int row = e >> 5, c2 = (e & 31) * 2;
        const unsigned u = *(const unsigned*)(src + (size_t)row * PW0 + c2);
        tt[row][c2] = (bfr)(u & 0xffffu); tt[row][c2 + 1] = (bfr)(u >> 16);
      }
      __syncthreads();
      for (int e = tid; e < 64 * 32; e += 256) {
        const int d = e >> 5, t2 = (e & 31) * 2;
        const unsigned u = (unsigned)tt[t2][d] | ((unsigned)tt[t2 + 1][d] << 16);
        *(unsigned*)(dst + (size_t)d * SEQ + t2) = u;
      }
      __syncthreads();
    }
  }
  const float* ropec = (const float*)(ws + O_ROPE);
  const float* ropes = ropec + 65536;
  bfr* QR = (bfr*)(ws + O_QR);
  bfr* KSR = (bfr*)(ws + O_KSR);
  bfr* KWR = (bfr*)(ws + O_KWR);
  bfr* MIX = (bfr*)(ws + O_MIX);
  const float* cw = p.in[I_CONVW];
  for (int item = blockIdx.x; item < NT / 8; item += gridDim.x) {
    for (int tt = 0; tt < 8; ++tt) {
      const int tok = item * 8 + tt, t = tok & (SEQ - 1);
      const bfr* pr = PROJ + (size_t)tok * PW0;
      {
        const int head = tid >> 5, i = tid & 31;
        const float c = ropec[t * 32 + i], s = ropes[t * 32 + i];
        const float t1 = bf2f(pr[C_Q + head * 64 + i]), t2 = bf2f(pr[C_Q + head * 64 + 32 + i]);
        QR[(size_t)tok * 512 + head * 64 + i] = f2bf(t1 * c - t2 * s);
        QR[(size_t)tok * 512 + head * 64 + 32 + i] = f2bf(t2 * c + t1 * s);
        if (tid < 128) {
          const int which = tid >> 6, hh = (tid >> 5) & 1;
          const int cb = (which ? C_KW : C_KS) + hh * 64;
          const float k1 = bf2f(pr[cb + i]), k2 = bf2f(pr[cb + 32 + i]);
          bfr* dst = (which ? KWR : KSR) + (size_t)tok * 128 + hh * 64;
          dst[i] = f2bf(k1 * c - k2 * s);
          dst[32 + i] = f2bf(k2 * c + k1 * s);
        }
      }
#pragma unroll
      for (int h2 = 0; h2 < 2; ++h2) {
        const int ch = tid + h2 * 256;
        const float u0 = bf2f(pr[C_CG + ch]) * bf2f(pr[C_XB + ch]);
        float u1 = 0.f, u2 = 0.f;
        if (t >= 1) u1 = bf2f(pr[C_CG + ch - PW0]) * bf2f(pr[C_XB + ch - PW0]);
        if (t >= 2) u2 = bf2f(pr[C_CG + ch - 2 * PW0]) * bf2f(pr[C_XB + ch - 2 * PW0]);
        const float y = cw[2 * 512 + ch] * u0 + cw[1 * 512 + ch] * u1 + cw[0 * 512 + ch] * u2;
        MIX[(size_t)tok * 1024 + 512 + ch] = f2bf(bf2f(pr[C_BG + ch]) * y);
      }
    }
  }
}

DI void cmp2_phase(const Params& p, char* smem) {
  char* ws = p.ws;
  for (int tile = blockIdx.x; tile < 32; tile += gridDim.x) {
    const int j = tile >> 4, mt = tile & 15;
    RowsContig A{(const bfr*)(ws + O_CH) + ((size_t)j * 2048 + mt * 128) * 256, 256, 127};
    RowsContig B{(const bfr*)(ws + O_WC2) + (size_t)j * 128 * 256, 256, 127};
    bfr* KC = (bfr*)(ws + O_KCVC) + (size_t)j * 2048 * 64;
    gemm_tile(smem, 8, A, B, [&](f32x4(&acc)[4][4], int wr, int wc, int fr, int fq) {
      if (wc == 0) {
#pragma unroll
        for (int m = 0; m < 4; ++m)
#pragma unroll
          for (int n = 0; n < 4; ++n)
#pragma unroll
            for (int jj = 0; jj < 4; ++jj) {
              const int row = mt * 128 + wr * 64 + m * 16 + fq * 4 + jj, col = n * 16 + fr;
              const bfr hv = f2bf(acc[m][n][jj]);
              KC[(size_t)row * 64 + col] = hv;
              if (j == 1 && row < 2032) {
                const int hk = row & 1, bn = row >> 1, bb = bn / 127, cc = bn % 127;
                ((bfr*)(ws + O_VCT))[((size_t)((bb * 2 + hk) * 64 + col)) * 128 + cc] = hv;
              }
            }
      }
    });
  }
}

DI void cmp_attn_phase(const Params& p, char* smem) {
  char* ws = p.ws;
  const bfr* PROJ = (const bfr*)(ws + O_PROJ);
  const bfr* KC = (const bfr*)(ws + O_KCVC);
  const bfr* VC = KC + 2048 * 64;
  bfr* OCMP = (bfr*)(ws + O_OCMP);
  unsigned* SEL = (unsigned*)(ws + O_SEL);
  const int tid = tid_opaque();
  for (int item = blockIdx.x; item < NT / 32; item += gridDim.x) {
    const int tok = item * 32 + (tid >> 3), head = tid & 7, hkv = head >> 2;
    const int b = tok >> 11, t = tok & (SEQ - 1);
    const int nv = t >= 31 ? ((t - 31) >> 4) + 1 : 0;
    unsigned q[32];
    {
      const uint4* qp = (const uint4*)(PROJ + (size_t)tok * PW0 + C_Q + head * 64);
#pragma unroll
      for (int i = 0; i < 8; ++i) { const uint4 u = qp[i]; q[i * 4] = u.x; q[i * 4 + 1] = u.y; q[i * 4 + 2] = u.z; q[i * 4 + 3] = u.w; }
    }
    const bfr* kb = KC + ((size_t)(b * 127) * 2 + hkv) * 64;
    const bfr* vb = VC + ((size_t)(b * 127) * 2 + hkv) * 64;
    auto dotk = [&](int c) {
      const uint4* kp = (const uint4*)(kb + (size_t)c * 128);
      float a = 0.f;
#pragma unroll
      for (int i = 0; i < 8; ++i) {
        const uint4 u = kp[i];
        a = dot2(q[i * 4], u.x, a); a = dot2(q[i * 4 + 1], u.y, a); a = dot2(q[i * 4 + 2], u.z, a); a = dot2(q[i * 4 + 3], u.w, a);
      }
      return a * 0.125f;
    };
    float mx = -1e30f;
    for (int c = 0; c < nv; ++c) mx = fmaxf(mx, dotk(c));
    float o[64];
#pragma unroll
    for (int i = 0; i < 64; ++i) o[i] = 0.f;
    float l = 0.f;
    for (int c = 0; c < nv; ++c) {
      const float pe = __expf(dotk(c) - mx);
      l += pe;
      const uint4* vp = (const uint4*)(vb + (size_t)c * 128);
#pragma unroll
      for (int i = 0; i < 8; ++i) {
        const uint4 u = vp[i];
        o[i * 8 + 0] += pe * lo2f(u.x); o[i * 8 + 1] += pe * hi2f(u.x);
        o[i * 8 + 2] += pe * lo2f(u.y); o[i * 8 + 3] += pe * hi2f(u.y);
        o[i * 8 + 4] += pe * lo2f(u.z); o[i * 8 + 5] += pe * hi2f(u.z);
        o[i * 8 + 6] += pe * lo2f(u.w); o[i * 8 + 7] += pe * hi2f(u.w);
      }
    }
    const float invl = nv > 0 ? 1.f / l : 0.f;
    {
      const float gl = bf2f(PROJ[(size_t)tok * PW0 + C_GL + head * 3 + 0]);
      const float g0 = sigmoidf_(gl) * invl;
      uint4* op = (uint4*)(OCMP + (size_t)tok * 512 + head * 64);
#pragma unroll
      for (int i = 0; i < 8; ++i) {
        uint4 u;
        u.x = pack2(o[i * 8 + 0] * g0, o[i * 8 + 1] * g0); u.y = pack2(o[i * 8 + 2] * g0, o[i * 8 + 3] * g0);
        u.z = pack2(o[i * 8 + 4] * g0, o[i * 8 + 5] * g0); u.w = pack2(o[i * 8 + 6] * g0, o[i * 8 + 7] * g0);
        op[i] = u;
      }
    }
    const int cur = t >> 6;
    float tv0 = -1.f, tv1 = -1.f, tv2 = -1.f, tv3 = -1.f, tv4 = -1.f;
    int ti0 = -1, ti1 = -1, ti2 = -1, ti3 = -1, ti4 = -1;
    float part = 0.f;
    int curmax = cur;
#pragma unroll
    for (int o2 = 32; o2 > 0; o2 >>= 1) curmax = max(curmax, __shfl_xor(curmax, o2));
#pragma unroll 1
    for (int j = 0; j <= curmax + 1 && j <= 32; ++j) {
      float e[4];
#pragma unroll
      for (int oo = 0; oo < 4; ++oo) {
        const int c = j * 4 + oo;
        float pe = 0.f;
        if (c < nv) pe = __expf(dotk(c) - mx) * invl;
        pe += __shfl_xor(pe, 1);
        pe += __shfl_xor(pe, 2);
        e[oo] = pe;
      }
      if (j >= 1) {
        const float val = part + e[0];
        const int jb = j - 1;
        if (jb >= 1 && jb <= cur - 2) {
          if (val > tv4) {
            tv4 = val; ti4 = jb;
            if (tv4 > tv3) { float tf = tv3; tv3 = tv4; tv4 = tf; int tii = ti3; ti3 = ti4; ti4 = tii; }
            if (tv3 > tv2) { float tf = tv2; tv2 = tv3; tv3 = tf; int tii = ti2; ti2 = ti3; ti3 = tii; }
            if (tv2 > tv1) { float tf = tv1; tv1 = tv2; tv2 = tf; int tii = ti1; ti1 = ti2; ti2 = tii; }
            if (tv1 > tv0) { float tf = tv0; tv0 = tv1; tv1 = tf; int tii = ti0; ti0 = ti1; ti1 = tii; }
          }
        }
      }
      part = e[0] + 2.f * (e[1] + e[2] + e[3]);
    }
    unsigned mask = 1u | (1u << cur);
    if (cur >= 1) mask |= 1u << (cur - 1);
    if (ti0 >= 0) mask |= 1u << ti0;
    if (ti1 >= 0) mask |= 1u << ti1;
    if (ti2 >= 0) mask |= 1u << ti2;
    if (ti3 >= 0) mask |= 1u << ti3;
    if (ti4 >= 0) mask |= 1u << ti4;
    if ((head & 3) == 0) SEL[tok * 2 + hkv] = mask;
  }
}

DI void slcwin_phase(const Params& p, char* smem) {
  char* ws = p.ws;
  const bfr* PROJ = (const bfr*)(ws + O_PROJ);
  const bfr* QR = (const bfr*)(ws + O_QR);
  const bfr* KSR = (const bfr*)(ws + O_KSR);
  const bfr* KWR = (const bfr*)(ws + O_KWR);
  const bfr* OCMP = (const bfr*)(ws + O_OCMP);
  const unsigned* SEL = (const unsigned*)(ws + O_SEL);
  bfr* MIX = (bfr*)(ws + O_MIX);
  const int tid = tid_opaque(), lane = tid & 63, wid = tid >> 6;
  for (int item = blockIdx.x; item < 512; item += gridDim.x) {
    const int tile = 31 - (item >> 4), bh = item & 15, b = bh >> 1, hkv = bh & 1;
    const int t = tile * 64 + lane, tok = b * SEQ + t, head = hkv * 4 + wid;
    unsigned q[32];
    {
      const uint4* qp = (const uint4*)(QR + (size_t)tok * 512 + head * 64);
#pragma unroll
      for (int i = 0; i < 8; ++i) { const uint4 u = qp[i]; q[i * 4] = u.x; q[i * 4 + 1] = u.y; q[i * 4 + 2] = u.z; q[i * 4 + 3] = u.w; }
    }
    const unsigned sel = SEL[tok * 2 + hkv];
#pragma unroll 1
    for (int pass = 0; pass < 2; ++pass) {
      const bfr* Kb = (pass == 0 ? KSR : KWR) + (size_t)b * SEQ * 128 + hkv * 64;
      const bfr* Vb = PROJ + (size_t)b * SEQ * PW0 + (pass == 0 ? C_VS : C_VW) + hkv * 64;
      float o[64];
#pragma unroll
      for (int i = 0; i < 64; ++i) o[i] = 0.f;
      float m = -1e30f, l = 0.f;
      const int jlo = pass == 0 ? 0 : (tile >= 8 ? tile - 8 : 0);
#pragma unroll 1
      for (int j = jlo; j <= tile; ++j) {
        const bool lane_ok = pass == 0 ? ((sel >> j) & 1u) != 0 : true;
        if (pass == 0 && !__any(lane_ok)) continue;
#pragma unroll 1
        for (int kb = 0; kb < 64; kb += 4) {
          float s[4];
#pragma unroll
          for (int kk = 0; kk < 4; ++kk) {
            const int key = j * 64 + kb + kk;
            const uint4* kp = (const uint4*)(Kb + (size_t)key * 128);
            float a = 0.f;
#pragma unroll
            for (int i = 0; i < 8; ++i) {
              const uint4 u = kp[i];
              a = dot2(q[i * 4], u.x, a); a = dot2(q[i * 4 + 1], u.y, a); a = dot2(q[i * 4 + 2], u.z, a); a = dot2(q[i * 4 + 3], u.w, a);
            }
            bool ok = lane_ok && key <= t;
            if (pass == 1) ok = ok && (t - key < 512);
            s[kk] = ok ? a * 0.125f : -1e30f;
          }
          const float cm = fmaxf(fmaxf(s[0], s[1]), fmaxf(s[2], s[3]));
          const float mn = fmaxf(m, cm);
          const float corr = __expf(m - mn);
          m = mn;
          float pe[4];
#pragma unroll
          for (int kk = 0; kk < 4; ++kk) pe[kk] = s[kk] > -1e29f ? __expf(s[kk] - mn) : 0.f;
          l = l * corr + (pe[0] + pe[1] + pe[2] + pe[3]);
#pragma unroll
          for (int i = 0; i < 64; ++i) o[i] *= corr;
#pragma unroll
          for (int kk = 0; kk < 4; ++kk) {
            const int key = j * 64 + kb + kk;
            const uint4* vp = (const uint4*)(Vb + (size_t)key * PW0);
#pragma unroll
            for (int i = 0; i < 8; ++i) {
              const uint4 u = vp[i];
              o[i * 8 + 0] += pe[kk] * lo2f(u.x); o[i * 8 + 1] += pe[kk] * hi2f(u.x);
              o[i * 8 + 2] += pe[kk] * lo2f(u.y); o[i * 8 + 3] += pe[kk] * hi2f(u.y);
              o[i * 8 + 4] += pe[kk] * lo2f(u.z); o[i * 8 + 5] += pe[kk] * hi2f(u.z);
              o[i * 8 + 6] += pe[kk] * lo2f(u.w); o[i * 8 + 7] += pe[kk] * hi2f(u.w);
            }
          }
        }
      }
      const float gate = sigmoidf_(bf2f(PROJ[(size_t)tok * PW0 + C_GL + head * 3 + 1 + pass]));
      const float gsc = gate * (l > 0.f ? 1.f / l : 0.f);
      uint4* op = (uint4*)(MIX + (size_t)tok * 1024 + head * 64);
      const uint4* cp = pass == 0 ? (const uint4*)(OCMP + (size_t)tok * 512 + head * 64) : (const uint4*)op;
#pragma unroll
      for (int i = 0; i < 8; ++i) {
        const uint4 c = cp[i];
        uint4 u;
        u.x = pack2(o[i * 8 + 0] * gsc + lo2f(c.x), o[i * 8 + 1] * gsc + hi2f(c.x));
        u.y = pack2(o[i * 8 + 2] * gsc + lo2f(c.y), o[i * 8 + 3] * gsc + hi2f(c.y));
        u.z = pack2(o[i * 8 + 4] * gsc + lo2f(c.z), o[i * 8 + 5] * gsc + hi2f(c.z));
        u.w = pack2(o[i * 8 + 6] * gsc + lo2f(c.w), o[i * 8 + 7] * gsc + hi2f(c.w));
        op[i] = u;
      }
    }
  }
}

using f32x16 = __attribute__((ext_vector_type(16))) float;
#define MFMA32(a, b, c) __builtin_amdgcn_mfma_f32_32x32x16_bf16((a), (b), (c), 0, 0, 0)
struct AttnLds { bfr k[2][64][72]; bfr vt[2][64][68]; };
static_assert(sizeof(AttnLds) <= 49152, "attn lds");
DI int crow16(int i, int h2) { return (i & 3) + 8 * (i >> 2) + 4 * h2; }

DI void attn_sw_phase(const Params& p, char* smem) {
  char* ws = p.ws;
  AttnLds& L = *(AttnLds*)smem;
  const bfr* PROJ = (const bfr*)(ws + O_PROJ);
  const bfr* QR = (const bfr*)(ws + O_QR);
  const bfr* OCMP = (const bfr*)(ws + O_OCMP);
  const unsigned* SEL = (const unsigned*)(ws + O_SEL);
  bfr* MIX = (bfr*)(ws + O_MIX);
  const int tid = tid_opaque(), lane = tid & 63, wid = tid >> 6, r = lane & 31, h2 = lane >> 5;
  const float CS = 0.125f * 1.4426950408889634f;
  const int lrow = tid >> 3, lc8 = (tid & 7) * 8;
  for (int item = blockIdx.x; item < 1024; item += gridDim.x) {
    const int qt = item < 512 ? 63 - (item >> 4) : ((item - 512) >> 4);
    const int bh = item & 15, b = bh >> 1, hkv = bh & 1;
    const int cur = qt >> 1;
    const int tokl = qt * 32 + wid * 8 + (r >> 2), g = r & 3, head = hkv * 4 + g, tok = b * SEQ + tokl;
    bf16x8 qf[4];
#pragma unroll
    for (int s = 0; s < 4; ++s) qf[s] = *(const bf16x8*)(QR + (size_t)tok * 512 + head * 64 + 16 * s + 8 * h2);
    const unsigned sel = SEL[tok * 2 + hkv];
    const int nslc = cur + 1, wlo = cur > 8 ? cur - 8 : 0, T = nslc + (cur - wlo + 1);
    const bfr* KS = (const bfr*)(ws + O_KSR) + (size_t)b * SEQ * 128 + hkv * 64;
    const bfr* KW = (const bfr*)(ws + O_KWR) + (size_t)b * SEQ * 128 + hkv * 64;
    const bfr* VS = (const bfr*)(ws + O_VST) + (size_t)((b * 2 + hkv) * 64) * SEQ;
    const bfr* VW = (const bfr*)(ws + O_VWT) + (size_t)((b * 2 + hkv) * 64) * SEQ;
    uint4 rk0, rk1, rv0, rv1;
    auto gload = [&](int tt) {
      const int pass = tt >= nslc, j = pass ? wlo + tt - nslc : tt;
      const bfr* kb = (pass ? KW : KS) + (size_t)(j * 64) * 128 + lc8;
      const bfr* vb = (pass ? VW : VS) + j * 64 + lc8;
      rk0 = *(const uint4*)(kb + (size_t)lrow * 128); rk1 = *(const uint4*)(kb + (size_t)(lrow + 32) * 128);
      rv0 = *(const uint4*)(vb + (size_t)lrow * SEQ); rv1 = *(const uint4*)(vb + (size_t)(lrow + 32) * SEQ);
    };
    auto lstore = [&](int buf) {
      *(uint4*)&L.k[buf][lrow][lc8] = rk0; *(uint4*)&L.k[buf][lrow + 32][lc8] = rk1;
      *(uint2*)&L.vt[buf][lrow][lc8] = make_uint2(rv0.x, rv0.y); *(uint2*)&L.vt[buf][lrow][lc8 + 4] = make_uint2(rv0.z, rv0.w);
      *(uint2*)&L.vt[buf][lrow + 32][lc8] = make_uint2(rv1.x, rv1.y); *(uint2*)&L.vt[buf][lrow + 32][lc8 + 4] = make_uint2(rv1.z, rv1.w);
    };
    gload(0); lstore(0);
    __syncthreads();
    float m = -1e30f, l = 0.f;
    f32x16 o0, o1;
#pragma unroll
    for (int i = 0; i < 16; ++i) { o0[i] = 0.f; o1[i] = 0.f; }
#pragma unroll 1
    for (int tt = 0; tt < T; ++tt) {
      const int buf = tt & 1;
      if (tt + 1 < T) gload(tt + 1);
      const int pass = tt >= nslc, j = pass ? wlo + tt - nslc : tt;
      const bool rowok = pass ? true : ((sel >> j) & 1u) != 0u;
      if (__any(rowok)) {
        f32x16 s0, s1;
#pragma unroll
        for (int i = 0; i < 16; ++i) { s0[i] = 0.f; s1[i] = 0.f; }
#pragma unroll
        for (int s = 0; s < 4; ++s) {
          const bf16x8 k0 = *(const bf16x8*)&L.k[buf][r][16 * s + 8 * h2];
          const bf16x8 k1 = *(const bf16x8*)&L.k[buf][32 + r][16 * s + 8 * h2];
          s0 = MFMA32(k0, qf[s], s0);
          s1 = MFMA32(k1, qf[s], s1);
        }
        if (!rowok) {
#pragma unroll
          for (int i = 0; i < 16; ++i) { s0[i] = -1e30f; s1[i] = -1e30f; }
        }
        if (j == cur) {
          const int lim = tokl - j * 64;
#pragma unroll
          for (int i = 0; i < 16; ++i) {
            if (crow16(i, h2) > lim) s0[i] = -1e30f;
            if (32 + crow16(i, h2) > lim) s1[i] = -1e30f;
          }
        }
        if (pass && cur >= 8 && j == cur - 8) {
          const int lo = tokl - 512 - j * 64;
#pragma unroll
          for (int i = 0; i < 16; ++i) {
            if (crow16(i, h2) <= lo) s0[i] = -1e30f;
            if (32 + crow16(i, h2) <= lo) s1[i] = -1e30f;
          }
        }
        float mx = -1e30f;
#pragma unroll
        for (int i = 0; i < 16; ++i) mx = fmaxf(mx, fmaxf(s0[i], s1[i]));
        mx = fmaxf(mx, __shfl_xor(mx, 32));
        const float mnew = fmaxf(m, mx);
        const float mu = fmaxf(mnew, -1e20f);
        const float corr = __builtin_amdgcn_exp2f((m - mu) * CS);
        m = mnew;
        const float muc = mu * CS;
        float ps = 0.f;
#pragma unroll
        for (int i = 0; i < 16; ++i) {
          s0[i] = __builtin_amdgcn_exp2f(fmaf(s0[i], CS, -muc));
          s1[i] = __builtin_amdgcn_exp2f(fmaf(s1[i], CS, -muc));
          ps += s0[i] + s1[i];
        }
        l = l * corr + ps;
#pragma unroll
        for (int i = 0; i < 16; ++i) { o0[i] *= corr; o1[i] *= corr; }
#pragma unroll
        for (int kb = 0; kb < 2; ++kb) {
#pragma unroll
          for (int s = 0; s < 2; ++s) {
            uint4 pk;
            if (kb == 0) {
              pk.x = pack2(s0[8 * s + 0], s0[8 * s + 1]); pk.y = pack2(s0[8 * s + 2], s0[8 * s + 3]);
              pk.z = pack2(s0[8 * s + 4], s0[8 * s + 5]); pk.w = pack2(s0[8 * s + 6], s0[8 * s + 7]);
            } else {
              pk.x = pack2(s1[8 * s + 0], s1[8 * s + 1]); pk.y = pack2(s1[8 * s + 2], s1[8 * s + 3]);
              pk.z = pack2(s1[8 * s + 4], s1[8 * s + 5]); pk.w = pack2(s1[8 * s + 6], s1[8 * s + 7]);
            }
            const bf16x8 pf = __builtin_bit_cast(bf16x8, pk);
            const int kc = kb * 32 + 16 * s + 4 * h2;
            const uint2 a0 = *(const uint2*)&L.vt[buf][r][kc];
            const uint2 a1 = *(const uint2*)&L.vt[buf][r][kc + 8];
            const uint2 c0 = *(const uint2*)&L.vt[buf][32 + r][kc];
            const uint2 c1 = *(const uint2*)&L.vt[buf][32 + r][kc + 8];
            const bf16x8 v0 = __builtin_bit_cast(bf16x8, make_uint4(a0.x, a0.y, a1.x, a1.y));
            const bf16x8 v1 = __builtin_bit_cast(bf16x8, make_uint4(c0.x, c0.y, c1.x, c1.y));
            o0 = MFMA32(v0, pf, o0);
            o1 = MFMA32(v1, pf, o1);
          }
        }
      }
      if (tt == nslc - 1 || tt == T - 1) {
        const float lt = l + __shfl_xor(l, 32);
        const float gate = sigmoidf_(bf2f(PROJ[(size_t)tok * PW0 + C_GL + head * 3 + 1 + pass]));
        const float sc = lt > 0.f ? gate / lt : 0.f;
        bfr* mixp = MIX + (size_t)tok * 1024 + head * 64;
        const bfr* addp = pass ? (const bfr*)mixp : OCMP + (size_t)tok * 512 + head * 64;
#pragma unroll
        for (int q4 = 0; q4 < 4; ++q4) {
          const int d0 = 8 * q4 + 4 * h2;
          const uint2 c = *(const uint2*)(addp + d0);
          uint2 u;
          u.x = pack2(o0[q4 * 4 + 0] * sc + lo2f(c.x), o0[q4 * 4 + 1] * sc + hi2f(c.x));
          u.y = pack2(o0[q4 * 4 + 2] * sc + lo2f(c.y), o0[q4 * 4 + 3] * sc + hi2f(c.y));
          *(uint2*)(mixp + d0) = u;
          const uint2 c2 = *(const uint2*)(addp + 32 + d0);
          u.x = pack2(o1[q4 * 4 + 0] * sc + lo2f(c2.x), o1[q4 * 4 + 1] * sc + hi2f(c2.x));
          u.y = pack2(o1[q4 * 4 + 2] * sc + lo2f(c2.y), o1[q4 * 4 + 3] * sc + hi2f(c2.y));
          *(uint2*)(mixp + 32 + d0) = u;
        }
#pragma unroll
        for (int i = 0; i < 16; ++i) { o0[i] = 0.f; o1[i] = 0.f; }
        m = -1e30f; l = 0.f;
      }
      if (tt + 1 < T) lstore(buf ^ 1);
      __syncthreads();
    }
  }
}

struct CmpLds { bfr k[128][72]; bfr vt[64][132]; };
static_assert(sizeof(CmpLds) <= 49152, "cmp lds");
DI float quad_sum(float x) {
  const float y = x + __int_as_float(__builtin_amdgcn_update_dpp(0, __float_as_int(x), 0xB1, 0xF, 0xF, true));
  return y + __int_as_float(__builtin_amdgcn_update_dpp(0, __float_as_int(y), 0x4E, 0xF, 0xF, true));
}

DI void cmp_attn_mfma_phase(const Params& p, char* smem) {
  char* ws = p.ws;
  CmpLds& L = *(CmpLds*)smem;
  const bfr* PROJ = (const bfr*)(ws + O_PROJ);
  const bfr* KC = (const bfr*)(ws + O_KCVC);
  const bfr* VCT = (const bfr*)(ws + O_VCT);
  bfr* OCMP = (bfr*)(ws + O_OCMP);
  unsigned* SEL = (unsigned*)(ws + O_SEL);
  const int tid = tid_opaque(), lane = tid & 63, wid = tid >> 6, r = lane & 31, h2 = lane >> 5;
  const float CS = 0.125f * 1.4426950408889634f;
  for (int item = blockIdx.x; item < 1024; item += gridDim.x) {
    const int qt = 63 - (item >> 4), bh = item & 15, b = bh >> 1, hkv = bh & 1;
    __syncthreads();
    {
      const bfr* kb = KC + ((size_t)(b * 127) * 2 + hkv) * 64;
      const bfr* vb = VCT + (size_t)((b * 2 + hkv) * 64) * 128;
#pragma unroll
      for (int i = 0; i < 4; ++i) {
        const int id = tid + i * 256;
        const int kr = id >> 3, kc = (id & 7) * 8;
        *(uint4*)&L.k[kr][kc] = *(const uint4*)(kb + (size_t)kr * 128 + kc);
        const int vr = id >> 4, vc = (id & 15) * 8;
        const uint4 v = *(const uint4*)(vb + (size_t)vr * 128 + vc);
        *(uint2*)&L.vt[vr][vc] = make_uint2(v.x, v.y);
        *(uint2*)&L.vt[vr][vc + 4] = make_uint2(v.z, v.w);
      }
    }
    __syncthreads();
    const int tokl = qt * 32 + wid * 8 + (r >> 2), g = r & 3, head = hkv * 4 + g, tok = b * SEQ + tokl;
    const int nv = tokl >= 31 ? ((tokl - 31) >> 4) + 1 : 0;
    bf16x8 qf[4];
#pragma unroll
    for (int s = 0; s < 4; ++s) qf[s] = *(const bf16x8*)(PROJ + (size_t)tok * PW0 + C_Q + head * 64 + 16 * s + 8 * h2);
    float m = -1e30f, l = 0.f;
#pragma unroll 1
    for (int kb4 = 0; kb4 < 4; ++kb4) {
      f32x16 sc;
#pragma unroll
      for (int i = 0; i < 16; ++i) sc[i] = 0.f;
#pragma unroll
      for (int s = 0; s < 4; ++s) {
        const bf16x8 kf = *(const bf16x8*)&L.k[kb4 * 32 + r][16 * s + 8 * h2];
        sc = MFMA32(kf, qf[s], sc);
      }
      float mx = -1e30f;
#pragma unroll
      for (int i = 0; i < 16; ++i) {
        if (kb4 * 32 + crow16(i, h2) >= nv) sc[i] = -1e30f;
        mx = fmaxf(mx, sc[i]);
      }
      const float mn = fmaxf(m, mx), mu = fmaxf(mn, -1e20f);
      float ps = 0.f;
#pragma unroll
      for (int i = 0; i < 16; ++i) ps += __builtin_amdgcn_exp2f((sc[i] - mu) * CS);
      l = l * __builtin_amdgcn_exp2f((m - mu) * CS) + ps;
      m = mn;
    }
    {
      const float mo = __shfl_xor(m, 32), lo = __shfl_xor(l, 32);
      const float mt = fmaxf(m, mo), mu = fmaxf(mt, -1e20f);
      l = l * __builtin_amdgcn_exp2f((m - mu) * CS) + lo * __builtin_amdgcn_exp2f((mo - mu) * CS);
      m = mu;
    }
    const float invl = l > 0.f ? 1.f / l : 0.f;
    const float muc = m * CS;
    f32x16 o0, o1;
#pragma unroll
    for (int i = 0; i < 16; ++i) { o0[i] = 0.f; o1[i] = 0.f; }
    float part[16], first[16];
#pragma unroll
    for (int kb4 = 0; kb4 < 4; ++kb4) {
      f32x16 sc;
#pragma unroll
      for (int i = 0; i < 16; ++i) sc[i] = 0.f;
#pragma unroll
      for (int s = 0; s < 4; ++s) {
        const bf16x8 kf = *(const bf16x8*)&L.k[kb4 * 32 + r][16 * s + 8 * h2];
        sc = MFMA32(kf, qf[s], sc);
      }
#pragma unroll
      for (int i = 0; i < 16; ++i) {
        const float pv = __builtin_amdgcn_exp2f(fmaf(sc[i], CS, -muc)) * invl;
        sc[i] = (kb4 * 32 + crow16(i, h2) >= nv) ? 0.f : pv;
      }
#pragma unroll
      for (int s = 0; s < 2; ++s) {
        uint4 pk;
        pk.x = pack2(sc[8 * s + 0], sc[8 * s + 1]); pk.y = pack2(sc[8 * s + 2], sc[8 * s + 3]);
        pk.z = pack2(sc[8 * s + 4], sc[8 * s + 5]); pk.w = pack2(sc[8 * s + 6], sc[8 * s + 7]);
        const bf16x8 pf = __builtin_bit_cast(bf16x8, pk);
        const int kc = kb4 * 32 + 16 * s + 4 * h2;
        const uint2 a0 = *(const uint2*)&L.vt[r][kc];
        const uint2 a1 = *(const uint2*)&L.vt[r][kc + 8];
        const uint2 c0 = *(const uint2*)&L.vt[32 + r][kc];
        const uint2 c1 = *(const uint2*)&L.vt[32 + r][kc + 8];
        o0 = MFMA32(__builtin_bit_cast(bf16x8, make_uint4(a0.x, a0.y, a1.x, a1.y)), pf, o0);
        o1 = MFMA32(__builtin_bit_cast(bf16x8, make_uint4(c0.x, c0.y, c1.x, c1.y)), pf, o1);
      }
#pragma unroll
      for (int q4 = 0; q4 < 4; ++q4) {
        const float e0 = quad_sum(sc[q4 * 4 + 0]), e1 = quad_sum(sc[q4 * 4 + 1]);
        const float e2 = quad_sum(sc[q4 * 4 + 2]), e3 = quad_sum(sc[q4 * 4 + 3]);
        part[kb4 * 4 + q4] = e0 + 2.f * (e1 + e2 + e3);
        first[kb4 * 4 + q4] = e0;
      }
      __builtin_amdgcn_sched_barrier(0);
    }
    {
      const float g0 = sigmoidf_(bf2f(PROJ[(size_t)tok * PW0 + C_GL + head * 3 + 0]));
      bfr* op = OCMP + (size_t)tok * 512 + head * 64;
#pragma unroll
      for (int q4 = 0; q4 < 4; ++q4) {
        const int d0 = 8 * q4 + 4 * h2;
        uint2 u;
        u.x = pack2(o0[q4 * 4 + 0] * g0, o0[q4 * 4 + 1] * g0); u.y = pack2(o0[q4 * 4 + 2] * g0, o0[q4 * 4 + 3] * g0);
        *(uint2*)(op + d0) = u;
        u.x = pack2(o1[q4 * 4 + 0] * g0, o1[q4 * 4 + 1] * g0); u.y = pack2(o1[q4 * 4 + 2] * g0, o1[q4 * 4 + 3] * g0);
        *(uint2*)(op + 32 + d0) = u;
      }
    }
    float val[16], oth[16];
    const float h2f = (float)h2;
    {
      float recv[17];
#pragma unroll
      for (int gi = 0; gi < 16; ++gi) recv[gi] = __shfl_xor(first[gi], 32);
      recv[16] = 0.f;
#pragma unroll
      for (int gi = 0; gi < 16; ++gi) val[gi] = part[gi] + (recv[gi] * (1.f - h2f) + recv[gi + 1] * h2f);
#pragma unroll
      for (int gi = 0; gi < 16; ++gi) oth[gi] = __shfl_xor(val[gi], 32);
    }
    const int cur = tokl >> 6;
    float cv[32];
#pragma unroll
    for (int gi = 0; gi < 16; ++gi) {
      cv[2 * gi] = val[gi] * (1.f - h2f) + oth[gi] * h2f;
      cv[2 * gi + 1] = val[gi] * h2f + oth[gi] * (1.f - h2f);
    }
    unsigned mask = 1u | (1u << cur);
    if (cur >= 1) mask |= 1u << (cur - 1);
    unsigned chosen = 0u;
#pragma unroll 1
    for (int rnd = 0; rnd < 5; ++rnd) {
      float best = -1.f; int bi = -1;
#pragma unroll
      for (int j = 1; j < 31; ++j) {
        const bool el = (j <= cur - 2) && !((chosen >> j) & 1u) && (cv[j] > best);
        best = el ? cv[j] : best;
        bi = el ? j : bi;
      }
      if (bi >= 0) chosen |= 1u << bi;
    }
    mask |= chosen;
    if (g == 0 && h2 == 0) SEL[tok * 2 + hkv] = mask;
  }
}

struct RowsGather {
  const bfr* base; const int* list; int i0; int cnt; int ld; bool viaTok;
  DI const bfr* row(int r) const {
    int i = i0 + r; if (i > cnt - 1) i = cnt - 1;
    const int e = list[i];
    return base + (size_t)(viaTok ? (e >> 1) : 0) * ld;
  }
  DI int koff(int k) const { return k; }
};

DI void moe1_phase(const Params& p, char* smem, int layer) {
  char* ws = p.ws;
  const int* cnt = (const int*)(ws + O_CNT) + layer * 16 * 64;
  const int* LIST = (const int*)(ws + O_LIST);
  const bfr* HB = (const bfr*)(ws + O_HB);
  bfr* HMID = (bfr*)(ws + O_HMID);
  int c[16], mtiles = 0;
#pragma unroll
  for (int e = 0; e < 16; ++e) { c[e] = cnt[e * 64]; mtiles += (c[e] + 127) >> 7; }
  const int ntiles = mtiles * 8;
  for (int tile = blockIdx.x; tile < ntiles; tile += gridDim.x) {
    int mg = tile >> 3; const int nt = tile & 7;
    int e = 0, off = 0, ce = 0;
#pragma unroll
    for (int k = 0; k < 16; ++k) {
      const int mk = (c[k] + 127) >> 7;
      if (k == e && mg >= mk) { mg -= mk; off += c[k]; e = k + 1; }
    }
#pragma unroll
    for (int k = 0; k < 16; ++k) if (k == e) ce = c[k];
    const int mt = mg;
    RowsGather A{HB, LIST + (size_t)e * NT, mt * 128, ce, 1024, true};
    RowsContig B{(const bfr*)(ws + O_WGU) + ((size_t)(layer * 16 + e) * 1024 + nt * 128) * 1024, 1024, 127};
    gemm_tile(smem, 32, A, B, [&](f32x4(&acc)[4][4], int wr, int wc, int fr, int fq) {
#pragma unroll
      for (int m = 0; m < 4; ++m)
#pragma unroll
        for (int n2 = 0; n2 < 2; ++n2) {
          const int col = nt * 64 + wc * 32 + n2 * 16 + fr;
#pragma unroll
          for (int j = 0; j < 4; ++j) {
            const int i = mt * 128 + wr * 64 + m * 16 + fq * 4 + j;
            if (i < ce) {
              const float g = acc[m][n2 * 2][j], u = acc[m][n2 * 2 + 1][j];
              HMID[(size_t)(off + i) * 512 + col] = f2bf(g / (1.f + __expf(-g)) * u);
            }
          }
        }
    });
  }
}

DI void moe2_phase(const Params& p, char* smem, int layer) {
  char* ws = p.ws;
  const int* cnt = (const int*)(ws + O_CNT) + layer * 16 * 64;
  const int* LIST = (const int*)(ws + O_LIST);
  const float* TOPW = (const float*)(ws + O_TOPW);
  const bfr* HMID = (const bfr*)(ws + O_HMID);
  bfr* MO = (bfr*)(ws + O_MOEOUT);
  int c[16], mtiles = 0;
#pragma unroll
  for (int e = 0; e < 16; ++e) { c[e] = cnt[e * 64]; mtiles += (c[e] + 127) >> 7; }
  const int ntiles = mtiles * 8;
  for (int tile = blockIdx.x; tile < ntiles; tile += gridDim.x) {
    int mg = tile >> 3; const int nt = tile & 7;
    int e = 0, off = 0, ce = 0;
#pragma unroll
    for (int k = 0; k < 16; ++k) {
      const int mk = (c[k] + 127) >> 7;
      if (k == e && mg >= mk) { mg -= mk; off += c[k]; e = k + 1; }
    }
#pragma unroll
    for (int k = 0; k < 16; ++k) if (k == e) ce = c[k];
    const int mt = mg;
    const int rows_here = ce - mt * 128;
    RowsContig A{HMID + (size_t)(off + mt * 128) * 512, 512, (rows_here < 128 ? rows_here : 128) - 1};
    RowsContig B{(const bfr*)(ws + O_WDN) + ((size_t)(layer * 16 + e) * 1024 + nt * 128) * 512, 512, 127};
    const int* lst = LIST + (size_t)e * NT;
    gemm_tile(smem, 16, A, B, [&](f32x4(&acc)[4][4], int wr, int wc, int fr, int fq) {
#pragma unroll
      for (int m = 0; m < 4; ++m)
#pragma unroll
        for (int j = 0; j < 4; ++j) {
          const int i = mt * 128 + wr * 64 + m * 16 + fq * 4 + j;
          if (i < ce) {
            const int en = lst[i];
            const float w = TOPW[en];
            bfr* dst = MO + ((size_t)(en & 1) * NT + (en >> 1)) * 1024 + nt * 128 + wc * 64 + fr;
#pragma unroll
            for (int n = 0; n < 4; ++n) dst[n * 16] = f2bf(acc[m][n][j] * w);
          }
        }
    });
  }
}

DI void rwkv_prep_phase(const Params& p, char* smem) {
  char* ws = p.ws;
  const bfr* PROJ = (const bfr*)(ws + O_PROJ);
  const int tid = tid_opaque();
  float* lw = (float*)smem;
  float* la = lw + 16 * 64;
  float* lg = la + 16 * 64;
  float* pl = (float*)smem;
  const float* mu = p.in[I_MU];
  float* W = (float*)(ws + O_RW_W);
  bfr* R = (bfr*)(ws + O_RW_R); bfr* K = (bfr*)(ws + O_RW_K); bfr* V = (bfr*)(ws + O_RW_V);
  bfr* A = (bfr*)(ws + O_RW_A); bfr* Bb = (bfr*)(ws + O_RW_B); bfr* G = (bfr*)(ws + O_RW_G);
  float* RK = (float*)(ws + O_RK);
  bfr* MIX = (bfr*)(ws + O_MIX);
  for (int item = blockIdx.x; item < 2 * (NT / 16); item += gridDim.x) {
    const int tok0 = (item >> 1) * 16;
    if ((item & 1) == 0) {
      for (int i = tid; i < 16 * 256; i += 256) {
        const int tt = i >> 8, cc = i & 255;
        const int tok = tok0 + tt, t = tok & (SEQ - 1);
        const int col = 1536 + cc;
        const float cur = bf2f(PROJ[(size_t)tok * PW1 + col]);
        const float prev = t > 0 ? bf2f(PROJ[(size_t)(tok - 1) * PW1 + col]) : 0.f;
        const float v = cur + (prev - cur) * mu[col];
        if (cc < 64) lw[tt * 64 + cc] = tanhf(v);
        else if (cc < 128) la[tt * 64 + cc - 64] = v;
        else lg[tt * 128 + cc - 128] = sigmoidf_(v);
      }
      __syncthreads();
      const int c0 = tid * 2;
      float ad[16][2], aa[16][2], ag[16][2];
#pragma unroll
      for (int tt = 0; tt < 16; ++tt) { ad[tt][0] = ad[tt][1] = aa[tt][0] = aa[tt][1] = ag[tt][0] = ag[tt][1] = 0.f; }
      const float* w2 = p.in[I_W2] + c0;
      const float* a2 = p.in[I_A2] + c0;
      const float* g2 = p.in[I_G2] + c0;
      for (int k = 0; k < 64; ++k) {
        const float2 ww = *(const float2*)(w2 + k * 512);
        const float2 wa = *(const float2*)(a2 + k * 512);
#pragma unroll
        for (int tt = 0; tt < 16; ++tt) {
          const float x = lw[tt * 64 + k], y = la[tt * 64 + k];
          ad[tt][0] += x * ww.x; ad[tt][1] += x * ww.y;
          aa[tt][0] += y * wa.x; aa[tt][1] += y * wa.y;
        }
      }
      for (int k = 0; k < 128; ++k) {
        const float2 wg = *(const float2*)(g2 + k * 512);
#pragma unroll
        for (int tt = 0; tt < 16; ++tt) {
          const float x = lg[tt * 128 + k];
          ag[tt][0] += x * wg.x; ag[tt][1] += x * wg.y;
        }
      }
      const float2 w0 = *(const float2*)(p.in[I_W0] + c0), a0 = *(const float2*)(p.in[I_A0] + c0);
      const float2 kkp = *(const float2*)(p.in[I_KK] + c0), kap = *(const float2*)(p.in[I_KA] + c0);
      const float2 rkp = *(const float2*)(p.in[I_RKP] + c0);
      const float2 mur = *(const float2*)(mu + c0), muk = *(const float2*)(mu + 512 + c0), muv = *(const float2*)(mu + 1024 + c0);
#pragma unroll
      for (int tt = 0; tt < 16; ++tt) {
        const int tok = tok0 + tt, t = tok & (SEQ - 1);
        const bfr* pr = PROJ + (size_t)tok * PW1;
        const unsigned ur = *(const unsigned*)(pr + c0), uk = *(const unsigned*)(pr + 512 + c0), uv = *(const unsigned*)(pr + 1024 + c0);
        unsigned pr_ = 0, pk_ = 0, pv_ = 0;
        if (t > 0) { pr_ = *(const unsigned*)(pr - PW1 + c0); pk_ = *(const unsigned*)(pr - PW1 + 512 + c0); pv_ = *(const unsigned*)(pr - PW1 + 1024 + c0); }
        float r[2], k[2], v[2];
        r[0] = lo2f(ur) + (lo2f(pr_) - lo2f(ur)) * mur.x; r[1] = hi2f(ur) + (hi2f(pr_) - hi2f(ur)) * mur.y;
        k[0] = lo2f(uk) + (lo2f(pk_) - lo2f(uk)) * muk.x; k[1] = hi2f(uk) + (hi2f(pk_) - hi2f(uk)) * muk.y;
        v[0] = lo2f(uv) + (lo2f(pv_) - lo2f(uv)) * muv.x; v[1] = hi2f(uv) + (hi2f(pv_) - hi2f(uv)) * muv.y;
        float dec[2], av[2], km[2], kk[2];
        const float w0v[2] = {w0.x, w0.y}, a0v[2] = {a0.x, a0.y}, kkv[2] = {kkp.x, kkp.y}, kav[2] = {kap.x, kap.y}, rkv[2] = {rkp.x, rkp.y};
        float nrm = 0.f, rk = 0.f;
#pragma unroll
        for (int u = 0; u < 2; ++u) {
          const float z = -(w0v[u] + ad[tt][u]);
          const float sp = fmaxf(z, 0.f) + log1pf(__expf(-fabsf(z)));
          const float wlog = -sp - 0.5f;
          dec[u] = __expf(-__expf(wlog));
          av[u] = sigmoidf_(a0v[u] + aa[tt][u]);
          km[u] = k[u] * (1.f + (av[u] - 1.f) * kav[u]);
          kk[u] = k[u] * kkv[u];
          nrm += kk[u] * kk[u];
          rk += r[u] * km[u] * rkv[u];
        }
#pragma unroll
        for (int o2 = 16; o2 > 0; o2 >>= 1) { nrm += __shfl_xor(nrm, o2); rk += __shfl_xor(rk, o2); }
        const float inv = 1.f / fmaxf(sqrtf(nrm), 1e-12f);
        kk[0] *= inv; kk[1] *= inv;
        const size_t o = (size_t)tok * 512 + c0;
        *(float2*)(W + o) = make_float2(dec[0], dec[1]);
        *(unsigned*)(R + o) = pack2(r[0], r[1]);
        *(unsigned*)(K + o) = pack2(km[0], km[1]);
        *(unsigned*)(V + o) = pack2(v[0], v[1]);
        *(unsigned*)(A + o) = pack2(-kk[0], -kk[1]);
        *(unsigned*)(Bb + o) = pack2(kk[0] * av[0], kk[1] * av[1]);
        *(unsigned*)(G + o) = pack2(ag[tt][0], ag[tt][1]);
        if ((tid & 31) == 0) RK[tok * 8 + (tid >> 5)] = rk;
      }
      __syncthreads();
    } else {
      {
        const int c0 = tid * 2, gi = c0 >> 7, win = 2 << gi;
        for (int tt = 0; tt < 16; ++tt) {
          const int tok = tok0 + tt, t = tok & (SEQ - 1);
          const int n = (t + 1 < win) ? t + 1 : win;
          float s0 = 0.f, s1 = 0.f;
          for (int d = 0; d < n; ++d) {
            const unsigned u = *(const unsigned*)(PROJ + (size_t)(tok - d) * PW1 + 1792 + c0);
            s0 += lo2f(u); s1 += hi2f(u);
          }
          const unsigned u = *(const unsigned*)(PROJ + (size_t)tok * PW1 + 1792 + c0);
          const float invn = 1.f / (float)n;
          pl[tt * 512 + c0] = s0 * invn - lo2f(u);
          pl[tt * 512 + c0 + 1] = s1 * invn - hi2f(u);
        }
      }
      __syncthreads();
      {
        const int d0 = tid * 2, gi = d0 >> 7, dl = d0 & 127;
        const float* pw = p.in[I_POOLW] + (size_t)gi * 128 * 128 + dl;
        float acc[16][2];
#pragma unroll
        for (int tt = 0; tt < 16; ++tt) acc[tt][0] = acc[tt][1] = 0.f;
        for (int c = 0; c < 128; ++c) {
          const float2 w = *(const float2*)(pw + c * 128);
#pragma unroll
          for (int tt = 0; tt < 16; ++tt) {
            const float x = pl[tt * 512 + gi * 128 + c];
            acc[tt][0] += x * w.x; acc[tt][1] += x * w.y;
          }
        }
        const float2 ps = *(const float2*)(p.in[I_POOLS] + d0);
#pragma unroll
        for (int tt = 0; tt < 16; ++tt)
          *(unsigned*)(MIX + (size_t)(tok0 + tt) * 1024 + 512 + d0) = pack2(acc[tt][0] * ps.x, acc[tt][1] * ps.y);
      }
      __syncthreads();
    }
  }
}

DI void scanA_phase(const Params& p, char* smem) {
  char* ws = p.ws;
  const int tid = tid_opaque(), lane = tid & 63, wid = tid >> 6;
  const int ul = wid >> 1, isP = wid & 1;
  float* stb = (float*)smem;
  const float* W = (const float*)(ws + O_RW_W);
  bfr* R = (bfr*)(ws + O_RW_R); bfr* K = (bfr*)(ws + O_RW_K); const bfr* V = (const bfr*)(ws + O_RW_V);
  const bfr* A = (const bfr*)(ws + O_RW_A); const bfr* Bb = (const bfr*)(ws + O_RW_B);
  float* CHP = (float*)(ws + O_CHP); float* CHL = (float*)(ws + O_CHL);
  for (int item = blockIdx.x; item < 1024; item += gridDim.x) {
    const int unit = item * 2 + ul;
    const int chain = unit >> 5, chunk = unit & 31, b = chain >> 3, h = chain & 7;
    const size_t base = ((size_t)b * SEQ + chunk * 64) * 512 + h * 64;
    float S[64];
    int diag = isP ? lane : -1;
    asm volatile("" : "+v"(diag));
#pragma unroll
    for (int j = 0; j < 64; ++j) S[j] = (j == diag) ? 1.f : 0.f;
#pragma unroll 1
    for (int sub = 0; sub < 4; ++sub) {
      __syncthreads();
      {
        float* d0 = stb + ul * (16 * 384);
#pragma unroll 4
        for (int s = 0; s < 16; ++s) {
          const size_t o = base + (size_t)(sub * 16 + s) * 512 + lane;
          float* d = d0 + s * 384;
          if (isP == 0) {
            d[lane] = bf2f(R[o]);
            d[64 + lane] = W[o];
            d[128 + lane] = bf2f(K[o]);
          } else {
            d[192 + lane] = bf2f(V[o]);
            d[256 + lane] = bf2f(A[o]);
            d[320 + lane] = bf2f(Bb[o]);
          }
        }
      }
      __syncthreads();
#pragma unroll 1
      for (int s = 0; s < 16; ++s) {
        const float* d = stb + ul * (16 * 384) + s * 384;
        float sa = 0.f;
#pragma unroll
        for (int j4 = 0; j4 < 16; ++j4) {
          const float4 a4 = *(const float4*)(d + 256 + j4 * 4);
          sa += S[j4 * 4] * a4.x + S[j4 * 4 + 1] * a4.y + S[j4 * 4 + 2] * a4.z + S[j4 * 4 + 3] * a4.w;
        }
        const float vi = isP ? 0.f : d[192 + lane];
        float y = 0.f;
#pragma unroll
        for (int j4 = 0; j4 < 16; ++j4) {
          if ((j4 & 3) == 0) asm volatile("" ::: "memory");
          const float4 w4 = *(const float4*)(d + 64 + j4 * 4);
          const float4 b4 = *(const float4*)(d + 320 + j4 * 4);
          const float4 k4 = *(const float4*)(d + 128 + j4 * 4);
          const float4 r4 = *(const float4*)(d + j4 * 4);
          S[j4 * 4 + 0] = S[j4 * 4 + 0] * w4.x + (sa * b4.x + vi * k4.x);
          S[j4 * 4 + 1] = S[j4 * 4 + 1] * w4.y + (sa * b4.y + vi * k4.y);
          S[j4 * 4 + 2] = S[j4 * 4 + 2] * w4.z + (sa * b4.z + vi * k4.z);
          S[j4 * 4 + 3] = S[j4 * 4 + 3] * w4.w + (sa * b4.w + vi * k4.w);
          y += S[j4 * 4] * r4.x + S[j4 * 4 + 1] * r4.y + S[j4 * 4 + 2] * r4.z + S[j4 * 4 + 3] * r4.w;
        }
        const size_t o = base + (size_t)(sub * 16 + s) * 512 + lane;
        if (isP) R[o] = f2bf(y);
        else K[o] = f2bf(y);
      }
    }
    float4* dp = (float4*)((isP ? CHP : CHL) + ((size_t)unit * 64 + lane) * 64);
#pragma unroll
    for (int j4 = 0; j4 < 16; ++j4) dp[j4] = make_float4(S[j4 * 4], S[j4 * 4 + 1], S[j4 * 4 + 2], S[j4 * 4 + 3]);
  }
}

DI void scanB_phase(const Params& p, char* smem) {
  char* ws = p.ws;
  const int tid = tid_opaque();
  float* Ss = (float*)smem;
  float* Ps = Ss + 64 * 65;
  const float* CHP = (const float*)(ws + O_CHP);
  float* CHL = (float*)(ws + O_CHL);
  const int i = tid >> 2, qd = tid & 3;
  for (int chain = blockIdx.x; chain < 64; chain += gridDim.x) {
    for (int e = tid; e < 64 * 65; e += 256) Ss[e] = 0.f;
    __syncthreads();
    for (int c = 0; c < 31; ++c) {
      const size_t ub = ((size_t)(chain * 32 + c)) * 4096;
      for (int e = tid; e < 1024; e += 256) ((float4*)Ps)[e] = ((const float4*)(CHP + ub))[e];
      float acc[16];
      {
        const float4* lp = (const float4*)(CHL + ub + i * 64 + qd * 16);
#pragma unroll
        for (int u = 0; u < 4; ++u) { const float4 v = lp[u]; acc[u * 4] = v.x; acc[u * 4 + 1] = v.y; acc[u * 4 + 2] = v.z; acc[u * 4 + 3] = v.w; }
      }
      __syncthreads();
      if (c > 0) {
        for (int k = 0; k < 64; ++k) {
          const float s = Ss[i * 65 + k];
          const float4* pr = (const float4*)(Ps + k * 64 + qd * 16);
#pragma unroll
          for (int u = 0; u < 4; ++u) {
            const float4 v = pr[u];
            acc[u * 4] += s * v.x; acc[u * 4 + 1] += s * v.y; acc[u * 4 + 2] += s * v.z; acc[u * 4 + 3] += s * v.w;
          }
        }
      }
      __syncthreads();
#pragma unroll
      for (int u = 0; u < 16; ++u) Ss[i * 65 + qd * 16 + u] = acc[u];
      {
        float4* lp = (float4*)(CHL + ub + i * 64 + qd * 16);
#pragma unroll
        for (int u = 0; u < 4; ++u) lp[u] = make_float4(acc[u * 4], acc[u * 4 + 1], acc[u * 4 + 2], acc[u * 4 + 3]);
      }
      __syncthreads();
    }
  }
}

DI void scanC_phase(const Params& p, char* smem) {
  char* ws = p.ws;
  const int tid = tid_opaque(), lane = tid & 63, wid = tid >> 6;
  float* st = (float*)smem + wid * (8 * 64);
  const bfr* Q = (const bfr*)(ws + O_RW_R); const bfr* YL = (const bfr*)(ws + O_RW_K); const bfr* V = (const bfr*)(ws + O_RW_V);
  const bfr* G = (const bfr*)(ws + O_RW_G);
  const float* RK = (const float*)(ws + O_RK);
  const float* CHL = (const float*)(ws + O_CHL);
  bfr* MIX = (bfr*)(ws + O_MIX);
  for (int item = blockIdx.x; item < 512; item += gridDim.x) {
    const int unit = item * 4 + wid;
    const int chain = unit >> 5, chunk = unit & 31, b = chain >> 3, h = chain & 7;
    const size_t base = ((size_t)b * SEQ + chunk * 64) * 512 + h * 64;
    float S[64];
    if (chunk > 0) {
      const float4* sp = (const float4*)(CHL + ((size_t)(unit - 1) * 64 + lane) * 64);
#pragma unroll
      for (int j4 = 0; j4 < 16; ++j4) { const float4 v = sp[j4]; S[j4 * 4] = v.x; S[j4 * 4 + 1] = v.y; S[j4 * 4 + 2] = v.z; S[j4 * 4 + 3] = v.w; }
    } else {
#pragma unroll
      for (int j = 0; j < 64; ++j) S[j] = 0.f;
    }
    const float lnw = p.in[I_LNW][h * 64 + lane], lnb = p.in[I_LNB][h * 64 + lane];
#pragma unroll 1
    for (int sub = 0; sub < 8; ++sub) {
#pragma unroll
      for (int s = 0; s < 8; ++s) st[s * 64 + lane] = bf2f(Q[base + (size_t)(sub * 8 + s) * 512 + lane]);
      __builtin_amdgcn_fence(__ATOMIC_RELEASE, "wavefront");
      __builtin_amdgcn_wave_barrier();
#pragma unroll 1
      for (int s = 0; s < 8; ++s) {
        const size_t o = base + (size_t)(sub * 8 + s) * 512 + lane;
        float y = bf2f(YL[o]);
        const float* d = st + s * 64;
#pragma unroll
        for (int j4 = 0; j4 < 16; ++j4) {
          const float4 q4 = *(const float4*)(d + j4 * 4);
          y += S[j4 * 4] * q4.x + S[j4 * 4 + 1] * q4.y + S[j4 * 4 + 2] * q4.z + S[j4 * 4 + 3] * q4.w;
        }
        const float mean = wave_sum(y) * (1.f / 64.f);
        const float dlt = y - mean;
        const float var = wave_sum(dlt * dlt) * (1.f / 64.f);
        const float yn = dlt * rsqrtf(var + 64e-5f) * lnw + lnb;
        const int tok = b * SEQ + chunk * 64 + sub * 8 + s;
        const float outv = (yn + RK[tok * 8 + h] * bf2f(V[o])) * bf2f(G[o]);
        MIX[(size_t)tok * 1024 + h * 64 + lane] = f2bf(outv);
      }
      __builtin_amdgcn_fence(__ATOMIC_RELEASE, "wavefront");
      __builtin_amdgcn_wave_barrier();
    }
  }
}

#ifndef REP_PREP
#define REP_PREP 1
#endif
#ifndef REP_PROJ0
#define REP_PROJ0 1
#endif
#ifndef REP_CMPA
#define REP_CMPA 1
#endif
#ifndef REP_SLC
#define REP_SLC 1
#endif
#ifndef REP_MOE1
#define REP_MOE1 1
#endif
#ifndef REP_MOE2
#define REP_MOE2 1
#endif
#ifndef REP_POST0
#define REP_POST0 1
#endif
#ifndef REP_RPREP
#define REP_RPREP 1
#endif
#ifndef REP_SCANB
#define REP_SCANB 1
#endif
#ifndef REP_SCANC
#define REP_SCANC 1
#endif
#ifndef REP_SYNC
#define REP_SYNC 1
#endif
__global__ void __launch_bounds__(256, 2) fwd_megakernel(Params p) {
  cg::grid_group grid = cg::this_grid();
  __shared__ __attribute__((aligned(16))) char smem[49152];
  __shared__ uint4 xb_words;
  char* ws = p.ws;
  const float* MOD = (const float*)(ws + O_MOD);
  const float* MOD1 = MOD + 8 * 6144;
  float* X = p.out;
  if (threadIdx.x == 0) xb_words = make_uint4(0u, 0u, 0u, 0u);

  for (int rep = 0; rep < REP_PREP; ++rep)
  for (int item = blockIdx.x; item < PREP_TOTAL; item += gridDim.x) prep_item(p, smem, item);
  grid.sync();
  const XcdBarrier xb = xcd_barrier_post((unsigned*)(ws + O_BAR), (volatile LAS unsigned*)&xb_words);
#define GSYNC() xcd_barrier(xb)
#ifndef XB_EXTRA_REL
#define XB_EXTRA_REL true
#endif
#ifndef XB_EXTRA_ACQ
#define XB_EXTRA_ACQ true
#endif
  for (int rep = 1; rep < REP_SYNC; ++rep) xcd_barrier<XB_EXTRA_REL, XB_EXTRA_ACQ>(xb);
  norm_phase<0, false>(p, smem, p.in[I_X], nullptr, p.in[I_NMIX], MOD, 0, 1024, 0, 0);
  GSYNC();
  for (int rep = 0; rep < REP_PROJ0; ++rep) gemm_proj_phase(p, smem, (const bfr*)(ws + O_WEIN), PW0, (bfr*)(ws + O_PROJ));
  GSYNC();
  for (int rep = 0; rep < REP_POST0; ++rep) post0_phase(p, smem);
  GSYNC();
  cmp2_phase(p, smem);
  GSYNC();
  for (int rep = 0; rep < REP_CMPA; ++rep) cmp_attn_mfma_phase(p, smem);
  GSYNC();
  for (int rep = 0; rep < REP_SLC; ++rep) attn_sw_phase(p, smem);
  GSYNC();
  gemm_out_phase(p, smem, (const bfr*)(ws + O_WEOUT), p.in[I_X], X, MOD + 2048);
  GSYNC();
  norm_phase<0, true>(p, smem, X, nullptr, p.in[I_NFFN], MOD, 3072, 4096, 0, 0);
  GSYNC();
  for (int rep = 0; rep < REP_MOE1; ++rep) moe1_phase(p, smem, 0);
  GSYNC();
  for (int rep = 0; rep < REP_MOE2; ++rep) moe2_phase(p, smem, 0);
  GSYNC();
  norm_phase<1, false>(p, smem, X, X, p.in[I_NMIX] + 1024, MOD1, 0, 1024, 5120 - 6144 * 8, 1);
  GSYNC();
  gemm_proj_phase(p, smem, (const bfr*)(ws + O_WOIN), PW1, (bfr*)(ws + O_PROJ));
  GSYNC();
  for (int rep = 0; rep < REP_RPREP; ++rep) rwkv_prep_phase(p, smem);
  GSYNC();
  scanA_phase(p, smem);
  GSYNC();
  scanB_phase(p, smem);
  GSYNC();
  for (int rep = 0; rep < REP_SCANC; ++rep) scanC_phase(p, smem);
  GSYNC();
  gemm_out_phase(p, smem, (const bfr*)(ws + O_WOOUT), X, X, MOD1 + 2048);
  GSYNC();
  norm_phase<0, true>(p, smem, X, nullptr, p.in[I_NFFN] + 1024, MOD1, 3072, 4096, 0, 1);
  GSYNC();
  moe1_phase(p, smem, 1);
  GSYNC();
  moe2_phase(p, smem, 1);
  GSYNC();
  norm_phase<2, false>(p, smem, X, X, p.in[I_FN], MOD1, 0, 0, 5120, 1);
}

extern "C" void kernel_launch(void* const* d_in, const int* in_sizes, int n_in,
                              void* d_out, int out_size, void* d_ws, size_t ws_size,
                              hipStream_t stream) {
  static int grid_blocks = 0;
  if (!grid_blocks) {
    int dev = 0, cus = 0, per_cu = 0;
    (void)hipGetDevice(&dev);
    (void)hipDeviceGetAttribute(&cus, hipDeviceAttributeMultiprocessorCount, dev);
    (void)hipOccupancyMaxActiveBlocksPerMultiprocessor(&per_cu, fwd_megakernel, 256, 0);
    if (per_cu > 2) per_cu = 2;
    if (per_cu < 1) per_cu = 1;
    grid_blocks = cus * per_cu;
    fprintf(stderr, "cus=%d per_cu=%d grid=%d ws=%zu need=%zu\n", cus, per_cu, grid_blocks, ws_size, (size_t)WS_NEED);
  }
  if (ws_size < WS_NEED || n_in < 33) { fprintf(stderr, "workspace too small\n"); return; }
  Params p{};
  for (int i = 0; i < 33; ++i) p.in[i] = (const float*)d_in[i];
  p.out = (float*)d_out;
  p.ws = (char*)d_ws;
  p.ws_size = (unsigned long long)ws_size;
  void* args[] = {&p};
  hipError_t e = hipLaunchCooperativeKernel((void*)fwd_megakernel, dim3(grid_blocks), dim3(256), args, 0, stream);
  if (e != hipSuccess) fprintf(stderr, "cooperative launch failed: %s (grid %d)\n", hipGetErrorString(e), grid_blocks);
}
```

```cpp
#include <hip/hip_runtime.h>
#include <hip/hip_cooperative_groups.h>
#include <cstdio>
namespace cg = cooperative_groups;

typedef unsigned short bfr;
using bf16x8 = __attribute__((ext_vector_type(8))) short;
using f32x4 = __attribute__((ext_vector_type(4))) float;
typedef __attribute__((ext_vector_type(2))) __bf16 bf2v;
#define DI __device__ __forceinline__

constexpr int NT = 16384;
constexpr int SEQ = 2048;
constexpr int DM = 1024;
constexpr int PW0 = 2944;
constexpr int PW1 = 2304;
constexpr int C_Q = 0, C_KC = 512, C_VC = 640, C_KS = 768, C_VS = 896, C_KW = 1024, C_VW = 1152;
constexpr int C_XB = 1280, C_BG = 1792, C_CG = 2304, C_GL = 2816;

constexpr size_t al256(size_t x) { return (x + 255) & ~size_t(255); }
constexpr size_t MB = 1024 * 1024;
constexpr size_t O_MOD = 0;
constexpr size_t O_ROPE = O_MOD + al256(2 * 8 * 6144 * 4);
constexpr size_t O_BIAS1 = O_ROPE + al256(2048 * 32 * 2 * 4);
constexpr size_t O_BAR = O_BIAS1 + al256(2 * 256 * 4);
constexpr size_t O_CNT = O_BAR + al256(3456 * 4);
constexpr size_t O_TOPW = O_CNT + al256(2 * 16 * 64 * 4);
constexpr size_t O_LIST = O_TOPW + al256((size_t)NT * 2 * 4);
constexpr size_t O_SEL = O_LIST + al256((size_t)16 * NT * 4);
constexpr size_t O_KCVC = O_SEL + al256((size_t)NT * 2 * 4);
constexpr size_t O_RK = O_KCVC + al256(2 * 2048 * 64 * 4);
constexpr size_t O_VCT = O_RK + al256((size_t)NT * 8 * 4);
constexpr size_t O_CH = O_VCT + al256(8 * 2 * 64 * 128 * 2);
constexpr size_t O_WEIN = O_CH + al256(2 * 2048 * 256 * 2);
constexpr size_t O_WEOUT = O_WEIN + al256((size_t)PW0 * 1024 * 2);
constexpr size_t O_WOIN = O_WEOUT + al256(1024 * 1024 * 2);
constexpr size_t O_WOOUT = O_WOIN + al256((size_t)PW1 * 1024 * 2);
constexpr size_t O_WC1 = O_WOOUT + al256(1024 * 1024 * 2);
constexpr size_t O_WC2 = O_WC1 + al256(2 * 256 * 2048 * 2);
constexpr size_t O_W2T = O_WC2 + al256(2 * 128 * 256 * 2);
constexpr size_t O_A2T = O_W2T + al256(512 * 64 * 2);
constexpr size_t O_G2T = O_A2T + al256(512 * 64 * 2);
constexpr size_t O_PWT = O_G2T + al256(512 * 128 * 2);
constexpr size_t O_WGU = O_PWT + al256(4 * 128 * 128 * 2);
constexpr size_t O_WDN = O_WGU + 64 * MB;
constexpr size_t O_HB = O_WDN + 32 * MB;
constexpr size_t O_MIX = O_HB + 32 * MB;
constexpr size_t O_E = O_MIX + 32 * MB;
constexpr size_t SZ_E = al256((size_t)NT * PW0 * 2);
constexpr size_t O_F = O_E + SZ_E;
constexpr size_t WS_NEED = O_F + 48 * MB;
constexpr size_t O_HMID = O_MIX;
constexpr size_t O_PROJ = O_E;
constexpr size_t O_MOEOUT = O_E;
constexpr size_t O_CHP = O_WGU;
constexpr size_t O_CHL = O_WGU + 16 * MB;
constexpr size_t O_QR = O_F;
constexpr size_t O_KSR = O_F + 16 * MB;
constexpr size_t O_KWR = O_F + 20 * MB;
constexpr size_t O_OCMP = O_F + 24 * MB;
constexpr size_t O_VST = O_F + 40 * MB;
constexpr size_t O_VWT = O_F + 44 * MB;
constexpr size_t O_RW_W = O_HB;
constexpr size_t O_RW_Q = O_F;
constexpr size_t O_RW_Y = O_F + 16 * MB;
constexpr size_t O_RW_AS = O_F + 32 * MB;
constexpr size_t O_RW_G = O_WDN;
constexpr size_t O_POOLED = O_E + 76 * MB;

struct Params {
  const float* in[33];
  float* out;
  char* ws;
  unsigned long long ws_size;
};

enum { I_X = 0, I_C, I_ADAW, I_ADAB, I_NMIX, I_NFFN, I_EWIN, I_CPOS, I_CW1, I_CW2, I_CONVW, I_EWOUT, I_OWIN, I_MU, I_W0, I_W2,
       I_A0, I_A2, I_G2, I_KK, I_KA, I_RKP, I_LNW, I_LNB, I_POOLW, I_POOLS, I_OWOUT, I_RTW, I_RTB, I_MG, I_MU_, I_MD, I_FN };

DI int tid_opaque() { int t = threadIdx.x & 255; asm volatile("" : "+v"(t)); __builtin_assume(t >= 0 && t < 256); return t; }
#define VB ((int)(blockIdx.x * 2 + (threadIdx.x >> 8)))
#define NVB ((int)(gridDim.x * 2))
DI float bf2f(bfr u) { return __uint_as_float(((unsigned)u) << 16); }
DI bfr f2bf(float x) { unsigned u = __float_as_uint(x); u += 0x7fffu + ((u >> 16) & 1u); return (bfr)(u >> 16); }
typedef __attribute__((ext_vector_type(2))) float f32x2_;
DI unsigned pack2(float a, float b) { f32x2_ x = {a, b}; return __builtin_bit_cast(unsigned, __builtin_convertvector(x, bf2v)); }
DI float lo2f(unsigned u) { return __uint_as_float(u << 16); }
DI float hi2f(unsigned u) { return __uint_as_float(u & 0xffff0000u); }
DI float wave_sum(float v) {
#pragma unroll
  for (int o = 32; o > 0; o >>= 1) v += __shfl_xor(v, o);
  return v;
}
DI float sigmoidf_(float x) { return 1.f / (1.f + __expf(-x)); }
DI float dot2(unsigned a, unsigned b, float c) {
  return __builtin_amdgcn_fdot2_f32_bf16(__builtin_bit_cast(bf2v, a), __builtin_bit_cast(bf2v, b), c, false);
}

#define XB_TMO      128
#define XB_XCNT(j)  (256  + 64 * (j))
#define XB_XSUB(j)  (1280 + 64 * (j))
#define XB_XGEN(j)  (2304 + 64 * (j))
#define XB_TOP      3328
#define XB_TOPGEN   3392
#define XCD_BAR_WORDS 3456
#define XB_SPIN_CAP (1u << 22)
#define LAS __attribute__((address_space(3)))
DI unsigned xb_ld(unsigned* p) { return __hip_atomic_load(p, __ATOMIC_RELAXED, __HIP_MEMORY_SCOPE_AGENT); }
DI unsigned xb_add(unsigned* p, unsigned v) { return __hip_atomic_fetch_add(p, v, __ATOMIC_RELAXED, __HIP_MEMORY_SCOPE_AGENT); }
DI unsigned xb_xcc_id() { return (unsigned)__builtin_amdgcn_s_getreg((3 << 11) | 20) & 0xFu; }
#define XB_SPIN(cond, bar) do { unsigned _sp = 0; while (cond) { __builtin_amdgcn_s_sleep(1); \
    if ((++_sp & 255u) == 0u) { if (xb_ld(&(bar)[XB_TMO])) break; if (_sp > XB_SPIN_CAP) { atomicAdd(&(bar)[XB_TMO], 1u); break; } } } } while (0)
struct XcdBarrier { unsigned* bar; unsigned x; volatile LAS unsigned* st; };
DI XcdBarrier xcd_barrier_post(unsigned* bar, volatile LAS unsigned* st) {
  XcdBarrier b; b.bar = bar; b.x = xb_xcc_id(); b.st = st;
  if (threadIdx.x == 0) (void)xb_add(&bar[XB_XCNT(b.x)], 1u);
  return b;
}
DI void xcd_barrier_complete(unsigned* bar, unsigned x, unsigned& nloc, unsigned& nx) {
  const unsigned G = gridDim.x * gridDim.y * gridDim.z;
  unsigned sum, cnt, mine, sp = 0u;
  for (;;) {
    sum = 0u; cnt = 0u; mine = 0u;
#pragma unroll
    for (unsigned j = 0; j < 16; ++j) { const unsigned c = xb_ld(&bar[XB_XCNT(j)]); sum += c; cnt += (c > 0u) ? 1u : 0u; mine = (j == x) ? c : mine; }
    if (sum == G) break;
    __builtin_amdgcn_s_sleep(1);
    if ((++sp & 255u) == 0u) { if (xb_ld(&bar[XB_TMO])) break; if (sp > XB_SPIN_CAP) { atomicAdd(&bar[XB_TMO], 1u); break; } }
  }
  nloc = mine > 0u ? mine : 1u; nx = cnt > 0u ? cnt : 1u;
}
template <bool REL = true, bool ACQ = true>
DI void xcd_barrier(const XcdBarrier& b) {
  asm volatile("s_waitcnt vmcnt(0)" ::: "memory");
  __syncthreads();
  if (threadIdx.x == 0) {
    unsigned* bar = b.bar;
    __builtin_amdgcn_s_waitcnt(0);
    unsigned nloc = b.st[0], nx = b.st[1];
    if (nloc == 0u) { xcd_barrier_complete(bar, b.x, nloc, nx); b.st[0] = nloc; b.st[1] = nx; }
    const unsigned old = xb_add(&bar[XB_XSUB(b.x)], 1u);
    const unsigned gen = old / nloc;
    if (old + 1u == (gen + 1u) * nloc) {
      if (REL) __builtin_amdgcn_fence(__ATOMIC_RELEASE, "agent");
      asm volatile("s_waitcnt vmcnt(0)" ::: "memory");
      const unsigned og = xb_add(&bar[XB_TOP], 1u);
      const unsigned tg = og / nx;
      if (og + 1u == (tg + 1u) * nx) xb_add(&bar[XB_TOPGEN], 1u);
      else XB_SPIN(xb_ld(&bar[XB_TOPGEN]) == tg, bar);
      if (ACQ) __builtin_amdgcn_fence(__ATOMIC_ACQUIRE, "agent");
      xb_add(&bar[XB_XGEN(b.x)], 1u);
      asm volatile("s_waitcnt vmcnt(0)" ::: "memory");
    } else {
      XB_SPIN(xb_ld(&bar[XB_XGEN(b.x)]) == gen, bar);
      if (ACQ) __builtin_amdgcn_fence(__ATOMIC_ACQUIRE, "agent");
      asm volatile("s_waitcnt vmcnt(0)" ::: "memory");
    }
  }
  __syncthreads();
}

struct GemmLds { bfr a[2][128][40]; bfr b[2][128][40]; };
static_assert(sizeof(GemmLds) == 40960, "lds");

template <class AF, class BF, class Epi>
DI void gemm_tile(char* smem, int nk, AF af, BF bfn, Epi&& epi) {
  GemmLds& L = *(GemmLds*)smem;
  const int tid = tid_opaque(), lane = tid & 63, wid = tid >> 6, wr = wid >> 1, wc = wid & 1, fr = lane & 15, fq = lane >> 4;
  const int lr = tid >> 2, lk = (tid & 3) * 8;
  af.init(lr);
  bfn.init(lr);
  f32x4 acc[4][4];
#pragma unroll
  for (int m = 0; m < 4; ++m)
#pragma unroll
    for (int n = 0; n < 4; ++n) acc[m][n] = f32x4{0.f, 0.f, 0.f, 0.f};
  uint4 ra0, ra1, rb0, rb1;
  ra0 = af.load(0, lk); ra1 = af.load(1, lk);
  rb0 = bfn.load(0, lk); rb1 = bfn.load(1, lk);
  *(uint4*)&L.a[0][lr][lk] = ra0; *(uint4*)&L.a[0][lr + 64][lk] = ra1;
  *(uint4*)&L.b[0][lr][lk] = rb0; *(uint4*)&L.b[0][lr + 64][lk] = rb1;
  __syncthreads();
  for (int kt = 0; kt < nk; ++kt) {
    const int cur = kt & 1;
    if (kt + 1 < nk) {
      const int k = (kt + 1) * 32 + lk;
      ra0 = af.load(0, k); ra1 = af.load(1, k);
      rb0 = bfn.load(0, k); rb1 = bfn.load(1, k);
    }
    __builtin_amdgcn_sched_barrier(0);
    bf16x8 fa[4], fb[4];
#pragma unroll
    for (int m = 0; m < 4; ++m) fa[m] = *(const bf16x8*)&L.a[cur][wr * 64 + m * 16 + fr][fq * 8];
#pragma unroll
    for (int n = 0; n < 4; ++n) fb[n] = *(const bf16x8*)&L.b[cur][wc * 64 + n * 16 + fr][fq * 8];
#pragma unroll
    for (int m = 0; m < 4; ++m)
#pragma unroll
      for (int n = 0; n < 4; ++n) acc[m][n] = __builtin_amdgcn_mfma_f32_16x16x32_bf16(fa[m], fb[n], acc[m][n], 0, 0, 0);
    __builtin_amdgcn_sched_barrier(0);
    if (kt + 1 < nk) {
      *(uint4*)&L.a[cur ^ 1][lr][lk] = ra0; *(uint4*)&L.a[cur ^ 1][lr + 64][lk] = ra1;
      *(uint4*)&L.b[cur ^ 1][lr][lk] = rb0; *(uint4*)&L.b[cur ^ 1][lr + 64][lk] = rb1;
    }
    __syncthreads();
  }
  epi(acc, wr, wc, fr, fq);
}

struct RowsContig {
  const bfr* base; int ld; int maxrow;
  const bfr* rp[2];
  DI void init(int lr) {
#pragma unroll
    for (int i = 0; i < 2; ++i) { const int r = lr + 64 * i; rp[i] = base + (size_t)(r < maxrow ? r : maxrow) * ld; }
  }
  DI uint4 load(int sel, int k) const { return *(const uint4*)(rp[sel] + k); }
  DI const bfr* ptr(int sel, int k) const { return rp[sel] + k; }
};

#ifndef KLOOP2
#define KLOOP2 1
#endif
struct RowsContigW {
  const bfr* base; int ld; int maxrow;
  const bfr* rp[2];
  DI void init(int lr) {
#pragma unroll
    for (int i = 0; i < 2; ++i) { const int r = lr + 64 * i; rp[i] = base + (size_t)(r < maxrow ? r : maxrow) * ld; }
  }
  DI const bfr* ptr(int sel, int k) const { return rp[sel] + (k & 1023); }
};
struct GemmLdsG { bfr a[3][128][32]; bfr b[3][128][32]; };
static_assert(sizeof(GemmLdsG) == 49152, "glds lds");
template <class AF, class BF, class Epi>
DI void gemm_tile_g(char* smem, int nk, AF af, BF bfn, Epi&& epi) {
  GemmLdsG& L = *(GemmLdsG*)smem;
  const int tid = tid_opaque(), lane = tid & 63, wid = tid >> 6, wr = wid >> 1, wc = wid & 1, fr = lane & 15, fq = lane >> 4;
  const int lr = tid >> 2;
  const int lk = ((tid & 3) ^ (2 * ((lr >> 3) & 1))) * 8;
  af.init(lr);
  bfn.init(lr);
  f32x4 acc[4][4];
#pragma unroll
  for (int m = 0; m < 4; ++m)
#pragma unroll
    for (int n = 0; n < 4; ++n) acc[m][n] = f32x4{0.f, 0.f, 0.f, 0.f};
  typedef __attribute__((address_space(3))) unsigned lds_u32;
  auto stage = [&](int buf, int kt) {
    const int k = kt * 32 + lk;
    char* la = (char*)&L.a[buf][0][0] + tid * 16;
    char* lb = (char*)&L.b[buf][0][0] + tid * 16;
    __builtin_amdgcn_global_load_lds((const unsigned*)af.ptr(0, k), (lds_u32*)la, 16, 0, 0);
    __builtin_amdgcn_global_load_lds((const unsigned*)af.ptr(1, k), (lds_u32*)(la + 4096), 16, 0, 0);
    __builtin_amdgcn_global_load_lds((const unsigned*)bfn.ptr(0, k), (lds_u32*)lb, 16, 0, 0);
    __builtin_amdgcn_global_load_lds((const unsigned*)bfn.ptr(1, k), (lds_u32*)(lb + 4096), 16, 0, 0);
  };
  const int cs = (fq ^ (2 * (fr >> 3))) * 8;
  stage(0, 0);
  stage(1, 1);
  int cur = 0;
  for (int kt = 0; kt < nk; ++kt) {
    if (kt + 1 < nk) asm volatile("s_waitcnt vmcnt(4)" ::: "memory");
    else asm volatile("s_waitcnt vmcnt(0)" ::: "memory");
    __builtin_amdgcn_s_barrier();
    asm volatile("" ::: "memory");
    if (kt + 2 < nk) stage(cur == 0 ? 2 : cur - 1, kt + 2);
    bf16x8 fa[4], fb[4];
#pragma unroll
    for (int m = 0; m < 4; ++m) fa[m] = *(const bf16x8*)&L.a[cur][wr * 64 + m * 16 + fr][cs];
#pragma unroll
    for (int n = 0; n < 4; ++n) fb[n] = *(const bf16x8*)&L.b[cur][wc * 64 + n * 16 + fr][cs];
#pragma unroll
    for (int m = 0; m < 4; ++m)
#pragma unroll
      for (int n = 0; n < 4; ++n) acc[m][n] = __builtin_amdgcn_mfma_f32_16x16x32_bf16(fb[n], fa[m], acc[m][n], 0, 0, 0);
    cur = cur == 2 ? 0 : cur + 1;
  }
  asm volatile("s_waitcnt lgkmcnt(0)" ::: "memory");
  __builtin_amdgcn_s_barrier();
  asm volatile("" ::: "memory");
  epi(acc, wr, wc, fr, fq);
}

DI int remap_col(int mode, int n) {
  if (mode == 1) return n < 1280 ? n : (n < 1304 ? C_GL + (n - 1280) : n - 24);
  if (mode == 2) return ((n >> 4) << 5) + (n & 15);
  if (mode == 3) return ((n >> 4) << 5) + 16 + (n & 15);
  return n;
}

DI void conv_tile(char* smem, const float* __restrict__ src, int ldsrc, int Ndim, int k0, int n0, bfr* dst, int ldd, int mode) {
  float(*t)[65] = (float(*)[65])smem;
  const int tid = tid_opaque();
  {
    const int n = tid & 63, kq = tid >> 6;
    const int nn = n0 + n;
#pragma unroll
    for (int i = 0; i < 16; ++i) {
      const int k = i * 4 + kq;
      t[k][n] = (nn < Ndim) ? src[(size_t)(k0 + k) * ldsrc + nn] : 0.f;
    }
  }
  __syncthreads();
  {
    const int nl = tid >> 2, kc = (tid & 3) * 16;
    const int nn = n0 + nl;
    if (nn < Ndim) {
      const int dr = remap_col(mode, nn);
      unsigned w[8];
#pragma unroll
      for (int i = 0; i < 8; ++i) w[i] = pack2(t[kc + 2 * i][nl], t[kc + 2 * i + 1][nl]);
      uint4* d = (uint4*)(dst + (size_t)dr * ldd + k0 + kc);
      d[0] = make_uint4(w[0], w[1], w[2], w[3]);
      d[1] = make_uint4(w[4], w[5], w[6], w[7]);
    }
  }
  __syncthreads();
}

constexpr int PREP_MOD = 192, PREP_ROPE = 256, PREP_MISC = 4;
constexpr int T_EIN = 16 * 45, T_SQ = 256, T_OIN = 16 * 36, T_C1 = 128, T_C2 = 4, T_G = 128, T_D = 128;
constexpr int PREP_CONV0 = PREP_MOD + PREP_ROPE + PREP_MISC;
constexpr int T_LORA = 8 + 8 + 16 + 16;
constexpr int PREP_TOTAL = PREP_CONV0 + T_EIN + T_SQ + T_OIN + T_SQ + 2 * T_C1 + 2 * T_C2 + T_LORA + 32 * (2 * T_G + T_D);

DI void prep_item(const Params& p, char* smem, int item) {
  const int tid = tid_opaque();
  char* ws = p.ws;
  if (item < PREP_MOD) {
    const int layer = item / 96, cch = item % 96;
    float* cond = (float*)smem;
    float* red = (float*)(smem + 32768);
    const float* c = p.in[I_C];
    for (int i = tid; i < 8192; i += 256) {
      const int b = i >> 10, k = i & 1023;
      const float v = c[i];
      cond[k * 8 + b] = v / (1.f + __expf(-v));
    }
    __syncthreads();
    const int col = cch * 64 + (tid & 63), kg = tid >> 6;
    const float* w = p.in[I_ADAW] + (size_t)layer * 1024 * 6144 + col;
    float acc[8] = {0, 0, 0, 0, 0, 0, 0, 0};
#pragma unroll 8
    for (int k = kg * 256; k < kg * 256 + 256; ++k) {
      const float wv = w[(size_t)k * 6144];
      const float4 c0 = *(const float4*)&cond[k * 8], c1 = *(const float4*)&cond[k * 8 + 4];
      acc[0] += c0.x * wv; acc[1] += c0.y * wv; acc[2] += c0.z * wv; acc[3] += c0.w * wv;
      acc[4] += c1.x * wv; acc[5] += c1.y * wv; acc[6] += c1.z * wv; acc[7] += c1.w * wv;
    }
#pragma unroll
    for (int b = 0; b < 8; ++b) red[(kg * 8 + b) * 64 + (tid & 63)] = acc[b];
    __syncthreads();
    for (int i = tid; i < 512; i += 256) {
      const int b = i >> 6, cc = i & 63;
      const float s = red[(0 * 8 + b) * 64 + cc] + red[(1 * 8 + b) * 64 + cc] + red[(2 * 8 + b) * 64 + cc] + red[(3 * 8 + b) * 64 + cc];
      const int cg_ = cch * 64 + cc;
      ((float*)(ws + O_MOD))[(layer * 8 + b) * 6144 + cg_] = s + p.in[I_ADAB][layer * 6144 + cg_];
    }
    __syncthreads();
    return;
  }
  item -= PREP_MOD;
  if (item < PREP_ROPE) {
    const int e = item * 256 + tid;
    const int t = e >> 5, i = e & 31;
    const float inv = powf(10000.f, -(float)i / 32.f);
    const float ang = (float)t * inv;
    float* rp = (float*)(ws + O_ROPE);
    rp[e] = cosf(ang);
    rp[65536 + e] = sinf(ang);
    return;
  }
  item -= PREP_ROPE;
  if (item < PREP_MISC) {
    if (item == 3) return;
    if (item < 2) {
      const int j = item, n = tid;
      const float* pos = p.in[I_CPOS] + j * 2048;
      const float* w1 = p.in[I_CW1] + (size_t)j * 2048 * 256 + n;
      float s = 0.f;
      for (int k = 0; k < 2048; ++k) s += pos[k] * w1[(size_t)k * 256];
      ((float*)(ws + O_BIAS1))[j * 256 + n] = s;
    } else {
      int* cnt = (int*)(ws + O_CNT);
      for (int i = tid; i < 2 * 16 * 64; i += 256) cnt[i] = 0;
      uint4* vct = (uint4*)(ws + O_VCT);
      for (int i = tid; i < 8 * 2 * 64 * 128 * 2 / 16; i += 256) vct[i] = make_uint4(0, 0, 0, 0);
      unsigned* barw = (unsigned*)(ws + O_BAR);
      for (int i = tid; i < XCD_BAR_WORDS; i += 256) barw[i] = 0u;
      uint4 z = make_uint4(0, 0, 0, 0);
      uint4* wpad = (uint4*)(ws + O_WEIN + (size_t)2840 * 1024 * 2);
      for (int i = tid; i < 104 * 1024 * 2 / 16; i += 256) wpad[i] = z;
      for (int j = 0; j < 2; ++j) {
        uint4* cp = (uint4*)(ws + O_WC2 + ((size_t)j * 128 + 64) * 256 * 2);
        for (int i = tid; i < 64 * 256 * 2 / 16; i += 256) cp[i] = z;
      }
    }
    return;
  }
  item -= PREP_MISC;
  if (item < T_EIN) { conv_tile(smem, p.in[I_EWIN], 2840, 2840, (item / 45) * 64, (item % 45) * 64, (bfr*)(ws + O_WEIN), 1024, 1); return; }
  item -= T_EIN;
  if (item < T_SQ) { conv_tile(smem, p.in[I_EWOUT], 1024, 1024, (item / 16) * 64, (item % 16) * 64, (bfr*)(ws + O_WEOUT), 1024, 0); return; }
  item -= T_SQ;
  if (item < T_OIN) { conv_tile(smem, p.in[I_OWIN], 2304, 2304, (item / 36) * 64, (item % 36) * 64, (bfr*)(ws + O_WOIN), 1024, 0); return; }
  item -= T_OIN;
  if (item < T_SQ) { conv_tile(smem, p.in[I_OWOUT], 1024, 1024, (item / 16) * 64, (item % 16) * 64, (bfr*)(ws + O_WOOUT), 1024, 0); return; }
  item -= T_SQ;
  if (item < 2 * T_C1) {
    const int j = item / T_C1, tt = item % T_C1;
    conv_tile(smem, p.in[I_CW1] + (size_t)j * 2048 * 256, 256, 256, (tt / 4) * 64, (tt % 4) * 64, (bfr*)(ws + O_WC1) + (size_t)j * 256 * 2048, 2048, 0);
    return;
  }
  item -= 2 * T_C1;
  if (item < 2 * T_C2) {
    const int j = item / T_C2, tt = item % T_C2;
    conv_tile(smem, p.in[I_CW2] + (size_t)j * 256 * 64, 64, 64, tt * 64, 0, (bfr*)(ws + O_WC2) + (size_t)j * 128 * 256, 256, 0);
    return;
  }
  item -= 2 * T_C2;
  if (item < T_LORA) {
    if (item < 8) conv_tile(smem, p.in[I_W2], 512, 512, 0, item * 64, (bfr*)(ws + O_W2T), 64, 0);
    else if (item < 16) conv_tile(smem, p.in[I_A2], 512, 512, 0, (item - 8) * 64, (bfr*)(ws + O_A2T), 64, 0);
    else if (item < 32) { const int t2 = item - 16; conv_tile(smem, p.in[I_G2], 512, 512, (t2 >> 3) * 64, (t2 & 7) * 64, (bfr*)(ws + O_G2T), 128, 0); }
    else { const int t2 = item - 32, gi = t2 >> 2; conv_tile(smem, p.in[I_POOLW] + gi * 128 * 128, 128, 128, ((t2 >> 1) & 1) * 64, (t2 & 1) * 64, (bfr*)(ws + O_PWT) + gi * 128 * 128, 128, 0); }
    return;
  }
  item -= T_LORA;
  {
    const int le = item / (2 * T_G + T_D), tt = item % (2 * T_G + T_D);
    if (tt < T_G) {
      conv_tile(smem, p.in[I_MG] + (size_t)le * 1024 * 512, 512, 512, (tt / 8) * 64, (tt % 8) * 64, (bfr*)(ws + O_WGU) + (size_t)le * 1024 * 1024, 1024, 2);
    } else if (tt < 2 * T_G) {
      const int t2 = tt - T_G;
      conv_tile(smem, p.in[I_MU_] + (size_t)le * 1024 * 512, 512, 512, (t2 / 8) * 64, (t2 % 8) * 64, (bfr*)(ws + O_WGU) + (size_t)le * 1024 * 1024, 1024, 3);
    } else {
      const int t2 = tt - 2 * T_G;
      conv_tile(smem, p.in[I_MD] + (size_t)le * 512 * 1024, 1024, 1024, (t2 / 16) * 64, (t2 % 16) * 64, (bfr*)(ws + O_WDN) + (size_t)le * 1024 * 512, 512, 0);
    }
  }
}

template <int MODE, bool ROUTER>
DI void norm_phase(const Params& p, char* smem, const float* xin, float* xout, const float* nw, const float* modl,
                   int sh_off, int sc_off, int g_off, int layer) {
  char* ws = p.ws;
  const int tid = tid_opaque(), lane = tid & 63, wid = tid >> 6;
  bfr* HB = (bfr*)(ws + O_HB);
  const bfr* MO0 = (const bfr*)(ws + O_MOEOUT);
  const bfr* MO1 = MO0 + (size_t)NT * 1024;
  int* lcnt = (int*)smem;
  int* lbase = lcnt + 16;
  int* lexp = lbase + 16;
  int* lrank = lexp + 64;
  for (int chunk = VB; chunk < NT / 32; chunk += NVB) {
    if (ROUTER) {
      if (tid < 16) lcnt[tid] = 0;
      __syncthreads();
    }
    for (int it = 0; it < 8; ++it) {
      const int row = chunk * 32 + it * 4 + wid;
      const int b = row >> 11;
      float v[16];
      float ss = 0.f;
#pragma unroll
      for (int i = 0; i < 4; ++i) {
        const int c = (i * 64 + lane) * 4;
        float4 x = *(const float4*)(xin + (size_t)row * 1024 + c);
        if (MODE >= 1) {
          const float4 g = *(const float4*)(modl + b * 6144 + g_off + c);
          const uint2 m0 = *(const uint2*)(MO0 + (size_t)row * 1024 + c);
          const uint2 m1 = *(const uint2*)(MO1 + (size_t)row * 1024 + c);
          x.x += g.x * (lo2f(m0.x) + lo2f(m1.x));
          x.y += g.y * (hi2f(m0.x) + hi2f(m1.x));
          x.z += g.z * (lo2f(m0.y) + lo2f(m1.y));
          x.w += g.w * (hi2f(m0.y) + hi2f(m1.y));
          if (MODE == 1) *(float4*)(xout + (size_t)row * 1024 + c) = x;
        }
        v[i * 4 + 0] = x.x; v[i * 4 + 1] = x.y; v[i * 4 + 2] = x.z; v[i * 4 + 3] = x.w;
        ss += x.x * x.x + x.y * x.y + x.z * x.z + x.w * x.w;
      }
      ss = wave_sum(ss);
      const float rstd = rsqrtf(ss * (1.f / 1024.f) + 1e-6f);
#pragma unroll
      for (int i = 0; i < 4; ++i) {
        const int c = (i * 64 + lane) * 4;
        const float4 w = *(const float4*)(nw + c);
        if (MODE == 2) {
          float4 o;
          o.x = v[i * 4 + 0] * rstd * w.x; o.y = v[i * 4 + 1] * rstd * w.y; o.z = v[i * 4 + 2] * rstd * w.z; o.w = v[i * 4 + 3] * rstd * w.w;
          *(float4*)(xout + (size_t)row * 1024 + c) = o;
        } else {
          const float4 sc = *(const float4*)(modl + b * 6144 + sc_off + c);
          const float4 sh = *(const float4*)(modl + b * 6144 + sh_off + c);
          v[i * 4 + 0] = v[i * 4 + 0] * rstd * w.x * (1.f + sc.x) + sh.x;
          v[i * 4 + 1] = v[i * 4 + 1] * rstd * w.y * (1.f + sc.y) + sh.y;
          v[i * 4 + 2] = v[i * 4 + 2] * rstd * w.z * (1.f + sc.z) + sh.z;
          v[i * 4 + 3] = v[i * 4 + 3] * rstd * w.w * (1.f + sc.w) + sh.w;
          uint2 o;
          o.x = pack2(v[i * 4 + 0], v[i * 4 + 1]);
          o.y = pack2(v[i * 4 + 2], v[i * 4 + 3]);
          *(uint2*)(HB + (size_t)row * 1024 + c) = o;
        }
      }
      if (ROUTER) {
        const float* rw = p.in[I_RTW];
        float sc[16], bi[16];
#pragma unroll
        for (int eh = 0; eh < 2; ++eh) {
          float lg[8];
#pragma unroll
          for (int e = 0; e < 8; ++e) lg[e] = 0.f;
#pragma unroll
          for (int i = 0; i < 4; ++i) {
#pragma unroll
            for (int q = 0; q < 4; ++q) {
              const int c = (i * 64 + lane) * 4 + q;
              const float4 w0 = *(const float4*)(rw + c * 16 + eh * 8), w1 = *(const float4*)(rw + c * 16 + eh * 8 + 4);
              const float h = v[i * 4 + q];
              lg[0] += h * w0.x; lg[1] += h * w0.y; lg[2] += h * w0.z; lg[3] += h * w0.w;
              lg[4] += h * w1.x; lg[5] += h * w1.y; lg[6] += h * w1.z; lg[7] += h * w1.w;
            }
            __builtin_amdgcn_sched_barrier(0);
          }
#pragma unroll
          for (int e = 0; e < 8; ++e) {
            const float lgv = wave_sum(lg[e]);
            sc[eh * 8 + e] = 1.f / (1.f + __expf(-lgv));
            bi[eh * 8 + e] = sc[eh * 8 + e] + p.in[I_RTB][eh * 8 + e];
          }
        }
        int tg = 0; float best = -3.0e38f;
#pragma unroll
        for (int g = 0; g < 4; ++g) {
          float m1 = -3.0e38f, m2 = -3.0e38f;
#pragma unroll
          for (int j = 0; j < 4; ++j) {
            const float x = bi[g * 4 + j];
            if (x > m1) { m2 = m1; m1 = x; } else if (x > m2) { m2 = x; }
          }
          const float gs = m1 + m2;
          if (gs > best) { best = gs; tg = g; }
        }
        int i0 = -1, i1 = -1; float b0 = -3.0e38f, b1 = -3.0e38f, s0 = 0.f, s1 = 0.f;
#pragma unroll
        for (int e = 0; e < 16; ++e) {
          if ((e >> 2) == tg) {
            const float x = bi[e];
            if (x > b0) { b1 = b0; i1 = i0; s1 = s0; b0 = x; i0 = e; s0 = sc[e]; }
            else if (x > b1) { b1 = x; i1 = e; s1 = sc[e]; }
          }
        }
        if (lane == 0) {
          const float inv = 1.f / (s0 + s1);
          float* topw = (float*)(ws + O_TOPW);
          topw[row * 2 + 0] = s0 * inv;
          topw[row * 2 + 1] = s1 * inv;
          const int a = (it * 4 + wid) * 2;
          lexp[a] = i0; lrank[a] = atomicAdd(&lcnt[i0], 1);
          lexp[a + 1] = i1; lrank[a + 1] = atomicAdd(&lcnt[i1], 1);
        }
      }
    }
    if (ROUTER) {
      __syncthreads();
      int* cnt = (int*)(ws + O_CNT) + layer * 16 * 64;
      if (tid < 16) lbase[tid] = atomicAdd(&cnt[tid * 64], lcnt[tid]);
      __syncthreads();
      if (tid < 64) {
        const int e = lexp[tid];
        const int slot = lbase[e] + lrank[tid];
        ((int*)(ws + O_LIST))[(size_t)e * NT + slot] = (chunk * 32 + (tid >> 1)) * 2 + (tid & 1);
      }
      __syncthreads();
    }
  }
}

constexpr int NR = 2;
DI void norm_router_phase(const Params& p, char* smem, const float* xin, const float* nw, const float* modl, int sh_off, int sc_off, int layer) {
  char* ws = p.ws;
  const int tid = tid_opaque(), lane = tid & 63, wid = tid >> 6;
  bfr* HB = (bfr*)(ws + O_HB);
  int* lcnt = (int*)smem;
  int* lbase = lcnt + 16;
  int* lexp = lbase + 16;
  int* lrank = lexp + 64;
  const float* rw = p.in[I_RTW];
  for (int chunk = VB; chunk < NT / 32; chunk += NVB) {
    if (tid < 16) lcnt[tid] = 0;
    __syncthreads();
#pragma unroll 1
    for (int it2 = 0; it2 < 8 / NR; ++it2) {
      const int row0 = chunk * 32 + wid * 8 + it2 * NR;
      const int b = row0 >> 11;
      float v[NR][16];
      float ss[NR];
#pragma unroll
      for (int rr = 0; rr < NR; ++rr) {
        ss[rr] = 0.f;
#pragma unroll
        for (int i = 0; i < 4; ++i) {
          const float4 x = *(const float4*)(xin + (size_t)(row0 + rr) * 1024 + (i * 64 + lane) * 4);
          v[rr][i * 4 + 0] = x.x; v[rr][i * 4 + 1] = x.y; v[rr][i * 4 + 2] = x.z; v[rr][i * 4 + 3] = x.w;
          ss[rr] += x.x * x.x + x.y * x.y + x.z * x.z + x.w * x.w;
        }
      }
#pragma unroll
      for (int rr = 0; rr < NR; ++rr) ss[rr] = rsqrtf(wave_sum(ss[rr]) * (1.f / 1024.f) + 1e-6f);
#pragma unroll
      for (int i = 0; i < 4; ++i) {
        const int c = (i * 64 + lane) * 4;
        const float4 w = *(const float4*)(nw + c);
        const float4 sc = *(const float4*)(modl + b * 6144 + sc_off + c);
        const float4 sh = *(const float4*)(modl + b * 6144 + sh_off + c);
#pragma unroll
        for (int rr = 0; rr < NR; ++rr) {
          v[rr][i * 4 + 0] = v[rr][i * 4 + 0] * ss[rr] * w.x * (1.f + sc.x) + sh.x;
          v[rr][i * 4 + 1] = v[rr][i * 4 + 1] * ss[rr] * w.y * (1.f + sc.y) + sh.y;
          v[rr][i * 4 + 2] = v[rr][i * 4 + 2] * ss[rr] * w.z * (1.f + sc.z) + sh.z;
          v[rr][i * 4 + 3] = v[rr][i * 4 + 3] * ss[rr] * w.w * (1.f + sc.w) + sh.w;
          *(uint2*)(HB + (size_t)(row0 + rr) * 1024 + c) = make_uint2(pack2(v[rr][i * 4 + 0], v[rr][i * 4 + 1]), pack2(v[rr][i * 4 + 2], v[rr][i * 4 + 3]));
        }
      }
      float* sgl = (float*)(smem + 1024) + wid * 64;
#pragma unroll 1
      for (int eh = 0; eh < 2; ++eh) {
        float lg[NR][8];
#pragma unroll
        for (int rr = 0; rr < NR; ++rr)
#pragma unroll
          for (int e = 0; e < 8; ++e) lg[rr][e] = 0.f;
#pragma unroll
        for (int i = 0; i < 4; ++i) {
#pragma unroll
          for (int q = 0; q < 4; ++q) {
            const int c = (i * 64 + lane) * 4 + q;
            const float4 w0 = *(const float4*)(rw + c * 16 + eh * 8), w1 = *(const float4*)(rw + c * 16 + eh * 8 + 4);
#pragma unroll
            for (int rr = 0; rr < NR; ++rr) {
              const float h = v[rr][i * 4 + q];
              lg[rr][0] += h * w0.x; lg[rr][1] += h * w0.y; lg[rr][2] += h * w0.z; lg[rr][3] += h * w0.w;
              lg[rr][4] += h * w1.x; lg[rr][5] += h * w1.y; lg[rr][6] += h * w1.z; lg[rr][7] += h * w1.w;
            }
          }
          __builtin_amdgcn_sched_barrier(0);
        }
#pragma unroll
        for (int rr = 0; rr < NR; ++rr)
#pragma unroll
          for (int e = 0; e < 8; ++e) {
            const float sv = 1.f / (1.f + __expf(-wave_sum(lg[rr][e])));
            if (lane == 0) sgl[rr * 16 + eh * 8 + e] = sv;
          }
      }
      __builtin_amdgcn_fence(__ATOMIC_RELEASE, "wavefront");
      __builtin_amdgcn_wave_barrier();
#pragma unroll
      for (int rr = 0; rr < NR; ++rr) {
        float bi[16], sgv[16];
#pragma unroll
        for (int e = 0; e < 16; ++e) { sgv[e] = sgl[rr * 16 + e]; bi[e] = sgv[e] + p.in[I_RTB][e]; }
        int tg = 0; float best = -3.0e38f;
#pragma unroll
        for (int g = 0; g < 4; ++g) {
          float m1 = -3.0e38f, m2 = -3.0e38f;
#pragma unroll
          for (int j = 0; j < 4; ++j) {
            const float x = bi[g * 4 + j];
            if (x > m1) { m2 = m1; m1 = x; } else if (x > m2) { m2 = x; }
          }
          const float gs = m1 + m2;
          if (gs > best) { best = gs; tg = g; }
        }
        int i0 = -1, i1 = -1; float b0 = -3.0e38f, b1 = -3.0e38f, s0 = 0.f, s1 = 0.f;
#pragma unroll
        for (int e = 0; e < 16; ++e) {
          if ((e >> 2) == tg) {
            const float x = bi[e];
            if (x > b0) { b1 = b0; i1 = i0; s1 = s0; b0 = x; i0 = e; s0 = sgv[e]; }
            else if (x > b1) { b1 = x; i1 = e; s1 = sgv[e]; }
          }
        }
        if (lane == 0) {
          const int row = row0 + rr;
          const float inv = 1.f / (s0 + s1);
          float* topw = (float*)(ws + O_TOPW);
          topw[row * 2 + 0] = s0 * inv;
          topw[row * 2 + 1] = s1 * inv;
          const int a = (wid * 8 + it2 * NR + rr) * 2;
          lexp[a] = i0; lrank[a] = atomicAdd(&lcnt[i0], 1);
          lexp[a + 1] = i1; lrank[a + 1] = atomicAdd(&lcnt[i1], 1);
        }
      }
    }
    __syncthreads();
    int* cnt = (int*)(ws + O_CNT) + layer * 16 * 64;
    if (tid < 16) lbase[tid] = atomicAdd(&cnt[tid * 64], lcnt[tid]);
    __syncthreads();
    if (tid < 64) {
      const int e = lexp[tid];
      const int slot = lbase[e] + lrank[tid];
      ((int*)(ws + O_LIST))[(size_t)e * NT + slot] = (chunk * 32 + (tid >> 1)) * 2 + (tid & 1);
    }
    __syncthreads();
  }
}

DI void gemm_proj_phase(const Params& p, char* smem, const bfr* Wt, int ncols_pad, bfr* out) {
  const bfr* HB = (const bfr*)(p.ws + O_HB);
  const int n_nt = ncols_pad / 128;
  const int ntiles = (NT / 128) * n_nt;
  for (int tile = VB; tile < ntiles; tile += NVB) {
    const int mt = tile / n_nt, nt = tile % n_nt;
    RowsContigW A{HB + (size_t)mt * 128 * 1024, 1024, 127};
    RowsContigW B{Wt + (size_t)nt * 128 * 1024, 1024, 127};
    gemm_tile_g(smem, 32 * KLOOP2, A, B, [&](f32x4(&acc)[4][4], int wr, int wc, int fr, int fq) {
      const float sc_ = 1.f / (float)KLOOP2;
#pragma unroll
      for (int m = 0; m < 4; ++m) {
        const int row = mt * 128 + wr * 64 + m * 16 + fr;
#pragma unroll
        for (int n = 0; n < 4; ++n) {
          const int col = nt * 128 + wc * 64 + n * 16 + fq * 4;
          *(uint2*)(out + (size_t)row * ncols_pad + col) = make_uint2(pack2(acc[m][n][0] * sc_, acc[m][n][1] * sc_), pack2(acc[m][n][2] * sc_, acc[m][n][3] * sc_));
        }
      }
    });
  }
}

DI void gemm_out_phase(const Params& p, char* smem, const bfr* Wt, const float* xin, float* xout, const float* gate  ) {
  const bfr* MIX = (const bfr*)(p.ws + O_MIX);
  const int ntiles = (NT / 128) * 8;
  for (int tile = VB; tile < ntiles; tile += NVB) {
    const int mt = tile / 8, nt = tile % 8;
    RowsContig A{MIX + (size_t)mt * 128 * 1024, 1024, 127};
    RowsContig B{Wt + (size_t)nt * 128 * 1024, 1024, 127};
    const int b = (mt * 128) >> 11;
    gemm_tile_g(smem, 32, A, B, [&](f32x4(&acc)[4][4], int wr, int wc, int fr, int fq) {
#pragma unroll
      for (int n = 0; n < 4; ++n) {
        const int col = nt * 128 + wc * 64 + n * 16 + fq * 4;
        const float4 g = *(const float4*)(gate + b * 6144 + col);
#pragma unroll
        for (int m = 0; m < 4; ++m) {
          const int row = mt * 128 + wr * 64 + m * 16 + fr;
          const float4 xi = *(const float4*)(xin + (size_t)row * 1024 + col);
          float4 o;
          o.x = xi.x + g.x * acc[m][n][0]; o.y = xi.y + g.y * acc[m][n][1]; o.z = xi.z + g.z * acc[m][n][2]; o.w = xi.w + g.w * acc[m][n][3];
          *(float4*)(xout + (size_t)row * 1024 + col) = o;
        }
      }
    });
  }
}

struct RowsCmp {
  const bfr* proj; int colbase; int mt;
  const bfr* rp[2];
  DI void init(int lr) {
#pragma unroll
    for (int i = 0; i < 2; ++i) {
      int rr = mt * 128 + lr + 64 * i; if (rr > 2031) rr = 2031;
      const int h = rr & 1, bn = rr >> 1, b = bn / 127, nc = bn % 127;
      rp[i] = proj + (size_t)(b * SEQ + nc * 16) * PW0 + colbase + h * 64;
    }
  }
  DI uint4 load(int sel, int k) const { return *(const uint4*)(rp[sel] + (k >> 6) * PW0 + (k & 63)); }
  DI const bfr* ptr(int sel, int k) const { return rp[sel] + (k >> 6) * PW0 + (k & 63); }
};

DI float gelu_tanh(float x) {
  const float u = 0.7978845608028654f * (x + 0.044715f * x * x * x);
  return 0.5f * x * (1.f + tanhf(u));
}

DI void post0_phase(const Params& p, char* smem) {
  char* ws = p.ws;
  const bfr* PROJ = (const bfr*)(ws + O_PROJ);
  const int tid = tid_opaque();
  for (int tile = VB; tile < 64; tile += NVB) {
    const int j = tile >> 5, mt = (tile >> 1) & 15, nt = tile & 1;
    RowsCmp A{PROJ, j ? C_VC : C_KC, mt};
    RowsContig B{(const bfr*)(ws + O_WC1) + ((size_t)j * 256 + nt * 128) * 2048, 2048, 127};
    bfr* CH = (bfr*)(ws + O_CH) + (size_t)j * 2048 * 256;
    const float* bias = (const float*)(ws + O_BIAS1) + j * 256;
    gemm_tile(smem, 64, A, B, [&](f32x4(&acc)[4][4], int wr, int wc, int fr, int fq) {
#pragma unroll
      for (int m = 0; m < 4; ++m)
#pragma unroll
        for (int n = 0; n < 4; ++n) {
          const int col = nt * 128 + wc * 64 + n * 16 + fr;
          const float bb = bias[col];
#pragma unroll
          for (int jj = 0; jj < 4; ++jj) {
            const int row = mt * 128 + wr * 64 + m * 16 + fq * 4 + jj;
            CH[(size_t)row * 256 + col] = f2bf(gelu_tanh(acc[m][n][jj] + bb));
          }
        }
    });
  }
  {
    bfr(*tt)[66] = (bfr(*)[66])smem;
    for (int item = VB; item < 1024; item += NVB) {
      const int tl = item & 31, hk = (item >> 5) & 1, which = (item >> 6) & 1, b = item >> 7;
      const bfr* src = PROJ + (size_t)(b * SEQ + tl * 64) * PW0 + (which ? C_VW : C_VS) + hk * 64;
      bfr* dst = (bfr*)(ws + (which ? O_VWT : O_VST)) + (size_t)((b * 2 + hk) * 64) * SEQ + tl * 64;
      for (int e = tid; e < 64 * 32; e += 256) {
        const int row = e >> 5, c2 = (e & 31) * 2;
        const unsigned u = *(const unsigned*)(src + (size_t)row * PW0 + c2);
        tt[row][c2] = (bfr)(u & 0xffffu); tt[row][c2 + 1] = (bfr)(u >> 16);
      }
      __syncthreads();
      for (int e = tid; e < 64 * 32; e += 256) {
        const int d = e >> 5, t2 = (e & 31) * 2;
        const unsigned u = (unsigned)tt[t2][d] | ((unsigned)tt[t2 + 1][d] << 16);
        *(unsigned*)(dst + (size_t)d * SEQ + t2) = u;
      }
      __syncthreads();
    }
  }
  const float* ropec = (const float*)(ws + O_ROPE);
  const float* ropes = ropec + 65536;
  bfr* QR = (bfr*)(ws + O_QR);
  bfr* KSR = (bfr*)(ws + O_KSR);
  bfr* KWR = (bfr*)(ws + O_KWR);
  bfr* MIX = (bfr*)(ws + O_MIX);
  const float* cw = p.in[I_CONVW];
  for (int item = VB; item < NT / 8; item += NVB) {
    for (int e = tid; e < 8 * 48; e += 256) {
      const int tt = e / 48, u = e % 48;
      const int tok = item * 8 + tt, t = tok & (SEQ - 1);
      const int hh = u >> 2, i0 = (u & 3) * 8;
      const bfr* src; bfr* dst;
      if (hh < 8) { src = PROJ + (size_t)tok * PW0 + C_Q + hh * 64; dst = QR + (size_t)tok * 512 + hh * 64; }
      else if (hh < 10) { src = PROJ + (size_t)tok * PW0 + C_KS + (hh - 8) * 64; dst = KSR + (size_t)tok * 128 + (hh - 8) * 64; }
      else { src = PROJ + (size_t)tok * PW0 + C_KW + (hh - 10) * 64; dst = KWR + (size_t)tok * 128 + (hh - 10) * 64; }
      const uint4 x1 = *(const uint4*)(src + i0), x2 = *(const uint4*)(src + 32 + i0);
      const float4 c0 = *(const float4*)(ropec + t * 32 + i0), c1 = *(const float4*)(ropec + t * 32 + i0 + 4);
      const float4 s0 = *(const float4*)(ropes + t * 32 + i0), s1 = *(const float4*)(ropes + t * 32 + i0 + 4);
      const float a[8] = {lo2f(x1.x), hi2f(x1.x), lo2f(x1.y), hi2f(x1.y), lo2f(x1.z), hi2f(x1.z), lo2f(x1.w), hi2f(x1.w)};
      const float bq[8] = {lo2f(x2.x), hi2f(x2.x), lo2f(x2.y), hi2f(x2.y), lo2f(x2.z), hi2f(x2.z), lo2f(x2.w), hi2f(x2.w)};
      const float cc[8] = {c0.x, c0.y, c0.z, c0.w, c1.x, c1.y, c1.z, c1.w};
      const float ss[8] = {s0.x, s0.y, s0.z, s0.w, s1.x, s1.y, s1.z, s1.w};
      float o1[8], o2[8];
#pragma unroll
      for (int i = 0; i < 8; ++i) { o1[i] = a[i] * cc[i] - bq[i] * ss[i]; o2[i] = bq[i] * cc[i] + a[i] * ss[i]; }
      *(uint4*)(dst + i0) = make_uint4(pack2(o1[0], o1[1]), pack2(o1[2], o1[3]), pack2(o1[4], o1[5]), pack2(o1[6], o1[7]));
      *(uint4*)(dst + 32 + i0) = make_uint4(pack2(o2[0], o2[1]), pack2(o2[2], o2[3]), pack2(o2[4], o2[5]), pack2(o2[6], o2[7]));
    }
    for (int e = tid; e < 8 * 64; e += 256) {
      const int tt = e >> 6, ch = (e & 63) * 8;
      const int tok = item * 8 + tt, t = tok & (SEQ - 1);
      const bfr* pr = PROJ + (size_t)tok * PW0;
      float u0[8], u1[8], u2[8], bgv[8];
      {
        const uint4 cg = *(const uint4*)(pr + C_CG + ch), xb = *(const uint4*)(pr + C_XB + ch), bg = *(const uint4*)(pr + C_BG + ch);
        u0[0] = lo2f(cg.x) * lo2f(xb.x); u0[1] = hi2f(cg.x) * hi2f(xb.x); u0[2] = lo2f(cg.y) * lo2f(xb.y); u0[3] = hi2f(cg.y) * hi2f(xb.y);
        u0[4] = lo2f(cg.z) * lo2f(xb.z); u0[5] = hi2f(cg.z) * hi2f(xb.z); u0[6] = lo2f(cg.w) * lo2f(xb.w); u0[7] = hi2f(cg.w) * hi2f(xb.w);
        bgv[0] = lo2f(bg.x); bgv[1] = hi2f(bg.x); bgv[2] = lo2f(bg.y); bgv[3] = hi2f(bg.y);
        bgv[4] = lo2f(bg.z); bgv[5] = hi2f(bg.z); bgv[6] = lo2f(bg.w); bgv[7] = hi2f(bg.w);
      }
#pragma unroll
      for (int i = 0; i < 8; ++i) { u1[i] = 0.f; u2[i] = 0.f; }
      if (t >= 1) {
        const uint4 cg = *(const uint4*)(pr - PW0 + C_CG + ch), xb = *(const uint4*)(pr - PW0 + C_XB + ch);
        u1[0] = lo2f(cg.x) * lo2f(xb.x); u1[1] = hi2f(cg.x) * hi2f(xb.x); u1[2] = lo2f(cg.y) * lo2f(xb.y); u1[3] = hi2f(cg.y) * hi2f(xb.y);
        u1[4] = lo2f(cg.z) * lo2f(xb.z); u1[5] = hi2f(cg.z) * hi2f(xb.z); u1[6] = lo2f(cg.w) * lo2f(xb.w); u1[7] = hi2f(cg.w) * hi2f(xb.w);
      }
      if (t >= 2) {
        const uint4 cg = *(const uint4*)(pr - 2 * PW0 + C_CG + ch), xb = *(const uint4*)(pr - 2 * PW0 + C_XB + ch);
        u2[0] = lo2f(cg.x) * lo2f(xb.x); u2[1] = hi2f(cg.x) * hi2f(xb.x); u2[2] = lo2f(cg.y) * lo2f(xb.y); u2[3] = hi2f(cg.y) * hi2f(xb.y);
        u2[4] = lo2f(cg.z) * lo2f(xb.z); u2[5] = hi2f(cg.z) * hi2f(xb.z); u2[6] = lo2f(cg.w) * lo2f(xb.w); u2[7] = hi2f(cg.w) * hi2f(xb.w);
      }
      float y[8];
#pragma unroll
      for (int i = 0; i < 8; ++i) y[i] = bgv[i] * (cw[2 * 512 + ch + i] * u0[i] + cw[1 * 512 + ch + i] * u1[i] + cw[0 * 512 + ch + i] * u2[i]);
      *(uint4*)(MIX + (size_t)tok * 1024 + 512 + ch) = make_uint4(pack2(y[0], y[1]), pack2(y[2], y[3]), pack2(y[4], y[5]), pack2(y[6], y[7]));
    }
  }
}

DI void cmp2_phase(const Params& p, char* smem) {
  char* ws = p.ws;
  for (int tile = VB; tile < 32; tile += NVB) {
    const int j = tile >> 4, mt = tile & 15;
    RowsContig A{(const bfr*)(ws + O_CH) + ((size_t)j * 2048 + mt * 128) * 256, 256, 127};
    RowsContig B{(const bfr*)(ws + O_WC2) + (size_t)j * 128 * 256, 256, 127};
    bfr* KC = (bfr*)(ws + O_KCVC) + (size_t)j * 2048 * 64;
    gemm_tile(smem, 8, A, B, [&](f32x4(&acc)[4][4], int wr, int wc, int fr, int fq) {
      if (wc == 0) {
#pragma unroll
        for (int m = 0; m < 4; ++m)
#pragma unroll
          for (int n = 0; n < 4; ++n)
#pragma unroll
            for (int jj = 0; jj < 4; ++jj) {
              const int row = mt * 128 + wr * 64 + m * 16 + fq * 4 + jj, col = n * 16 + fr;
              const bfr hv = f2bf(acc[m][n][jj]);
              KC[(size_t)row * 64 + col] = hv;
              if (j == 1 && row < 2032) {
                const int hk = row & 1, bn = row >> 1, bb = bn / 127, cc = bn % 127;
                ((bfr*)(ws + O_VCT))[((size_t)((bb * 2 + hk) * 64 + col)) * 128 + cc] = hv;
              }
            }
      }
    });
  }
}

DI void cmp_attn_phase(const Params& p, char* smem) {
  char* ws = p.ws;
  const bfr* PROJ = (const bfr*)(ws + O_PROJ);
  const bfr* KC = (const bfr*)(ws + O_KCVC);
  const bfr* VC = KC + 2048 * 64;
  bfr* OCMP = (bfr*)(ws + O_OCMP);
  unsigned* SEL = (unsigned*)(ws + O_SEL);
  const int tid = tid_opaque();
  for (int item = VB; item < NT / 32; item += NVB) {
    const int tok = item * 32 + (tid >> 3), head = tid & 7, hkv = head >> 2;
    const int b = tok >> 11, t = tok & (SEQ - 1);
    const int nv = t >= 31 ? ((t - 31) >> 4) + 1 : 0;
    unsigned q[32];
    {
      const uint4* qp = (const uint4*)(PROJ + (size_t)tok * PW0 + C_Q + head * 64);
#pragma unroll
      for (int i = 0; i < 8; ++i) { const uint4 u = qp[i]; q[i * 4] = u.x; q[i * 4 + 1] = u.y; q[i * 4 + 2] = u.z; q[i * 4 + 3] = u.w; }
    }
    const bfr* kb = KC + ((size_t)(b * 127) * 2 + hkv) * 64;
    const bfr* vb = VC + ((size_t)(b * 127) * 2 + hkv) * 64;
    auto dotk = [&](int c) {
      const uint4* kp = (const uint4*)(kb + (size_t)c * 128);
      float a = 0.f;
#pragma unroll
      for (int i = 0; i < 8; ++i) {
        const uint4 u = kp[i];
        a = dot2(q[i * 4], u.x, a); a = dot2(q[i * 4 + 1], u.y, a); a = dot2(q[i * 4 + 2], u.z, a); a = dot2(q[i * 4 + 3], u.w, a);
      }
      return a * 0.125f;
    };
    float mx = -1e30f;
    for (int c = 0; c < nv; ++c) mx = fmaxf(mx, dotk(c));
    float o[64];
#pragma unroll
    for (int i = 0; i < 64; ++i) o[i] = 0.f;
    float l = 0.f;
    for (int c = 0; c < nv; ++c) {
      const float pe = __expf(dotk(c) - mx);
      l += pe;
      const uint4* vp = (const uint4*)(vb + (size_t)c * 128);
#pragma unroll
      for (int i = 0; i < 8; ++i) {
        const uint4 u = vp[i];
        o[i * 8 + 0] += pe * lo2f(u.x); o[i * 8 + 1] += pe * hi2f(u.x);
        o[i * 8 + 2] += pe * lo2f(u.y); o[i * 8 + 3] += pe * hi2f(u.y);
        o[i * 8 + 4] += pe * lo2f(u.z); o[i * 8 + 5] += pe * hi2f(u.z);
        o[i * 8 + 6] += pe * lo2f(u.w); o[i * 8 + 7] += pe * hi2f(u.w);
      }
    }
    const float invl = nv > 0 ? 1.f / l : 0.f;
    {
      const float gl = bf2f(PROJ[(size_t)tok * PW0 + C_GL + head * 3 + 0]);
      const float g0 = sigmoidf_(gl) * invl;
      uint4* op = (uint4*)(OCMP + (size_t)tok * 512 + head * 64);
#pragma unroll
      for (int i = 0; i < 8; ++i) {
        uint4 u;
        u.x = pack2(o[i * 8 + 0] * g0, o[i * 8 + 1] * g0); u.y = pack2(o[i * 8 + 2] * g0, o[i * 8 + 3] * g0);
        u.z = pack2(o[i * 8 + 4] * g0, o[i * 8 + 5] * g0); u.w = pack2(o[i * 8 + 6] * g0, o[i * 8 + 7] * g0);
        op[i] = u;
      }
    }
    const int cur = t >> 6;
    float tv0 = -1.f, tv1 = -1.f, tv2 = -1.f, tv3 = -1.f, tv4 = -1.f;
    int ti0 = -1, ti1 = -1, ti2 = -1, ti3 = -1, ti4 = -1;
    float part = 0.f;
    int curmax = cur;
#pragma unroll
    for (int o2 = 32; o2 > 0; o2 >>= 1) curmax = max(curmax, __shfl_xor(curmax, o2));
#pragma unroll 1
    for (int j = 0; j <= curmax + 1 && j <= 32; ++j) {
      float e[4];
#pragma unroll
      for (int oo = 0; oo < 4; ++oo) {
        const int c = j * 4 + oo;
        float pe = 0.f;
        if (c < nv) pe = __expf(dotk(c) - mx) * invl;
        pe += __shfl_xor(pe, 1);
        pe += __shfl_xor(pe, 2);
        e[oo] = pe;
      }
      if (j >= 1) {
        const float val = part + e[0];
        const int jb = j - 1;
        if (jb >= 1 && jb <= cur - 2) {
          if (val > tv4) {
            tv4 = val; ti4 = jb;
            if (tv4 > tv3) { float tf = tv3; tv3 = tv4; tv4 = tf; int tii = ti3; ti3 = ti4; ti4 = tii; }
            if (tv3 > tv2) { float tf = tv2; tv2 = tv3; tv3 = tf; int tii = ti2; ti2 = ti3; ti3 = tii; }
            if (tv2 > tv1) { float tf = tv1; tv1 = tv2; tv2 = tf; int tii = ti1; ti1 = ti2; ti2 = tii; }
            if (tv1 > tv0) { float tf = tv0; tv0 = tv1; tv1 = tf; int tii = ti0; ti0 = ti1; ti1 = tii; }
          }
        }
      }
      part = e[0] + 2.f * (e[1] + e[2] + e[3]);
    }
    unsigned mask = 1u | (1u << cur);
    if (cur >= 1) mask |= 1u << (cur - 1);
    if (ti0 >= 0) mask |= 1u << ti0;
    if (ti1 >= 0) mask |= 1u << ti1;
    if (ti2 >= 0) mask |= 1u << ti2;
    if (ti3 >= 0) mask |= 1u << ti3;
    if (ti4 >= 0) mask |= 1u << ti4;
    if ((head & 3) == 0) SEL[tok * 2 + hkv] = mask;
  }
}

DI void slcwin_phase(const Params& p, char* smem) {
  char* ws = p.ws;
  const bfr* PROJ = (const bfr*)(ws + O_PROJ);
  const bfr* QR = (const bfr*)(ws + O_QR);
  const bfr* KSR = (const bfr*)(ws + O_KSR);
  const bfr* KWR = (const bfr*)(ws + O_KWR);
  const bfr* OCMP = (const bfr*)(ws + O_OCMP);
  const unsigned* SEL = (const unsigned*)(ws + O_SEL);
  bfr* MIX = (bfr*)(ws + O_MIX);
  const int tid = tid_opaque(), lane = tid & 63, wid = tid >> 6;
  for (int item = VB; item < 512; item += NVB) {
    const int tile = 31 - (item >> 4), bh = item & 15, b = bh >> 1, hkv = bh & 1;
    const int t = tile * 64 + lane, tok = b * SEQ + t, head = hkv * 4 + wid;
    unsigned q[32];
    {
      const uint4* qp = (const uint4*)(QR + (size_t)tok * 512 + head * 64);
#pragma unroll
      for (int i = 0; i < 8; ++i) { const uint4 u = qp[i]; q[i * 4] = u.x; q[i * 4 + 1] = u.y; q[i * 4 + 2] = u.z; q[i * 4 + 3] = u.w; }
    }
    const unsigned sel = SEL[tok * 2 + hkv];
#pragma unroll 1
    for (int pass = 0; pass < 2; ++pass) {
      const bfr* Kb = (pass == 0 ? KSR : KWR) + (size_t)b * SEQ * 128 + hkv * 64;
      const bfr* Vb = PROJ + (size_t)b * SEQ * PW0 + (pass == 0 ? C_VS : C_VW) + hkv * 64;
      float o[64];
#pragma unroll
      for (int i = 0; i < 64; ++i) o[i] = 0.f;
      float m = -1e30f, l = 0.f;
      const int jlo = pass == 0 ? 0 : (tile >= 8 ? tile - 8 : 0);
#pragma unroll 1
      for (int j = jlo; j <= tile; ++j) {
        const bool lane_ok = pass == 0 ? ((sel >> j) & 1u) != 0 : true;
        if (pass == 0 && !__any(lane_ok)) continue;
#pragma unroll 1
        for (int kb = 0; kb < 64; kb += 4) {
          float s[4];
#pragma unroll
          for (int kk = 0; kk < 4; ++kk) {
            const int key = j * 64 + kb + kk;
            const uint4* kp = (const uint4*)(Kb + (size_t)key * 128);
            float a = 0.f;
#pragma unroll
            for (int i = 0; i < 8; ++i) {
              const uint4 u = kp[i];
              a = dot2(q[i * 4], u.x, a); a = dot2(q[i * 4 + 1], u.y, a); a = dot2(q[i * 4 + 2], u.z, a); a = dot2(q[i * 4 + 3], u.w, a);
            }
            bool ok = lane_ok && key <= t;
            if (pass == 1) ok = ok && (t - key < 512);
            s[kk] = ok ? a * 0.125f : -1e30f;
          }
          const float cm = fmaxf(fmaxf(s[0], s[1]), fmaxf(s[2], s[3]));
          const float mn = fmaxf(m, cm);
          const float corr = __expf(m - mn);
          m = mn;
          float pe[4];
#pragma unroll
          for (int kk = 0; kk < 4; ++kk) pe[kk] = s[kk] > -1e29f ? __expf(s[kk] - mn) : 0.f;
          l = l * corr + (pe[0] + pe[1] + pe[2] + pe[3]);
#pragma unroll
          for (int i = 0; i < 64; ++i) o[i] *= corr;
#pragma unroll
          for (int kk = 0; kk < 4; ++kk) {
            const int key = j * 64 + kb + kk;
            const uint4* vp = (const uint4*)(Vb + (size_t)key * PW0);
#pragma unroll
            for (int i = 0; i < 8; ++i) {
              const uint4 u = vp[i];
              o[i * 8 + 0] += pe[kk] * lo2f(u.x); o[i * 8 + 1] += pe[kk] * hi2f(u.x);
              o[i * 8 + 2] += pe[kk] * lo2f(u.y); o[i * 8 + 3] += pe[kk] * hi2f(u.y);
              o[i * 8 + 4] += pe[kk] * lo2f(u.z); o[i * 8 + 5] += pe[kk] * hi2f(u.z);
              o[i * 8 + 6] += pe[kk] * lo2f(u.w); o[i * 8 + 7] += pe[kk] * hi2f(u.w);
            }
          }
        }
      }
      const float gate = sigmoidf_(bf2f(PROJ[(size_t)tok * PW0 + C_GL + head * 3 + 1 + pass]));
      const float gsc = gate * (l > 0.f ? 1.f / l : 0.f);
      uint4* op = (uint4*)(MIX + (size_t)tok * 1024 + head * 64);
      const uint4* cp = pass == 0 ? (const uint4*)(OCMP + (size_t)tok * 512 + head * 64) : (const uint4*)op;
#pragma unroll
      for (int i = 0; i < 8; ++i) {
        const uint4 c = cp[i];
        uint4 u;
        u.x = pack2(o[i * 8 + 0] * gsc + lo2f(c.x), o[i * 8 + 1] * gsc + hi2f(c.x));
        u.y = pack2(o[i * 8 + 2] * gsc + lo2f(c.y), o[i * 8 + 3] * gsc + hi2f(c.y));
        u.z = pack2(o[i * 8 + 4] * gsc + lo2f(c.z), o[i * 8 + 5] * gsc + hi2f(c.z));
        u.w = pack2(o[i * 8 + 6] * gsc + lo2f(c.w), o[i * 8 + 7] * gsc + hi2f(c.w));
        op[i] = u;
      }
    }
  }
}

using f32x16 = __attribute__((ext_vector_type(16))) float;
#define MFMA32(a, b, c) __builtin_amdgcn_mfma_f32_32x32x16_bf16((a), (b), (c), 0, 0, 0)
struct AttnLds { bfr k[2][64][72]; bfr vt[2][64][68]; };
static_assert(sizeof(AttnLds) <= 49152, "attn lds");
DI int crow16(int i, int h2) { return (i & 3) + 8 * (i >> 2) + 4 * h2; }

DI void attn_sw_phase(const Params& p, char* smem) {
  char* ws = p.ws;
  AttnLds& L = *(AttnLds*)smem;
  const bfr* PROJ = (const bfr*)(ws + O_PROJ);
  const bfr* QR = (const bfr*)(ws + O_QR);
  const bfr* OCMP = (const bfr*)(ws + O_OCMP);
  const unsigned* SEL = (const unsigned*)(ws + O_SEL);
  bfr* MIX = (bfr*)(ws + O_MIX);
  const int tid = tid_opaque(), lane = tid & 63, wid = tid >> 6, r = lane & 31, h2 = lane >> 5;
  const float CS = 0.125f * 1.4426950408889634f;
  const int lrow = tid >> 3, lc8 = (tid & 7) * 8;
  for (int item = VB; item < 1024; item += NVB) {
    const int qt = item < 512 ? 63 - (item >> 4) : ((item - 512) >> 4);
    const int bh = item & 15, b = bh >> 1, hkv = bh & 1;
    const int cur = qt >> 1;
    const int tokl = qt * 32 + wid * 8 + (r >> 2), g = r & 3, head = hkv * 4 + g, tok = b * SEQ + tokl;
    bf16x8 qf[4];
#pragma unroll
    for (int s = 0; s < 4; ++s) qf[s] = *(const bf16x8*)(QR + (size_t)tok * 512 + head * 64 + 16 * s + 8 * h2);
    const unsigned sel = SEL[tok * 2 + hkv];
    const int nslc = cur + 1, wlo = cur > 8 ? cur - 8 : 0, T = nslc + (cur - wlo + 1);
    const bfr* KS = (const bfr*)(ws + O_KSR) + (size_t)b * SEQ * 128 + hkv * 64;
    const bfr* KW = (const bfr*)(ws + O_KWR) + (size_t)b * SEQ * 128 + hkv * 64;
    const bfr* VS = (const bfr*)(ws + O_VST) + (size_t)((b * 2 + hkv) * 64) * SEQ;
    const bfr* VW = (const bfr*)(ws + O_VWT) + (size_t)((b * 2 + hkv) * 64) * SEQ;
    uint4 rk0, rk1, rv0, rv1;
    auto gload = [&](int tt) {
      const int pass = tt >= nslc, j = pass ? wlo + tt - nslc : tt;
      const bfr* kb = (pass ? KW : KS) + (size_t)(j * 64) * 128 + lc8;
      const bfr* vb = (pass ? VW : VS) + j * 64 + lc8;
      rk0 = *(const uint4*)(kb + (size_t)lrow * 128); rk1 = *(const uint4*)(kb + (size_t)(lrow + 32) * 128);
      rv0 = *(const uint4*)(vb + (size_t)lrow * SEQ); rv1 = *(const uint4*)(vb + (size_t)(lrow + 32) * SEQ);
    };
    auto lstore = [&](int buf) {
      *(uint4*)&L.k[buf][lrow][lc8] = rk0; *(uint4*)&L.k[buf][lrow + 32][lc8] = rk1;
      *(uint2*)&L.vt[buf][lrow][lc8] = make_uint2(rv0.x, rv0.y); *(uint2*)&L.vt[buf][lrow][lc8 + 4] = make_uint2(rv0.z, rv0.w);
      *(uint2*)&L.vt[buf][lrow + 32][lc8] = make_uint2(rv1.x, rv1.y); *(uint2*)&L.vt[buf][lrow + 32][lc8 + 4] = make_uint2(rv1.z, rv1.w);
    };
    gload(0); lstore(0);
    __syncthreads();
    float m = -1e30f, l = 0.f;
    f32x16 o0, o1;
#pragma unroll
    for (int i = 0; i < 16; ++i) { o0[i] = 0.f; o1[i] = 0.f; }
#pragma unroll 1
    for (int tt = 0; tt < T; ++tt) {
      const int buf = tt & 1;
      if (tt + 1 < T) gload(tt + 1);
      const int pass = tt >= nslc, j = pass ? wlo + tt - nslc : tt;
      const bool rowok = pass ? true : ((sel >> j) & 1u) != 0u;
      if (__any(rowok)) {
        f32x16 s0, s1;
#pragma unroll
        for (int i = 0; i < 16; ++i) { s0[i] = 0.f; s1[i] = 0.f; }
#pragma unroll
        for (int s = 0; s < 4; ++s) {
          const bf16x8 k0 = *(const bf16x8*)&L.k[buf][r][16 * s + 8 * h2];
          const bf16x8 k1 = *(const bf16x8*)&L.k[buf][32 + r][16 * s + 8 * h2];
          s0 = MFMA32(k0, qf[s], s0);
          s1 = MFMA32(k1, qf[s], s1);
        }
        if (!rowok) {
#pragma unroll
          for (int i = 0; i < 16; ++i) { s0[i] = -1e30f; s1[i] = -1e30f; }
        }
        if (j == cur) {
          const int lim = tokl - j * 64;
#pragma unroll
          for (int i = 0; i < 16; ++i) {
            if (crow16(i, h2) > lim) s0[i] = -1e30f;
            if (32 + crow16(i, h2) > lim) s1[i] = -1e30f;
          }
        }
        if (pass && cur >= 8 && j == cur - 8) {
          const int lo = tokl - 512 - j * 64;
#pragma unroll
          for (int i = 0; i < 16; ++i) {
            if (crow16(i, h2) <= lo) s0[i] = -1e30f;
            if (32 + crow16(i, h2) <= lo) s1[i] = -1e30f;
          }
        }
        float mx = -1e30f;
#pragma unroll
        for (int i = 0; i < 16; ++i) mx = fmaxf(mx, fmaxf(s0[i], s1[i]));
        mx = fmaxf(mx, __shfl_xor(mx, 32));
        const float mnew = fmaxf(m, mx);
        const float mu = fmaxf(mnew, -1e20f);
        const float corr = __builtin_amdgcn_exp2f((m - mu) * CS);
        m = mnew;
        const float muc = mu * CS;
        float ps = 0.f;
#pragma unroll
        for (int i = 0; i < 16; ++i) {
          s0[i] = __builtin_amdgcn_exp2f(fmaf(s0[i], CS, -muc));
          s1[i] = __builtin_amdgcn_exp2f(fmaf(s1[i], CS, -muc));
          ps += s0[i] + s1[i];
        }
        l = l * corr + ps;
#pragma unroll
        for (int i = 0; i < 16; ++i) { o0[i] *= corr; o1[i] *= corr; }
#pragma unroll
        for (int kb = 0; kb < 2; ++kb) {
#pragma unroll
          for (int s = 0; s < 2; ++s) {
            uint4 pk;
            if (kb == 0) {
              pk.x = pack2(s0[8 * s + 0], s0[8 * s + 1]); pk.y = pack2(s0[8 * s + 2], s0[8 * s + 3]);
              pk.z = pack2(s0[8 * s + 4], s0[8 * s + 5]); pk.w = pack2(s0[8 * s + 6], s0[8 * s + 7]);
            } else {
              pk.x = pack2(s1[8 * s + 0], s1[8 * s + 1]); pk.y = pack2(s1[8 * s + 2], s1[8 * s + 3]);
              pk.z = pack2(s1[8 * s + 4], s1[8 * s + 5]); pk.w = pack2(s1[8 * s + 6], s1[8 * s + 7]);
            }
            const bf16x8 pf = __builtin_bit_cast(bf16x8, pk);
            const int kc = kb * 32 + 16 * s + 4 * h2;
            const uint2 a0 = *(const uint2*)&L.vt[buf][r][kc];
            const uint2 a1 = *(const uint2*)&L.vt[buf][r][kc + 8];
            const uint2 c0 = *(const uint2*)&L.vt[buf][32 + r][kc];
            const uint2 c1 = *(const uint2*)&L.vt[buf][32 + r][kc + 8];
            const bf16x8 v0 = __builtin_bit_cast(bf16x8, make_uint4(a0.x, a0.y, a1.x, a1.y));
            const bf16x8 v1 = __builtin_bit_cast(bf16x8, make_uint4(c0.x, c0.y, c1.x, c1.y));
            o0 = MFMA32(v0, pf, o0);
            o1 = MFMA32(v1, pf, o1);
          }
        }
      }
      if (tt == nslc - 1 || tt == T - 1) {
        const float lt = l + __shfl_xor(l, 32);
        const float gate = sigmoidf_(bf2f(PROJ[(size_t)tok * PW0 + C_GL + head * 3 + 1 + pass]));
        const float sc = lt > 0.f ? gate / lt : 0.f;
        bfr* mixp = MIX + (size_t)tok * 1024 + head * 64;
        const bfr* addp = pass ? (const bfr*)mixp : OCMP + (size_t)tok * 512 + head * 64;
#pragma unroll
        for (int q4 = 0; q4 < 4; ++q4) {
          const int d0 = 8 * q4 + 4 * h2;
          const uint2 c = *(const uint2*)(addp + d0);
          uint2 u;
          u.x = pack2(o0[q4 * 4 + 0] * sc + lo2f(c.x), o0[q4 * 4 + 1] * sc + hi2f(c.x));
          u.y = pack2(o0[q4 * 4 + 2] * sc + lo2f(c.y), o0[q4 * 4 + 3] * sc + hi2f(c.y));
          *(uint2*)(mixp + d0) = u;
          const uint2 c2 = *(const uint2*)(addp + 32 + d0);
          u.x = pack2(o1[q4 * 4 + 0] * sc + lo2f(c2.x), o1[q4 * 4 + 1] * sc + hi2f(c2.x));
          u.y = pack2(o1[q4 * 4 + 2] * sc + lo2f(c2.y), o1[q4 * 4 + 3] * sc + hi2f(c2.y));
          *(uint2*)(mixp + 32 + d0) = u;
        }
#pragma unroll
        for (int i = 0; i < 16; ++i) { o0[i] = 0.f; o1[i] = 0.f; }
        m = -1e30f; l = 0.f;
      }
      if (tt + 1 < T) lstore(buf ^ 1);
      __syncthreads();
    }
  }
}

struct CmpLds { bfr k[128][72]; bfr vt[64][132]; };
static_assert(sizeof(CmpLds) <= 49152, "cmp lds");
DI float quad_sum(float x) {
  const float y = x + __int_as_float(__builtin_amdgcn_update_dpp(0, __float_as_int(x), 0xB1, 0xF, 0xF, true));
  return y + __int_as_float(__builtin_amdgcn_update_dpp(0, __float_as_int(y), 0x4E, 0xF, 0xF, true));
}

DI void cmp_attn_mfma_phase(const Params& p, char* smem) {
  char* ws = p.ws;
  CmpLds& L = *(CmpLds*)smem;
  const bfr* PROJ = (const bfr*)(ws + O_PROJ);
  const bfr* KC = (const bfr*)(ws + O_KCVC);
  const bfr* VCT = (const bfr*)(ws + O_VCT);
  bfr* OCMP = (bfr*)(ws + O_OCMP);
  unsigned* SEL = (unsigned*)(ws + O_SEL);
  const int tid = tid_opaque(), lane = tid & 63, wid = tid >> 6, r = lane & 31, h2 = lane >> 5;
  const float CS = 0.125f * 1.4426950408889634f;
  for (int item = VB; item < 1024; item += NVB) {
    const int qt = 63 - (item >> 4), bh = item & 15, b = bh >> 1, hkv = bh & 1;
    __syncthreads();
    {
      const bfr* kb = KC + ((size_t)(b * 127) * 2 + hkv) * 64;
      const bfr* vb = VCT + (size_t)((b * 2 + hkv) * 64) * 128;
#pragma unroll
      for (int i = 0; i < 4; ++i) {
        const int id = tid + i * 256;
        const int kr = id >> 3, kc = (id & 7) * 8;
        *(uint4*)&L.k[kr][kc] = *(const uint4*)(kb + (size_t)kr * 128 + kc);
        const int vr = id >> 4, vc = (id & 15) * 8;
        const uint4 v = *(const uint4*)(vb + (size_t)vr * 128 + vc);
        *(uint2*)&L.vt[vr][vc] = make_uint2(v.x, v.y);
        *(uint2*)&L.vt[vr][vc + 4] = make_uint2(v.z, v.w);
      }
    }
    __syncthreads();
    const int tokl = qt * 32 + wid * 8 + (r >> 2), g = r & 3, head = hkv * 4 + g, tok = b * SEQ + tokl;
    const int nv = tokl >= 31 ? ((tokl - 31) >> 4) + 1 : 0;
    bf16x8 qf[4];
#pragma unroll
    for (int s = 0; s < 4; ++s) qf[s] = *(const bf16x8*)(PROJ + (size_t)tok * PW0 + C_Q + head * 64 + 16 * s + 8 * h2);
    float m = -1e30f, l = 0.f;
#pragma unroll 1
    for (int kb4 = 0; kb4 < 4; ++kb4) {
      f32x16 sc;
#pragma unroll
      for (int i = 0; i < 16; ++i) sc[i] = 0.f;
#pragma unroll
      for (int s = 0; s < 4; ++s) {
        const bf16x8 kf = *(const bf16x8*)&L.k[kb4 * 32 + r][16 * s + 8 * h2];
        sc = MFMA32(kf, qf[s], sc);
      }
      float mx = -1e30f;
#pragma unroll
      for (int i = 0; i < 16; ++i) {
        if (kb4 * 32 + crow16(i, h2) >= nv) sc[i] = -1e30f;
        mx = fmaxf(mx, sc[i]);
      }
      const float mn = fmaxf(m, mx), mu = fmaxf(mn, -1e20f);
      float ps = 0.f;
#pragma unroll
      for (int i = 0; i < 16; ++i) ps += __builtin_amdgcn_exp2f((sc[i] - mu) * CS);
      l = l * __builtin_amdgcn_exp2f((m - mu) * CS) + ps;
      m = mn;
    }
    {
      const float mo = __shfl_xor(m, 32), lo = __shfl_xor(l, 32);
      const float mt = fmaxf(m, mo), mu = fmaxf(mt, -1e20f);
      l = l * __builtin_amdgcn_exp2f((m - mu) * CS) + lo * __builtin_amdgcn_exp2f((mo - mu) * CS);
      m = mu;
    }
    const float invl = l > 0.f ? 1.f / l : 0.f;
    const float muc = m * CS;
    f32x16 o0, o1;
#pragma unroll
    for (int i = 0; i < 16; ++i) { o0[i] = 0.f; o1[i] = 0.f; }
    float part[16], first[16];
#pragma unroll
    for (int kb4 = 0; kb4 < 4; ++kb4) {
      f32x16 sc;
#pragma unroll
      for (int i = 0; i < 16; ++i) sc[i] = 0.f;
#pragma unroll
      for (int s = 0; s < 4; ++s) {
        const bf16x8 kf = *(const bf16x8*)&L.k[kb4 * 32 + r][16 * s + 8 * h2];
        sc = MFMA32(kf, qf[s], sc);
      }
#pragma unroll
      for (int i = 0; i < 16; ++i) {
        const float pv = __builtin_amdgcn_exp2f(fmaf(sc[i], CS, -muc)) * invl;
        sc[i] = (kb4 * 32 + crow16(i, h2) >= nv) ? 0.f : pv;
      }
#pragma unroll
      for (int s = 0; s < 2; ++s) {
        uint4 pk;
        pk.x = pack2(sc[8 * s + 0], sc[8 * s + 1]); pk.y = pack2(sc[8 * s + 2], sc[8 * s + 3]);
        pk.z = pack2(sc[8 * s + 4], sc[8 * s + 5]); pk.w = pack2(sc[8 * s + 6], sc[8 * s + 7]);
        const bf16x8 pf = __builtin_bit_cast(bf16x8, pk);
        const int kc = kb4 * 32 + 16 * s + 4 * h2;
        const uint2 a0 = *(const uint2*)&L.vt[r][kc];
        const uint2 a1 = *(const uint2*)&L.vt[r][kc + 8];
        const uint2 c0 = *(const uint2*)&L.vt[32 + r][kc];
        const uint2 c1 = *(const uint2*)&L.vt[32 + r][kc + 8];
        o0 = MFMA32(__builtin_bit_cast(bf16x8, make_uint4(a0.x, a0.y, a1.x, a1.y)), pf, o0);
        o1 = MFMA32(__builtin_bit_cast(bf16x8, make_uint4(c0.x, c0.y, c1.x, c1.y)), pf, o1);
      }
#pragma unroll
      for (int q4 = 0; q4 < 4; ++q4) {
        const float e0 = quad_sum(sc[q4 * 4 + 0]), e1 = quad_sum(sc[q4 * 4 + 1]);
        const float e2 = quad_sum(sc[q4 * 4 + 2]), e3 = quad_sum(sc[q4 * 4 + 3]);
        part[kb4 * 4 + q4] = e0 + 2.f * (e1 + e2 + e3);
        first[kb4 * 4 + q4] = e0;
      }
      __builtin_amdgcn_sched_barrier(0);
    }
    {
      const float g0 = sigmoidf_(bf2f(PROJ[(size_t)tok * PW0 + C_GL + head * 3 + 0]));
      bfr* op = OCMP + (size_t)tok * 512 + head * 64;
#pragma unroll
      for (int q4 = 0; q4 < 4; ++q4) {
        const int d0 = 8 * q4 + 4 * h2;
        uint2 u;
        u.x = pack2(o0[q4 * 4 + 0] * g0, o0[q4 * 4 + 1] * g0); u.y = pack2(o0[q4 * 4 + 2] * g0, o0[q4 * 4 + 3] * g0);
        *(uint2*)(op + d0) = u;
        u.x = pack2(o1[q4 * 4 + 0] * g0, o1[q4 * 4 + 1] * g0); u.y = pack2(o1[q4 * 4 + 2] * g0, o1[q4 * 4 + 3] * g0);
        *(uint2*)(op + 32 + d0) = u;
      }
    }
    float val[16], oth[16];
    const float h2f = (float)h2;
    {
      float recv[17];
#pragma unroll
      for (int gi = 0; gi < 16; ++gi) recv[gi] = __shfl_xor(first[gi], 32);
      recv[16] = 0.f;
#pragma unroll
      for (int gi = 0; gi < 16; ++gi) val[gi] = part[gi] + (recv[gi] * (1.f - h2f) + recv[gi + 1] * h2f);
#pragma unroll
      for (int gi = 0; gi < 16; ++gi) oth[gi] = __shfl_xor(val[gi], 32);
    }
    const int cur = tokl >> 6;
    float cv[32];
#pragma unroll
    for (int gi = 0; gi < 16; ++gi) {
      cv[2 * gi] = val[gi] * (1.f - h2f) + oth[gi] * h2f;
      cv[2 * gi + 1] = val[gi] * h2f + oth[gi] * (1.f - h2f);
    }
    unsigned mask = 1u | (1u << cur);
    if (cur >= 1) mask |= 1u << (cur - 1);
    unsigned chosen = 0u;
#pragma unroll 1
    for (int rnd = 0; rnd < 5; ++rnd) {
      float best = -1.f; int bi = -1;
#pragma unroll
      for (int j = 1; j < 31; ++j) {
        const bool el = (j <= cur - 2) && !((chosen >> j) & 1u) && (cv[j] > best);
        best = el ? cv[j] : best;
        bi = el ? j : bi;
      }
      if (bi >= 0) chosen |= 1u << bi;
    }
    mask |= chosen;
    if (g == 0 && h2 == 0) SEL[tok * 2 + hkv] = mask;
  }
}

struct RowsGather {
  const bfr* base; const int* list; int i0; int cnt; int ld;
  const bfr* rp[2];
  DI void init(int lr) {
#pragma unroll
    for (int i = 0; i < 2; ++i) {
      int ii = i0 + lr + 64 * i; if (ii > cnt - 1) ii = cnt - 1;
      rp[i] = base + (size_t)(list[ii] >> 1) * ld;
    }
  }
  DI uint4 load(int sel, int k) const { return *(const uint4*)(rp[sel] + k); }
  DI const bfr* ptr(int sel, int k) const { return rp[sel] + k; }
};

DI void moe1_phase(const Params& p, char* smem, int layer) {
  char* ws = p.ws;
  const int* cnt = (const int*)(ws + O_CNT) + layer * 16 * 64;
  const int* LIST = (const int*)(ws + O_LIST);
  const bfr* HB = (const bfr*)(ws + O_HB);
  bfr* HMID = (bfr*)(ws + O_HMID);
  int c[16], mtiles = 0;
#pragma unroll
  for (int e = 0; e < 16; ++e) { c[e] = cnt[e * 64]; mtiles += (c[e] + 127) >> 7; }
  const int ntiles = mtiles * 8;
  for (int tile = VB; tile < ntiles; tile += NVB) {
    int mg = tile >> 3; const int nt = tile & 7;
    int e = 0, off = 0, ce = 0;
#pragma unroll
    for (int k = 0; k < 16; ++k) {
      const int mk = (c[k] + 127) >> 7;
      if (k == e && mg >= mk) { mg -= mk; off += c[k]; e = k + 1; }
    }
#pragma unroll
    for (int k = 0; k < 16; ++k) if (k == e) ce = c[k];
    const int mt = mg;
    RowsGather A{HB, LIST + (size_t)e * NT, mt * 128, ce, 1024};
    RowsContig B{(const bfr*)(ws + O_WGU) + ((size_t)(layer * 16 + e) * 1024 + nt * 128) * 1024, 1024, 127};
    gemm_tile_g(smem, 32, A, B, [&](f32x4(&acc)[4][4], int wr, int wc, int fr, int fq) {
#pragma unroll
      for (int m = 0; m < 4; ++m) {
        const int i = mt * 128 + wr * 64 + m * 16 + fr;
        if (i < ce) {
#pragma unroll
          for (int n2 = 0; n2 < 2; ++n2) {
            const int col = nt * 64 + wc * 32 + n2 * 16 + fq * 4;
            float h[4];
#pragma unroll
            for (int j = 0; j < 4; ++j) { const float g = acc[m][n2 * 2][j], u = acc[m][n2 * 2 + 1][j]; h[j] = g / (1.f + __expf(-g)) * u; }
            *(uint2*)(HMID + (size_t)(off + i) * 512 + col) = make_uint2(pack2(h[0], h[1]), pack2(h[2], h[3]));
          }
        }
      }
    });
  }
}

DI void moe2_phase(const Params& p, char* smem, int layer) {
  char* ws = p.ws;
  const int* cnt = (const int*)(ws + O_CNT) + layer * 16 * 64;
  const int* LIST = (const int*)(ws + O_LIST);
  const float* TOPW = (const float*)(ws + O_TOPW);
  const bfr* HMID = (const bfr*)(ws + O_HMID);
  bfr* MO = (bfr*)(ws + O_MOEOUT);
  int c[16], mtiles = 0;
#pragma unroll
  for (int e = 0; e < 16; ++e) { c[e] = cnt[e * 64]; mtiles += (c[e] + 127) >> 7; }
  const int ntiles = mtiles * 8;
  for (int tile = VB; tile < ntiles; tile += NVB) {
    int mg = tile >> 3; const int nt = tile & 7;
    int e = 0, off = 0, ce = 0;
#pragma unroll
    for (int k = 0; k < 16; ++k) {
      const int mk = (c[k] + 127) >> 7;
      if (k == e && mg >= mk) { mg -= mk; off += c[k]; e = k + 1; }
    }
#pragma unroll
    for (int k = 0; k < 16; ++k) if (k == e) ce = c[k];
    const int mt = mg;
    const int rows_here = ce - mt * 128;
    RowsContig A{HMID + (size_t)(off + mt * 128) * 512, 512, (rows_here < 128 ? rows_here : 128) - 1};
    RowsContig B{(const bfr*)(ws + O_WDN) + ((size_t)(layer * 16 + e) * 1024 + nt * 128) * 512, 512, 127};
    const int* lst = LIST + (size_t)e * NT;
    gemm_tile_g(smem, 16, A, B, [&](f32x4(&acc)[4][4], int wr, int wc, int fr, int fq) {
#pragma unroll
      for (int m = 0; m < 4; ++m) {
        const int i = mt * 128 + wr * 64 + m * 16 + fr;
        if (i < ce) {
          const int en = lst[i];
          const float w = TOPW[en];
          bfr* dst = MO + ((size_t)(en & 1) * NT + (en >> 1)) * 1024 + nt * 128 + wc * 64 + fq * 4;
#pragma unroll
          for (int n = 0; n < 4; ++n)
            *(uint2*)(dst + n * 16) = make_uint2(pack2(acc[m][n][0] * w, acc[m][n][1] * w), pack2(acc[m][n][2] * w, acc[m][n][3] * w));
        }
      }
    });
  }
}

struct ALora {
  const bfr* proj; const float* mu; int tok0; int colbase; int mode;
  const bfr* rp[2]; bool hp[2];
  DI void init(int lr) {
#pragma unroll
    for (int i = 0; i < 2; ++i) { const int tok = tok0 + lr + 64 * i; rp[i] = proj + (size_t)tok * PW1 + colbase; hp[i] = (tok & (SEQ - 1)) != 0; }
  }
  DI uint4 load(int sel, int k) const {
    const uint4 c = *(const uint4*)(rp[sel] + k);
    uint4 pv = make_uint4(0, 0, 0, 0);
    if (hp[sel]) pv = *(const uint4*)(rp[sel] - PW1 + k);
    const float4 m0 = *(const float4*)(mu + colbase + k), m1 = *(const float4*)(mu + colbase + k + 4);
    float v[8];
    v[0] = lo2f(c.x) + (lo2f(pv.x) - lo2f(c.x)) * m0.x; v[1] = hi2f(c.x) + (hi2f(pv.x) - hi2f(c.x)) * m0.y;
    v[2] = lo2f(c.y) + (lo2f(pv.y) - lo2f(c.y)) * m0.z; v[3] = hi2f(c.y) + (hi2f(pv.y) - hi2f(c.y)) * m0.w;
    v[4] = lo2f(c.z) + (lo2f(pv.z) - lo2f(c.z)) * m1.x; v[5] = hi2f(c.z) + (hi2f(pv.z) - hi2f(c.z)) * m1.y;
    v[6] = lo2f(c.w) + (lo2f(pv.w) - lo2f(c.w)) * m1.z; v[7] = hi2f(c.w) + (hi2f(pv.w) - hi2f(c.w)) * m1.w;
#pragma unroll
    for (int i = 0; i < 8; ++i) v[i] = mode == 0 ? tanhf(v[i]) : (mode == 2 ? sigmoidf_(v[i]) : v[i]);
    return make_uint4(pack2(v[0], v[1]), pack2(v[2], v[3]), pack2(v[4], v[5]), pack2(v[6], v[7]));
  }
};
DI void rwkv_lora_pool_phase(const Params& p, char* smem) {
  char* ws = p.ws;
  const bfr* PROJ = (const bfr*)(ws + O_PROJ);
  float* W = (float*)(ws + O_RW_W);
  bfr* AS = (bfr*)(ws + O_RW_AS);
  bfr* G = (bfr*)(ws + O_RW_G);
  bfr* MIX = (bfr*)(ws + O_MIX);
  for (int item = VB; item < 1024; item += NVB) {
    const int mt = item >> 3, sub = item & 7, tok0 = mt * 128;
    if (sub < 4) {
      const int cp = sub;
      {
        ALora A{PROJ, p.in[I_MU], tok0, 1536, 0};
        RowsContig B{(const bfr*)(ws + O_W2T) + (size_t)cp * 128 * 64, 64, 127};
        const float* w0 = p.in[I_W0];
        gemm_tile(smem, 2, A, B, [&](f32x4(&acc)[4][4], int wr, int wc, int fr, int fq) {
#pragma unroll
          for (int n = 0; n < 4; ++n) {
            const int col = cp * 128 + wc * 64 + n * 16 + fr;
            const float w0v = w0[col];
#pragma unroll
            for (int m = 0; m < 4; ++m)
#pragma unroll
              for (int j = 0; j < 4; ++j) {
                const int tok = tok0 + wr * 64 + m * 16 + fq * 4 + j;
                const float z = -(w0v + acc[m][n][j]);
                const float sp = fmaxf(z, 0.f) + log1pf(__expf(-fabsf(z)));
                W[(size_t)tok * 512 + col] = __expf(-__expf(-sp - 0.5f));
              }
          }
        });
      }
      {
        ALora A{PROJ, p.in[I_MU], tok0, 1600, 1};
        RowsContig B{(const bfr*)(ws + O_A2T) + (size_t)cp * 128 * 64, 64, 127};
        const float* a0 = p.in[I_A0];
        gemm_tile(smem, 2, A, B, [&](f32x4(&acc)[4][4], int wr, int wc, int fr, int fq) {
#pragma unroll
          for (int n = 0; n < 4; ++n) {
            const int col = cp * 128 + wc * 64 + n * 16 + fr;
            const float a0v = a0[col];
#pragma unroll
            for (int m = 0; m < 4; ++m)
#pragma unroll
              for (int j = 0; j < 4; ++j) {
                const int tok = tok0 + wr * 64 + m * 16 + fq * 4 + j;
                AS[(size_t)tok * 512 + col] = f2bf(sigmoidf_(a0v + acc[m][n][j]));
              }
          }
        });
      }
      {
        ALora A{PROJ, p.in[I_MU], tok0, 1664, 2};
        RowsContig B{(const bfr*)(ws + O_G2T) + (size_t)cp * 128 * 128, 128, 127};
        gemm_tile(smem, 4, A, B, [&](f32x4(&acc)[4][4], int wr, int wc, int fr, int fq) {
#pragma unroll
          for (int n = 0; n < 4; ++n) {
            const int col = cp * 128 + wc * 64 + n * 16 + fr;
#pragma unroll
            for (int m = 0; m < 4; ++m)
#pragma unroll
              for (int j = 0; j < 4; ++j) {
                const int tok = tok0 + wr * 64 + m * 16 + fq * 4 + j;
                G[(size_t)tok * 512 + col] = f2bf(acc[m][n][j]);
              }
          }
        });
      }
    } else {
      bfr* POOLED = (bfr*)(ws + O_POOLED);
      const int tid = tid_opaque();
      for (int e = tid; e < 32 * 64; e += 256) {
        const int tok = tok0 + (sub - 4) * 32 + (e >> 6), ch = (e & 63) * 8, gi = ch >> 7;
        const int t = tok & (SEQ - 1), win = 2 << gi, n = (t + 1 < win) ? t + 1 : win;
        const bfr* rp = PROJ + (size_t)tok * PW1 + 1792 + ch;
        const uint4 c = *(const uint4*)rp;
        const float a[8] = {lo2f(c.x), hi2f(c.x), lo2f(c.y), hi2f(c.y), lo2f(c.z), hi2f(c.z), lo2f(c.w), hi2f(c.w)};
        float sm[8];
#pragma unroll
        for (int i = 0; i < 8; ++i) sm[i] = a[i];
#pragma unroll
        for (int d0 = 1; d0 < 16; d0 += 5) {
          uint4 u[5];
#pragma unroll
          for (int q = 0; q < 5; ++q) {
            const int d = d0 + q;
            u[q] = make_uint4(0, 0, 0, 0);
            if (d < n) u[q] = *(const uint4*)(rp - (size_t)d * PW1);
          }
#pragma unroll
          for (int q = 0; q < 5; ++q) {
            sm[0] += lo2f(u[q].x); sm[1] += hi2f(u[q].x); sm[2] += lo2f(u[q].y); sm[3] += hi2f(u[q].y);
            sm[4] += lo2f(u[q].z); sm[5] += hi2f(u[q].z); sm[6] += lo2f(u[q].w); sm[7] += hi2f(u[q].w);
          }
        }
        const float inv = 1.f / (float)n;
#pragma unroll
        for (int i = 0; i < 8; ++i) sm[i] = sm[i] * inv - a[i];
        *(uint4*)(POOLED + (size_t)tok * 512 + ch) = make_uint4(pack2(sm[0], sm[1]), pack2(sm[2], sm[3]), pack2(sm[4], sm[5]), pack2(sm[6], sm[7]));
      }
    }
  }
}

DI void pool_gemm_tiles(const Params& p, char* smem, int first, int stride) {
  char* ws = p.ws;
  bfr* MIX = (bfr*)(ws + O_MIX);
  for (int tile = first; tile < 512; tile += stride) {
    const int mt = tile >> 2, gi = tile & 3, tok0 = mt * 128;
    RowsContig A{(const bfr*)(ws + O_POOLED) + (size_t)tok0 * 512 + gi * 128, 512, 127};
    RowsContig B{(const bfr*)(ws + O_PWT) + (size_t)gi * 128 * 128, 128, 127};
    const float* ps = p.in[I_POOLS] + gi * 128;
    gemm_tile(smem, 4, A, B, [&](f32x4(&acc)[4][4], int wr, int wc, int fr, int fq) {
#pragma unroll
      for (int n = 0; n < 4; ++n) {
        const int col = wc * 64 + n * 16 + fr;
        const float sc = ps[col];
#pragma unroll
        for (int m = 0; m < 4; ++m)
#pragma unroll
          for (int j = 0; j < 4; ++j) {
            const int tok = tok0 + wr * 64 + m * 16 + fq * 4 + j;
            MIX[(size_t)tok * 1024 + 512 + gi * 128 + col] = f2bf(acc[m][n][j] * sc);
          }
      }
    });
  }
}

constexpr int CHUNK = 128, NCH = SEQ / CHUNK;
DI void scanA_phase(const Params& p, char* smem) {
  char* ws = p.ws;
  const int tid = tid_opaque(), lane = tid & 63, wid = tid >> 6;
  const int ul = wid >> 1, isP = wid & 1;
  float* st = (float*)smem + wid * (8 * 384);
  const bfr* PROJ = (const bfr*)(ws + O_PROJ);
  const float* W = (const float*)(ws + O_RW_W);
  const bfr* AS = (const bfr*)(ws + O_RW_AS);
  bfr* QT = (bfr*)(ws + O_RW_Q); bfr* YL = (bfr*)(ws + O_RW_Y);
  float* RK = (float*)(ws + O_RK);
  float* CHP = (float*)(ws + O_CHP); float* CHL = (float*)(ws + O_CHL);
  const float* mu = p.in[I_MU];
  for (int item = VB; item < 512; item += NVB) {
    const int unit = item * 2 + ul;
    const int chain = unit >> 4, chunk = unit & 15, b = chain >> 3, h = chain & 7;
    const int c = h * 64 + lane;
    const int tok_base = b * SEQ + chunk * CHUNK;
    const float mu_r = mu[c], mu_k = mu[512 + c], mu_v = mu[1024 + c];
    const float kkp = p.in[I_KK][c], kap = p.in[I_KA][c], rkp = p.in[I_RKP][c];
    float S[64];
    int diag = isP ? lane : -1;
    asm volatile("" : "+v"(diag));
#pragma unroll
    for (int j = 0; j < 64; ++j) S[j] = (j == diag) ? 1.f : 0.f;
#pragma unroll 1
    for (int sub = 0; sub < CHUNK / 8; ++sub) {
#pragma unroll 4
      for (int s = 0; s < 8; ++s) {
        const int tl = chunk * CHUNK + sub * 8 + s, tok = tok_base + sub * 8 + s;
        const bfr* pr = PROJ + (size_t)tok * PW1 + c;
        const bool hp = tl > 0;
        const float rc = bf2f(pr[0]), rpv = hp ? bf2f(pr[-PW1]) : 0.f;
        const float kc = bf2f(pr[512]), kpv = hp ? bf2f(pr[512 - PW1]) : 0.f;
        const float vc = bf2f(pr[1024]), vpv = hp ? bf2f(pr[1024 - PW1]) : 0.f;
        const float r = rc + (rpv - rc) * mu_r, k = kc + (kpv - kc) * mu_k, v = vc + (vpv - vc) * mu_v;
        const float as = bf2f(AS[(size_t)tok * 512 + c]);
        const float km = k * (1.f + (as - 1.f) * kap);
        float kk = k * kkp;
        float nrm = kk * kk, rk = r * km * rkp;
#pragma unroll
        for (int o2 = 32; o2 > 0; o2 >>= 1) { nrm += __shfl_xor(nrm, o2); rk += __shfl_xor(rk, o2); }
        kk *= 1.f / fmaxf(sqrtf(nrm), 1e-12f);
        float* d = st + s * 384;
        d[lane] = r;
        d[64 + lane] = W[(size_t)tok * 512 + c];
        d[128 + lane] = km;
        d[192 + lane] = v;
        d[256 + lane] = -kk;
        d[320 + lane] = kk * as;
        if (!isP && lane == 0) RK[tok * 8 + h] = rk;
      }
      __builtin_amdgcn_fence(__ATOMIC_RELEASE, "wavefront");
      __builtin_amdgcn_wave_barrier();
#pragma unroll 1
      for (int s = 0; s < 8; ++s) {
        const float* d = st + s * 384;
        float sa = 0.f;
#pragma unroll
        for (int j4 = 0; j4 < 16; ++j4) {
          const float4 a4 = *(const float4*)(d + 256 + j4 * 4);
          sa += S[j4 * 4] * a4.x + S[j4 * 4 + 1] * a4.y + S[j4 * 4 + 2] * a4.z + S[j4 * 4 + 3] * a4.w;
        }
        const float vi = isP ? 0.f : d[192 + lane];
        float y = 0.f;
#pragma unroll
        for (int j4 = 0; j4 < 16; ++j4) {
          if ((j4 & 3) == 0) asm volatile("" ::: "memory");
          const float4 w4 = *(const float4*)(d + 64 + j4 * 4);
          const float4 b4 = *(const float4*)(d + 320 + j4 * 4);
          const float4 k4 = *(const float4*)(d + 128 + j4 * 4);
          const float4 r4 = *(const float4*)(d + j4 * 4);
          S[j4 * 4 + 0] = S[j4 * 4 + 0] * w4.x + (sa * b4.x + vi * k4.x);
          S[j4 * 4 + 1] = S[j4 * 4 + 1] * w4.y + (sa * b4.y + vi * k4.y);
          S[j4 * 4 + 2] = S[j4 * 4 + 2] * w4.z + (sa * b4.z + vi * k4.z);
          S[j4 * 4 + 3] = S[j4 * 4 + 3] * w4.w + (sa * b4.w + vi * k4.w);
          y += S[j4 * 4] * r4.x + S[j4 * 4 + 1] * r4.y + S[j4 * 4 + 2] * r4.z + S[j4 * 4 + 3] * r4.w;
        }
        const size_t o = (size_t)(tok_base + sub * 8 + s) * 512 + c;
        if (isP) QT[o] = f2bf(y);
        else YL[o] = f2bf(y);
      }
      __builtin_amdgcn_fence(__ATOMIC_RELEASE, "wavefront");
      __builtin_amdgcn_wave_barrier();
    }
    float4* dp = (float4*)((isP ? CHP : CHL) + ((size_t)unit * 64 + lane) * 64);
#pragma unroll
    for (int j4 = 0; j4 < 16; ++j4) dp[j4] = make_float4(S[j4 * 4], S[j4 * 4 + 1], S[j4 * 4 + 2], S[j4 * 4 + 3]);
  }
}

DI void scanB_phase(const Params& p, char* smem) {
  char* ws = p.ws;
  const int tid = tid_opaque();
  float* Ss = (float*)smem;
  float* Ps = Ss + 64 * 65;
  const float* CHP = (const float*)(ws + O_CHP);
  float* CHL = (float*)(ws + O_CHL);
  const int i = tid >> 2, qd = tid & 3;
#if POOL_IN_SCANB
  if (NVB > 128) {
    if (VB >= 64) { pool_gemm_tiles(p, smem, VB - 64, NVB - 64); return; }
  } else {
    pool_gemm_tiles(p, smem, VB, NVB);
    __syncthreads();
  }
#endif
  for (int chain = VB; chain < 64; chain += NVB) {
    for (int e = tid; e < 64 * 65; e += 256) Ss[e] = 0.f;
    float4 pn0, pn1, pn2, pn3, ln0, ln1, ln2, ln3;
    {
      const float4* pp = (const float4*)(CHP + ((size_t)(chain * NCH)) * 4096) + tid;
      pn0 = pp[0]; pn1 = pp[256]; pn2 = pp[512]; pn3 = pp[768];
      const float4* lp = (const float4*)(CHL + ((size_t)(chain * NCH)) * 4096 + i * 64 + qd * 16);
      ln0 = lp[0]; ln1 = lp[1]; ln2 = lp[2]; ln3 = lp[3];
    }
    __syncthreads();
    for (int c = 0; c < NCH - 1; ++c) {
      const size_t ub = ((size_t)(chain * NCH + c)) * 4096;
      ((float4*)Ps)[tid] = pn0; ((float4*)Ps)[tid + 256] = pn1; ((float4*)Ps)[tid + 512] = pn2; ((float4*)Ps)[tid + 768] = pn3;
      float acc[16];
      acc[0] = ln0.x; acc[1] = ln0.y; acc[2] = ln0.z; acc[3] = ln0.w; acc[4] = ln1.x; acc[5] = ln1.y; acc[6] = ln1.z; acc[7] = ln1.w;
      acc[8] = ln2.x; acc[9] = ln2.y; acc[10] = ln2.z; acc[11] = ln2.w; acc[12] = ln3.x; acc[13] = ln3.y; acc[14] = ln3.z; acc[15] = ln3.w;
      if (c + 1 < NCH - 1) {
        const float4* pp = (const float4*)(CHP + ub + 4096) + tid;
        pn0 = pp[0]; pn1 = pp[256]; pn2 = pp[512]; pn3 = pp[768];
        const float4* lp = (const float4*)(CHL + ub + 4096 + i * 64 + qd * 16);
        ln0 = lp[0]; ln1 = lp[1]; ln2 = lp[2]; ln3 = lp[3];
      }
      __syncthreads();
      if (c > 0) {
#pragma unroll 4
        for (int k = 0; k < 64; ++k) {
          const float sv = Ss[i * 65 + k];
          const float4* pr = (const float4*)(Ps + k * 64 + qd * 16);
#pragma unroll
          for (int u = 0; u < 4; ++u) {
            const float4 v = pr[u];
            acc[u * 4] += sv * v.x; acc[u * 4 + 1] += sv * v.y; acc[u * 4 + 2] += sv * v.z; acc[u * 4 + 3] += sv * v.w;
          }
        }
      }
      __syncthreads();
#pragma unroll
      for (int u = 0; u < 16; ++u) Ss[i * 65 + qd * 16 + u] = acc[u];
      {
        float4* lp = (float4*)(CHL + ub + i * 64 + qd * 16);
#pragma unroll
        for (int u = 0; u < 4; ++u) lp[u] = make_float4(acc[u * 4], acc[u * 4 + 1], acc[u * 4 + 2], acc[u * 4 + 3]);
      }
      __syncthreads();
    }
  }
}

DI void scanC_phase(const Params& p, char* smem) {
  char* ws = p.ws;
  const int tid = tid_opaque(), lane = tid & 63, wid = tid >> 6;
  float* st = (float*)smem + wid * (8 * 64);
  const bfr* PROJ = (const bfr*)(ws + O_PROJ);
  const bfr* Q = (const bfr*)(ws + O_RW_Q); const bfr* YL = (const bfr*)(ws + O_RW_Y);
  const bfr* G = (const bfr*)(ws + O_RW_G);
  const float* RK = (const float*)(ws + O_RK);
  const float* CHL = (const float*)(ws + O_CHL);
  bfr* MIX = (bfr*)(ws + O_MIX);
  for (int unit = VB; unit < 64 * NCH; unit += NVB) {
    const int chain = unit >> 4, chunk = unit & 15, b = chain >> 3, h = chain & 7;
    const int c = h * 64 + lane;
    const int tl0 = chunk * CHUNK + wid * 32;
    const size_t base = ((size_t)b * SEQ + tl0) * 512 + c;
    const float mu_v = p.in[I_MU][1024 + c];
    float S[64];
    if (chunk > 0) {
      const float4* sp = (const float4*)(CHL + ((size_t)(unit - 1) * 64 + lane) * 64);
#pragma unroll
      for (int j4 = 0; j4 < 16; ++j4) { const float4 v = sp[j4]; S[j4 * 4] = v.x; S[j4 * 4 + 1] = v.y; S[j4 * 4 + 2] = v.z; S[j4 * 4 + 3] = v.w; }
    } else {
#pragma unroll
      for (int j = 0; j < 64; ++j) S[j] = 0.f;
    }
    const float lnw = p.in[I_LNW][c], lnb = p.in[I_LNB][c];
#pragma unroll 1
    for (int sub = 0; sub < 4; ++sub) {
      const int tl = tl0 + sub * 8, tok0 = b * SEQ + tl;
      float qv[8], yv[8], vv[9], gv[8], rkv[8];
      {
        const bfr* pr = PROJ + (size_t)tok0 * PW1 + 1024 + c;
        vv[0] = tl > 0 ? bf2f(pr[-PW1]) : 0.f;
#pragma unroll
        for (int s8 = 0; s8 < 8; ++s8) {
          const size_t o = base + (size_t)(sub * 8 + s8) * 512;
          qv[s8] = bf2f(Q[o]); yv[s8] = bf2f(YL[o]); gv[s8] = bf2f(G[o]);
          vv[s8 + 1] = bf2f(pr[(size_t)s8 * PW1]);
          rkv[s8] = RK[(tok0 + s8) * 8 + h];
        }
      }
#pragma unroll
      for (int s8 = 0; s8 < 8; ++s8) st[s8 * 64 + lane] = qv[s8];
      __builtin_amdgcn_fence(__ATOMIC_RELEASE, "wavefront");
      __builtin_amdgcn_wave_barrier();
#pragma unroll
      for (int s8 = 0; s8 < 8; ++s8) {
        float y = yv[s8];
        const float* d = st + s8 * 64;
#pragma unroll
        for (int j4 = 0; j4 < 16; ++j4) {
          const float4 q4 = *(const float4*)(d + j4 * 4);
          y += S[j4 * 4] * q4.x + S[j4 * 4 + 1] * q4.y + S[j4 * 4 + 2] * q4.z + S[j4 * 4 + 3] * q4.w;
        }
        const float mean = wave_sum(y) * (1.f / 64.f);
        const float dlt = y - mean;
        const float var = wave_sum(dlt * dlt) * (1.f / 64.f);
        const float yn = dlt * rsqrtf(var + 64e-5f) * lnw + lnb;
        const float v = vv[s8 + 1] + (vv[s8] - vv[s8 + 1]) * mu_v;
        const float outv = (yn + rkv[s8] * v) * gv[s8];
        MIX[(size_t)(tok0 + s8) * 1024 + c] = f2bf(outv);
      }
      __builtin_amdgcn_fence(__ATOMIC_RELEASE, "wavefront");
      __builtin_amdgcn_wave_barrier();
    }
  }
}

#ifndef REP_PREP
#define REP_PREP 1
#endif
#ifndef REP_PROJ0
#define REP_PROJ0 1
#endif
#ifndef REP_CMPA
#define REP_CMPA 1
#endif
#ifndef REP_SLC
#define REP_SLC 1
#endif
#ifndef REP_MOE1
#define REP_MOE1 1
#endif
#ifndef REP_MOE2
#define REP_MOE2 1
#endif
#ifndef REP_POST0
#define REP_POST0 1
#endif
#ifndef REP_RPREP
#define REP_RPREP 1
#endif
#ifndef REP_SCANB
#define REP_SCANB 1
#endif
#ifndef POOL_IN_SCANB
#define POOL_IN_SCANB 0
#endif
#ifndef REP_POOLG
#define REP_POOLG 1
#endif
#ifndef REP_SCANA
#define REP_SCANA 1
#endif
#ifndef REP_SCANAB
#define REP_SCANAB 1
#endif
#ifndef REP_SCANC
#define REP_SCANC 1
#endif
#ifndef REP_SYNC
#define REP_SYNC 1
#endif
extern __shared__ __attribute__((aligned(16))) char dyn_smem[];
__global__ void __launch_bounds__(512, 2) fwd_megakernel(Params p) {
  cg::grid_group grid = cg::this_grid();
  char* smem = dyn_smem + (threadIdx.x >> 8) * 49152;
  __shared__ uint4 xb_words;
  char* ws = p.ws;
  const float* MOD = (const float*)(ws + O_MOD);
  const float* MOD1 = MOD + 8 * 6144;
  float* X = p.out;
  if (threadIdx.x == 0) xb_words = make_uint4(0u, 0u, 0u, 0u);

  for (int rep = 0; rep < REP_PREP; ++rep)
  for (int item = VB; item < PREP_TOTAL; item += NVB) prep_item(p, smem, item);
  grid.sync();
  const XcdBarrier xb = xcd_barrier_post((unsigned*)(ws + O_BAR), (volatile LAS unsigned*)&xb_words);
#ifndef TIMEPH
#define TIMEPH -1
#endif
  unsigned long long t_start = 0, t_mark = 0; int gs_count = 0;
  if (TIMEPH >= 0) t_start = __builtin_amdgcn_s_memrealtime();
#define GSYNC() do { xcd_barrier(xb); if (TIMEPH >= 0) { ++gs_count; if (gs_count == TIMEPH) t_mark = __builtin_amdgcn_s_memrealtime(); } } while (0)
#ifndef XB_EXTRA_REL
#define XB_EXTRA_REL true
#endif
#ifndef XB_EXTRA_ACQ
#define XB_EXTRA_ACQ true
#endif
  for (int rep = 1; rep < REP_SYNC; ++rep) xcd_barrier<XB_EXTRA_REL, XB_EXTRA_ACQ>(xb);
  norm_phase<0, false>(p, smem, p.in[I_X], nullptr, p.in[I_NMIX], MOD, 0, 1024, 0, 0);
  GSYNC();
  for (int rep = 0; rep < REP_PROJ0; ++rep) gemm_proj_phase(p, smem, (const bfr*)(ws + O_WEIN), PW0, (bfr*)(ws + O_PROJ));
  GSYNC();
  for (int rep = 0; rep < REP_POST0; ++rep) post0_phase(p, smem);
  GSYNC();
  cmp2_phase(p, smem);
  GSYNC();
  for (int rep = 0; rep < REP_CMPA; ++rep) cmp_attn_mfma_phase(p, smem);
  GSYNC();
  for (int rep = 0; rep < REP_SLC; ++rep) attn_sw_phase(p, smem);
  GSYNC();
  gemm_out_phase(p, smem, (const bfr*)(ws + O_WEOUT), p.in[I_X], X, MOD + 2048);
  GSYNC();
  norm_router_phase(p, smem, X, p.in[I_NFFN], MOD, 3072, 4096, 0);
  GSYNC();
  for (int rep = 0; rep < REP_MOE1; ++rep) moe1_phase(p, smem, 0);
  GSYNC();
  for (int rep = 0; rep < REP_MOE2; ++rep) moe2_phase(p, smem, 0);
  GSYNC();
  norm_phase<1, false>(p, smem, X, X, p.in[I_NMIX] + 1024, MOD1, 0, 1024, 5120 - 6144 * 8, 1);
  GSYNC();
  gemm_proj_phase(p, smem, (const bfr*)(ws + O_WOIN), PW1, (bfr*)(ws + O_PROJ));
  GSYNC();
  for (int rep = 0; rep < REP_RPREP; ++rep) rwkv_lora_pool_phase(p, smem);
  GSYNC();
  for (int rep = 0; rep < REP_SCANA; ++rep) scanA_phase(p, smem);
  GSYNC();
  for (int rep = 0; rep < REP_SCANAB; ++rep) {
    if (rep > 0) { scanA_phase(p, smem); GSYNC(); }
    scanB_phase(p, smem);
    GSYNC();
  }
  for (int rep = 0; rep < REP_SCANC; ++rep) scanC_phase(p, smem);
#if !POOL_IN_SCANB
  __syncthreads();
  for (int rep = 0; rep < REP_POOLG; ++rep) pool_gemm_tiles(p, smem, VB, NVB);
#endif
  GSYNC();
  gemm_out_phase(p, smem, (const bfr*)(ws + O_WOOUT), X, X, MOD1 + 2048);
  GSYNC();
  norm_router_phase(p, smem, X, p.in[I_NFFN] + 1024, MOD1, 3072, 4096, 1);
  GSYNC();
  moe1_phase(p, smem, 1);
  GSYNC();
  moe2_phase(p, smem, 1);
  GSYNC();
  norm_phase<2, false>(p, smem, X, X, p.in[I_FN], MOD1, 0, 0, 5120, 1);
  if (TIMEPH >= 0 && blockIdx.x == 0 && threadIdx.x == 0) {
    const unsigned long long dt = t_mark - t_start, t0 = __builtin_amdgcn_s_memrealtime();
    while (__builtin_amdgcn_s_memrealtime() - t0 < dt) __builtin_amdgcn_s_sleep(8);
  }
}

constexpr int DYN_LDS = 2 * 49152;
extern "C" void kernel_launch(void* const* d_in, const int* in_sizes, int n_in,
                              void* d_out, int out_size, void* d_ws, size_t ws_size,
                              hipStream_t stream) {
  static int grid_blocks = 0;
  if (!grid_blocks) {
    int dev = 0, cus = 0, per_cu = 0;
    (void)hipGetDevice(&dev);
    (void)hipDeviceGetAttribute(&cus, hipDeviceAttributeMultiprocessorCount, dev);
    (void)hipFuncSetAttribute((const void*)fwd_megakernel, hipFuncAttributeMaxDynamicSharedMemorySize, DYN_LDS);
    (void)hipOccupancyMaxActiveBlocksPerMultiprocessor(&per_cu, fwd_megakernel, 512, DYN_LDS);
    if (per_cu > 1) per_cu = 1;
    if (per_cu < 1) per_cu = 1;
    grid_blocks = cus * per_cu;
    fprintf(stderr, "cus=%d per_cu=%d grid=%d ws=%zu need=%zu\n", cus, per_cu, grid_blocks, ws_size, (size_t)WS_NEED);
  }
  if (ws_size < WS_NEED || n_in < 33) { fprintf(stderr, "workspace too small\n"); return; }
  Params p{};
  for (int i = 0; i < 33; ++i) p.in[i] = (const float*)d_in[i];
  p.out = (float*)d_out;
  p.ws = (char*)d_ws;
  p.ws_size = (unsigned long long)ws_size;
  void* args[] = {&p};
  hipError_t e = hipLaunchCooperativeKernel((void*)fwd_megakernel, dim3(grid_blocks), dim3(512), args, DYN_LDS, stream);
  if (e != hipSuccess) fprintf(stderr, "cooperative launch failed: %s (grid %d)\n", hipGetErrorString(e), grid_blocks);
}
```

```cpp
#include <hip/hip_runtime.h>
#include <hip/hip_cooperative_groups.h>
#include <cstdio>
namespace cg = cooperative_groups;

typedef unsigned short bfr;
using bf16x8 = __attribute__((ext_vector_type(8))) short;
using f32x4 = __attribute__((ext_vector_type(4))) float;
typedef __attribute__((ext_vector_type(2))) __bf16 bf2v;
#define DI __device__ __forceinline__

constexpr int NT = 16384;
constexpr int SEQ = 2048;
constexpr int DM = 1024;
constexpr int PW0 = 3072;
constexpr int PW1 = 2304;
constexpr int C_Q = 0, C_KC = 512, C_VC = 640, C_KS = 768, C_VS = 896, C_KW = 1024, C_VW = 1152;
constexpr int C_XB = 1280, C_BG = 1792, C_CG = 2304, C_GL = 2816;

constexpr size_t al256(size_t x) { return (x + 255) & ~size_t(255); }
constexpr size_t MB = 1024 * 1024;
constexpr size_t O_MOD = 0;
constexpr size_t O_ROPE = O_MOD + al256(2 * 8 * 6144 * 4);
constexpr size_t O_BIAS1 = O_ROPE + al256(2048 * 32 * 2 * 4);
constexpr size_t O_BAR = O_BIAS1 + al256(2 * 256 * 4);
constexpr size_t O_CNT = O_BAR + al256(3456 * 4);
constexpr size_t O_TOPW = O_CNT + al256(2 * 16 * 64 * 4);
constexpr size_t O_LIST = O_TOPW + al256((size_t)NT * 2 * 4);
constexpr size_t O_SEL = O_LIST + al256((size_t)16 * NT * 4);
constexpr size_t O_KCVC = O_SEL + al256((size_t)NT * 2 * 4);
constexpr size_t O_RK = O_KCVC + al256(2 * 2048 * 64 * 4);
constexpr size_t O_VCT = O_RK + al256((size_t)NT * 8 * 4);
constexpr size_t O_CH = O_VCT + al256(8 * 2 * 64 * 128 * 2);
constexpr size_t O_WEIN = O_CH + al256(2 * 2048 * 256 * 2);
constexpr size_t O_WEOUT = O_WEIN + al256((size_t)PW0 * 1024 * 2);
constexpr size_t O_WOIN = O_WEOUT + al256(1024 * 1024 * 2);
constexpr size_t O_WOOUT = O_WOIN + al256((size_t)PW1 * 1024 * 2);
constexpr size_t O_WC1 = O_WOOUT + al256(1024 * 1024 * 2);
constexpr size_t O_WC2 = O_WC1 + al256(2 * 256 * 2048 * 2);
constexpr size_t O_W2T = O_WC2 + al256(2 * 128 * 256 * 2);
constexpr size_t O_A2T = O_W2T + al256(512 * 64 * 2);
constexpr size_t O_G2T = O_A2T + al256(512 * 64 * 2);
constexpr size_t O_PWT = O_G2T + al256(512 * 128 * 2);
constexpr size_t O_WGU = O_PWT + al256(4 * 128 * 128 * 2);
constexpr size_t O_WDN = O_WGU + 64 * MB;
constexpr size_t O_HB = O_WDN + 32 * MB;
constexpr size_t O_MIX = O_HB + 32 * MB;
constexpr size_t O_E = O_MIX + 32 * MB;
constexpr size_t SZ_E = al256((size_t)NT * PW0 * 2);
constexpr size_t O_F = O_E + SZ_E;
constexpr size_t WS_NEED = O_F + 48 * MB;
constexpr size_t O_HMID = O_MIX;
constexpr size_t O_PROJ = O_E;
constexpr size_t O_MOEOUT = O_E;
constexpr size_t O_CHP = O_WGU;
constexpr size_t O_CHL = O_WGU + 16 * MB;
constexpr size_t O_QR = O_F;
constexpr size_t O_KSR = O_F + 16 * MB;
constexpr size_t O_KWR = O_F + 20 * MB;
constexpr size_t O_OCMP = O_F + 24 * MB;
constexpr size_t O_VST = O_F + 40 * MB;
constexpr size_t O_VWT = O_F + 44 * MB;
constexpr size_t O_RW_W = O_HB;
constexpr size_t O_RW_Q = O_F;
constexpr size_t O_RW_Y = O_F + 16 * MB;
constexpr size_t O_RW_AS = O_F + 32 * MB;
constexpr size_t O_RW_G = O_WDN;
constexpr size_t O_POOLED = O_E + 76 * MB;

struct Params {
  const float* in[33];
  float* out;
  char* ws;
  unsigned long long ws_size;
};

enum { I_X = 0, I_C, I_ADAW, I_ADAB, I_NMIX, I_NFFN, I_EWIN, I_CPOS, I_CW1, I_CW2, I_CONVW, I_EWOUT, I_OWIN, I_MU, I_W0, I_W2,
       I_A0, I_A2, I_G2, I_KK, I_KA, I_RKP, I_LNW, I_LNB, I_POOLW, I_POOLS, I_OWOUT, I_RTW, I_RTB, I_MG, I_MU_, I_MD, I_FN };

DI int tid_opaque() { int t = threadIdx.x & 255; asm volatile("" : "+v"(t)); __builtin_assume(t >= 0 && t < 256); return t; }
#define VB ((int)(blockIdx.x * 2 + (threadIdx.x >> 8)))
#define NVB ((int)(gridDim.x * 2))
DI float bf2f(bfr u) { return __uint_as_float(((unsigned)u) << 16); }
DI bfr f2bf(float x) { unsigned u = __float_as_uint(x); u += 0x7fffu + ((u >> 16) & 1u); return (bfr)(u >> 16); }
typedef __attribute__((ext_vector_type(2))) float f32x2_;
DI unsigned pack2(float a, float b) { f32x2_ x = {a, b}; return __builtin_bit_cast(unsigned, __builtin_convertvector(x, bf2v)); }
DI float lo2f(unsigned u) { return __uint_as_float(u << 16); }
DI float hi2f(unsigned u) { return __uint_as_float(u & 0xffff0000u); }
DI float wave_sum(float v) {
#pragma unroll
  for (int o = 32; o > 0; o >>= 1) v += __shfl_xor(v, o);
  return v;
}
DI float sigmoidf_(float x) { return 1.f / (1.f + __expf(-x)); }
DI float dot2(unsigned a, unsigned b, float c) {
  return __builtin_amdgcn_fdot2_f32_bf16(__builtin_bit_cast(bf2v, a), __builtin_bit_cast(bf2v, b), c, false);
}

#define XB_TMO      128
#define XB_XCNT(j)  (256  + 64 * (j))
#define XB_XSUB(j)  (1280 + 64 * (j))
#define XB_XGEN(j)  (2304 + 64 * (j))
#define XB_TOP      3328
#define XB_TOPGEN   3392
#define XCD_BAR_WORDS 3456
#define XB_SPIN_CAP (1u << 22)
#define LAS __attribute__((address_space(3)))
DI unsigned xb_ld(unsigned* p) { return __hip_atomic_load(p, __ATOMIC_RELAXED, __HIP_MEMORY_SCOPE_AGENT); }
DI unsigned xb_add(unsigned* p, unsigned v) { return __hip_atomic_fetch_add(p, v, __ATOMIC_RELAXED, __HIP_MEMORY_SCOPE_AGENT); }
DI unsigned xb_xcc_id() { return (unsigned)__builtin_amdgcn_s_getreg((3 << 11) | 20) & 0xFu; }
#define XB_SPIN(cond, bar) do { unsigned _sp = 0; while (cond) { __builtin_amdgcn_s_sleep(1); \
    if ((++_sp & 255u) == 0u) { if (xb_ld(&(bar)[XB_TMO])) break; if (_sp > XB_SPIN_CAP) { atomicAdd(&(bar)[XB_TMO], 1u); break; } } } } while (0)
struct XcdBarrier { unsigned* bar; unsigned x; volatile LAS unsigned* st; };
DI XcdBarrier xcd_barrier_post(unsigned* bar, volatile LAS unsigned* st) {
  XcdBarrier b; b.bar = bar; b.x = xb_xcc_id(); b.st = st;
  if (threadIdx.x == 0) (void)xb_add(&bar[XB_XCNT(b.x)], 1u);
  return b;
}
DI void xcd_barrier_complete(unsigned* bar, unsigned x, unsigned& nloc, unsigned& nx) {
  const unsigned G = gridDim.x * gridDim.y * gridDim.z;
  unsigned sum, cnt, mine, sp = 0u;
  for (;;) {
    sum = 0u; cnt = 0u; mine = 0u;
#pragma unroll
    for (unsigned j = 0; j < 16; ++j) { const unsigned c = xb_ld(&bar[XB_XCNT(j)]); sum += c; cnt += (c > 0u) ? 1u : 0u; mine = (j == x) ? c : mine; }
    if (sum == G) break;
    __builtin_amdgcn_s_sleep(1);
    if ((++sp & 255u) == 0u) { if (xb_ld(&bar[XB_TMO])) break; if (sp > XB_SPIN_CAP) { atomicAdd(&bar[XB_TMO], 1u); break; } }
  }
  nloc = mine > 0u ? mine : 1u; nx = cnt > 0u ? cnt : 1u;
}
template <bool REL = true, bool ACQ = true>
DI void xcd_barrier(const XcdBarrier& b) {
  asm volatile("s_waitcnt vmcnt(0)" ::: "memory");
  __syncthreads();
  if (threadIdx.x == 0) {
    unsigned* bar = b.bar;
    __builtin_amdgcn_s_waitcnt(0);
    unsigned nloc = b.st[0], nx = b.st[1];
    if (nloc == 0u) { xcd_barrier_complete(bar, b.x, nloc, nx); b.st[0] = nloc; b.st[1] = nx; }
    const unsigned old = xb_add(&bar[XB_XSUB(b.x)], 1u);
    const unsigned gen = old / nloc;
    if (old + 1u == (gen + 1u) * nloc) {
      if (REL) __builtin_amdgcn_fence(__ATOMIC_RELEASE, "agent");
      asm volatile("s_waitcnt vmcnt(0)" ::: "memory");
      const unsigned og = xb_add(&bar[XB_TOP], 1u);
      const unsigned tg = og / nx;
      if (og + 1u == (tg + 1u) * nx) xb_add(&bar[XB_TOPGEN], 1u);
      else XB_SPIN(xb_ld(&bar[XB_TOPGEN]) == tg, bar);
      if (ACQ) __builtin_amdgcn_fence(__ATOMIC_ACQUIRE, "agent");
      xb_add(&bar[XB_XGEN(b.x)], 1u);
      asm volatile("s_waitcnt vmcnt(0)" ::: "memory");
    } else {
      XB_SPIN(xb_ld(&bar[XB_XGEN(b.x)]) == gen, bar);
      if (ACQ) __builtin_amdgcn_fence(__ATOMIC_ACQUIRE, "agent");
      asm volatile("s_waitcnt vmcnt(0)" ::: "memory");
    }
  }
  __syncthreads();
}

struct GemmLds { bfr a[2][128][40]; bfr b[2][128][40]; };
static_assert(sizeof(GemmLds) == 40960, "lds");

template <class AF, class BF, class Epi>
DI void gemm_tile(char* smem, int nk, AF af, BF bfn, Epi&& epi) {
  GemmLds& L = *(GemmLds*)smem;
  const int tid = tid_opaque(), lane = tid & 63, wid = tid >> 6, wr = wid >> 1, wc = wid & 1, fr = lane & 15, fq = lane >> 4;
  const int lr = tid >> 2, lk = (tid & 3) * 8;
  af.init(lr);
  bfn.init(lr);
  f32x4 acc[4][4];
#pragma unroll
  for (int m = 0; m < 4; ++m)
#pragma unroll
    for (int n = 0; n < 4; ++n) acc[m][n] = f32x4{0.f, 0.f, 0.f, 0.f};
  uint4 ra0, ra1, rb0, rb1;
  ra0 = af.load(0, lk); ra1 = af.load(1, lk);
  rb0 = bfn.load(0, lk); rb1 = bfn.load(1, lk);
  *(uint4*)&L.a[0][lr][lk] = ra0; *(uint4*)&L.a[0][lr + 64][lk] = ra1;
  *(uint4*)&L.b[0][lr][lk] = rb0; *(uint4*)&L.b[0][lr + 64][lk] = rb1;
  __syncthreads();
  for (int kt = 0; kt < nk; ++kt) {
    const int cur = kt & 1;
    if (kt + 1 < nk) {
      const int k = (kt + 1) * 32 + lk;
      ra0 = af.load(0, k); ra1 = af.load(1, k);
      rb0 = bfn.load(0, k); rb1 = bfn.load(1, k);
    }
    __builtin_amdgcn_sched_barrier(0);
    bf16x8 fa[4], fb[4];
#pragma unroll
    for (int m = 0; m < 4; ++m) fa[m] = *(const bf16x8*)&L.a[cur][wr * 64 + m * 16 + fr][fq * 8];
#pragma unroll
    for (int n = 0; n < 4; ++n) fb[n] = *(const bf16x8*)&L.b[cur][wc * 64 + n * 16 + fr][fq * 8];
#pragma unroll
    for (int m = 0; m < 4; ++m)
#pragma unroll
      for (int n = 0; n < 4; ++n) acc[m][n] = __builtin_amdgcn_mfma_f32_16x16x32_bf16(fa[m], fb[n], acc[m][n], 0, 0, 0);
    __builtin_amdgcn_sched_barrier(0);
    if (kt + 1 < nk) {
      *(uint4*)&L.a[cur ^ 1][lr][lk] = ra0; *(uint4*)&L.a[cur ^ 1][lr + 64][lk] = ra1;
      *(uint4*)&L.b[cur ^ 1][lr][lk] = rb0; *(uint4*)&L.b[cur ^ 1][lr + 64][lk] = rb1;
    }
    __syncthreads();
  }
  epi(acc, wr, wc, fr, fq);
}

struct RowsContig {
  const bfr* base; int ld; int maxrow;
  const bfr* rp[2];
  DI void init(int lr) {
#pragma unroll
    for (int i = 0; i < 2; ++i) { const int r = lr + 64 * i; rp[i] = base + (size_t)(r < maxrow ? r : maxrow) * ld; }
  }
  DI uint4 load(int sel, int k) const { return *(const uint4*)(rp[sel] + k); }
  DI const bfr* ptr(int sel, int k) const { return rp[sel] + k; }
};

#ifndef KLOOP2
#define KLOOP2 1
#endif
struct RowsContigW {
  const bfr* base; int ld; int maxrow;
  const bfr* rp[2];
  DI void init(int lr) {
#pragma unroll
    for (int i = 0; i < 2; ++i) { const int r = lr + 64 * i; rp[i] = base + (size_t)(r < maxrow ? r : maxrow) * ld; }
  }
  DI const bfr* ptr(int sel, int k) const { return rp[sel] + (k & 1023); }
};
struct GemmLdsG { bfr a[3][128][32]; bfr b[3][128][32]; };
static_assert(sizeof(GemmLdsG) == 49152, "glds lds");
template <class AF, class BF, class Epi>
DI void gemm_tile_g(char* smem, int nk, AF af, BF bfn, Epi&& epi) {
  GemmLdsG& L = *(GemmLdsG*)smem;
  const int tid = tid_opaque(), lane = tid & 63, wid = tid >> 6, wr = wid >> 1, wc = wid & 1, fr = lane & 15, fq = lane >> 4;
  const int lr = tid >> 2;
  const int lk = ((tid & 3) ^ (2 * ((lr >> 3) & 1))) * 8;
  af.init(lr);
  bfn.init(lr);
  f32x4 acc[4][4];
#pragma unroll
  for (int m = 0; m < 4; ++m)
#pragma unroll
    for (int n = 0; n < 4; ++n) acc[m][n] = f32x4{0.f, 0.f, 0.f, 0.f};
  typedef __attribute__((address_space(3))) unsigned lds_u32;
  auto stage = [&](int buf, int kt) {
    const int k = kt * 32 + lk;
    char* la = (char*)&L.a[buf][0][0] + tid * 16;
    char* lb = (char*)&L.b[buf][0][0] + tid * 16;
    __builtin_amdgcn_global_load_lds((const unsigned*)af.ptr(0, k), (lds_u32*)la, 16, 0, 0);
    __builtin_amdgcn_global_load_lds((const unsigned*)af.ptr(1, k), (lds_u32*)(la + 4096), 16, 0, 0);
    __builtin_amdgcn_global_load_lds((const unsigned*)bfn.ptr(0, k), (lds_u32*)lb, 16, 0, 0);
    __builtin_amdgcn_global_load_lds((const unsigned*)bfn.ptr(1, k), (lds_u32*)(lb + 4096), 16, 0, 0);
  };
  const int cs = (fq ^ (2 * (fr >> 3))) * 8;
  stage(0, 0);
  stage(1, 1);
  int cur = 0;
  for (int kt = 0; kt < nk; ++kt) {
    if (kt + 1 < nk) asm volatile("s_waitcnt vmcnt(4)" ::: "memory");
    else asm volatile("s_waitcnt vmcnt(0)" ::: "memory");
    __builtin_amdgcn_s_barrier();
    asm volatile("" ::: "memory");
    if (kt + 2 < nk) stage(cur == 0 ? 2 : cur - 1, kt + 2);
    bf16x8 fa[4], fb[4];
#pragma unroll
    for (int m = 0; m < 4; ++m) fa[m] = *(const bf16x8*)&L.a[cur][wr * 64 + m * 16 + fr][cs];
#pragma unroll
    for (int n = 0; n < 4; ++n) fb[n] = *(const bf16x8*)&L.b[cur][wc * 64 + n * 16 + fr][cs];
#pragma unroll
    for (int m = 0; m < 4; ++m)
#pragma unroll
      for (int n = 0; n < 4; ++n) acc[m][n] = __builtin_amdgcn_mfma_f32_16x16x32_bf16(fb[n], fa[m], acc[m][n], 0, 0, 0);
    cur = cur == 2 ? 0 : cur + 1;
  }
  asm volatile("s_waitcnt lgkmcnt(0)" ::: "memory");
  __builtin_amdgcn_s_barrier();
  asm volatile("" ::: "memory");
  epi(acc, wr, wc, fr, fq);
}

DI int tid512_opaque() { int t = threadIdx.x; asm volatile("" : "+v"(t)); __builtin_assume(t >= 0 && t < 512); return t; }
struct GemmLds256 { bfr a[3][256][32]; bfr b[3][256][32]; };
static_assert(sizeof(GemmLds256) == 98304, "lds256");
struct Rows256 {
  const bfr* base; int ld; int maxrow;
  const bfr* rp[2];
  DI void init(int lr) {
#pragma unroll
    for (int i = 0; i < 2; ++i) { const int r = lr + 128 * i; rp[i] = base + (size_t)(r < maxrow ? r : maxrow) * ld; }
  }
  DI const bfr* ptr(int sel, int k) const { return rp[sel] + k; }
};
template <int NS, class AF, class BF, class Epi>
DI void gemm_tile_256(char* smem_all, int nk, AF af, BF bfn, Epi&& epi) {
  GemmLds256& L = *(GemmLds256*)smem_all;
  const int tid = tid512_opaque(), lane = tid & 63, wid = tid >> 6, wr = wid >> 2, wc = wid & 3, fr = lane & 15, fq = lane >> 4;
  const int lr = tid >> 2;
  const int lk = ((tid & 3) ^ (2 * ((lr >> 3) & 1))) * 8;
  af.init(lr);
  bfn.init(lr);
  f32x4 acc[8][NS];
#pragma unroll
  for (int m = 0; m < 8; ++m)
#pragma unroll
    for (int n = 0; n < NS; ++n) acc[m][n] = f32x4{0.f, 0.f, 0.f, 0.f};
  typedef __attribute__((address_space(3))) unsigned lds_u32;
  auto stage = [&](int buf, int kt) {
    const int k = kt * 32 + lk;
    char* la = (char*)&L.a[buf][0][0] + tid * 16;
    char* lb = (char*)&L.b[buf][0][0] + tid * 16;
    __builtin_amdgcn_global_load_lds((const unsigned*)af.ptr(0, k), (lds_u32*)la, 16, 0, 0);
    __builtin_amdgcn_global_load_lds((const unsigned*)af.ptr(1, k), (lds_u32*)(la + 8192), 16, 0, 0);
    __builtin_amdgcn_global_load_lds((const unsigned*)bfn.ptr(0, k), (lds_u32*)lb, 16, 0, 0);
    __builtin_amdgcn_global_load_lds((const unsigned*)bfn.ptr(1, k), (lds_u32*)(lb + 8192), 16, 0, 0);
  };
  const int cs = (fq ^ (2 * (fr >> 3))) * 8;
  stage(0, 0);
  stage(1, 1);
  int cur = 0;
  for (int kt = 0; kt < nk; ++kt) {
    if (kt + 1 < nk) asm volatile("s_waitcnt vmcnt(4)" ::: "memory");
    else asm volatile("s_waitcnt vmcnt(0)" ::: "memory");
    __builtin_amdgcn_s_barrier();
    asm volatile("" ::: "memory");
    if (kt + 2 < nk) stage(cur == 0 ? 2 : cur - 1, kt + 2);
    bf16x8 fb[NS];
#pragma unroll
    for (int n = 0; n < NS; ++n) fb[n] = *(const bf16x8*)&L.b[cur][wc * (NS * 16) + n * 16 + fr][cs];
#pragma unroll
    for (int mh = 0; mh < 2; ++mh) {
      bf16x8 fa[4];
#pragma unroll
      for (int m = 0; m < 4; ++m) fa[m] = *(const bf16x8*)&L.a[cur][wr * 128 + (mh * 4 + m) * 16 + fr][cs];
#pragma unroll
      for (int m = 0; m < 4; ++m)
#pragma unroll
        for (int n = 0; n < NS; ++n) acc[mh * 4 + m][n] = __builtin_amdgcn_mfma_f32_16x16x32_bf16(fb[n], fa[m], acc[mh * 4 + m][n], 0, 0, 0);
    }
    cur = cur == 2 ? 0 : cur + 1;
  }
  asm volatile("s_waitcnt lgkmcnt(0)" ::: "memory");
  __builtin_amdgcn_s_barrier();
  asm volatile("" ::: "memory");
  epi(acc, wr, wc, fr, fq);
}

DI int remap_col(int mode, int n) {
  if (mode == 1) return n < 1280 ? n : (n < 1304 ? C_GL + (n - 1280) : n - 24);
  if (mode == 2) return ((n >> 4) << 5) + (n & 15);
  if (mode == 3) return ((n >> 4) << 5) + 16 + (n & 15);
  return n;
}

DI void conv_tile(char* smem, const float* __restrict__ src, int ldsrc, int Ndim, int k0, int n0, bfr* dst, int ldd, int mode) {
  float(*t)[65] = (float(*)[65])smem;
  const int tid = tid_opaque();
  {
    const int n = tid & 63, kq = tid >> 6;
    const int nn = n0 + n;
#pragma unroll
    for (int i = 0; i < 16; ++i) {
      const int k = i * 4 + kq;
      t[k][n] = (nn < Ndim) ? src[(size_t)(k0 + k) * ldsrc + nn] : 0.f;
    }
  }
  __syncthreads();
  {
    const int nl = tid >> 2, kc = (tid & 3) * 16;
    const int nn = n0 + nl;
    if (nn < Ndim) {
      const int dr = remap_col(mode, nn);
      unsigned w[8];
#pragma unroll
      for (int i = 0; i < 8; ++i) w[i] = pack2(t[kc + 2 * i][nl], t[kc + 2 * i + 1][nl]);
      uint4* d = (uint4*)(dst + (size_t)dr * ldd + k0 + kc);
      d[0] = make_uint4(w[0], w[1], w[2], w[3]);
      d[1] = make_uint4(w[4], w[5], w[6], w[7]);
    }
  }
  __syncthreads();
}

constexpr int PREP_MOD = 192, PREP_ROPE = 256, PREP_MISC = 4;
constexpr int T_EIN = 16 * 45, T_SQ = 256, T_OIN = 16 * 36, T_C1 = 128, T_C2 = 4, T_G = 128, T_D = 128;
constexpr int PREP_CONV0 = PREP_MOD + PREP_ROPE + PREP_MISC;
constexpr int T_LORA = 8 + 8 + 16 + 16;
constexpr int PREP_TOTAL = PREP_CONV0 + T_EIN + T_SQ + T_OIN + T_SQ + 2 * T_C1 + 2 * T_C2 + T_LORA + 16 * (2 * T_G + T_D);

DI void conv_expert_item(const Params& p, char* smem, int item) {
  char* ws = p.ws;
  const int le = item / (2 * T_G + T_D), tt = item % (2 * T_G + T_D);
  if (tt < T_G) {
    conv_tile(smem, p.in[I_MG] + (size_t)le * 1024 * 512, 512, 512, (tt / 8) * 64, (tt % 8) * 64, (bfr*)(ws + O_WGU) + (size_t)le * 1024 * 1024, 1024, 2);
  } else if (tt < 2 * T_G) {
    const int t2 = tt - T_G;
    conv_tile(smem, p.in[I_MU_] + (size_t)le * 1024 * 512, 512, 512, (t2 / 8) * 64, (t2 % 8) * 64, (bfr*)(ws + O_WGU) + (size_t)le * 1024 * 1024, 1024, 3);
  } else {
    const int t2 = tt - 2 * T_G;
    conv_tile(smem, p.in[I_MD] + (size_t)le * 512 * 1024, 1024, 1024, (t2 / 16) * 64, (t2 % 16) * 64, (bfr*)(ws + O_WDN) + (size_t)le * 1024 * 512, 512, 0);
  }
}

DI void prep_item(const Params& p, char* smem, int item) {
  const int tid = tid_opaque();
  char* ws = p.ws;
  if (item < PREP_MOD) {
    const int layer = item / 96, cch = item % 96;
    float* cond = (float*)smem;
    float* red = (float*)(smem + 32768);
    const float* c = p.in[I_C];
    for (int i = tid; i < 8192; i += 256) {
      const int b = i >> 10, k = i & 1023;
      const float v = c[i];
      cond[k * 8 + b] = v / (1.f + __expf(-v));
    }
    __syncthreads();
    const int col = cch * 64 + (tid & 63), kg = tid >> 6;
    const float* w = p.in[I_ADAW] + (size_t)layer * 1024 * 6144 + col;
    float acc[8] = {0, 0, 0, 0, 0, 0, 0, 0};
#pragma unroll 8
    for (int k = kg * 256; k < kg * 256 + 256; ++k) {
      const float wv = w[(size_t)k * 6144];
      const float4 c0 = *(const float4*)&cond[k * 8], c1 = *(const float4*)&cond[k * 8 + 4];
      acc[0] += c0.x * wv; acc[1] += c0.y * wv; acc[2] += c0.z * wv; acc[3] += c0.w * wv;
      acc[4] += c1.x * wv; acc[5] += c1.y * wv; acc[6] += c1.z * wv; acc[7] += c1.w * wv;
    }
#pragma unroll
    for (int b = 0; b < 8; ++b) red[(kg * 8 + b) * 64 + (tid & 63)] = acc[b];
    __syncthreads();
    for (int i = tid; i < 512; i += 256) {
      const int b = i >> 6, cc = i & 63;
      const float s = red[(0 * 8 + b) * 64 + cc] + red[(1 * 8 + b) * 64 + cc] + red[(2 * 8 + b) * 64 + cc] + red[(3 * 8 + b) * 64 + cc];
      const int cg_ = cch * 64 + cc;
      ((float*)(ws + O_MOD))[(layer * 8 + b) * 6144 + cg_] = s + p.in[I_ADAB][layer * 6144 + cg_];
    }
    __syncthreads();
    return;
  }
  item -= PREP_MOD;
  if (item < PREP_ROPE) {
    const int e = item * 256 + tid;
    const int t = e >> 5, i = e & 31;
    const float inv = powf(10000.f, -(float)i / 32.f);
    const float ang = (float)t * inv;
    float* rp = (float*)(ws + O_ROPE);
    rp[e] = cosf(ang);
    rp[65536 + e] = sinf(ang);
    return;
  }
  item -= PREP_ROPE;
  if (item < PREP_MISC) {
    if (item == 3) return;
    if (item < 2) {
      const int j = item, n = tid;
      const float* pos = p.in[I_CPOS] + j * 2048;
      const float* w1 = p.in[I_CW1] + (size_t)j * 2048 * 256 + n;
      float s = 0.f;
      for (int k = 0; k < 2048; ++k) s += pos[k] * w1[(size_t)k * 256];
      ((float*)(ws + O_BIAS1))[j * 256 + n] = s;
    } else {
      int* cnt = (int*)(ws + O_CNT);
      for (int i = tid; i < 2 * 16 * 64; i += 256) cnt[i] = 0;
      uint4* vct = (uint4*)(ws + O_VCT);
      for (int i = tid; i < 8 * 2 * 64 * 128 * 2 / 16; i += 256) vct[i] = make_uint4(0, 0, 0, 0);
      unsigned* barw = (unsigned*)(ws + O_BAR);
      for (int i = tid; i < XCD_BAR_WORDS; i += 256) barw[i] = 0u;
      uint4 z = make_uint4(0, 0, 0, 0);
      uint4* wpad = (uint4*)(ws + O_WEIN + (size_t)2840 * 1024 * 2);
      for (int i = tid; i < (PW0 - 2840) * 1024 * 2 / 16; i += 256) wpad[i] = z;
      for (int j = 0; j < 2; ++j) {
        uint4* cp = (uint4*)(ws + O_WC2 + ((size_t)j * 128 + 64) * 256 * 2);
        for (int i = tid; i < 64 * 256 * 2 / 16; i += 256) cp[i] = z;
      }
    }
    return;
  }
  item -= PREP_MISC;
  if (item < T_EIN) { conv_tile(smem, p.in[I_EWIN], 2840, 2840, (item / 45) * 64, (item % 45) * 64, (bfr*)(ws + O_WEIN), 1024, 1); return; }
  item -= T_EIN;
  if (item < T_SQ) { conv_tile(smem, p.in[I_EWOUT], 1024, 1024, (item / 16) * 64, (item % 16) * 64, (bfr*)(ws + O_WEOUT), 1024, 0); return; }
  item -= T_SQ;
  if (item < T_OIN) { conv_tile(smem, p.in[I_OWIN], 2304, 2304, (item / 36) * 64, (item % 36) * 64, (bfr*)(ws + O_WOIN), 1024, 0); return; }
  item -= T_OIN;
  if (item < T_SQ) { conv_tile(smem, p.in[I_OWOUT], 1024, 1024, (item / 16) * 64, (item % 16) * 64, (bfr*)(ws + O_WOOUT), 1024, 0); return; }
  item -= T_SQ;
  if (item < 2 * T_C1) {
    const int j = item / T_C1, tt = item % T_C1;
    conv_tile(smem, p.in[I_CW1] + (size_t)j * 2048 * 256, 256, 256, (tt / 4) * 64, (tt % 4) * 64, (bfr*)(ws + O_WC1) + (size_t)j * 256 * 2048, 2048, 0);
    return;
  }
  item -= 2 * T_C1;
  if (item < 2 * T_C2) {
    const int j = item / T_C2, tt = item % T_C2;
    conv_tile(smem, p.in[I_CW2] + (size_t)j * 256 * 64, 64, 64, tt * 64, 0, (bfr*)(ws + O_WC2) + (size_t)j * 128 * 256, 256, 0);
    return;
  }
  item -= 2 * T_C2;
  if (item < T_LORA) {
    if (item < 8) conv_tile(smem, p.in[I_W2], 512, 512, 0, item * 64, (bfr*)(ws + O_W2T), 64, 0);
    else if (item < 16) conv_tile(smem, p.in[I_A2], 512, 512, 0, (item - 8) * 64, (bfr*)(ws + O_A2T), 64, 0);
    else if (item < 32) { const int t2 = item - 16; conv_tile(smem, p.in[I_G2], 512, 512, (t2 >> 3) * 64, (t2 & 7) * 64, (bfr*)(ws + O_G2T), 128, 0); }
    else { const int t2 = item - 32, gi = t2 >> 2; conv_tile(smem, p.in[I_POOLW] + gi * 128 * 128, 128, 128, ((t2 >> 1) & 1) * 64, (t2 & 1) * 64, (bfr*)(ws + O_PWT) + gi * 128 * 128, 128, 0); }
    return;
  }
  item -= T_LORA;
  conv_expert_item(p, smem, item);
}

template <int MODE, bool ROUTER>
DI void norm_phase(const Params& p, char* smem, const float* xin, float* xout, const float* nw, const float* modl,
                   int sh_off, int sc_off, int g_off, int layer) {
  char* ws = p.ws;
  const int tid = tid_opaque(), lane = tid & 63, wid = tid >> 6;
  bfr* HB = (bfr*)(ws + O_HB);
  const bfr* MO0 = (const bfr*)(ws + O_MOEOUT);
  const bfr* MO1 = MO0 + (size_t)NT * 1024;
  int* lcnt = (int*)smem;
  int* lbase = lcnt + 16;
  int* lexp = lbase + 16;
  int* lrank = lexp + 64;
  for (int chunk = VB; chunk < NT / 32; chunk += NVB) {
    if (ROUTER) {
      if (tid < 16) lcnt[tid] = 0;
      __syncthreads();
    }
    for (int it = 0; it < 8; ++it) {
      const int row = chunk * 32 + it * 4 + wid;
      const int b = row >> 11;
      float v[16];
      float ss = 0.f;
#pragma unroll
      for (int i = 0; i < 2; ++i) {
        const int c = (i * 64 + lane) * 8;
        float4 x0 = *(const float4*)(xin + (size_t)row * 1024 + c), x1 = *(const float4*)(xin + (size_t)row * 1024 + c + 4);
        if (MODE >= 1) {
          const float4 g0 = *(const float4*)(modl + b * 6144 + g_off + c), g1 = *(const float4*)(modl + b * 6144 + g_off + c + 4);
          const uint4 m0 = *(const uint4*)(MO0 + (size_t)row * 1024 + c);
          const uint4 m1 = *(const uint4*)(MO1 + (size_t)row * 1024 + c);
          x0.x += g0.x * (lo2f(m0.x) + lo2f(m1.x)); x0.y += g0.y * (hi2f(m0.x) + hi2f(m1.x));
          x0.z += g0.z * (lo2f(m0.y) + lo2f(m1.y)); x0.w += g0.w * (hi2f(m0.y) + hi2f(m1.y));
          x1.x += g1.x * (lo2f(m0.z) + lo2f(m1.z)); x1.y += g1.y * (hi2f(m0.z) + hi2f(m1.z));
          x1.z += g1.z * (lo2f(m0.w) + lo2f(m1.w)); x1.w += g1.w * (hi2f(m0.w) + hi2f(m1.w));
          if (MODE == 1) { *(float4*)(xout + (size_t)row * 1024 + c) = x0; *(float4*)(xout + (size_t)row * 1024 + c + 4) = x1; }
        }
        v[i * 8 + 0] = x0.x; v[i * 8 + 1] = x0.y; v[i * 8 + 2] = x0.z; v[i * 8 + 3] = x0.w;
        v[i * 8 + 4] = x1.x; v[i * 8 + 5] = x1.y; v[i * 8 + 6] = x1.z; v[i * 8 + 7] = x1.w;
        ss += x0.x * x0.x + x0.y * x0.y + x0.z * x0.z + x0.w * x0.w + x1.x * x1.x + x1.y * x1.y + x1.z * x1.z + x1.w * x1.w;
      }
      ss = wave_sum(ss);
      const float rstd = rsqrtf(ss * (1.f / 1024.f) + 1e-6f);
#pragma unroll
      for (int i = 0; i < 2; ++i) {
        const int c = (i * 64 + lane) * 8;
        const float4 w0 = *(const float4*)(nw + c), w1 = *(const float4*)(nw + c + 4);
        const float wv[8] = {w0.x, w0.y, w0.z, w0.w, w1.x, w1.y, w1.z, w1.w};
        if (MODE == 2) {
          float4 o0, o1;
          o0.x = v[i * 8 + 0] * rstd * wv[0]; o0.y = v[i * 8 + 1] * rstd * wv[1]; o0.z = v[i * 8 + 2] * rstd * wv[2]; o0.w = v[i * 8 + 3] * rstd * wv[3];
          o1.x = v[i * 8 + 4] * rstd * wv[4]; o1.y = v[i * 8 + 5] * rstd * wv[5]; o1.z = v[i * 8 + 6] * rstd * wv[6]; o1.w = v[i * 8 + 7] * rstd * wv[7];
          *(float4*)(xout + (size_t)row * 1024 + c) = o0; *(float4*)(xout + (size_t)row * 1024 + c + 4) = o1;
        } else {
          const float4 sc0 = *(const float4*)(modl + b * 6144 + sc_off + c), sc1 = *(const float4*)(modl + b * 6144 + sc_off + c + 4);
          const float4 sh0 = *(const float4*)(modl + b * 6144 + sh_off + c), sh1 = *(const float4*)(modl + b * 6144 + sh_off + c + 4);
          const float scv[8] = {sc0.x, sc0.y, sc0.z, sc0.w, sc1.x, sc1.y, sc1.z, sc1.w};
          const float shv[8] = {sh0.x, sh0.y, sh0.z, sh0.w, sh1.x, sh1.y, sh1.z, sh1.w};
#pragma unroll
          for (int q = 0; q < 8; ++q) v[i * 8 + q] = v[i * 8 + q] * rstd * wv[q] * (1.f + scv[q]) + shv[q];
          *(uint4*)(HB + (size_t)row * 1024 + c) = make_uint4(pack2(v[i * 8 + 0], v[i * 8 + 1]), pack2(v[i * 8 + 2], v[i * 8 + 3]),
                                                                pack2(v[i * 8 + 4], v[i * 8 + 5]), pack2(v[i * 8 + 6], v[i * 8 + 7]));
        }
      }
      if (ROUTER) {
        const float* rw = p.in[I_RTW];
        float sc[16], bi[16];
#pragma unroll
        for (int eh = 0; eh < 2; ++eh) {
          float lg[8];
#pragma unroll
          for (int e = 0; e < 8; ++e) lg[e] = 0.f;
#pragma unroll
          for (int i = 0; i < 4; ++i) {
#pragma unroll
            for (int q = 0; q < 4; ++q) {
              const int c = (i * 64 + lane) * 4 + q;
              const float4 w0 = *(const float4*)(rw + c * 16 + eh * 8), w1 = *(const float4*)(rw + c * 16 + eh * 8 + 4);
              const float h = v[i * 4 + q];
              lg[0] += h * w0.x; lg[1] += h * w0.y; lg[2] += h * w0.z; lg[3] += h * w0.w;
              lg[4] += h * w1.x; lg[5] += h * w1.y; lg[6] += h * w1.z; lg[7] += h * w1.w;
            }
            __builtin_amdgcn_sched_barrier(0);
          }
#pragma unroll
          for (int e = 0; e < 8; ++e) {
            const float lgv = wave_sum(lg[e]);
            sc[eh * 8 + e] = 1.f / (1.f + __expf(-lgv));
            bi[eh * 8 + e] = sc[eh * 8 + e] + p.in[I_RTB][eh * 8 + e];
          }
        }
        int tg = 0; float best = -3.0e38f;
#pragma unroll
        for (int g = 0; g < 4; ++g) {
          float m1 = -3.0e38f, m2 = -3.0e38f;
#pragma unroll
          for (int j = 0; j < 4; ++j) {
            const float x = bi[g * 4 + j];
            if (x > m1) { m2 = m1; m1 = x; } else if (x > m2) { m2 = x; }
          }
          const float gs = m1 + m2;
          if (gs > best) { best = gs; tg = g; }
        }
        int i0 = -1, i1 = -1; float b0 = -3.0e38f, b1 = -3.0e38f, s0 = 0.f, s1 = 0.f;
#pragma unroll
        for (int e = 0; e < 16; ++e) {
          if ((e >> 2) == tg) {
            const float x = bi[e];
            if (x > b0) { b1 = b0; i1 = i0; s1 = s0; b0 = x; i0 = e; s0 = sc[e]; }
            else if (x > b1) { b1 = x; i1 = e; s1 = sc[e]; }
          }
        }
        if (lane == 0) {
          const float inv = 1.f / (s0 + s1);
          float* topw = (float*)(ws + O_TOPW);
          topw[row * 2 + 0] = s0 * inv;
          topw[row * 2 + 1] = s1 * inv;
          const int a = (it * 4 + wid) * 2;
          lexp[a] = i0; lrank[a] = atomicAdd(&lcnt[i0], 1);
          lexp[a + 1] = i1; lrank[a + 1] = atomicAdd(&lcnt[i1], 1);
        }
      }
    }
    if (ROUTER) {
      __syncthreads();
      int* cnt = (int*)(ws + O_CNT) + layer * 16 * 64;
      if (tid < 16) lbase[tid] = atomicAdd(&cnt[tid * 64], lcnt[tid]);
      __syncthreads();
      if (tid < 64) {
        const int e = lexp[tid];
        const int slot = lbase[e] + lrank[tid];
        ((int*)(ws + O_LIST))[(size_t)e * NT + slot] = (chunk * 32 + (tid >> 1)) * 2 + (tid & 1);
      }
      __syncthreads();
    }
  }
}

constexpr int NR = 2;
DI void norm_router_phase(const Params& p, char* smem, const float* xin, const float* nw, const float* modl, int sh_off, int sc_off, int layer) {
  char* ws = p.ws;
  const int tid = tid_opaque(), lane = tid & 63, wid = tid >> 6;
  bfr* HB = (bfr*)(ws + O_HB);
  int* lcnt = (int*)smem;
  int* lbase = lcnt + 16;
  int* lexp = lbase + 16;
  int* lrank = lexp + 64;
  const float* rw = p.in[I_RTW];
  for (int chunk = VB; chunk < NT / 32; chunk += NVB) {
    if (tid < 16) lcnt[tid] = 0;
    __syncthreads();
#pragma unroll 1
    for (int it2 = 0; it2 < 8 / NR; ++it2) {
      const int row0 = chunk * 32 + wid * 8 + it2 * NR;
      const int b = row0 >> 11;
      float v[NR][16];
      float ss[NR];
#pragma unroll
      for (int rr = 0; rr < NR; ++rr) {
        ss[rr] = 0.f;
#pragma unroll
        for (int i = 0; i < 2; ++i) {
          const float* xp = xin + (size_t)(row0 + rr) * 1024 + (i * 64 + lane) * 8;
          const float4 x0 = *(const float4*)xp, x1 = *(const float4*)(xp + 4);
          v[rr][i * 8 + 0] = x0.x; v[rr][i * 8 + 1] = x0.y; v[rr][i * 8 + 2] = x0.z; v[rr][i * 8 + 3] = x0.w;
          v[rr][i * 8 + 4] = x1.x; v[rr][i * 8 + 5] = x1.y; v[rr][i * 8 + 6] = x1.z; v[rr][i * 8 + 7] = x1.w;
          ss[rr] += x0.x * x0.x + x0.y * x0.y + x0.z * x0.z + x0.w * x0.w + x1.x * x1.x + x1.y * x1.y + x1.z * x1.z + x1.w * x1.w;
        }
      }
#pragma unroll
      for (int rr = 0; rr < NR; ++rr) ss[rr] = rsqrtf(wave_sum(ss[rr]) * (1.f / 1024.f) + 1e-6f);
#pragma unroll
      for (int i = 0; i < 2; ++i) {
        const int c = (i * 64 + lane) * 8;
        const float4 w0 = *(const float4*)(nw + c), w1 = *(const float4*)(nw + c + 4);
        const float4 sc0 = *(const float4*)(modl + b * 6144 + sc_off + c), sc1 = *(const float4*)(modl + b * 6144 + sc_off + c + 4);
        const float4 sh0 = *(const float4*)(modl + b * 6144 + sh_off + c), sh1 = *(const float4*)(modl + b * 6144 + sh_off + c + 4);
        const float wv[8] = {w0.x * (1.f + sc0.x), w0.y * (1.f + sc0.y), w0.z * (1.f + sc0.z), w0.w * (1.f + sc0.w),
                             w1.x * (1.f + sc1.x), w1.y * (1.f + sc1.y), w1.z * (1.f + sc1.z), w1.w * (1.f + sc1.w)};
        const float shv[8] = {sh0.x, sh0.y, sh0.z, sh0.w, sh1.x, sh1.y, sh1.z, sh1.w};
#pragma unroll
        for (int rr = 0; rr < NR; ++rr) {
#pragma unroll
          for (int q = 0; q < 8; ++q) v[rr][i * 8 + q] = v[rr][i * 8 + q] * ss[rr] * wv[q] + shv[q];
          *(uint4*)(HB + (size_t)(row0 + rr) * 1024 + c) = make_uint4(pack2(v[rr][i * 8 + 0], v[rr][i * 8 + 1]), pack2(v[rr][i * 8 + 2], v[rr][i * 8 + 3]),
                                                                          pack2(v[rr][i * 8 + 4], v[rr][i * 8 + 5]), pack2(v[rr][i * 8 + 6], v[rr][i * 8 + 7]));
        }
      }
      float* sgl = (float*)(smem + 1024) + wid * 64;
#pragma unroll 1
      for (int eh = 0; eh < 2; ++eh) {
        float lg[NR][8];
#pragma unroll
        for (int rr = 0; rr < NR; ++rr)
#pragma unroll
          for (int e = 0; e < 8; ++e) lg[rr][e] = 0.f;
#pragma unroll
        for (int i = 0; i < 4; ++i) {
#pragma unroll
          for (int q = 0; q < 4; ++q) {
            const int c = ((i >> 1) * 64 + lane) * 8 + (i & 1) * 4 + q;
            const float4 w0 = *(const float4*)(rw + c * 16 + eh * 8), w1 = *(const float4*)(rw + c * 16 + eh * 8 + 4);
#pragma unroll
            for (int rr = 0; rr < NR; ++rr) {
              const float h = v[rr][i * 4 + q];
              lg[rr][0] += h * w0.x; lg[rr][1] += h * w0.y; lg[rr][2] += h * w0.z; lg[rr][3] += h * w0.w;
              lg[rr][4] += h * w1.x; lg[rr][5] += h * w1.y; lg[rr][6] += h * w1.z; lg[rr][7] += h * w1.w;
            }
          }
          if (i == 1) __builtin_amdgcn_sched_barrier(0);
        }
#pragma unroll
        for (int rr = 0; rr < NR; ++rr)
#pragma unroll
          for (int e = 0; e < 8; ++e) {
            const float sv = 1.f / (1.f + __expf(-wave_sum(lg[rr][e])));
            if (lane == 0) sgl[rr * 16 + eh * 8 + e] = sv;
          }
      }
      __builtin_amdgcn_fence(__ATOMIC_RELEASE, "wavefront");
      __builtin_amdgcn_wave_barrier();
#pragma unroll
      for (int rr = 0; rr < NR; ++rr) {
        float bi[16], sgv[16];
#pragma unroll
        for (int e = 0; e < 16; ++e) { sgv[e] = sgl[rr * 16 + e]; bi[e] = sgv[e] + p.in[I_RTB][e]; }
        int tg = 0; float best = -3.0e38f;
#pragma unroll
        for (int g = 0; g < 4; ++g) {
          float m1 = -3.0e38f, m2 = -3.0e38f;
#pragma unroll
          for (int j = 0; j < 4; ++j) {
            const float x = bi[g * 4 + j];
            if (x > m1) { m2 = m1; m1 = x; } else if (x > m2) { m2 = x; }
          }
          const float gs = m1 + m2;
          if (gs > best) { best = gs; tg = g; }
        }
        int i0 = -1, i1 = -1; float b0 = -3.0e38f, b1 = -3.0e38f, s0 = 0.f, s1 = 0.f;
#pragma unroll
        for (int e = 0; e < 16; ++e) {
          if ((e >> 2) == tg) {
            const float x = bi[e];
            if (x > b0) { b1 = b0; i1 = i0; s1 = s0; b0 = x; i0 = e; s0 = sgv[e]; }
            else if (x > b1) { b1 = x; i1 = e; s1 = sgv[e]; }
          }
        }
        if (lane == 0) {
          const int row = row0 + rr;
          const float inv = 1.f / (s0 + s1);
          float* topw = (float*)(ws + O_TOPW);
          topw[row * 2 + 0] = s0 * inv;
          topw[row * 2 + 1] = s1 * inv;
          const int a = (wid * 8 + it2 * NR + rr) * 2;
          lexp[a] = i0; lrank[a] = atomicAdd(&lcnt[i0], 1);
          lexp[a + 1] = i1; lrank[a + 1] = atomicAdd(&lcnt[i1], 1);
        }
      }
    }
    __syncthreads();
    int* cnt = (int*)(ws + O_CNT) + layer * 16 * 64;
    if (tid < 16) lbase[tid] = atomicAdd(&cnt[tid * 64], lcnt[tid]);
    __syncthreads();
    if (tid < 64) {
      const int e = lexp[tid];
      const int slot = lbase[e] + lrank[tid];
      ((int*)(ws + O_LIST))[(size_t)e * NT + slot] = (chunk * 32 + (tid >> 1)) * 2 + (tid & 1);
    }
    __syncthreads();
  }
}

template <int NS>
DI void gemm_proj_phase(const Params& p, char* smem_all, const bfr* Wt, int ncols_pad, bfr* out) {
  const bfr* HB = (const bfr*)(p.ws + O_HB);
  constexpr int TN = NS * 64;
  const int n_nt = ncols_pad / TN;
  const int ntiles = (NT / 256) * n_nt;
  for (int tile = blockIdx.x; tile < ntiles; tile += gridDim.x) {
    const int mt = tile / n_nt, nt = tile % n_nt;
    Rows256 A{HB + (size_t)mt * 256 * 1024, 1024, 255};
    Rows256 B{Wt + (size_t)nt * TN * 1024, 1024, TN - 1};
    gemm_tile_256<NS>(smem_all, 32, A, B, [&](f32x4(&acc)[8][NS], int wr, int wc, int fr, int fq) {
#pragma unroll
      for (int m = 0; m < 8; ++m) {
        const int row = mt * 256 + wr * 128 + m * 16 + fr;
#pragma unroll
        for (int n = 0; n < NS; ++n) {
          const int col = nt * TN + wc * (NS * 16) + n * 16 + fq * 4;
          *(uint2*)(out + (size_t)row * ncols_pad + col) = make_uint2(pack2(acc[m][n][0], acc[m][n][1]), pack2(acc[m][n][2], acc[m][n][3]));
        }
      }
    });
  }
}

DI void gemm_out_phase(const Params& p, char* smem_all, const bfr* Wt, const float* xin, float* xout, const float* gate  ) {
  const bfr* MIX = (const bfr*)(p.ws + O_MIX);
  const int ntiles = (NT / 256) * 4;
  for (int tile = blockIdx.x; tile < ntiles; tile += gridDim.x) {
    const int mt = tile / 4, nt = tile % 4;
    Rows256 A{MIX + (size_t)mt * 256 * 1024, 1024, 255};
    Rows256 B{Wt + (size_t)nt * 256 * 1024, 1024, 255};
    const int b = (mt * 256) >> 11;
    gemm_tile_256<4>(smem_all, 32, A, B, [&](f32x4(&acc)[8][4], int wr, int wc, int fr, int fq) {
#pragma unroll
      for (int n = 0; n < 4; ++n) {
        const int col = nt * 256 + wc * 64 + n * 16 + fq * 4;
        const float4 g = *(const float4*)(gate + b * 6144 + col);
#pragma unroll
        for (int m = 0; m < 8; ++m) {
          const int row = mt * 256 + wr * 128 + m * 16 + fr;
          const float4 xi = *(const float4*)(xin + (size_t)row * 1024 + col);
          float4 o;
          o.x = xi.x + g.x * acc[m][n][0]; o.y = xi.y + g.y * acc[m][n][1]; o.z = xi.z + g.z * acc[m][n][2]; o.w = xi.w + g.w * acc[m][n][3];
          *(float4*)(xout + (size_t)row * 1024 + col) = o;
        }
      }
    });
  }
}

struct RowsCmp {
  const bfr* proj; int colbase; int mt;
  const bfr* rp[2];
  DI void init(int lr) {
#pragma unroll
    for (int i = 0; i < 2; ++i) {
      int rr = mt * 128 + lr + 64 * i; if (rr > 2031) rr = 2031;
      const int h = rr & 1, bn = rr >> 1, b = bn / 127, nc = bn % 127;
      rp[i] = proj + (size_t)(b * SEQ + nc * 16) * PW0 + colbase + h * 64;
    }
  }
  DI uint4 load(int sel, int k) const { return *(const uint4*)(rp[sel] + (k >> 6) * PW0 + (k & 63)); }
  DI const bfr* ptr(int sel, int k) const { return rp[sel] + (k >> 6) * PW0 + (k & 63); }
};

DI float gelu_tanh(float x) {
  const float u = 0.7978845608028654f * (x + 0.044715f * x * x * x);
  return 0.5f * x * (1.f + tanhf(u));
}

DI void post0_phase(const Params& p, char* smem) {
  char* ws = p.ws;
  const bfr* PROJ = (const bfr*)(ws + O_PROJ);
  const int tid = tid_opaque();
  for (int tile = VB; tile < 64; tile += NVB) {
    const int j = tile >> 5, mt = (tile >> 1) & 15, nt = tile & 1;
    RowsCmp A{PROJ, j ? C_VC : C_KC, mt};
    RowsContig B{(const bfr*)(ws + O_WC1) + ((size_t)j * 256 + nt * 128) * 2048, 2048, 127};
    bfr* CH = (bfr*)(ws + O_CH) + (size_t)j * 2048 * 256;
    const float* bias = (const float*)(ws + O_BIAS1) + j * 256;
    gemm_tile_g(smem, 64, A, B, [&](f32x4(&acc)[4][4], int wr, int wc, int fr, int fq) {
#pragma unroll
      for (int m = 0; m < 4; ++m) {
        const int row = mt * 128 + wr * 64 + m * 16 + fr;
#pragma unroll
        for (int n = 0; n < 4; ++n) {
          const int col = nt * 128 + wc * 64 + n * 16 + fq * 4;
          const float4 bb = *(const float4*)(bias + col);
          *(uint2*)(CH + (size_t)row * 256 + col) = make_uint2(pack2(gelu_tanh(acc[m][n][0] + bb.x), gelu_tanh(acc[m][n][1] + bb.y)),
                                                               pack2(gelu_tanh(acc[m][n][2] + bb.z), gelu_tanh(acc[m][n][3] + bb.w)));
        }
      }
    });
  }
  {
    bfr(*tt)[66] = (bfr(*)[66])smem;
    for (int item = VB; item < 1024; item += NVB) {
      const int tl = item & 31, hk = (item >> 5) & 1, which = (item >> 6) & 1, b = item >> 7;
      const bfr* src = PROJ + (size_t)(b * SEQ + tl * 64) * PW0 + (which ? C_VW : C_VS) + hk * 64;
      bfr* dst = (bfr*)(ws + (which ? O_VWT : O_VST)) + (size_t)((b * 2 + hk) * 64) * SEQ + tl * 64;
      for (int e = tid; e < 64 * 32; e += 256) {
        const int row = e >> 5, c2 = (e & 31) * 2;
        const unsigned u = *(const unsigned*)(src + (size_t)row * PW0 + c2);
        tt[row][c2] = (bfr)(u & 0xffffu); tt[row][c2 + 1] = (bfr)(u >> 16);
      }
      __syncthreads();
      for (int e = tid; e < 64 * 32; e += 256) {
        const int d = e >> 5, t2 = (e & 31) * 2;
        const unsigned u = (unsigned)tt[t2][d] | ((unsigned)tt[t2 + 1][d] << 16);
        *(unsigned*)(dst + (size_t)d * SEQ + t2) = u;
      }
      __syncthreads();
    }
  }
  const float* ropec = (const float*)(ws + O_ROPE);
  const float* ropes = ropec + 65536;
  bfr* QR = (bfr*)(ws + O_QR);
  bfr* KSR = (bfr*)(ws + O_KSR);
  bfr* KWR = (bfr*)(ws + O_KWR);
  bfr* MIX = (bfr*)(ws + O_MIX);
  const float* cw = p.in[I_CONVW];
  for (int item = VB; item < NT / 8; item += NVB) {
    for (int e = tid; e < 8 * 48; e += 256) {
      const int tt = e / 48, u = e % 48;
      const int tok = item * 8 + tt, t = tok & (SEQ - 1);
      const int hh = u >> 2, i0 = (u & 3) * 8;
      const bfr* src; bfr* dst;
      if (hh < 8) { src = PROJ + (size_t)tok * PW0 + C_Q + hh * 64; dst = QR + (size_t)tok * 512 + hh * 64; }
      else if (hh < 10) { src = PROJ + (size_t)tok * PW0 + C_KS + (hh - 8) * 64; dst = KSR + (size_t)tok * 128 + (hh - 8) * 64; }
      else { src = PROJ + (size_t)tok * PW0 + C_KW + (hh - 10) * 64; dst = KWR + (size_t)tok * 128 + (hh - 10) * 64; }
      const uint4 x1 = *(const uint4*)(src + i0), x2 = *(const uint4*)(src + 32 + i0);
      const float4 c0 = *(const float4*)(ropec + t * 32 + i0), c1 = *(const float4*)(ropec + t * 32 + i0 + 4);
      const float4 s0 = *(const float4*)(ropes + t * 32 + i0), s1 = *(const float4*)(ropes + t * 32 + i0 + 4);
      const float a[8] = {lo2f(x1.x), hi2f(x1.x), lo2f(x1.y), hi2f(x1.y), lo2f(x1.z), hi2f(x1.z), lo2f(x1.w), hi2f(x1.w)};
      const float bq[8] = {lo2f(x2.x), hi2f(x2.x), lo2f(x2.y), hi2f(x2.y), lo2f(x2.z), hi2f(x2.z), lo2f(x2.w), hi2f(x2.w)};
      const float cc[8] = {c0.x, c0.y, c0.z, c0.w, c1.x, c1.y, c1.z, c1.w};
      const float ss[8] = {s0.x, s0.y, s0.z, s0.w, s1.x, s1.y, s1.z, s1.w};
      float o1[8], o2[8];
#pragma unroll
      for (int i = 0; i < 8; ++i) { o1[i] = a[i] * cc[i] - bq[i] * ss[i]; o2[i] = bq[i] * cc[i] + a[i] * ss[i]; }
      *(uint4*)(dst + i0) = make_uint4(pack2(o1[0], o1[1]), pack2(o1[2], o1[3]), pack2(o1[4], o1[5]), pack2(o1[6], o1[7]));
      *(uint4*)(dst + 32 + i0) = make_uint4(pack2(o2[0], o2[1]), pack2(o2[2], o2[3]), pack2(o2[4], o2[5]), pack2(o2[6], o2[7]));
    }
    for (int e = tid; e < 8 * 64; e += 256) {
      const int tt = e >> 6, ch = (e & 63) * 8;
      const int tok = item * 8 + tt, t = tok & (SEQ - 1);
      const bfr* pr = PROJ + (size_t)tok * PW0;
      float u0[8], u1[8], u2[8], bgv[8];
      {
        const uint4 cg = *(const uint4*)(pr + C_CG + ch), xb = *(const uint4*)(pr + C_XB + ch), bg = *(const uint4*)(pr + C_BG + ch);
        u0[0] = lo2f(cg.x) * lo2f(xb.x); u0[1] = hi2f(cg.x) * hi2f(xb.x); u0[2] = lo2f(cg.y) * lo2f(xb.y); u0[3] = hi2f(cg.y) * hi2f(xb.y);
        u0[4] = lo2f(cg.z) * lo2f(xb.z); u0[5] = hi2f(cg.z) * hi2f(xb.z); u0[6] = lo2f(cg.w) * lo2f(xb.w); u0[7] = hi2f(cg.w) * hi2f(xb.w);
        bgv[0] = lo2f(bg.x); bgv[1] = hi2f(bg.x); bgv[2] = lo2f(bg.y); bgv[3] = hi2f(bg.y);
        bgv[4] = lo2f(bg.z); bgv[5] = hi2f(bg.z); bgv[6] = lo2f(bg.w); bgv[7] = hi2f(bg.w);
      }
#pragma unroll
      for (int i = 0; i < 8; ++i) { u1[i] = 0.f; u2[i] = 0.f; }
      if (t >= 1) {
        const uint4 cg = *(const uint4*)(pr - PW0 + C_CG + ch), xb = *(const uint4*)(pr - PW0 + C_XB + ch);
        u1[0] = lo2f(cg.x) * lo2f(xb.x); u1[1] = hi2f(cg.x) * hi2f(xb.x); u1[2] = lo2f(cg.y) * lo2f(xb.y); u1[3] = hi2f(cg.y) * hi2f(xb.y);
        u1[4] = lo2f(cg.z) * lo2f(xb.z); u1[5] = hi2f(cg.z) * hi2f(xb.z); u1[6] = lo2f(cg.w) * lo2f(xb.w); u1[7] = hi2f(cg.w) * hi2f(xb.w);
      }
      if (t >= 2) {
        const uint4 cg = *(const uint4*)(pr - 2 * PW0 + C_CG + ch), xb = *(const uint4*)(pr - 2 * PW0 + C_XB + ch);
        u2[0] = lo2f(cg.x) * lo2f(xb.x); u2[1] = hi2f(cg.x) * hi2f(xb.x); u2[2] = lo2f(cg.y) * lo2f(xb.y); u2[3] = hi2f(cg.y) * hi2f(xb.y);
        u2[4] = lo2f(cg.z) * lo2f(xb.z); u2[5] = hi2f(cg.z) * hi2f(xb.z); u2[6] = lo2f(cg.w) * lo2f(xb.w); u2[7] = hi2f(cg.w) * hi2f(xb.w);
      }
      float y[8];
#pragma unroll
      for (int i = 0; i < 8; ++i) y[i] = bgv[i] * (cw[2 * 512 + ch + i] * u0[i] + cw[1 * 512 + ch + i] * u1[i] + cw[0 * 512 + ch + i] * u2[i]);
      *(uint4*)(MIX + (size_t)tok * 1024 + 512 + ch) = make_uint4(pack2(y[0], y[1]), pack2(y[2], y[3]), pack2(y[4], y[5]), pack2(y[6], y[7]));
    }
  }
}

DI void cmp2_phase(const Params& p, char* smem) {
  char* ws = p.ws;
  for (int tile = VB; tile < 32; tile += NVB) {
    const int j = tile >> 4, mt = tile & 15;
    RowsContig A{(const bfr*)(ws + O_CH) + ((size_t)j * 2048 + mt * 128) * 256, 256, 127};
    RowsContig B{(const bfr*)(ws + O_WC2) + (size_t)j * 128 * 256, 256, 127};
    bfr* KC = (bfr*)(ws + O_KCVC) + (size_t)j * 2048 * 64;
    gemm_tile(smem, 8, A, B, [&](f32x4(&acc)[4][4], int wr, int wc, int fr, int fq) {
      if (wc == 0) {
#pragma unroll
        for (int m = 0; m < 4; ++m)
#pragma unroll
          for (int n = 0; n < 4; ++n)
#pragma unroll
            for (int jj = 0; jj < 4; ++jj) {
              const int row = mt * 128 + wr * 64 + m * 16 + fq * 4 + jj, col = n * 16 + fr;
              const bfr hv = f2bf(acc[m][n][jj]);
              KC[(size_t)row * 64 + col] = hv;
              if (j == 1 && row < 2032) {
                const int hk = row & 1, bn = row >> 1, bb = bn / 127, cc = bn % 127;
                ((bfr*)(ws + O_VCT))[((size_t)((bb * 2 + hk) * 64 + col)) * 128 + cc] = hv;
              }
            }
      }
    });
  }
}

DI void cmp_attn_phase(const Params& p, char* smem) {
  char* ws = p.ws;
  const bfr* PROJ = (const bfr*)(ws + O_PROJ);
  const bfr* KC = (const bfr*)(ws + O_KCVC);
  const bfr* VC = KC + 2048 * 64;
  bfr* OCMP = (bfr*)(ws + O_OCMP);
  unsigned* SEL = (unsigned*)(ws + O_SEL);
  const int tid = tid_opaque();
  for (int item = VB; item < NT / 32; item += NVB) {
    const int tok = item * 32 + (tid >> 3), head = tid & 7, hkv = head >> 2;
    const int b = tok >> 11, t = tok & (SEQ - 1);
    const int nv = t >= 31 ? ((t - 31) >> 4) + 1 : 0;
    unsigned q[32];
    {
      const uint4* qp = (const uint4*)(PROJ + (size_t)tok * PW0 + C_Q + head * 64);
#pragma unroll
      for (int i = 0; i < 8; ++i) { const uint4 u = qp[i]; q[i * 4] = u.x; q[i * 4 + 1] = u.y; q[i * 4 + 2] = u.z; q[i * 4 + 3] = u.w; }
    }
    const bfr* kb = KC + ((size_t)(b * 127) * 2 + hkv) * 64;
    const bfr* vb = VC + ((size_t)(b * 127) * 2 + hkv) * 64;
    auto dotk = [&](int c) {
      const uint4* kp = (const uint4*)(kb + (size_t)c * 128);
      float a = 0.f;
#pragma unroll
      for (int i = 0; i < 8; ++i) {
        const uint4 u = kp[i];
        a = dot2(q[i * 4], u.x, a); a = dot2(q[i * 4 + 1], u.y, a); a = dot2(q[i * 4 + 2], u.z, a); a = dot2(q[i * 4 + 3], u.w, a);
      }
      return a * 0.125f;
    };
    float mx = -1e30f;
    for (int c = 0; c < nv; ++c) mx = fmaxf(mx, dotk(c));
    float o[64];
#pragma unroll
    for (int i = 0; i < 64; ++i) o[i] = 0.f;
    float l = 0.f;
    for (int c = 0; c < nv; ++c) {
      const float pe = __expf(dotk(c) - mx);
      l += pe;
      const uint4* vp = (const uint4*)(vb + (size_t)c * 128);
#pragma unroll
      for (int i = 0; i < 8; ++i) {
        const uint4 u = vp[i];
        o[i * 8 + 0] += pe * lo2f(u.x); o[i * 8 + 1] += pe * hi2f(u.x);
        o[i * 8 + 2] += pe * lo2f(u.y); o[i * 8 + 3] += pe * hi2f(u.y);
        o[i * 8 + 4] += pe * lo2f(u.z); o[i * 8 + 5] += pe * hi2f(u.z);
        o[i * 8 + 6] += pe * lo2f(u.w); o[i * 8 + 7] += pe * hi2f(u.w);
      }
    }
    const float invl = nv > 0 ? 1.f / l : 0.f;
    {
      const float gl = bf2f(PROJ[(size_t)tok * PW0 + C_GL + head * 3 + 0]);
      const float g0 = sigmoidf_(gl) * invl;
      uint4* op = (uint4*)(OCMP + (size_t)tok * 512 + head * 64);
#pragma unroll
      for (int i = 0; i < 8; ++i) {
        uint4 u;
        u.x = pack2(o[i * 8 + 0] * g0, o[i * 8 + 1] * g0); u.y = pack2(o[i * 8 + 2] * g0, o[i * 8 + 3] * g0);
        u.z = pack2(o[i * 8 + 4] * g0, o[i * 8 + 5] * g0); u.w = pack2(o[i * 8 + 6] * g0, o[i * 8 + 7] * g0);
        op[i] = u;
      }
    }
    const int cur = t >> 6;
    float tv0 = -1.f, tv1 = -1.f, tv2 = -1.f, tv3 = -1.f, tv4 = -1.f;
    int ti0 = -1, ti1 = -1, ti2 = -1, ti3 = -1, ti4 = -1;
    float part = 0.f;
    int curmax = cur;
#pragma unroll
    for (int o2 = 32; o2 > 0; o2 >>= 1) curmax = max(curmax, __shfl_xor(curmax, o2));
#pragma unroll 1
    for (int j = 0; j <= curmax + 1 && j <= 32; ++j) {
      float e[4];
#pragma unroll
      for (int oo = 0; oo < 4; ++oo) {
        const int c = j * 4 + oo;
        float pe = 0.f;
        if (c < nv) pe = __expf(dotk(c) - mx) * invl;
        pe += __shfl_xor(pe, 1);
        pe += __shfl_xor(pe, 2);
        e[oo] = pe;
      }
      if (j >= 1) {
        const float val = part + e[0];
        const int jb = j - 1;
        if (jb >= 1 && jb <= cur - 2) {
          if (val > tv4) {
            tv4 = val; ti4 = jb;
            if (tv4 > tv3) { float tf = tv3; tv3 = tv4; tv4 = tf; int tii = ti3; ti3 = ti4; ti4 = tii; }
            if (tv3 > tv2) { float tf = tv2; tv2 = tv3; tv3 = tf; int tii = ti2; ti2 = ti3; ti3 = tii; }
            if (tv2 > tv1) { float tf = tv1; tv1 = tv2; tv2 = tf; int tii = ti1; ti1 = ti2; ti2 = tii; }
            if (tv1 > tv0) { float tf = tv0; tv0 = tv1; tv1 = tf; int tii = ti0; ti0 = ti1; ti1 = tii; }
          }
        }
      }
      part = e[0] + 2.f * (e[1] + e[2] + e[3]);
    }
    unsigned mask = 1u | (1u << cur);
    if (cur >= 1) mask |= 1u << (cur - 1);
    if (ti0 >= 0) mask |= 1u << ti0;
    if (ti1 >= 0) mask |= 1u << ti1;
    if (ti2 >= 0) mask |= 1u << ti2;
    if (ti3 >= 0) mask |= 1u << ti3;
    if (ti4 >= 0) mask |= 1u << ti4;
    if ((head & 3) == 0) SEL[tok * 2 + hkv] = mask;
  }
}

DI void slcwin_phase(const Params& p, char* smem) {
  char* ws = p.ws;
  const bfr* PROJ = (const bfr*)(ws + O_PROJ);
  const bfr* QR = (const bfr*)(ws + O_QR);
  const bfr* KSR = (const bfr*)(ws + O_KSR);
  const bfr* KWR = (const bfr*)(ws + O_KWR);
  const bfr* OCMP = (const bfr*)(ws + O_OCMP);
  const unsigned* SEL = (const unsigned*)(ws + O_SEL);
  bfr* MIX = (bfr*)(ws + O_MIX);
  const int tid = tid_opaque(), lane = tid & 63, wid = tid >> 6;
  for (int item = VB; item < 512; item += NVB) {
    const int tile = 31 - (item >> 4), bh = item & 15, b = bh >> 1, hkv = bh & 1;
    const int t = tile * 64 + lane, tok = b * SEQ + t, head = hkv * 4 + wid;
    unsigned q[32];
    {
      const uint4* qp = (const uint4*)(QR + (size_t)tok * 512 + head * 64);
#pragma unroll
      for (int i = 0; i < 8; ++i) { const uint4 u = qp[i]; q[i * 4] = u.x; q[i * 4 + 1] = u.y; q[i * 4 + 2] = u.z; q[i * 4 + 3] = u.w; }
    }
    const unsigned sel = SEL[tok * 2 + hkv];
#pragma unroll 1
    for (int pass = 0; pass < 2; ++pass) {
      const bfr* Kb = (pass == 0 ? KSR : KWR) + (size_t)b * SEQ * 128 + hkv * 64;
      const bfr* Vb = PROJ + (size_t)b * SEQ * PW0 + (pass == 0 ? C_VS : C_VW) + hkv * 64;
      float o[64];
#pragma unroll
      for (int i = 0; i < 64; ++i) o[i] = 0.f;
      float m = -1e30f, l = 0.f;
      const int jlo = pass == 0 ? 0 : (tile >= 8 ? tile - 8 : 0);
#pragma unroll 1
      for (int j = jlo; j <= tile; ++j) {
        const bool lane_ok = pass == 0 ? ((sel >> j) & 1u) != 0 : true;
        if (pass == 0 && !__any(lane_ok)) continue;
#pragma unroll 1
        for (int kb = 0; kb < 64; kb += 4) {
          float s[4];
#pragma unroll
          for (int kk = 0; kk < 4; ++kk) {
            const int key = j * 64 + kb + kk;
            const uint4* kp = (const uint4*)(Kb + (size_t)key * 128);
            float a = 0.f;
#pragma unroll
            for (int i = 0; i < 8; ++i) {
              const uint4 u = kp[i];
              a = dot2(q[i * 4], u.x, a); a = dot2(q[i * 4 + 1], u.y, a); a = dot2(q[i * 4 + 2], u.z, a); a = dot2(q[i * 4 + 3], u.w, a);
            }
            bool ok = lane_ok && key <= t;
            if (pass == 1) ok = ok && (t - key < 512);
            s[kk] = ok ? a * 0.125f : -1e30f;
          }
          const float cm = fmaxf(fmaxf(s[0], s[1]), fmaxf(s[2], s[3]));
          const float mn = fmaxf(m, cm);
          const float corr = __expf(m - mn);
          m = mn;
          float pe[4];
#pragma unroll
          for (int kk = 0; kk < 4; ++kk) pe[kk] = s[kk] > -1e29f ? __expf(s[kk] - mn) : 0.f;
          l = l * corr + (pe[0] + pe[1] + pe[2] + pe[3]);
#pragma unroll
          for (int i = 0; i < 64; ++i) o[i] *= corr;
#pragma unroll
          for (int kk = 0; kk < 4; ++kk) {
            const int key = j * 64 + kb + kk;
            const uint4* vp = (const uint4*)(Vb + (size_t)key * PW0);
#pragma unroll
            for (int i = 0; i < 8; ++i) {
              const uint4 u = vp[i];
              o[i * 8 + 0] += pe[kk] * lo2f(u.x); o[i * 8 + 1] += pe[kk] * hi2f(u.x);
              o[i * 8 + 2] += pe[kk] * lo2f(u.y); o[i * 8 + 3] += pe[kk] * hi2f(u.y);
              o[i * 8 + 4] += pe[kk] * lo2f(u.z); o[i * 8 + 5] += pe[kk] * hi2f(u.z);
              o[i * 8 + 6] += pe[kk] * lo2f(u.w); o[i * 8 + 7] += pe[kk] * hi2f(u.w);
            }
          }
        }
      }
      const float gate = sigmoidf_(bf2f(PROJ[(size_t)tok * PW0 + C_GL + head * 3 + 1 + pass]));
      const float gsc = gate * (l > 0.f ? 1.f / l : 0.f);
      uint4* op = (uint4*)(MIX + (size_t)tok * 1024 + head * 64);
      const uint4* cp = pass == 0 ? (const uint4*)(OCMP + (size_t)tok * 512 + head * 64) : (const uint4*)op;
#pragma unroll
      for (int i = 0; i < 8; ++i) {
        const uint4 c = cp[i];
        uint4 u;
        u.x = pack2(o[i * 8 + 0] * gsc + lo2f(c.x), o[i * 8 + 1] * gsc + hi2f(c.x));
        u.y = pack2(o[i * 8 + 2] * gsc + lo2f(c.y), o[i * 8 + 3] * gsc + hi2f(c.y));
        u.z = pack2(o[i * 8 + 4] * gsc + lo2f(c.z), o[i * 8 + 5] * gsc + hi2f(c.z));
        u.w = pack2(o[i * 8 + 6] * gsc + lo2f(c.w), o[i * 8 + 7] * gsc + hi2f(c.w));
        op[i] = u;
      }
    }
  }
}

using f32x16 = __attribute__((ext_vector_type(16))) float;
#define MFMA32(a, b, c) __builtin_amdgcn_mfma_f32_32x32x16_bf16((a), (b), (c), 0, 0, 0)
struct AttnLds { bfr k[2][64][72]; bfr vt[2][64][68]; };
static_assert(sizeof(AttnLds) <= 49152, "attn lds");
DI int crow16(int i, int h2) { return (i & 3) + 8 * (i >> 2) + 4 * h2; }

DI void attn_sw_phase(const Params& p, char* smem) {
  char* ws = p.ws;
  AttnLds& L = *(AttnLds*)smem;
  const bfr* PROJ = (const bfr*)(ws + O_PROJ);
  const bfr* QR = (const bfr*)(ws + O_QR);
  const bfr* OCMP = (const bfr*)(ws + O_OCMP);
  const unsigned* SEL = (const unsigned*)(ws + O_SEL);
  bfr* MIX = (bfr*)(ws + O_MIX);
  const int tid = tid_opaque(), lane = tid & 63, wid = tid >> 6, r = lane & 31, h2 = lane >> 5;
  const float CS = 0.125f * 1.4426950408889634f;
  const int lrow = tid >> 3, lc8 = (tid & 7) * 8;
  for (int item = VB; item < 1024; item += NVB) {
    const int qt = item < 512 ? 63 - (item >> 4) : ((item - 512) >> 4);
    const int bh = item & 15, b = bh >> 1, hkv = bh & 1;
    const int cur = qt >> 1;
    const int tokl = qt * 32 + wid * 8 + (r >> 2), g = r & 3, head = hkv * 4 + g, tok = b * SEQ + tokl;
    bf16x8 qf[4];
#pragma unroll
    for (int s = 0; s < 4; ++s) qf[s] = *(const bf16x8*)(QR + (size_t)tok * 512 + head * 64 + 16 * s + 8 * h2);
    const unsigned sel = SEL[tok * 2 + hkv];
    const int nslc = cur + 1, wlo = cur > 8 ? cur - 8 : 0, T = nslc + (cur - wlo + 1);
    const bfr* KS = (const bfr*)(ws + O_KSR) + (size_t)b * SEQ * 128 + hkv * 64;
    const bfr* KW = (const bfr*)(ws + O_KWR) + (size_t)b * SEQ * 128 + hkv * 64;
    const bfr* VS = (const bfr*)(ws + O_VST) + (size_t)((b * 2 + hkv) * 64) * SEQ;
    const bfr* VW = (const bfr*)(ws + O_VWT) + (size_t)((b * 2 + hkv) * 64) * SEQ;
    uint4 rk0, rk1, rv0, rv1;
    auto gload = [&](int tt) {
      const int pass = tt >= nslc, j = pass ? wlo + tt - nslc : tt;
      const bfr* kb = (pass ? KW : KS) + (size_t)(j * 64) * 128 + lc8;
      const bfr* vb = (pass ? VW : VS) + j * 64 + lc8;
      rk0 = *(const uint4*)(kb + (size_t)lrow * 128); rk1 = *(const uint4*)(kb + (size_t)(lrow + 32) * 128);
      rv0 = *(const uint4*)(vb + (size_t)lrow * SEQ); rv1 = *(const uint4*)(vb + (size_t)(lrow + 32) * SEQ);
    };
    auto lstore = [&](int buf) {
      *(uint4*)&L.k[buf][lrow][lc8] = rk0; *(uint4*)&L.k[buf][lrow + 32][lc8] = rk1;
      *(uint2*)&L.vt[buf][lrow][lc8] = make_uint2(rv0.x, rv0.y); *(uint2*)&L.vt[buf][lrow][lc8 + 4] = make_uint2(rv0.z, rv0.w);
      *(uint2*)&L.vt[buf][lrow + 32][lc8] = make_uint2(rv1.x, rv1.y); *(uint2*)&L.vt[buf][lrow + 32][lc8 + 4] = make_uint2(rv1.z, rv1.w);
    };
    gload(0); lstore(0);
    __syncthreads();
    float m = -1e30f, l = 0.f;
    f32x16 o0, o1;
#pragma unroll
    for (int i = 0; i < 16; ++i) { o0[i] = 0.f; o1[i] = 0.f; }
#pragma unroll 1
    for (int tt = 0; tt < T; ++tt) {
      const int buf = tt & 1;
      if (tt + 1 < T) gload(tt + 1);
      const int pass = tt >= nslc, j = pass ? wlo + tt - nslc : tt;
      const bool rowok = pass ? true : ((sel >> j) & 1u) != 0u;
      if (__any(rowok)) {
        f32x16 s0, s1;
#pragma unroll
        for (int i = 0; i < 16; ++i) { s0[i] = 0.f; s1[i] = 0.f; }
#pragma unroll
        for (int s = 0; s < 4; ++s) {
          const bf16x8 k0 = *(const bf16x8*)&L.k[buf][r][16 * s + 8 * h2];
          const bf16x8 k1 = *(const bf16x8*)&L.k[buf][32 + r][16 * s + 8 * h2];
          s0 = MFMA32(k0, qf[s], s0);
          s1 = MFMA32(k1, qf[s], s1);
        }
        if (!rowok) {
#pragma unroll
          for (int i = 0; i < 16; ++i) { s0[i] = -1e30f; s1[i] = -1e30f; }
        }
        if (j == cur) {
          const int lim = tokl - j * 64;
#pragma unroll
          for (int i = 0; i < 16; ++i) {
            if (crow16(i, h2) > lim) s0[i] = -1e30f;
            if (32 + crow16(i, h2) > lim) s1[i] = -1e30f;
          }
        }
        if (pass && cur >= 8 && j == cur - 8) {
          const int lo = tokl - 512 - j * 64;
#pragma unroll
          for (int i = 0; i < 16; ++i) {
            if (crow16(i, h2) <= lo) s0[i] = -1e30f;
            if (32 + crow16(i, h2) <= lo) s1[i] = -1e30f;
          }
        }
        float mx = -1e30f;
#pragma unroll
        for (int i = 0; i < 16; ++i) mx = fmaxf(mx, fmaxf(s0[i], s1[i]));
        mx = fmaxf(mx, __shfl_xor(mx, 32));
        const float mnew = fmaxf(m, mx);
        const float mu = fmaxf(mnew, -1e20f);
        const float corr = __builtin_amdgcn_exp2f((m - mu) * CS);
        m = mnew;
        const float muc = mu * CS;
        float ps = 0.f;
#pragma unroll
        for (int i = 0; i < 16; ++i) {
          s0[i] = __builtin_amdgcn_exp2f(fmaf(s0[i], CS, -muc));
          s1[i] = __builtin_amdgcn_exp2f(fmaf(s1[i], CS, -muc));
          ps += s0[i] + s1[i];
        }
        l = l * corr + ps;
#pragma unroll
        for (int i = 0; i < 16; ++i) { o0[i] *= corr; o1[i] *= corr; }
#pragma unroll
        for (int kb = 0; kb < 2; ++kb) {
#pragma unroll
          for (int s = 0; s < 2; ++s) {
            uint4 pk;
            if (kb == 0) {
              pk.x = pack2(s0[8 * s + 0], s0[8 * s + 1]); pk.y = pack2(s0[8 * s + 2], s0[8 * s + 3]);
              pk.z = pack2(s0[8 * s + 4], s0[8 * s + 5]); pk.w = pack2(s0[8 * s + 6], s0[8 * s + 7]);
            } else {
              pk.x = pack2(s1[8 * s + 0], s1[8 * s + 1]); pk.y = pack2(s1[8 * s + 2], s1[8 * s + 3]);
              pk.z = pack2(s1[8 * s + 4], s1[8 * s + 5]); pk.w = pack2(s1[8 * s + 6], s1[8 * s + 7]);
            }
            const bf16x8 pf = __builtin_bit_cast(bf16x8, pk);
            const int kc = kb * 32 + 16 * s + 4 * h2;
            const uint2 a0 = *(const uint2*)&L.vt[buf][r][kc];
            const uint2 a1 = *(const uint2*)&L.vt[buf][r][kc + 8];
            const uint2 c0 = *(const uint2*)&L.vt[buf][32 + r][kc];
            const uint2 c1 = *(const uint2*)&L.vt[buf][32 + r][kc + 8];
            const bf16x8 v0 = __builtin_bit_cast(bf16x8, make_uint4(a0.x, a0.y, a1.x, a1.y));
            const bf16x8 v1 = __builtin_bit_cast(bf16x8, make_uint4(c0.x, c0.y, c1.x, c1.y));
            o0 = MFMA32(v0, pf, o0);
            o1 = MFMA32(v1, pf, o1);
          }
        }
      }
      if (tt == nslc - 1 || tt == T - 1) {
        const float lt = l + __shfl_xor(l, 32);
        const float gate = sigmoidf_(bf2f(PROJ[(size_t)tok * PW0 + C_GL + head * 3 + 1 + pass]));
        const float sc = lt > 0.f ? gate / lt : 0.f;
        bfr* mixp = MIX + (size_t)tok * 1024 + head * 64;
        const bfr* addp = pass ? (const bfr*)mixp : OCMP + (size_t)tok * 512 + head * 64;
#pragma unroll
        for (int q4 = 0; q4 < 4; ++q4) {
          const int d0 = 8 * q4 + 4 * h2;
          const uint2 c = *(const uint2*)(addp + d0);
          uint2 u;
          u.x = pack2(o0[q4 * 4 + 0] * sc + lo2f(c.x), o0[q4 * 4 + 1] * sc + hi2f(c.x));
          u.y = pack2(o0[q4 * 4 + 2] * sc + lo2f(c.y), o0[q4 * 4 + 3] * sc + hi2f(c.y));
          *(uint2*)(mixp + d0) = u;
          const uint2 c2 = *(const uint2*)(addp + 32 + d0);
          u.x = pack2(o1[q4 * 4 + 0] * sc + lo2f(c2.x), o1[q4 * 4 + 1] * sc + hi2f(c2.x));
          u.y = pack2(o1[q4 * 4 + 2] * sc + lo2f(c2.y), o1[q4 * 4 + 3] * sc + hi2f(c2.y));
          *(uint2*)(mixp + 32 + d0) = u;
        }
#pragma unroll
        for (int i = 0; i < 16; ++i) { o0[i] = 0.f; o1[i] = 0.f; }
        m = -1e30f; l = 0.f;
      }
      if (tt + 1 < T) lstore(buf ^ 1);
      __syncthreads();
    }
  }
}

struct CmpLds { bfr k[128][72]; bfr vt[64][132]; };
static_assert(sizeof(CmpLds) <= 49152, "cmp lds");
DI float quad_sum(float x) {
  const float y = x + __int_as_float(__builtin_amdgcn_update_dpp(0, __float_as_int(x), 0xB1, 0xF, 0xF, true));
  return y + __int_as_float(__builtin_amdgcn_update_dpp(0, __float_as_int(y), 0x4E, 0xF, 0xF, true));
}

DI void cmp_attn_mfma_phase(const Params& p, char* smem) {
  char* ws = p.ws;
  CmpLds& L = *(CmpLds*)smem;
  const bfr* PROJ = (const bfr*)(ws + O_PROJ);
  const bfr* KC = (const bfr*)(ws + O_KCVC);
  const bfr* VCT = (const bfr*)(ws + O_VCT);
  bfr* OCMP = (bfr*)(ws + O_OCMP);
  unsigned* SEL = (unsigned*)(ws + O_SEL);
  const int tid = tid_opaque(), lane = tid & 63, wid = tid >> 6, r = lane & 31, h2 = lane >> 5;
  const float CS = 0.125f * 1.4426950408889634f;
  for (int item = VB; item < 1024; item += NVB) {
    const int qt = 63 - (item >> 4), bh = item & 15, b = bh >> 1, hkv = bh & 1;
    __syncthreads();
    {
      const bfr* kb = KC + ((size_t)(b * 127) * 2 + hkv) * 64;
      const bfr* vb = VCT + (size_t)((b * 2 + hkv) * 64) * 128;
#pragma unroll
      for (int i = 0; i < 4; ++i) {
        const int id = tid + i * 256;
        const int kr = id >> 3, kc = (id & 7) * 8;
        *(uint4*)&L.k[kr][kc] = *(const uint4*)(kb + (size_t)kr * 128 + kc);
        const int vr = id >> 4, vc = (id & 15) * 8;
        const uint4 v = *(const uint4*)(vb + (size_t)vr * 128 + vc);
        *(uint2*)&L.vt[vr][vc] = make_uint2(v.x, v.y);
        *(uint2*)&L.vt[vr][vc + 4] = make_uint2(v.z, v.w);
      }
    }
    __syncthreads();
    const int tokl = qt * 32 + wid * 8 + (r >> 2), g = r & 3, head = hkv * 4 + g, tok = b * SEQ + tokl;
    const int nv = tokl >= 31 ? ((tokl - 31) >> 4) + 1 : 0;
    bf16x8 qf[4];
#pragma unroll
    for (int s = 0; s < 4; ++s) qf[s] = *(const bf16x8*)(PROJ + (size_t)tok * PW0 + C_Q + head * 64 + 16 * s + 8 * h2);
    float m = -1e30f, l = 0.f;
#pragma unroll 1
    for (int kb4 = 0; kb4 < 4; ++kb4) {
      f32x16 sc;
#pragma unroll
      for (int i = 0; i < 16; ++i) sc[i] = 0.f;
#pragma unroll
      for (int s = 0; s < 4; ++s) {
        const bf16x8 kf = *(const bf16x8*)&L.k[kb4 * 32 + r][16 * s + 8 * h2];
        sc = MFMA32(kf, qf[s], sc);
      }
      float mx = -1e30f;
#pragma unroll
      for (int i = 0; i < 16; ++i) {
        if (kb4 * 32 + crow16(i, h2) >= nv) sc[i] = -1e30f;
        mx = fmaxf(mx, sc[i]);
      }
      const float mn = fmaxf(m, mx), mu = fmaxf(mn, -1e20f);
      float ps = 0.f;
#pragma unroll
      for (int i = 0; i < 16; ++i) ps += __builtin_amdgcn_exp2f((sc[i] - mu) * CS);
      l = l * __builtin_amdgcn_exp2f((m - mu) * CS) + ps;
      m = mn;
    }
    {
      const float mo = __shfl_xor(m, 32), lo = __shfl_xor(l, 32);
      const float mt = fmaxf(m, mo), mu = fmaxf(mt, -1e20f);
      l = l * __builtin_amdgcn_exp2f((m - mu) * CS) + lo * __builtin_amdgcn_exp2f((mo - mu) * CS);
      m = mu;
    }
    const float invl = l > 0.f ? 1.f / l : 0.f;
    const float muc = m * CS;
    f32x16 o0, o1;
#pragma unroll
    for (int i = 0; i < 16; ++i) { o0[i] = 0.f; o1[i] = 0.f; }
    float part[16], first[16];
#pragma unroll
    for (int kb4 = 0; kb4 < 4; ++kb4) {
      f32x16 sc;
#pragma unroll
      for (int i = 0; i < 16; ++i) sc[i] = 0.f;
#pragma unroll
      for (int s = 0; s < 4; ++s) {
        const bf16x8 kf = *(const bf16x8*)&L.k[kb4 * 32 + r][16 * s + 8 * h2];
        sc = MFMA32(kf, qf[s], sc);
      }
#pragma unroll
      for (int i = 0; i < 16; ++i) {
        const float pv = __builtin_amdgcn_exp2f(fmaf(sc[i], CS, -muc)) * invl;
        sc[i] = (kb4 * 32 + crow16(i, h2) >= nv) ? 0.f : pv;
      }
#pragma unroll
      for (int s = 0; s < 2; ++s) {
        uint4 pk;
        pk.x = pack2(sc[8 * s + 0], sc[8 * s + 1]); pk.y = pack2(sc[8 * s + 2], sc[8 * s + 3]);
        pk.z = pack2(sc[8 * s + 4], sc[8 * s + 5]); pk.w = pack2(sc[8 * s + 6], sc[8 * s + 7]);
        const bf16x8 pf = __builtin_bit_cast(bf16x8, pk);
        const int kc = kb4 * 32 + 16 * s + 4 * h2;
        const uint2 a0 = *(const uint2*)&L.vt[r][kc];
        const uint2 a1 = *(const uint2*)&L.vt[r][kc + 8];
        const uint2 c0 = *(const uint2*)&L.vt[32 + r][kc];
        const uint2 c1 = *(const uint2*)&L.vt[32 + r][kc + 8];
        o0 = MFMA32(__builtin_bit_cast(bf16x8, make_uint4(a0.x, a0.y, a1.x, a1.y)), pf, o0);
        o1 = MFMA32(__builtin_bit_cast(bf16x8, make_uint4(c0.x, c0.y, c1.x, c1.y)), pf, o1);
      }
#pragma unroll
      for (int q4 = 0; q4 < 4; ++q4) {
        const float e0 = quad_sum(sc[q4 * 4 + 0]), e1 = quad_sum(sc[q4 * 4 + 1]);
        const float e2 = quad_sum(sc[q4 * 4 + 2]), e3 = quad_sum(sc[q4 * 4 + 3]);
        part[kb4 * 4 + q4] = e0 + 2.f * (e1 + e2 + e3);
        first[kb4 * 4 + q4] = e0;
      }
      __builtin_amdgcn_sched_barrier(0);
    }
    {
      const float g0 = sigmoidf_(bf2f(PROJ[(size_t)tok * PW0 + C_GL + head * 3 + 0]));
      bfr* op = OCMP + (size_t)tok * 512 + head * 64;
#pragma unroll
      for (int q4 = 0; q4 < 4; ++q4) {
        const int d0 = 8 * q4 + 4 * h2;
        uint2 u;
        u.x = pack2(o0[q4 * 4 + 0] * g0, o0[q4 * 4 + 1] * g0); u.y = pack2(o0[q4 * 4 + 2] * g0, o0[q4 * 4 + 3] * g0);
        *(uint2*)(op + d0) = u;
        u.x = pack2(o1[q4 * 4 + 0] * g0, o1[q4 * 4 + 1] * g0); u.y = pack2(o1[q4 * 4 + 2] * g0, o1[q4 * 4 + 3] * g0);
        *(uint2*)(op + 32 + d0) = u;
      }
    }
    float val[16], oth[16];
    const float h2f = (float)h2;
    {
      float recv[17];
#pragma unroll
      for (int gi = 0; gi < 16; ++gi) recv[gi] = __shfl_xor(first[gi], 32);
      recv[16] = 0.f;
#pragma unroll
      for (int gi = 0; gi < 16; ++gi) val[gi] = part[gi] + (recv[gi] * (1.f - h2f) + recv[gi + 1] * h2f);
#pragma unroll
      for (int gi = 0; gi < 16; ++gi) oth[gi] = __shfl_xor(val[gi], 32);
    }
    const int cur = tokl >> 6;
    float cv[32];
#pragma unroll
    for (int gi = 0; gi < 16; ++gi) {
      cv[2 * gi] = val[gi] * (1.f - h2f) + oth[gi] * h2f;
      cv[2 * gi + 1] = val[gi] * h2f + oth[gi] * (1.f - h2f);
    }
    unsigned mask = 1u | (1u << cur);
    if (cur >= 1) mask |= 1u << (cur - 1);
    unsigned chosen = 0u;
#pragma unroll 1
    for (int rnd = 0; rnd < 5; ++rnd) {
      float best = -1.f; int bi = -1;
#pragma unroll
      for (int j = 1; j < 31; ++j) {
        const bool el = (j <= cur - 2) && !((chosen >> j) & 1u) && (cv[j] > best);
        best = el ? cv[j] : best;
        bi = el ? j : bi;
      }
      if (bi >= 0) chosen |= 1u << bi;
    }
    mask |= chosen;
    if (g == 0 && h2 == 0) SEL[tok * 2 + hkv] = mask;
  }
}

struct RowsGather {
  const bfr* base; const int* list; int i0; int cnt; int ld;
  const bfr* rp[2];
  DI void init(int lr) {
#pragma unroll
    for (int i = 0; i < 2; ++i) {
      int ii = i0 + lr + 64 * i; if (ii > cnt - 1) ii = cnt - 1;
      rp[i] = base + (size_t)(list[ii] >> 1) * ld;
    }
  }
  DI uint4 load(int sel, int k) const { return *(const uint4*)(rp[sel] + k); }
  DI const bfr* ptr(int sel, int k) const { return rp[sel] + k; }
};

DI void moe1_phase(const Params& p, char* smem, int layer) {
  char* ws = p.ws;
  const int* cnt = (const int*)(ws + O_CNT) + layer * 16 * 64;
  const int* LIST = (const int*)(ws + O_LIST);
  const bfr* HB = (const bfr*)(ws + O_HB);
  bfr* HMID = (bfr*)(ws + O_HMID);
  int c[16], mtiles = 0;
#pragma unroll
  for (int e = 0; e < 16; ++e) { c[e] = cnt[e * 64]; mtiles += (c[e] + 127) >> 7; }
  const int ntiles = mtiles * 8;
  for (int tile = VB; tile < ntiles; tile += NVB) {
    int mg = tile >> 3; const int nt = tile & 7;
    int e = 0, off = 0, ce = 0;
#pragma unroll
    for (int k = 0; k < 16; ++k) {
      const int mk = (c[k] + 127) >> 7;
      if (k == e && mg >= mk) { mg -= mk; off += c[k]; e = k + 1; }
    }
#pragma unroll
    for (int k = 0; k < 16; ++k) if (k == e) ce = c[k];
    const int mt = mg;
    RowsGather A{HB, LIST + (size_t)e * NT, mt * 128, ce, 1024};
    RowsContig B{(const bfr*)(ws + O_WGU) + ((size_t)(layer * 16 + e) * 1024 + nt * 128) * 1024, 1024, 127};
    gemm_tile_g(smem, 32, A, B, [&](f32x4(&acc)[4][4], int wr, int wc, int fr, int fq) {
#pragma unroll
      for (int m = 0; m < 4; ++m) {
        const int i = mt * 128 + wr * 64 + m * 16 + fr;
        if (i < ce) {
#pragma unroll
          for (int n2 = 0; n2 < 2; ++n2) {
            const int col = nt * 64 + wc * 32 + n2 * 16 + fq * 4;
            float h[4];
#pragma unroll
            for (int j = 0; j < 4; ++j) { const float g = acc[m][n2 * 2][j], u = acc[m][n2 * 2 + 1][j]; h[j] = g / (1.f + __expf(-g)) * u; }
            *(uint2*)(HMID + (size_t)(off + i) * 512 + col) = make_uint2(pack2(h[0], h[1]), pack2(h[2], h[3]));
          }
        }
      }
    });
  }
}

DI void moe2_phase(const Params& p, char* smem, int layer) {
  char* ws = p.ws;
  const int* cnt = (const int*)(ws + O_CNT) + layer * 16 * 64;
  const int* LIST = (const int*)(ws + O_LIST);
  const float* TOPW = (const float*)(ws + O_TOPW);
  const bfr* HMID = (const bfr*)(ws + O_HMID);
  bfr* MO = (bfr*)(ws + O_MOEOUT);
  int c[16], mtiles = 0;
#pragma unroll
  for (int e = 0; e < 16; ++e) { c[e] = cnt[e * 64]; mtiles += (c[e] + 127) >> 7; }
  const int ntiles = mtiles * 8;
  for (int tile = VB; tile < ntiles; tile += NVB) {
    int mg = tile >> 3; const int nt = tile & 7;
    int e = 0, off = 0, ce = 0;
#pragma unroll
    for (int k = 0; k < 16; ++k) {
      const int mk = (c[k] + 127) >> 7;
      if (k == e && mg >= mk) { mg -= mk; off += c[k]; e = k + 1; }
    }
#pragma unroll
    for (int k = 0; k < 16; ++k) if (k == e) ce = c[k];
    const int mt = mg;
    const int rows_here = ce - mt * 128;
    RowsContig A{HMID + (size_t)(off + mt * 128) * 512, 512, (rows_here < 128 ? rows_here : 128) - 1};
    RowsContig B{(const bfr*)(ws + O_WDN) + ((size_t)(layer * 16 + e) * 1024 + nt * 128) * 512, 512, 127};
    const int* lst = LIST + (size_t)e * NT;
    gemm_tile_g(smem, 16, A, B, [&](f32x4(&acc)[4][4], int wr, int wc, int fr, int fq) {
#pragma unroll
      for (int m = 0; m < 4; ++m) {
        const int i = mt * 128 + wr * 64 + m * 16 + fr;
        if (i < ce) {
          const int en = lst[i];
          const float w = TOPW[en];
          bfr* dst = MO + ((size_t)(en & 1) * NT + (en >> 1)) * 1024 + nt * 128 + wc * 64 + fq * 4;
#pragma unroll
          for (int n = 0; n < 4; ++n)
            *(uint2*)(dst + n * 16) = make_uint2(pack2(acc[m][n][0] * w, acc[m][n][1] * w), pack2(acc[m][n][2] * w, acc[m][n][3] * w));
        }
      }
    });
  }
}

struct ALora {
  const bfr* proj; const float* mu; int tok0; int colbase; int mode;
  const bfr* rp[2]; bool hp[2];
  DI void init(int lr) {
#pragma unroll
    for (int i = 0; i < 2; ++i) { const int tok = tok0 + lr + 64 * i; rp[i] = proj + (size_t)tok * PW1 + colbase; hp[i] = (tok & (SEQ - 1)) != 0; }
  }
  DI uint4 load(int sel, int k) const {
    const uint4 c = *(const uint4*)(rp[sel] + k);
    uint4 pv = make_uint4(0, 0, 0, 0);
    if (hp[sel]) pv = *(const uint4*)(rp[sel] - PW1 + k);
    const float4 m0 = *(const float4*)(mu + colbase + k), m1 = *(const float4*)(mu + colbase + k + 4);
    float v[8];
    v[0] = lo2f(c.x) + (lo2f(pv.x) - lo2f(c.x)) * m0.x; v[1] = hi2f(c.x) + (hi2f(pv.x) - hi2f(c.x)) * m0.y;
    v[2] = lo2f(c.y) + (lo2f(pv.y) - lo2f(c.y)) * m0.z; v[3] = hi2f(c.y) + (hi2f(pv.y) - hi2f(c.y)) * m0.w;
    v[4] = lo2f(c.z) + (lo2f(pv.z) - lo2f(c.z)) * m1.x; v[5] = hi2f(c.z) + (hi2f(pv.z) - hi2f(c.z)) * m1.y;
    v[6] = lo2f(c.w) + (lo2f(pv.w) - lo2f(c.w)) * m1.z; v[7] = hi2f(c.w) + (hi2f(pv.w) - hi2f(c.w)) * m1.w;
#pragma unroll
    for (int i = 0; i < 8; ++i) v[i] = mode == 0 ? tanhf(v[i]) : (mode == 2 ? sigmoidf_(v[i]) : v[i]);
    return make_uint4(pack2(v[0], v[1]), pack2(v[2], v[3]), pack2(v[4], v[5]), pack2(v[6], v[7]));
  }
};
DI void rwkv_lora_pool_phase(const Params& p, char* smem) {
  char* ws = p.ws;
  const bfr* PROJ = (const bfr*)(ws + O_PROJ);
  float* W = (float*)(ws + O_RW_W);
  bfr* AS = (bfr*)(ws + O_RW_AS);
  bfr* G = (bfr*)(ws + O_RW_G);
  bfr* MIX = (bfr*)(ws + O_MIX);
  for (int item = VB; item < 1024; item += NVB) {
    const int mt = item >> 3, sub = item & 7, tok0 = mt * 128;
    if (sub < 4) {
      const int cp = sub;
      {
        ALora A{PROJ, p.in[I_MU], tok0, 1536, 0};
        RowsContig B{(const bfr*)(ws + O_W2T) + (size_t)cp * 128 * 64, 64, 127};
        const float* w0 = p.in[I_W0];
        gemm_tile(smem, 2, A, B, [&](f32x4(&acc)[4][4], int wr, int wc, int fr, int fq) {
#pragma unroll
          for (int n = 0; n < 4; ++n) {
            const int col = cp * 128 + wc * 64 + n * 16 + fr;
            const float w0v = w0[col];
#pragma unroll
            for (int m = 0; m < 4; ++m)
#pragma unroll
              for (int j = 0; j < 4; ++j) {
                const int tok = tok0 + wr * 64 + m * 16 + fq * 4 + j;
                const float z = -(w0v + acc[m][n][j]);
                const float sp = fmaxf(z, 0.f) + log1pf(__expf(-fabsf(z)));
                W[(size_t)tok * 512 + col] = __expf(-__expf(-sp - 0.5f));
              }
          }
        });
      }
      {
        ALora A{PROJ, p.in[I_MU], tok0, 1600, 1};
        RowsContig B{(const bfr*)(ws + O_A2T) + (size_t)cp * 128 * 64, 64, 127};
        const float* a0 = p.in[I_A0];
        gemm_tile(smem, 2, A, B, [&](f32x4(&acc)[4][4], int wr, int wc, int fr, int fq) {
#pragma unroll
          for (int n = 0; n < 4; ++n) {
            const int col = cp * 128 + wc * 64 + n * 16 + fr;
            const float a0v = a0[col];
#pragma unroll
            for (int m = 0; m < 4; ++m)
#pragma unroll
              for (int j = 0; j < 4; ++j) {
                const int tok = tok0 + wr * 64 + m * 16 + fq * 4 + j;
                AS[(size_t)tok * 512 + col] = f2bf(sigmoidf_(a0v + acc[m][n][j]));
              }
          }
        });
      }
      {
        ALora A{PROJ, p.in[I_MU], tok0, 1664, 2};
        RowsContig B{(const bfr*)(ws + O_G2T) + (size_t)cp * 128 * 128, 128, 127};
        gemm_tile(smem, 4, A, B, [&](f32x4(&acc)[4][4], int wr, int wc, int fr, int fq) {
#pragma unroll
          for (int n = 0; n < 4; ++n) {
            const int col = cp * 128 + wc * 64 + n * 16 + fr;
#pragma unroll
            for (int m = 0; m < 4; ++m)
#pragma unroll
              for (int j = 0; j < 4; ++j) {
                const int tok = tok0 + wr * 64 + m * 16 + fq * 4 + j;
                G[(size_t)tok * 512 + col] = f2bf(acc[m][n][j]);
              }
          }
        });
      }
    } else {
      bfr* POOLED = (bfr*)(ws + O_POOLED);
      const int tid = tid_opaque();
      for (int e = tid; e < 32 * 64; e += 256) {
        const int tok = tok0 + (sub - 4) * 32 + (e >> 6), ch = (e & 63) * 8, gi = ch >> 7;
        const int t = tok & (SEQ - 1), win = 2 << gi, n = (t + 1 < win) ? t + 1 : win;
        const bfr* rp = PROJ + (size_t)tok * PW1 + 1792 + ch;
        const uint4 c = *(const uint4*)rp;
        const float a[8] = {lo2f(c.x), hi2f(c.x), lo2f(c.y), hi2f(c.y), lo2f(c.z), hi2f(c.z), lo2f(c.w), hi2f(c.w)};
        float sm[8];
#pragma unroll
        for (int i = 0; i < 8; ++i) sm[i] = a[i];
#pragma unroll
        for (int d0 = 1; d0 < 16; d0 += 5) {
          uint4 u[5];
#pragma unroll
          for (int q = 0; q < 5; ++q) {
            const int d = d0 + q;
            u[q] = make_uint4(0, 0, 0, 0);
            if (d < n) u[q] = *(const uint4*)(rp - (size_t)d * PW1);
          }
#pragma unroll
          for (int q = 0; q < 5; ++q) {
            sm[0] += lo2f(u[q].x); sm[1] += hi2f(u[q].x); sm[2] += lo2f(u[q].y); sm[3] += hi2f(u[q].y);
            sm[4] += lo2f(u[q].z); sm[5] += hi2f(u[q].z); sm[6] += lo2f(u[q].w); sm[7] += hi2f(u[q].w);
          }
        }
        const float inv = 1.f / (float)n;
#pragma unroll
        for (int i = 0; i < 8; ++i) sm[i] = sm[i] * inv - a[i];
        *(uint4*)(POOLED + (size_t)tok * 512 + ch) = make_uint4(pack2(sm[0], sm[1]), pack2(sm[2], sm[3]), pack2(sm[4], sm[5]), pack2(sm[6], sm[7]));
      }
    }
  }
}

DI void pool_gemm_tiles(const Params& p, char* smem, int first, int stride) {
  char* ws = p.ws;
  bfr* MIX = (bfr*)(ws + O_MIX);
  for (int tile = first; tile < 512; tile += stride) {
    const int mt = tile >> 2, gi = tile & 3, tok0 = mt * 128;
    RowsContig A{(const bfr*)(ws + O_POOLED) + (size_t)tok0 * 512 + gi * 128, 512, 127};
    RowsContig B{(const bfr*)(ws + O_PWT) + (size_t)gi * 128 * 128, 128, 127};
    const float* ps = p.in[I_POOLS] + gi * 128;
    gemm_tile(smem, 4, A, B, [&](f32x4(&acc)[4][4], int wr, int wc, int fr, int fq) {
#pragma unroll
      for (int n = 0; n < 4; ++n) {
        const int col = wc * 64 + n * 16 + fr;
        const float sc = ps[col];
#pragma unroll
        for (int m = 0; m < 4; ++m)
#pragma unroll
          for (int j = 0; j < 4; ++j) {
            const int tok = tok0 + wr * 64 + m * 16 + fq * 4 + j;
            MIX[(size_t)tok * 1024 + 512 + gi * 128 + col] = f2bf(acc[m][n][j] * sc);
          }
      }
    });
  }
}

constexpr int CHUNK = 128, NCH = SEQ / CHUNK;
DI void scanA_phase(const Params& p, char* smem) {
  char* ws = p.ws;
  const int tid = tid_opaque(), lane = tid & 63, wid = tid >> 6;
  const int ul = wid >> 1, isP = wid & 1;
  float* st = (float*)smem + wid * (8 * 384);
  const bfr* PROJ = (const bfr*)(ws + O_PROJ);
  const float* W = (const float*)(ws + O_RW_W);
  const bfr* AS = (const bfr*)(ws + O_RW_AS);
  bfr* QT = (bfr*)(ws + O_RW_Q); bfr* YL = (bfr*)(ws + O_RW_Y);
  float* RK = (float*)(ws + O_RK);
  float* CHP = (float*)(ws + O_CHP); float* CHL = (float*)(ws + O_CHL);
  const float* mu = p.in[I_MU];
  for (int item = VB; item < 512; item += NVB) {
    const int unit = item * 2 + ul;
    const int chain = unit >> 4, chunk = unit & 15, b = chain >> 3, h = chain & 7;
    const int c = h * 64 + lane;
    const int tok_base = b * SEQ + chunk * CHUNK;
    const float mu_r = mu[c], mu_k = mu[512 + c], mu_v = mu[1024 + c];
    const float kkp = p.in[I_KK][c], kap = p.in[I_KA][c], rkp = p.in[I_RKP][c];
    float S[64];
    int diag = isP ? lane : -1;
    asm volatile("" : "+v"(diag));
#pragma unroll
    for (int j = 0; j < 64; ++j) S[j] = (j == diag) ? 1.f : 0.f;
    bfr qr[9], qk[9], qv[9], qa[8]; float qw[8];
    auto issue = [&](int sub) {
      const int tl = chunk * CHUNK + sub * 8, tok0 = tok_base + sub * 8;
      const bfr* pr = PROJ + (size_t)tok0 * PW1 + c;
      qr[0] = 0; qk[0] = 0; qv[0] = 0;
      if (tl > 0) { qr[0] = pr[-PW1]; qk[0] = pr[512 - PW1]; qv[0] = pr[1024 - PW1]; }
#pragma unroll
      for (int s8 = 0; s8 < 8; ++s8) {
        qr[s8 + 1] = pr[(size_t)s8 * PW1]; qk[s8 + 1] = pr[(size_t)s8 * PW1 + 512]; qv[s8 + 1] = pr[(size_t)s8 * PW1 + 1024];
        qa[s8] = AS[(size_t)(tok0 + s8) * 512 + c]; qw[s8] = W[(size_t)(tok0 + s8) * 512 + c];
      }
    };
    issue(0);
#pragma unroll 1
    for (int sub = 0; sub < CHUNK / 8; ++sub) {
#pragma unroll
      for (int s = 0; s < 8; ++s) {
        const int tok = tok_base + sub * 8 + s;
        const float rc = bf2f(qr[s + 1]), rpv = bf2f(qr[s]);
        const float kc = bf2f(qk[s + 1]), kpv = bf2f(qk[s]);
        const float vc = bf2f(qv[s + 1]), vpv = bf2f(qv[s]);
        const float r = rc + (rpv - rc) * mu_r, k = kc + (kpv - kc) * mu_k, v = vc + (vpv - vc) * mu_v;
        const float as = bf2f(qa[s]);
        const float km = k * (1.f + (as - 1.f) * kap);
        float kk = k * kkp;
        float nrm = kk * kk, rk = r * km * rkp;
#pragma unroll
        for (int o2 = 32; o2 > 0; o2 >>= 1) { nrm += __shfl_xor(nrm, o2); rk += __shfl_xor(rk, o2); }
        kk *= 1.f / fmaxf(sqrtf(nrm), 1e-12f);
        float* d = st + s * 384;
        d[lane] = r;
        d[64 + lane] = qw[s];
        d[128 + lane] = km;
        d[192 + lane] = v;
        d[256 + lane] = -kk;
        d[320 + lane] = kk * as;
        if (!isP && lane == 0) RK[tok * 8 + h] = rk;
      }
      if (sub + 1 < CHUNK / 8) issue(sub + 1);
      __builtin_amdgcn_fence(__ATOMIC_RELEASE, "wavefront");
      __builtin_amdgcn_wave_barrier();
#pragma unroll 1
      for (int s = 0; s < 8; ++s) {
        const float* d = st + s * 384;
        float sa0 = 0.f, sa1 = 0.f, sa2 = 0.f, sa3 = 0.f;
#pragma unroll
        for (int j4 = 0; j4 < 16; ++j4) {
          const float4 a4 = *(const float4*)(d + 256 + j4 * 4);
          sa0 = fmaf(S[j4 * 4], a4.x, sa0); sa1 = fmaf(S[j4 * 4 + 1], a4.y, sa1); sa2 = fmaf(S[j4 * 4 + 2], a4.z, sa2); sa3 = fmaf(S[j4 * 4 + 3], a4.w, sa3);
        }
        const float sa = (sa0 + sa1) + (sa2 + sa3);
        const float vi = isP ? 0.f : d[192 + lane];
        float y0 = 0.f, y1 = 0.f, y2 = 0.f, y3 = 0.f;
#pragma unroll
        for (int j4 = 0; j4 < 16; ++j4) {
          if ((j4 & 3) == 0) asm volatile("" ::: "memory");
          const float4 w4 = *(const float4*)(d + 64 + j4 * 4);
          const float4 b4 = *(const float4*)(d + 320 + j4 * 4);
          const float4 k4 = *(const float4*)(d + 128 + j4 * 4);
          const float4 r4 = *(const float4*)(d + j4 * 4);
          S[j4 * 4 + 0] = S[j4 * 4 + 0] * w4.x + (sa * b4.x + vi * k4.x);
          S[j4 * 4 + 1] = S[j4 * 4 + 1] * w4.y + (sa * b4.y + vi * k4.y);
          S[j4 * 4 + 2] = S[j4 * 4 + 2] * w4.z + (sa * b4.z + vi * k4.z);
          S[j4 * 4 + 3] = S[j4 * 4 + 3] * w4.w + (sa * b4.w + vi * k4.w);
          y0 = fmaf(S[j4 * 4], r4.x, y0); y1 = fmaf(S[j4 * 4 + 1], r4.y, y1); y2 = fmaf(S[j4 * 4 + 2], r4.z, y2); y3 = fmaf(S[j4 * 4 + 3], r4.w, y3);
        }
        const float y = (y0 + y1) + (y2 + y3);
        const size_t o = (size_t)(tok_base + sub * 8 + s) * 512 + c;
        if (isP) QT[o] = f2bf(y);
        else YL[o] = f2bf(y);
      }
      __builtin_amdgcn_fence(__ATOMIC_RELEASE, "wavefront");
      __builtin_amdgcn_wave_barrier();
    }
    float4* dp = (float4*)((isP ? CHP : CHL) + ((size_t)unit * 64 + lane) * 64);
#pragma unroll
    for (int j4 = 0; j4 < 16; ++j4) dp[j4] = make_float4(S[j4 * 4], S[j4 * 4 + 1], S[j4 * 4 + 2], S[j4 * 4 + 3]);
  }
}

DI void scanB_phase(const Params& p, char* smem) {
  char* ws = p.ws;
  const int tid = tid_opaque();
  float* Ss = (float*)smem;
  float* Ps = Ss + 64 * 65;
  const float* CHP = (const float*)(ws + O_CHP);
  float* CHL = (float*)(ws + O_CHL);
  const int i = tid >> 2, qd = tid & 3;
#if POOL_IN_SCANB
  if (NVB > 128) {
    if (VB >= 64) { pool_gemm_tiles(p, smem, VB - 64, NVB - 64); return; }
  } else {
    pool_gemm_tiles(p, smem, VB, NVB);
    __syncthreads();
  }
#endif
  if (NVB > 128 && VB >= 64) {
    constexpr int N1 = 16 * (2 * T_G + T_D);
    for (int it = VB - 64; it < N1; it += NVB - 64) conv_expert_item(p, smem, N1 + it);
    return;
  }
  for (int chain = VB; chain < 64; chain += NVB) {
    for (int e = tid; e < 64 * 65; e += 256) Ss[e] = 0.f;
    float4 pn0, pn1, pn2, pn3, ln0, ln1, ln2, ln3;
    {
      const float4* pp = (const float4*)(CHP + ((size_t)(chain * NCH)) * 4096) + tid;
      pn0 = pp[0]; pn1 = pp[256]; pn2 = pp[512]; pn3 = pp[768];
      const float4* lp = (const float4*)(CHL + ((size_t)(chain * NCH)) * 4096 + i * 64 + qd * 16);
      ln0 = lp[0]; ln1 = lp[1]; ln2 = lp[2]; ln3 = lp[3];
    }
    __syncthreads();
    for (int c = 0; c < NCH - 1; ++c) {
      const size_t ub = ((size_t)(chain * NCH + c)) * 4096;
      ((float4*)Ps)[tid] = pn0; ((float4*)Ps)[tid + 256] = pn1; ((float4*)Ps)[tid + 512] = pn2; ((float4*)Ps)[tid + 768] = pn3;
      float acc[16];
      acc[0] = ln0.x; acc[1] = ln0.y; acc[2] = ln0.z; acc[3] = ln0.w; acc[4] = ln1.x; acc[5] = ln1.y; acc[6] = ln1.z; acc[7] = ln1.w;
      acc[8] = ln2.x; acc[9] = ln2.y; acc[10] = ln2.z; acc[11] = ln2.w; acc[12] = ln3.x; acc[13] = ln3.y; acc[14] = ln3.z; acc[15] = ln3.w;
      if (c + 1 < NCH - 1) {
        const float4* pp = (const float4*)(CHP + ub + 4096) + tid;
        pn0 = pp[0]; pn1 = pp[256]; pn2 = pp[512]; pn3 = pp[768];
        const float4* lp = (const float4*)(CHL + ub + 4096 + i * 64 + qd * 16);
        ln0 = lp[0]; ln1 = lp[1]; ln2 = lp[2]; ln3 = lp[3];
      }
      __syncthreads();
      if (c > 0) {
#pragma unroll 4
        for (int k = 0; k < 64; ++k) {
          const float sv = Ss[i * 65 + k];
          const float4* pr = (const float4*)(Ps + k * 64 + qd * 16);
#pragma unroll
          for (int u = 0; u < 4; ++u) {
            const float4 v = pr[u];
            acc[u * 4] += sv * v.x; acc[u * 4 + 1] += sv * v.y; acc[u * 4 + 2] += sv * v.z; acc[u * 4 + 3] += sv * v.w;
          }
        }
      }
      __syncthreads();
#pragma unroll
      for (int u = 0; u < 16; ++u) Ss[i * 65 + qd * 16 + u] = acc[u];
      {
        float4* lp = (float4*)(CHL + ub + i * 64 + qd * 16);
#pragma unroll
        for (int u = 0; u < 4; ++u) lp[u] = make_float4(acc[u * 4], acc[u * 4 + 1], acc[u * 4 + 2], acc[u * 4 + 3]);
      }
      __syncthreads();
    }
  }
}

DI void scanC_phase(const Params& p, char* smem) {
  char* ws = p.ws;
  const int tid = tid_opaque(), lane = tid & 63, wid = tid >> 6;
  float* st = (float*)smem + wid * (8 * 64);
  const bfr* PROJ = (const bfr*)(ws + O_PROJ);
  const bfr* Q = (const bfr*)(ws + O_RW_Q); const bfr* YL = (const bfr*)(ws + O_RW_Y);
  const bfr* G = (const bfr*)(ws + O_RW_G);
  const float* RK = (const float*)(ws + O_RK);
  const float* CHL = (const float*)(ws + O_CHL);
  bfr* MIX = (bfr*)(ws + O_MIX);
  for (int unit = VB; unit < 64 * NCH; unit += NVB) {
    const int chain = unit >> 4, chunk = unit & 15, b = chain >> 3, h = chain & 7;
    const int c = h * 64 + lane;
    const int tl0 = chunk * CHUNK + wid * 32;
    const size_t base = ((size_t)b * SEQ + tl0) * 512 + c;
    const float mu_v = p.in[I_MU][1024 + c];
    float S[64];
    if (chunk > 0) {
      const float4* sp = (const float4*)(CHL + ((size_t)(unit - 1) * 64 + lane) * 64);
#pragma unroll
      for (int j4 = 0; j4 < 16; ++j4) { const float4 v = sp[j4]; S[j4 * 4] = v.x; S[j4 * 4 + 1] = v.y; S[j4 * 4 + 2] = v.z; S[j4 * 4 + 3] = v.w; }
    } else {
#pragma unroll
      for (int j = 0; j < 64; ++j) S[j] = 0.f;
    }
    const float lnw = p.in[I_LNW][c], lnb = p.in[I_LNB][c];
#pragma unroll 1
    for (int sub = 0; sub < 4; ++sub) {
      const int tl = tl0 + sub * 8, tok0 = b * SEQ + tl;
      float qv[8], yv[8], vv[9], gv[8], rkv[8];
      {
        const bfr* pr = PROJ + (size_t)tok0 * PW1 + 1024 + c;
        vv[0] = tl > 0 ? bf2f(pr[-PW1]) : 0.f;
#pragma unroll
        for (int s8 = 0; s8 < 8; ++s8) {
          const size_t o = base + (size_t)(sub * 8 + s8) * 512;
          qv[s8] = bf2f(Q[o]); yv[s8] = bf2f(YL[o]); gv[s8] = bf2f(G[o]);
          vv[s8 + 1] = bf2f(pr[(size_t)s8 * PW1]);
          rkv[s8] = RK[(tok0 + s8) * 8 + h];
        }
      }
#pragma unroll
      for (int s8 = 0; s8 < 8; ++s8) st[s8 * 64 + lane] = qv[s8];
      __builtin_amdgcn_fence(__ATOMIC_RELEASE, "wavefront");
      __builtin_amdgcn_wave_barrier();
#pragma unroll
      for (int s8 = 0; s8 < 8; ++s8) {
        float y = yv[s8];
        const float* d = st + s8 * 64;
#pragma unroll
        for (int j4 = 0; j4 < 16; ++j4) {
          const float4 q4 = *(const float4*)(d + j4 * 4);
          y += S[j4 * 4] * q4.x + S[j4 * 4 + 1] * q4.y + S[j4 * 4 + 2] * q4.z + S[j4 * 4 + 3] * q4.w;
        }
        const float mean = wave_sum(y) * (1.f / 64.f);
        const float dlt = y - mean;
        const float var = wave_sum(dlt * dlt) * (1.f / 64.f);
        const float yn = dlt * rsqrtf(var + 64e-5f) * lnw + lnb;
        const float v = vv[s8 + 1] + (vv[s8] - vv[s8 + 1]) * mu_v;
        const float outv = (yn + rkv[s8] * v) * gv[s8];
        MIX[(size_t)(tok0 + s8) * 1024 + c] = f2bf(outv);
      }
      __builtin_amdgcn_fence(__ATOMIC_RELEASE, "wavefront");
      __builtin_amdgcn_wave_barrier();
    }
  }
}

#ifndef REP_PREP
#define REP_PREP 1
#endif
#ifndef REP_PROJ0
#define REP_PROJ0 1
#endif
#ifndef REP_CMPA
#define REP_CMPA 1
#endif
#ifndef REP_SLC
#define REP_SLC 1
#endif
#ifndef REP_MOE1
#define REP_MOE1 1
#endif
#ifndef REP_MOE2
#define REP_MOE2 1
#endif
#ifndef REP_POST0
#define REP_POST0 1
#endif
#ifndef REP_RPREP
#define REP_RPREP 1
#endif
#ifndef REP_SCANB
#define REP_SCANB 1
#endif
#ifndef POOL_IN_SCANB
#define POOL_IN_SCANB 0
#endif
#ifndef REP_POOLG
#define REP_POOLG 1
#endif
#ifndef REP_SCANA
#define REP_SCANA 1
#endif
#ifndef REP_SCANAB
#define REP_SCANAB 1
#endif
#ifndef REP_SCANC
#define REP_SCANC 1
#endif
#ifndef REP_SYNC
#define REP_SYNC 1
#endif
extern __shared__ __attribute__((aligned(16))) char dyn_smem[];
__global__ void __launch_bounds__(512, 2) fwd_megakernel(Params p) {
  cg::grid_group grid = cg::this_grid();
  char* smem = dyn_smem + (threadIdx.x >> 8) * 49152;
  __shared__ uint4 xb_words;
  char* ws = p.ws;
  const float* MOD = (const float*)(ws + O_MOD);
  const float* MOD1 = MOD + 8 * 6144;
  float* X = p.out;
  if (threadIdx.x == 0) xb_words = make_uint4(0u, 0u, 0u, 0u);

  for (int rep = 0; rep < REP_PREP; ++rep)
  for (int item = VB; item < PREP_TOTAL; item += NVB) prep_item(p, smem, item);
  if (NVB <= 128) { constexpr int N1 = 16 * (2 * T_G + T_D); for (int it = VB; it < N1; it += NVB) conv_expert_item(p, smem, N1 + it); }
  grid.sync();
  const XcdBarrier xb = xcd_barrier_post((unsigned*)(ws + O_BAR), (volatile LAS unsigned*)&xb_words);
#ifndef TIMEPH
#define TIMEPH -1
#endif
  unsigned long long t_start = 0, t_mark = 0; int gs_count = 0;
  if (TIMEPH >= 0) t_start = __builtin_amdgcn_s_memrealtime();
#define GSYNC() do { xcd_barrier(xb); if (TIMEPH >= 0) { ++gs_count; if (gs_count == TIMEPH) t_mark = __builtin_amdgcn_s_memrealtime(); } } while (0)
#ifndef XB_EXTRA_REL
#define XB_EXTRA_REL true
#endif
#ifndef XB_EXTRA_ACQ
#define XB_EXTRA_ACQ true
#endif
  for (int rep = 1; rep < REP_SYNC; ++rep) xcd_barrier<XB_EXTRA_REL, XB_EXTRA_ACQ>(xb);
  norm_phase<0, false>(p, smem, p.in[I_X], nullptr, p.in[I_NMIX], MOD, 0, 1024, 0, 0);
  GSYNC();
  for (int rep = 0; rep < REP_PROJ0; ++rep) gemm_proj_phase<4>(p, dyn_smem, (const bfr*)(ws + O_WEIN), PW0, (bfr*)(ws + O_PROJ));
  GSYNC();
  for (int rep = 0; rep < REP_POST0; ++rep) post0_phase(p, smem);
  GSYNC();
  cmp2_phase(p, smem);
  GSYNC();
  for (int rep = 0; rep < REP_CMPA; ++rep) cmp_attn_mfma_phase(p, smem);
  GSYNC();
  for (int rep = 0; rep < REP_SLC; ++rep) attn_sw_phase(p, smem);
  GSYNC();
  gemm_out_phase(p, dyn_smem, (const bfr*)(ws + O_WEOUT), p.in[I_X], X, MOD + 2048);
  GSYNC();
  norm_router_phase(p, smem, X, p.in[I_NFFN], MOD, 3072, 4096, 0);
  GSYNC();
  for (int rep = 0; rep < REP_MOE1; ++rep) moe1_phase(p, smem, 0);
  GSYNC();
  for (int rep = 0; rep < REP_MOE2; ++rep) moe2_phase(p, smem, 0);
  GSYNC();
  norm_phase<1, false>(p, smem, X, X, p.in[I_NMIX] + 1024, MOD1, 0, 1024, 5120 - 6144 * 8, 1);
  GSYNC();
  gemm_proj_phase<3>(p, dyn_smem, (const bfr*)(ws + O_WOIN), PW1, (bfr*)(ws + O_PROJ));
  GSYNC();
  for (int rep = 0; rep < REP_RPREP; ++rep) rwkv_lora_pool_phase(p, smem);
  GSYNC();
  for (int rep = 0; rep < REP_SCANA; ++rep) scanA_phase(p, smem);
  GSYNC();
  for (int rep = 0; rep < REP_SCANAB; ++rep) {
    if (rep > 0) { scanA_phase(p, smem); GSYNC(); }
    scanB_phase(p, smem);
    GSYNC();
  }
  for (int rep = 0; rep < REP_SCANC; ++rep) scanC_phase(p, smem);
#if !POOL_IN_SCANB
  __syncthreads();
  for (int rep = 0; rep < REP_POOLG; ++rep) pool_gemm_tiles(p, smem, VB, NVB);
#endif
  GSYNC();
  gemm_out_phase(p, dyn_smem, (const bfr*)(ws + O_WOOUT), X, X, MOD1 + 2048);
  GSYNC();
  norm_router_phase(p, smem, X, p.in[I_NFFN] + 1024, MOD1, 3072, 4096, 1);
  GSYNC();
  moe1_phase(p, smem, 1);
  GSYNC();
  moe2_phase(p, smem, 1);
  GSYNC();
  norm_phase<2, false>(p, smem, X, X, p.in[I_FN], MOD1, 0, 0, 5120, 1);
  if (TIMEPH >= 0 && blockIdx.x == 0 && threadIdx.x == 0) {
    const unsigned long long dt = t_mark - t_start, t0 = __builtin_amdgcn_s_memrealtime();
    while (__builtin_amdgcn_s_memrealtime() - t0 < dt) __builtin_amdgcn_s_sleep(8);
  }
}

constexpr int DYN_LDS = 2 * 49152;
extern "C" void kernel_launch(void* const* d_in, const int* in_sizes, int n_in,
                              void* d_out, int out_size, void* d_ws, size_t ws_size,
                              hipStream_t stream) {
  static int grid_blocks = 0;
  if (!grid_blocks) {
    int dev = 0, cus = 0, per_cu = 0;
    (void)hipGetDevice(&dev);
    (void)hipDeviceGetAttribute(&cus, hipDeviceAttributeMultiprocessorCount, dev);
    (void)hipFuncSetAttribute((const void*)fwd_megakernel, hipFuncAttributeMaxDynamicSharedMemorySize, DYN_LDS);
    (void)hipOccupancyMaxActiveBlocksPerMultiprocessor(&per_cu, fwd_megakernel, 512, DYN_LDS);
    if (per_cu > 1) per_cu = 1;
    if (per_cu < 1) per_cu = 1;
    grid_blocks = cus * per_cu;
    fprintf(stderr, "cus=%d per_cu=%d grid=%d ws=%zu need=%zu\n", cus, per_cu, grid_blocks, ws_size, (size_t)WS_NEED);
  }
  if (ws_size < WS_NEED || n_in < 33) { fprintf(stderr, "workspace too small\n"); return; }
  Params p{};
  for (int i = 0; i < 33; ++i) p.in[i] = (const float*)d_in[i];
  p.out = (float*)d_out;
  p.ws = (char*)d_ws;
  p.ws_size = (unsigned long long)ws_size;
  void* args[] = {&p};
  hipError_t e = hipLaunchCooperativeKernel((void*)fwd_megakernel, dim3(grid_blocks), dim3(512), args, DYN_LDS, stream);
  if (e != hipSuccess) fprintf(stderr, "cooperative launch failed: %s (grid %d)\n", hipGetErrorString(e), grid_blocks);
}
```

```cpp
#include <hip/hip_runtime.h>
#include <hip/hip_cooperative_groups.h>
#include <cstdio>
namespace cg = cooperative_groups;

typedef unsigned short bfr;
using bf16x8 = __attribute__((ext_vector_type(8))) short;
using f32x4 = __attribute__((ext_vector_type(4))) float;
typedef __attribute__((ext_vector_type(2))) __bf16 bf2v;
#define DI __device__ __forceinline__

constexpr int NT = 16384;
constexpr int SEQ = 2048;
constexpr int DM = 1024;
constexpr int PW0 = 3072;
constexpr int PW1 = 2304;
constexpr int C_Q = 0, C_KC = 512, C_VC = 640, C_KS = 768, C_VS = 896, C_KW = 1024, C_VW = 1152;
constexpr int C_XB = 1280, C_BG = 1792, C_CG = 2304, C_GL = 2816;

constexpr size_t al256(size_t x) { return (x + 255) & ~size_t(255); }
constexpr size_t MB = 1024 * 1024;
constexpr size_t O_MOD = 0;
constexpr size_t O_ROPE = O_MOD + al256(2 * 8 * 6144 * 4);
constexpr size_t O_BIAS1 = O_ROPE + al256(2048 * 32 * 2 * 4);
constexpr size_t O_BAR = O_BIAS1 + al256(2 * 256 * 4);
constexpr size_t O_CNT = O_BAR + al256(3456 * 4);
constexpr size_t O_TOPW = O_CNT + al256(2 * 16 * 64 * 4);
constexpr size_t O_LIST = O_TOPW + al256((size_t)NT * 2 * 4);
constexpr size_t O_SEL = O_LIST + al256((size_t)16 * NT * 4);
constexpr size_t O_KCVC = O_SEL + al256((size_t)NT * 2 * 4);
constexpr size_t O_RK = O_KCVC + al256(2 * 2048 * 64 * 4);
constexpr size_t O_VCT = O_RK + al256((size_t)NT * 8 * 4);
constexpr size_t O_CH = O_VCT + al256(8 * 2 * 64 * 128 * 2);
constexpr size_t O_WEIN = O_CH + al256(2 * 2048 * 256 * 2);
constexpr size_t O_WEOUT = O_WEIN + al256((size_t)PW0 * 1024 * 2);
constexpr size_t O_WOIN = O_WEOUT + al256(1024 * 1024 * 2);
constexpr size_t O_WOOUT = O_WOIN + al256((size_t)PW1 * 1024 * 2);
constexpr size_t O_WC1 = O_WOOUT + al256(1024 * 1024 * 2);
constexpr size_t O_WC2 = O_WC1 + al256(2 * 256 * 2048 * 2);
constexpr size_t O_W2T = O_WC2 + al256(2 * 128 * 256 * 2);
constexpr size_t O_A2T = O_W2T + al256(512 * 64 * 2);
constexpr size_t O_G2T = O_A2T + al256(512 * 64 * 2);
constexpr size_t O_PWT = O_G2T + al256(512 * 128 * 2);
constexpr size_t O_WGU = O_PWT + al256(4 * 128 * 128 * 2);
constexpr size_t O_WDN = O_WGU + 64 * MB;
constexpr size_t O_HB = O_WDN + 32 * MB;
constexpr size_t O_MIX = O_HB + 32 * MB;
constexpr size_t O_E = O_MIX + 32 * MB;
constexpr size_t SZ_E = al256((size_t)NT * PW0 * 2);
constexpr size_t O_F = O_E + SZ_E;
constexpr size_t WS_NEED = O_F + 48 * MB;
constexpr size_t O_HMID = O_MIX;
constexpr size_t O_PROJ = O_E;
constexpr size_t O_MOEOUT = O_E;
constexpr size_t O_CHP = O_WGU;
constexpr size_t O_CHL = O_WGU + 16 * MB;
constexpr size_t O_QR = O_F;
constexpr size_t O_KSR = O_F + 16 * MB;
constexpr size_t O_KWR = O_F + 20 * MB;
constexpr size_t O_OCMP = O_F + 24 * MB;
constexpr size_t O_VST = O_F + 40 * MB;
constexpr size_t O_VWT = O_F + 44 * MB;
constexpr size_t O_RW_W = O_HB;
constexpr size_t O_RW_Q = O_F;
constexpr size_t O_RW_Y = O_F + 16 * MB;
constexpr size_t O_RW_AS = O_F + 32 * MB;
constexpr size_t O_RW_G = O_WDN;
constexpr size_t O_POOLED = O_E + 76 * MB;

struct Params {
  const float* in[33];
  float* out;
  char* ws;
  unsigned long long ws_size;
};

enum { I_X = 0, I_C, I_ADAW, I_ADAB, I_NMIX, I_NFFN, I_EWIN, I_CPOS, I_CW1, I_CW2, I_CONVW, I_EWOUT, I_OWIN, I_MU, I_W0, I_W2,
       I_A0, I_A2, I_G2, I_KK, I_KA, I_RKP, I_LNW, I_LNB, I_POOLW, I_POOLS, I_OWOUT, I_RTW, I_RTB, I_MG, I_MU_, I_MD, I_FN };

DI int tid_opaque() { int t = threadIdx.x & 255; asm volatile("" : "+v"(t) :: "memory"); __builtin_assume(t >= 0 && t < 256); return t; }
#define VB ((int)(blockIdx.x * 2 + __builtin_amdgcn_readfirstlane((int)(threadIdx.x >> 8))))
#define NVB ((int)(gridDim.x * 2))
DI float bf2f(bfr u) { return __uint_as_float(((unsigned)u) << 16); }
DI bfr f2bf(float x) { unsigned u = __float_as_uint(x); u += 0x7fffu + ((u >> 16) & 1u); return (bfr)(u >> 16); }
typedef __attribute__((ext_vector_type(2))) float f32x2_;
DI unsigned pack2(float a, float b) { f32x2_ x = {a, b}; return __builtin_bit_cast(unsigned, __builtin_convertvector(x, bf2v)); }
DI float lo2f(unsigned u) { return __uint_as_float(u << 16); }
DI float hi2f(unsigned u) { return __uint_as_float(u & 0xffff0000u); }
DI float wave_sum(float v) {
#pragma unroll
  for (int o = 32; o > 0; o >>= 1) v += __shfl_xor(v, o);
  return v;
}
DI float sigmoidf_(float x) { return 1.f / (1.f + __expf(-x)); }
DI float dot2(unsigned a, unsigned b, float c) {
  return __builtin_amdgcn_fdot2_f32_bf16(__builtin_bit_cast(bf2v, a), __builtin_bit_cast(bf2v, b), c, false);
}

#define XB_TMO      128
#define XB_XCNT(j)  (256  + 64 * (j))
#define XB_XSUB(j)  (1280 + 64 * (j))
#define XB_XGEN(j)  (2304 + 64 * (j))
#define XB_TOP      3328
#define XB_TOPGEN   3392
#define XCD_BAR_WORDS 3456
#define XB_SPIN_CAP (1u << 22)
#define LAS __attribute__((address_space(3)))
DI unsigned xb_ld(unsigned* p) { return __hip_atomic_load(p, __ATOMIC_RELAXED, __HIP_MEMORY_SCOPE_AGENT); }
DI unsigned xb_add(unsigned* p, unsigned v) { return __hip_atomic_fetch_add(p, v, __ATOMIC_RELAXED, __HIP_MEMORY_SCOPE_AGENT); }
DI unsigned xb_xcc_id() { return (unsigned)__builtin_amdgcn_s_getreg((3 << 11) | 20) & 0xFu; }
#define XB_SPIN(cond, bar) do { unsigned _sp = 0; while (cond) { __builtin_amdgcn_s_sleep(1); \
    if ((++_sp & 255u) == 0u) { if (xb_ld(&(bar)[XB_TMO])) break; if (_sp > XB_SPIN_CAP) { atomicAdd(&(bar)[XB_TMO], 1u); break; } } } } while (0)
struct XcdBarrier { unsigned* bar; unsigned x; volatile LAS unsigned* st; };
DI XcdBarrier xcd_barrier_post(unsigned* bar, volatile LAS unsigned* st) {
  XcdBarrier b; b.bar = bar; b.x = (unsigned)__builtin_amdgcn_readfirstlane((int)xb_xcc_id()); b.st = st;
  if (threadIdx.x == 0) (void)xb_add(&bar[XB_XCNT(b.x)], 1u);
  return b;
}
DI void xcd_barrier_complete(unsigned* bar, unsigned x, unsigned& nloc, unsigned& nx) {
  const unsigned G = gridDim.x * gridDim.y * gridDim.z;
  unsigned sum, cnt, mine, sp = 0u;
  for (;;) {
    sum = 0u; cnt = 0u; mine = 0u;
#pragma unroll
    for (unsigned j = 0; j < 16; ++j) { const unsigned c = xb_ld(&bar[XB_XCNT(j)]); sum += c; cnt += (c > 0u) ? 1u : 0u; mine = (j == x) ? c : mine; }
    if (sum == G) break;
    __builtin_amdgcn_s_sleep(1);
    if ((++sp & 255u) == 0u) { if (xb_ld(&bar[XB_TMO])) break; if (sp > XB_SPIN_CAP) { atomicAdd(&bar[XB_TMO], 1u); break; } }
  }
  nloc = mine > 0u ? mine : 1u; nx = cnt > 0u ? cnt : 1u;
}
template <bool REL = true, bool ACQ = true>
DI void xcd_barrier(const XcdBarrier& b) {
  asm volatile("s_waitcnt vmcnt(0)" ::: "memory");
  __syncthreads();
  if (threadIdx.x == 0) {
    unsigned* bar = b.bar;
    unsigned bx = b.x;
    asm volatile("" : "+s"(bx));
    __builtin_amdgcn_s_waitcnt(0);
    unsigned nloc = b.st[0], nx = b.st[1];
    if (nloc == 0u) { xcd_barrier_complete(bar, bx, nloc, nx); b.st[0] = nloc; b.st[1] = nx; }
    const unsigned old = xb_add(&bar[XB_XSUB(bx)], 1u);
    const unsigned gen = old / nloc;
    if (old + 1u == (gen + 1u) * nloc) {
      if (REL) __builtin_amdgcn_fence(__ATOMIC_RELEASE, "agent");
      asm volatile("s_waitcnt vmcnt(0)" ::: "memory");
      const unsigned og = xb_add(&bar[XB_TOP], 1u);
      const unsigned tg = og / nx;
      if (og + 1u == (tg + 1u) * nx) xb_add(&bar[XB_TOPGEN], 1u);
      else XB_SPIN(xb_ld(&bar[XB_TOPGEN]) == tg, bar);
      if (ACQ) __builtin_amdgcn_fence(__ATOMIC_ACQUIRE, "agent");
      xb_add(&bar[XB_XGEN(bx)], 1u);
      asm volatile("s_waitcnt vmcnt(0)" ::: "memory");
    } else {
      XB_SPIN(xb_ld(&bar[XB_XGEN(bx)]) == gen, bar);
      if (ACQ) __builtin_amdgcn_fence(__ATOMIC_ACQUIRE, "agent");
      asm volatile("s_waitcnt vmcnt(0)" ::: "memory");
    }
  }
  __syncthreads();
}

struct GemmLds { bfr a[2][128][40]; bfr b[2][128][40]; };
static_assert(sizeof(GemmLds) == 40960, "lds");

template <class AF, class BF, class Epi>
DI void gemm_tile(char* smem, int nk, AF af, BF bfn, Epi&& epi) {
  GemmLds& L = *(GemmLds*)smem;
  const int tid = tid_opaque(), lane = tid & 63, wid = tid >> 6, wr = wid >> 1, wc = wid & 1, fr = lane & 15, fq = lane >> 4;
  const int lr = tid >> 2, lk = (tid & 3) * 8;
  af.init(lr);
  bfn.init(lr);
  f32x4 acc[4][4];
#pragma unroll
  for (int m = 0; m < 4; ++m)
#pragma unroll
    for (int n = 0; n < 4; ++n) acc[m][n] = f32x4{0.f, 0.f, 0.f, 0.f};
  uint4 ra0, ra1, rb0, rb1;
  ra0 = af.load(0, lk); ra1 = af.load(1, lk);
  rb0 = bfn.load(0, lk); rb1 = bfn.load(1, lk);
  *(uint4*)&L.a[0][lr][lk] = ra0; *(uint4*)&L.a[0][lr + 64][lk] = ra1;
  *(uint4*)&L.b[0][lr][lk] = rb0; *(uint4*)&L.b[0][lr + 64][lk] = rb1;
  __syncthreads();
  for (int kt = 0; kt < nk; ++kt) {
    const int cur = kt & 1;
    if (kt + 1 < nk) {
      const int k = (kt + 1) * 32 + lk;
      ra0 = af.load(0, k); ra1 = af.load(1, k);
      rb0 = bfn.load(0, k); rb1 = bfn.load(1, k);
    }
    __builtin_amdgcn_sched_barrier(0);
    bf16x8 fa[4], fb[4];
#pragma unroll
    for (int m = 0; m < 4; ++m) fa[m] = *(const bf16x8*)&L.a[cur][wr * 64 + m * 16 + fr][fq * 8];
#pragma unroll
    for (int n = 0; n < 4; ++n) fb[n] = *(const bf16x8*)&L.b[cur][wc * 64 + n * 16 + fr][fq * 8];
#pragma unroll
    for (int m = 0; m < 4; ++m)
#pragma unroll
      for (int n = 0; n < 4; ++n) acc[m][n] = __builtin_amdgcn_mfma_f32_16x16x32_bf16(fa[m], fb[n], acc[m][n], 0, 0, 0);
    __builtin_amdgcn_sched_barrier(0);
    if (kt + 1 < nk) {
      *(uint4*)&L.a[cur ^ 1][lr][lk] = ra0; *(uint4*)&L.a[cur ^ 1][lr + 64][lk] = ra1;
      *(uint4*)&L.b[cur ^ 1][lr][lk] = rb0; *(uint4*)&L.b[cur ^ 1][lr + 64][lk] = rb1;
    }
    __syncthreads();
  }
  epi(acc, wr, wc, fr, fq);
}

struct RowsContig {
  const bfr* base; int ld; int maxrow;
  const bfr* rp[2];
  DI void init(int lr) {
#pragma unroll
    for (int i = 0; i < 2; ++i) { const int r = lr + 64 * i; rp[i] = base + (size_t)(r < maxrow ? r : maxrow) * ld; }
  }
  DI uint4 load(int sel, int k) const { return *(const uint4*)(rp[sel] + k); }
  DI const bfr* ptr(int sel, int k) const { return rp[sel] + k; }
};

#ifndef KLOOP2
#define KLOOP2 1
#endif
struct RowsContigW {
  const bfr* base; int ld; int maxrow;
  const bfr* rp[2];
  DI void init(int lr) {
#pragma unroll
    for (int i = 0; i < 2; ++i) { const int r = lr + 64 * i; rp[i] = base + (size_t)(r < maxrow ? r : maxrow) * ld; }
  }
  DI const bfr* ptr(int sel, int k) const { return rp[sel] + (k & 1023); }
};
struct GemmLdsG { bfr a[3][128][32]; bfr b[3][128][32]; };
static_assert(sizeof(GemmLdsG) == 49152, "glds lds");
template <class AF, class BF, class Epi>
DI void gemm_tile_g(char* smem, int nk, AF af, BF bfn, Epi&& epi) {
  GemmLdsG& L = *(GemmLdsG*)smem;
  const int tid = tid_opaque(), lane = tid & 63, wid = tid >> 6, wr = wid >> 1, wc = wid & 1, fr = lane & 15, fq = lane >> 4;
  const int lr = tid >> 2;
  const int lk = ((tid & 3) ^ (2 * ((lr >> 3) & 1))) * 8;
  af.init(lr);
  bfn.init(lr);
  f32x4 acc[4][4];
#pragma unroll
  for (int m = 0; m < 4; ++m)
#pragma unroll
    for (int n = 0; n < 4; ++n) acc[m][n] = f32x4{0.f, 0.f, 0.f, 0.f};
  typedef __attribute__((address_space(3))) unsigned lds_u32;
  auto stage = [&](int buf, int kt) {
    const int k = kt * 32 + lk;
    char* la = (char*)&L.a[buf][0][0] + tid * 16;
    char* lb = (char*)&L.b[buf][0][0] + tid * 16;
    __builtin_amdgcn_global_load_lds((const unsigned*)af.ptr(0, k), (lds_u32*)la, 16, 0, 0);
    __builtin_amdgcn_global_load_lds((const unsigned*)af.ptr(1, k), (lds_u32*)(la + 4096), 16, 0, 0);
    __builtin_amdgcn_global_load_lds((const unsigned*)bfn.ptr(0, k), (lds_u32*)lb, 16, 0, 0);
    __builtin_amdgcn_global_load_lds((const unsigned*)bfn.ptr(1, k), (lds_u32*)(lb + 4096), 16, 0, 0);
  };
  const int cs = (fq ^ (2 * (fr >> 3))) * 8;
  stage(0, 0);
  stage(1, 1);
  int cur = 0;
  for (int kt = 0; kt < nk; ++kt) {
    if (kt + 1 < nk) asm volatile("s_waitcnt vmcnt(4)" ::: "memory");
    else asm volatile("s_waitcnt vmcnt(0)" ::: "memory");
    __builtin_amdgcn_s_barrier();
    asm volatile("" ::: "memory");
    if (kt + 2 < nk) stage(cur == 0 ? 2 : cur - 1, kt + 2);
    bf16x8 fa[4], fb[4];
#pragma unroll
    for (int m = 0; m < 4; ++m) fa[m] = *(const bf16x8*)&L.a[cur][wr * 64 + m * 16 + fr][cs];
#pragma unroll
    for (int n = 0; n < 4; ++n) fb[n] = *(const bf16x8*)&L.b[cur][wc * 64 + n * 16 + fr][cs];
#pragma unroll
    for (int m = 0; m < 4; ++m)
#pragma unroll
      for (int n = 0; n < 4; ++n) acc[m][n] = __builtin_amdgcn_mfma_f32_16x16x32_bf16(fb[n], fa[m], acc[m][n], 0, 0, 0);
    cur = cur == 2 ? 0 : cur + 1;
  }
  asm volatile("s_waitcnt lgkmcnt(0)" ::: "memory");
  __builtin_amdgcn_s_barrier();
  asm volatile("" ::: "memory");
  epi(acc, wr, wc, fr, fq);
}

DI int tid512_opaque() { int t = threadIdx.x; asm volatile("" : "+v"(t) :: "memory"); __builtin_assume(t >= 0 && t < 512); return t; }
struct GemmLds256 { bfr a[3][256][32]; bfr b[3][256][32]; };
static_assert(sizeof(GemmLds256) == 98304, "lds256");
struct Rows256 {
  const bfr* base; int ld; int maxrow;
  const bfr* rp[2];
  DI void init(int lr) {
#pragma unroll
    for (int i = 0; i < 2; ++i) { const int r = lr + 128 * i; rp[i] = base + (size_t)(r < maxrow ? r : maxrow) * ld; }
  }
  DI const bfr* ptr(int sel, int k) const { return rp[sel] + k; }
};
template <int NS, class AF, class BF, class Epi>
DI void gemm_tile_256(char* smem_all, int nk, AF af, BF bfn, Epi&& epi) {
  GemmLds256& L = *(GemmLds256*)smem_all;
  const int tid = tid512_opaque(), lane = tid & 63, wid = tid >> 6, wr = wid >> 2, wc = wid & 3, fr = lane & 15, fq = lane >> 4;
  const int lr = tid >> 2;
  const int lk = ((tid & 3) ^ (2 * ((lr >> 3) & 1))) * 8;
  af.init(lr);
  bfn.init(lr);
  f32x4 acc[8][NS];
#pragma unroll
  for (int m = 0; m < 8; ++m)
#pragma unroll
    for (int n = 0; n < NS; ++n) acc[m][n] = f32x4{0.f, 0.f, 0.f, 0.f};
  typedef __attribute__((address_space(3))) unsigned lds_u32;
  auto stage = [&](int buf, int kt) {
    const int k = kt * 32 + lk;
    char* la = (char*)&L.a[buf][0][0] + tid * 16;
    char* lb = (char*)&L.b[buf][0][0] + tid * 16;
    __builtin_amdgcn_global_load_lds((const unsigned*)af.ptr(0, k), (lds_u32*)la, 16, 0, 0);
    __builtin_amdgcn_global_load_lds((const unsigned*)af.ptr(1, k), (lds_u32*)(la + 8192), 16, 0, 0);
    __builtin_amdgcn_global_load_lds((const unsigned*)bfn.ptr(0, k), (lds_u32*)lb, 16, 0, 0);
    __builtin_amdgcn_global_load_lds((const unsigned*)bfn.ptr(1, k), (lds_u32*)(lb + 8192), 16, 0, 0);
  };
  const int cs = (fq ^ (2 * (fr >> 3))) * 8;
  stage(0, 0);
  stage(1, 1);
  int cur = 0;
  for (int kt = 0; kt < nk; ++kt) {
    if (kt + 1 < nk) asm volatile("s_waitcnt vmcnt(4)" ::: "memory");
    else asm volatile("s_waitcnt vmcnt(0)" ::: "memory");
    __builtin_amdgcn_s_barrier();
    asm volatile("" ::: "memory");
    if (kt + 2 < nk) stage(cur == 0 ? 2 : cur - 1, kt + 2);
    bf16x8 fb[NS];
#pragma unroll
    for (int n = 0; n < NS; ++n) fb[n] = *(const bf16x8*)&L.b[cur][wc * (NS * 16) + n * 16 + fr][cs];
#pragma unroll
    for (int mh = 0; mh < 2; ++mh) {
      bf16x8 fa[4];
#pragma unroll
      for (int m = 0; m < 4; ++m) fa[m] = *(const bf16x8*)&L.a[cur][wr * 128 + (mh * 4 + m) * 16 + fr][cs];
#pragma unroll
      for (int m = 0; m < 4; ++m)
#pragma unroll
        for (int n = 0; n < NS; ++n) acc[mh * 4 + m][n] = __builtin_amdgcn_mfma_f32_16x16x32_bf16(fb[n], fa[m], acc[mh * 4 + m][n], 0, 0, 0);
    }
    cur = cur == 2 ? 0 : cur + 1;
  }
  asm volatile("s_waitcnt lgkmcnt(0)" ::: "memory");
  __builtin_amdgcn_s_barrier();
  asm volatile("" ::: "memory");
  epi(acc, wr, wc, fr, fq);
}

DI int remap_col(int mode, int n) {
  if (mode == 1) return n < 1280 ? n : (n < 1304 ? C_GL + (n - 1280) : n - 24);
  if (mode == 2) return ((n >> 4) << 5) + (n & 15);
  if (mode == 3) return ((n >> 4) << 5) + 16 + (n & 15);
  return n;
}

DI void conv_tile(char* smem, const float* __restrict__ src, int ldsrc, int Ndim, int k0, int n0, bfr* dst, int ldd, int mode) {
  float(*t)[65] = (float(*)[65])smem;
  const int tid = tid_opaque();
  {
    const int n = tid & 63, kq = tid >> 6;
    const int nn = n0 + n;
#pragma unroll
    for (int i = 0; i < 16; ++i) {
      const int k = i * 4 + kq;
      t[k][n] = (nn < Ndim) ? src[(size_t)(k0 + k) * ldsrc + nn] : 0.f;
    }
  }
  __syncthreads();
  {
    const int nl = tid >> 2, kc = (tid & 3) * 16;
    const int nn = n0 + nl;
    if (nn < Ndim) {
      const int dr = remap_col(mode, nn);
      unsigned w[8];
#pragma unroll
      for (int i = 0; i < 8; ++i) w[i] = pack2(t[kc + 2 * i][nl], t[kc + 2 * i + 1][nl]);
      uint4* d = (uint4*)(dst + (size_t)dr * ldd + k0 + kc);
      d[0] = make_uint4(w[0], w[1], w[2], w[3]);
      d[1] = make_uint4(w[4], w[5], w[6], w[7]);
    }
  }
  __syncthreads();
}

constexpr int PREP_MOD = 192, PREP_ROPE = 256, PREP_MISC = 4;
constexpr int T_EIN = 16 * 45, T_SQ = 256, T_OIN = 16 * 36, T_C1 = 128, T_C2 = 4, T_G = 128, T_D = 128;
constexpr int PREP_CONV0 = PREP_MOD + PREP_ROPE + PREP_MISC;
constexpr int T_LORA = 8 + 8 + 16 + 16;
constexpr int PREP_TOTAL = PREP_CONV0;

struct ConvJob { const float* src; bfr* dst; int ldsrc, Ndim, k0, n0, ldd, mode; };
constexpr int J_EIN = 16 * 23, J_SQ = 16 * 8, J_OIN = 16 * 18, J_C1 = 32 * 2, J_C2 = 4, J_LORA = 4 + 4 + 8 + 8, J_G = 16 * 4, J_D = 8 * 8;
constexpr int NC_MISC = J_EIN + J_SQ + J_OIN + J_SQ + 2 * J_C1 + 2 * J_C2 + J_LORA;
constexpr int NC_EXP = 2 * J_G + J_D;
constexpr int NC_PREP = NC_MISC + 16 * NC_EXP;
constexpr int NC_ALL = NC_MISC + 32 * NC_EXP;
static_assert(NC_MISC % 2 == 0 && NC_EXP % 2 == 0, "paired halves need even job counts");
DI ConvJob conv_decode(const Params& p, int item) {
  char* ws = p.ws;
  ConvJob j;
  if (item < J_EIN) { j = ConvJob{p.in[I_EWIN], (bfr*)(ws + O_WEIN), 2840, 2840, (item / 23) * 64, (item % 23) * 128, 1024, 1}; return j; }
  item -= J_EIN;
  if (item < J_SQ) { j = ConvJob{p.in[I_EWOUT], (bfr*)(ws + O_WEOUT), 1024, 1024, (item / 8) * 64, (item % 8) * 128, 1024, 0}; return j; }
  item -= J_SQ;
  if (item < J_OIN) { j = ConvJob{p.in[I_OWIN], (bfr*)(ws + O_WOIN), 2304, 2304, (item / 18) * 64, (item % 18) * 128, 1024, 0}; return j; }
  item -= J_OIN;
  if (item < J_SQ) { j = ConvJob{p.in[I_OWOUT], (bfr*)(ws + O_WOOUT), 1024, 1024, (item / 8) * 64, (item % 8) * 128, 1024, 0}; return j; }
  item -= J_SQ;
  if (item < 2 * J_C1) {
    const int jj = item / J_C1, tt = item % J_C1;
    j = ConvJob{p.in[I_CW1] + (size_t)jj * 2048 * 256, (bfr*)(ws + O_WC1) + (size_t)jj * 256 * 2048, 256, 256, (tt / 2) * 64, (tt % 2) * 128, 2048, 0}; return j;
  }
  item -= 2 * J_C1;
  if (item < 2 * J_C2) {
    const int jj = item / J_C2, tt = item % J_C2;
    j = ConvJob{p.in[I_CW2] + (size_t)jj * 256 * 64, (bfr*)(ws + O_WC2) + (size_t)jj * 128 * 256, 64, 64, tt * 64, 0, 256, 0}; return j;
  }
  item -= 2 * J_C2;
  if (item < J_LORA) {
    if (item < 4) j = ConvJob{p.in[I_W2], (bfr*)(ws + O_W2T), 512, 512, 0, item * 128, 64, 0};
    else if (item < 8) j = ConvJob{p.in[I_A2], (bfr*)(ws + O_A2T), 512, 512, 0, (item - 4) * 128, 64, 0};
    else if (item < 16) { const int t2 = item - 8; j = ConvJob{p.in[I_G2], (bfr*)(ws + O_G2T), 512, 512, (t2 >> 2) * 64, (t2 & 3) * 128, 128, 0}; }
    else { const int t2 = item - 16, gi = t2 >> 1; j = ConvJob{p.in[I_POOLW] + gi * 128 * 128, (bfr*)(ws + O_PWT) + gi * 128 * 128, 128, 128, (t2 & 1) * 64, 0, 128, 0}; }
    return j;
  }
  item -= J_LORA;
  const int le = item / NC_EXP, tt = item % NC_EXP;
  if (tt < J_G) j = ConvJob{p.in[I_MG] + (size_t)le * 1024 * 512, (bfr*)(ws + O_WGU) + (size_t)le * 1024 * 1024, 512, 512, (tt / 4) * 64, (tt % 4) * 128, 1024, 2};
  else if (tt < 2 * J_G) { const int t2 = tt - J_G; j = ConvJob{p.in[I_MU_] + (size_t)le * 1024 * 512, (bfr*)(ws + O_WGU) + (size_t)le * 1024 * 1024, 512, 512, (t2 / 4) * 64, (t2 % 4) * 128, 1024, 3}; }
  else { const int t2 = tt - 2 * J_G; j = ConvJob{p.in[I_MD] + (size_t)le * 512 * 1024, (bfr*)(ws + O_WDN) + (size_t)le * 1024 * 512, 1024, 1024, (t2 / 8) * 64, (t2 % 8) * 128, 512, 0}; }
  return j;
}
DI void conv_run(const Params& p, char* smem, int first, int end, int stride) {
  float(*t)[129] = (float(*)[129])smem;
  const int tid = tid_opaque();
  const int lk = tid >> 5, ln = (tid & 31) * 4;
  float4 r[8];
  auto gload = [&](const ConvJob& j) {
#pragma unroll
    for (int ps = 0; ps < 8; ++ps) {
      r[ps] = make_float4(0.f, 0.f, 0.f, 0.f);
      if (j.n0 + ln < j.Ndim) r[ps] = *(const float4*)(j.src + (size_t)(j.k0 + lk + 8 * ps) * j.ldsrc + j.n0 + ln);
    }
  };
  int ci = first;
  ConvJob cur{};
  if (ci < end) { cur = conv_decode(p, ci); gload(cur); }
  for (; ci < end; ci += stride) {
#pragma unroll
    for (int ps = 0; ps < 8; ++ps) {
      t[lk + 8 * ps][ln] = r[ps].x; t[lk + 8 * ps][ln + 1] = r[ps].y; t[lk + 8 * ps][ln + 2] = r[ps].z; t[lk + 8 * ps][ln + 3] = r[ps].w;
    }
    __syncthreads();
    ConvJob nxt = cur;
    if (ci + stride < end) { nxt = conv_decode(p, ci + stride); gload(nxt); }
    {
      const int nl = tid >> 1, kc = (tid & 1) * 32;
      const int nn = cur.n0 + nl;
      if (nn < cur.Ndim) {
        const int dr = remap_col(cur.mode, nn);
        unsigned w[16];
#pragma unroll
        for (int i = 0; i < 16; ++i) w[i] = pack2(t[kc + 2 * i][nl], t[kc + 2 * i + 1][nl]);
        uint4* d = (uint4*)(cur.dst + (size_t)dr * cur.ldd + cur.k0 + kc);
        d[0] = make_uint4(w[0], w[1], w[2], w[3]);
        d[1] = make_uint4(w[4], w[5], w[6], w[7]);
        d[2] = make_uint4(w[8], w[9], w[10], w[11]);
        d[3] = make_uint4(w[12], w[13], w[14], w[15]);
      }
    }
    __syncthreads();
    cur = nxt;
  }
}

DI void prep_item(const Params& p, char* smem, int item) {
  const int tid = tid_opaque();
  char* ws = p.ws;
  if (item < PREP_MOD) {
    const int layer = item / 96, cch = item % 96;
    float* cond = (float*)smem;
    float* red = (float*)(smem + 32768);
    const float* c = p.in[I_C];
    for (int i = tid; i < 8192; i += 256) {
      const int b = i >> 10, k = i & 1023;
      const float v = c[i];
      cond[k * 8 + b] = v / (1.f + __expf(-v));
    }
    __syncthreads();
    const int col = cch * 64 + (tid & 63), kg = tid >> 6;
    const float* w = p.in[I_ADAW] + (size_t)layer * 1024 * 6144 + col;
    float acc[8] = {0, 0, 0, 0, 0, 0, 0, 0};
#pragma unroll 8
    for (int k = kg * 256; k < kg * 256 + 256; ++k) {
      const float wv = w[(size_t)k * 6144];
      const float4 c0 = *(const float4*)&cond[k * 8], c1 = *(const float4*)&cond[k * 8 + 4];
      acc[0] += c0.x * wv; acc[1] += c0.y * wv; acc[2] += c0.z * wv; acc[3] += c0.w * wv;
      acc[4] += c1.x * wv; acc[5] += c1.y * wv; acc[6] += c1.z * wv; acc[7] += c1.w * wv;
    }
#pragma unroll
    for (int b = 0; b < 8; ++b) red[(kg * 8 + b) * 64 + (tid & 63)] = acc[b];
    __syncthreads();
    for (int i = tid; i < 512; i += 256) {
      const int b = i >> 6, cc = i & 63;
      const float s = red[(0 * 8 + b) * 64 + cc] + red[(1 * 8 + b) * 64 + cc] + red[(2 * 8 + b) * 64 + cc] + red[(3 * 8 + b) * 64 + cc];
      const int cg_ = cch * 64 + cc;
      ((float*)(ws + O_MOD))[(layer * 8 + b) * 6144 + cg_] = s + p.in[I_ADAB][layer * 6144 + cg_];
    }
    __syncthreads();
    return;
  }
  item -= PREP_MOD;
  if (item < PREP_ROPE) {
    const int e = item * 256 + tid;
    const int t = e >> 5, i = e & 31;
    const float inv = powf(10000.f, -(float)i / 32.f);
    const float ang = (float)t * inv;
    float* rp = (float*)(ws + O_ROPE);
    rp[e] = cosf(ang);
    rp[65536 + e] = sinf(ang);
    return;
  }
  item -= PREP_ROPE;
  if (item < PREP_MISC) {
    if (item == 3) return;
    if (item < 2) {
      const int j = item, n = tid;
      const float* pos = p.in[I_CPOS] + j * 2048;
      const float* w1 = p.in[I_CW1] + (size_t)j * 2048 * 256 + n;
      float s = 0.f;
      for (int k = 0; k < 2048; ++k) s += pos[k] * w1[(size_t)k * 256];
      ((float*)(ws + O_BIAS1))[j * 256 + n] = s;
    } else {
      int* cnt = (int*)(ws + O_CNT);
      for (int i = tid; i < 2 * 16 * 64; i += 256) cnt[i] = 0;
      uint4* vct = (uint4*)(ws + O_VCT);
      for (int i = tid; i < 8 * 2 * 64 * 128 * 2 / 16; i += 256) vct[i] = make_uint4(0, 0, 0, 0);
      unsigned* barw = (unsigned*)(ws + O_BAR);
      for (int i = tid; i < XCD_BAR_WORDS; i += 256) barw[i] = 0u;
      uint4 z = make_uint4(0, 0, 0, 0);
      uint4* wpad = (uint4*)(ws + O_WEIN + (size_t)2840 * 1024 * 2);
      for (int i = tid; i < (PW0 - 2840) * 1024 * 2 / 16; i += 256) wpad[i] = z;
      for (int j = 0; j < 2; ++j) {
        uint4* cp = (uint4*)(ws + O_WC2 + ((size_t)j * 128 + 64) * 256 * 2);
        for (int i = tid; i < 64 * 256 * 2 / 16; i += 256) cp[i] = z;
      }
    }
    return;
  }
}

template <int MODE, bool ROUTER>
DI void norm_phase(const Params& p, char* smem, const float* xin, float* xout, const float* nw, const float* modl,
                   int sh_off, int sc_off, int g_off, int layer) {
  char* ws = p.ws;
  const int tid = tid_opaque(), lane = tid & 63, wid = tid >> 6;
  bfr* HB = (bfr*)(ws + O_HB);
  const bfr* MO0 = (const bfr*)(ws + O_MOEOUT);
  const bfr* MO1 = MO0 + (size_t)NT * 1024;
  int* lcnt = (int*)smem;
  int* lbase = lcnt + 16;
  int* lexp = lbase + 16;
  int* lrank = lexp + 64;
  for (int chunk = VB; chunk < NT / 32; chunk += NVB) {
    if (ROUTER) {
      if (tid < 16) lcnt[tid] = 0;
      __syncthreads();
    }
    for (int it = 0; it < 8; ++it) {
      const int row = chunk * 32 + it * 4 + wid;
      const int b = row >> 11;
      float v[16];
      float ss = 0.f;
#pragma unroll
      for (int i = 0; i < 2; ++i) {
        const int c = (i * 64 + lane) * 8;
        float4 x0 = *(const float4*)(xin + (size_t)row * 1024 + c), x1 = *(const float4*)(xin + (size_t)row * 1024 + c + 4);
        if (MODE >= 1) {
          const float4 g0 = *(const float4*)(modl + b * 6144 + g_off + c), g1 = *(const float4*)(modl + b * 6144 + g_off + c + 4);
          const uint4 m0 = *(const uint4*)(MO0 + (size_t)row * 1024 + c);
          const uint4 m1 = *(const uint4*)(MO1 + (size_t)row * 1024 + c);
          x0.x += g0.x * (lo2f(m0.x) + lo2f(m1.x)); x0.y += g0.y * (hi2f(m0.x) + hi2f(m1.x));
          x0.z += g0.z * (lo2f(m0.y) + lo2f(m1.y)); x0.w += g0.w * (hi2f(m0.y) + hi2f(m1.y));
          x1.x += g1.x * (lo2f(m0.z) + lo2f(m1.z)); x1.y += g1.y * (hi2f(m0.z) + hi2f(m1.z));
          x1.z += g1.z * (lo2f(m0.w) + lo2f(m1.w)); x1.w += g1.w * (hi2f(m0.w) + hi2f(m1.w));
          if (MODE == 1) { *(float4*)(xout + (size_t)row * 1024 + c) = x0; *(float4*)(xout + (size_t)row * 1024 + c + 4) = x1; }
        }
        v[i * 8 + 0] = x0.x; v[i * 8 + 1] = x0.y; v[i * 8 + 2] = x0.z; v[i * 8 + 3] = x0.w;
        v[i * 8 + 4] = x1.x; v[i * 8 + 5] = x1.y; v[i * 8 + 6] = x1.z; v[i * 8 + 7] = x1.w;
        ss += x0.x * x0.x + x0.y * x0.y + x0.z * x0.z + x0.w * x0.w + x1.x * x1.x + x1.y * x1.y + x1.z * x1.z + x1.w * x1.w;
      }
      ss = wave_sum(ss);
      const float rstd = rsqrtf(ss * (1.f / 1024.f) + 1e-6f);
#pragma unroll
      for (int i = 0; i < 2; ++i) {
        const int c = (i * 64 + lane) * 8;
        const float4 w0 = *(const float4*)(nw + c), w1 = *(const float4*)(nw + c + 4);
        const float wv[8] = {w0.x, w0.y, w0.z, w0.w, w1.x, w1.y, w1.z, w1.w};
        if (MODE == 2) {
          float4 o0, o1;
          o0.x = v[i * 8 + 0] * rstd * wv[0]; o0.y = v[i * 8 + 1] * rstd * wv[1]; o0.z = v[i * 8 + 2] * rstd * wv[2]; o0.w = v[i * 8 + 3] * rstd * wv[3];
          o1.x = v[i * 8 + 4] * rstd * wv[4]; o1.y = v[i * 8 + 5] * rstd * wv[5]; o1.z = v[i * 8 + 6] * rstd * wv[6]; o1.w = v[i * 8 + 7] * rstd * wv[7];
          *(float4*)(xout + (size_t)row * 1024 + c) = o0; *(float4*)(xout + (size_t)row * 1024 + c + 4) = o1;
        } else {
          const float4 sc0 = *(const float4*)(modl + b * 6144 + sc_off + c), sc1 = *(const float4*)(modl + b * 6144 + sc_off + c + 4);
          const float4 sh0 = *(const float4*)(modl + b * 6144 + sh_off + c), sh1 = *(const float4*)(modl + b * 6144 + sh_off + c + 4);
          const float scv[8] = {sc0.x, sc0.y, sc0.z, sc0.w, sc1.x, sc1.y, sc1.z, sc1.w};
          const float shv[8] = {sh0.x, sh0.y, sh0.z, sh0.w, sh1.x, sh1.y, sh1.z, sh1.w};
#pragma unroll
          for (int q = 0; q < 8; ++q) v[i * 8 + q] = v[i * 8 + q] * rstd * wv[q] * (1.f + scv[q]) + shv[q];
          *(uint4*)(HB + (size_t)row * 1024 + c) = make_uint4(pack2(v[i * 8 + 0], v[i * 8 + 1]), pack2(v[i * 8 + 2], v[i * 8 + 3]),
                                                                pack2(v[i * 8 + 4], v[i * 8 + 5]), pack2(v[i * 8 + 6], v[i * 8 + 7]));
        }
      }
      if (ROUTER) {
        const float* rw = p.in[I_RTW];
        float sc[16], bi[16];
#pragma unroll
        for (int eh = 0; eh < 2; ++eh) {
          float lg[8];
#pragma unroll
          for (int e = 0; e < 8; ++e) lg[e] = 0.f;
#pragma unroll
          for (int i = 0; i < 4; ++i) {
#pragma unroll
            for (int q = 0; q < 4; ++q) {
              const int c = (i * 64 + lane) * 4 + q;
              const float4 w0 = *(const float4*)(rw + c * 16 + eh * 8), w1 = *(const float4*)(rw + c * 16 + eh * 8 + 4);
              const float h = v[i * 4 + q];
              lg[0] += h * w0.x; lg[1] += h * w0.y; lg[2] += h * w0.z; lg[3] += h * w0.w;
              lg[4] += h * w1.x; lg[5] += h * w1.y; lg[6] += h * w1.z; lg[7] += h * w1.w;
            }
            __builtin_amdgcn_sched_barrier(0);
          }
#pragma unroll
          for (int e = 0; e < 8; ++e) {
            const float lgv = wave_sum(lg[e]);
            sc[eh * 8 + e] = 1.f / (1.f + __expf(-lgv));
            bi[eh * 8 + e] = sc[eh * 8 + e] + p.in[I_RTB][eh * 8 + e];
          }
        }
        int tg = 0; float best = -3.0e38f;
#pragma unroll
        for (int g = 0; g < 4; ++g) {
          float m1 = -3.0e38f, m2 = -3.0e38f;
#pragma unroll
          for (int j = 0; j < 4; ++j) {
            const float x = bi[g * 4 + j];
            if (x > m1) { m2 = m1; m1 = x; } else if (x > m2) { m2 = x; }
          }
          const float gs = m1 + m2;
          if (gs > best) { best = gs; tg = g; }
        }
        int i0 = -1, i1 = -1; float b0 = -3.0e38f, b1 = -3.0e38f, s0 = 0.f, s1 = 0.f;
#pragma unroll
        for (int e = 0; e < 16; ++e) {
          if ((e >> 2) == tg) {
            const float x = bi[e];
            if (x > b0) { b1 = b0; i1 = i0; s1 = s0; b0 = x; i0 = e; s0 = sc[e]; }
            else if (x > b1) { b1 = x; i1 = e; s1 = sc[e]; }
          }
        }
        if (lane == 0) {
          const float inv = 1.f / (s0 + s1);
          float* topw = (float*)(ws + O_TOPW);
          topw[row * 2 + 0] = s0 * inv;
          topw[row * 2 + 1] = s1 * inv;
          const int a = (it * 4 + wid) * 2;
          lexp[a] = i0; lrank[a] = atomicAdd(&lcnt[i0], 1);
          lexp[a + 1] = i1; lrank[a + 1] = atomicAdd(&lcnt[i1], 1);
        }
      }
    }
    if (ROUTER) {
      __syncthreads();
      int* cnt = (int*)(ws + O_CNT) + layer * 16 * 64;
      if (tid < 16) lbase[tid] = atomicAdd(&cnt[tid * 64], lcnt[tid]);
      __syncthreads();
      if (tid < 64) {
        const int e = lexp[tid];
        const int slot = lbase[e] + lrank[tid];
        ((int*)(ws + O_LIST))[(size_t)e * NT + slot] = (chunk * 32 + (tid >> 1)) * 2 + (tid & 1);
      }
      __syncthreads();
    }
  }
}

constexpr int NR = 2;
DI void norm_router_phase(const Params& p, char* smem_all, const float* xin, const float* nw, const float* modl, int sh_off, int sc_off, int layer) {
  char* ws = p.ws;
  const int tid = tid_opaque(), lane = tid & 63, wid = tid >> 6;
  bfr* HB = (bfr*)(ws + O_HB);
  float* rwl = (float*)smem_all;
  {
    const float* rwg = p.in[I_RTW];
    for (int idx = threadIdx.x; idx < 16384; idx += 512) {
      const int e3 = idx & 3, ln = (idx >> 2) & 63, eq = (idx >> 8) & 3, iq = idx >> 10;
      const int c = ((iq >> 3) * 64 + ln) * 8 + (iq & 7);
      rwl[idx] = rwg[c * 16 + eq * 4 + e3];
    }
  }
  char* smem = smem_all + 65536 + (threadIdx.x >> 8) * 4096;
  __syncthreads();
  int* lcnt = (int*)smem;
  int* lbase = lcnt + 16;
  int* lexp = lbase + 16;
  int* lrank = lexp + 64;
  for (int chunk = VB; chunk < NT / 32; chunk += NVB) {
    if (tid < 16) lcnt[tid] = 0;
    __syncthreads();
#pragma unroll 1
    for (int it2 = 0; it2 < 8 / NR; ++it2) {
      const int row0 = chunk * 32 + wid * 8 + it2 * NR;
      const int b = row0 >> 11;
      float v[NR][16];
      float ss[NR];
#pragma unroll
      for (int rr = 0; rr < NR; ++rr) {
        ss[rr] = 0.f;
#pragma unroll
        for (int i = 0; i < 2; ++i) {
          const float* xp = xin + (size_t)(row0 + rr) * 1024 + (i * 64 + lane) * 8;
          const float4 x0 = *(const float4*)xp, x1 = *(const float4*)(xp + 4);
          v[rr][i * 8 + 0] = x0.x; v[rr][i * 8 + 1] = x0.y; v[rr][i * 8 + 2] = x0.z; v[rr][i * 8 + 3] = x0.w;
          v[rr][i * 8 + 4] = x1.x; v[rr][i * 8 + 5] = x1.y; v[rr][i * 8 + 6] = x1.z; v[rr][i * 8 + 7] = x1.w;
          ss[rr] += x0.x * x0.x + x0.y * x0.y + x0.z * x0.z + x0.w * x0.w + x1.x * x1.x + x1.y * x1.y + x1.z * x1.z + x1.w * x1.w;
        }
      }
#pragma unroll
      for (int rr = 0; rr < NR; ++rr) ss[rr] = rsqrtf(wave_sum(ss[rr]) * (1.f / 1024.f) + 1e-6f);
#pragma unroll
      for (int i = 0; i < 2; ++i) {
        const int c = (i * 64 + lane) * 8;
        const float4 w0 = *(const float4*)(nw + c), w1 = *(const float4*)(nw + c + 4);
        const float4 sc0 = *(const float4*)(modl + b * 6144 + sc_off + c), sc1 = *(const float4*)(modl + b * 6144 + sc_off + c + 4);
        const float4 sh0 = *(const float4*)(modl + b * 6144 + sh_off + c), sh1 = *(const float4*)(modl + b * 6144 + sh_off + c + 4);
        const float wv[8] = {w0.x * (1.f + sc0.x), w0.y * (1.f + sc0.y), w0.z * (1.f + sc0.z), w0.w * (1.f + sc0.w),
                             w1.x * (1.f + sc1.x), w1.y * (1.f + sc1.y), w1.z * (1.f + sc1.z), w1.w * (1.f + sc1.w)};
        const float shv[8] = {sh0.x, sh0.y, sh0.z, sh0.w, sh1.x, sh1.y, sh1.z, sh1.w};
#pragma unroll
        for (int rr = 0; rr < NR; ++rr) {
#pragma unroll
          for (int q = 0; q < 8; ++q) v[rr][i * 8 + q] = v[rr][i * 8 + q] * ss[rr] * wv[q] + shv[q];
          *(uint4*)(HB + (size_t)(row0 + rr) * 1024 + c) = make_uint4(pack2(v[rr][i * 8 + 0], v[rr][i * 8 + 1]), pack2(v[rr][i * 8 + 2], v[rr][i * 8 + 3]),
                                                                          pack2(v[rr][i * 8 + 4], v[rr][i * 8 + 5]), pack2(v[rr][i * 8 + 6], v[rr][i * 8 + 7]));
        }
      }
      float* sgl = (float*)(smem + 1024) + wid * 64;
#pragma unroll 1
      for (int eh = 0; eh < 2; ++eh) {
        float lg[NR][8];
#pragma unroll
        for (int rr = 0; rr < NR; ++rr)
#pragma unroll
          for (int e = 0; e < 8; ++e) lg[rr][e] = 0.f;
#pragma unroll
        for (int i = 0; i < 4; ++i) {
#pragma unroll
          for (int q = 0; q < 4; ++q) {
            const int iq = (i >> 1) * 8 + (i & 1) * 4 + q;
            const float4 w0 = *(const float4*)(rwl + ((iq * 4 + eh * 2) * 64 + lane) * 4), w1 = *(const float4*)(rwl + ((iq * 4 + eh * 2 + 1) * 64 + lane) * 4);
#pragma unroll
            for (int rr = 0; rr < NR; ++rr) {
              const float h = v[rr][i * 4 + q];
              lg[rr][0] += h * w0.x; lg[rr][1] += h * w0.y; lg[rr][2] += h * w0.z; lg[rr][3] += h * w0.w;
              lg[rr][4] += h * w1.x; lg[rr][5] += h * w1.y; lg[rr][6] += h * w1.z; lg[rr][7] += h * w1.w;
            }
          }
          __builtin_amdgcn_sched_barrier(0);
        }
#pragma unroll
        for (int rr = 0; rr < NR; ++rr)
#pragma unroll
          for (int e = 0; e < 8; ++e) {
            const float sv = 1.f / (1.f + __expf(-wave_sum(lg[rr][e])));
            if (lane == 0) sgl[rr * 16 + eh * 8 + e] = sv;
          }
      }
      __builtin_amdgcn_fence(__ATOMIC_RELEASE, "wavefront");
      __builtin_amdgcn_wave_barrier();
#pragma unroll
      for (int rr = 0; rr < NR; ++rr) {
        float bi[16], sgv[16];
#pragma unroll
        for (int e = 0; e < 16; ++e) { sgv[e] = sgl[rr * 16 + e]; bi[e] = sgv[e] + p.in[I_RTB][e]; }
        int tg = 0; float best = -3.0e38f;
#pragma unroll
        for (int g = 0; g < 4; ++g) {
          float m1 = -3.0e38f, m2 = -3.0e38f;
#pragma unroll
          for (int j = 0; j < 4; ++j) {
            const float x = bi[g * 4 + j];
            if (x > m1) { m2 = m1; m1 = x; } else if (x > m2) { m2 = x; }
          }
          const float gs = m1 + m2;
          if (gs > best) { best = gs; tg = g; }
        }
        int i0 = -1, i1 = -1; float b0 = -3.0e38f, b1 = -3.0e38f, s0 = 0.f, s1 = 0.f;
#pragma unroll
        for (int e = 0; e < 16; ++e) {
          if ((e >> 2) == tg) {
            const float x = bi[e];
            if (x > b0) { b1 = b0; i1 = i0; s1 = s0; b0 = x; i0 = e; s0 = sgv[e]; }
            else if (x > b1) { b1 = x; i1 = e; s1 = sgv[e]; }
          }
        }
        if (lane == 0) {
          const int row = row0 + rr;
          const float inv = 1.f / (s0 + s1);
          float* topw = (float*)(ws + O_TOPW);
          topw[row * 2 + 0] = s0 * inv;
          topw[row * 2 + 1] = s1 * inv;
          const int a = (wid * 8 + it2 * NR + rr) * 2;
          lexp[a] = i0; lrank[a] = atomicAdd(&lcnt[i0], 1);
          lexp[a + 1] = i1; lrank[a + 1] = atomicAdd(&lcnt[i1], 1);
        }
      }
    }
    __syncthreads();
    int* cnt = (int*)(ws + O_CNT) + layer * 16 * 64;
    if (tid < 16) lbase[tid] = atomicAdd(&cnt[tid * 64], lcnt[tid]);
    __syncthreads();
    if (tid < 64) {
      const int e = lexp[tid];
      const int slot = lbase[e] + lrank[tid];
      ((int*)(ws + O_LIST))[(size_t)e * NT + slot] = (chunk * 32 + (tid >> 1)) * 2 + (tid & 1);
    }
    __syncthreads();
  }
}

template <int NS>
DI void gemm_proj_phase(const Params& p, char* smem_all, const bfr* Wt, int ncols_pad, bfr* out) {
  const bfr* HB = (const bfr*)(p.ws + O_HB);
  constexpr int TN = NS * 64;
  const int n_nt = ncols_pad / TN;
  const int ntiles = (NT / 256) * n_nt;
  for (int tile = blockIdx.x; tile < ntiles; tile += gridDim.x) {
    const int mt = tile / n_nt, nt = tile % n_nt;
    Rows256 A{HB + (size_t)mt * 256 * 1024, 1024, 255};
    Rows256 B{Wt + (size_t)nt * TN * 1024, 1024, TN - 1};
    gemm_tile_256<NS>(smem_all, 32, A, B, [&](f32x4(&acc)[8][NS], int wr, int wc, int fr, int fq) {
#pragma unroll
      for (int m = 0; m < 8; ++m) {
        const int row = mt * 256 + wr * 128 + m * 16 + fr;
#pragma unroll
        for (int n = 0; n < NS; ++n) {
          const int col = nt * TN + wc * (NS * 16) + n * 16 + fq * 4;
          *(uint2*)(out + (size_t)row * ncols_pad + col) = make_uint2(pack2(acc[m][n][0], acc[m][n][1]), pack2(acc[m][n][2], acc[m][n][3]));
        }
      }
    });
  }
}

DI void gemm_out_phase(const Params& p, char* smem_all, const bfr* Wt, const float* xin, float* xout, const float* gate  ) {
  const bfr* MIX = (const bfr*)(p.ws + O_MIX);
  const int ntiles = (NT / 256) * 4;
  for (int tile = blockIdx.x; tile < ntiles; tile += gridDim.x) {
    const int mt = tile / 4, nt = tile % 4;
    Rows256 A{MIX + (size_t)mt * 256 * 1024, 1024, 255};
    Rows256 B{Wt + (size_t)nt * 256 * 1024, 1024, 255};
    const int b = (mt * 256) >> 11;
    gemm_tile_256<4>(smem_all, 32, A, B, [&](f32x4(&acc)[8][4], int wr, int wc, int fr, int fq) {
#pragma unroll
      for (int n = 0; n < 4; ++n) {
        const int col = nt * 256 + wc * 64 + n * 16 + fq * 4;
        const float4 g = *(const float4*)(gate + b * 6144 + col);
#pragma unroll
        for (int m = 0; m < 8; ++m) {
          const int row = mt * 256 + wr * 128 + m * 16 + fr;
          const float4 xi = *(const float4*)(xin + (size_t)row * 1024 + col);
          float4 o;
          o.x = xi.x + g.x * acc[m][n][0]; o.y = xi.y + g.y * acc[m][n][1]; o.z = xi.z + g.z * acc[m][n][2]; o.w = xi.w + g.w * acc[m][n][3];
          *(float4*)(xout + (size_t)row * 1024 + col) = o;
        }
      }
    });
  }
}

struct RowsCmp {
  const bfr* proj; int colbase; int mt;
  const bfr* rp[2];
  DI void init(int lr) {
#pragma unroll
    for (int i = 0; i < 2; ++i) {
      int rr = mt * 128 + lr + 64 * i; if (rr > 2031) rr = 2031;
      const int h = rr & 1, bn = rr >> 1, b = bn / 127, nc = bn % 127;
      rp[i] = proj + (size_t)(b * SEQ + nc * 16) * PW0 + colbase + h * 64;
    }
  }
  DI uint4 load(int sel, int k) const { return *(const uint4*)(rp[sel] + (k >> 6) * PW0 + (k & 63)); }
  DI const bfr* ptr(int sel, int k) const { return rp[sel] + (k >> 6) * PW0 + (k & 63); }
};

DI float gelu_tanh(float x) {
  const float u = 0.7978845608028654f * (x + 0.044715f * x * x * x);
  return 0.5f * x * (1.f + tanhf(u));
}

DI void post0_phase(const Params& p, char* smem) {
  char* ws = p.ws;
  const bfr* PROJ = (const bfr*)(ws + O_PROJ);
  const int tid = tid_opaque();
  for (int tile = VB; tile < 64; tile += NVB) {
    const int j = tile >> 5, mt = (tile >> 1) & 15, nt = tile & 1;
    RowsCmp A{PROJ, j ? C_VC : C_KC, mt};
    RowsContig B{(const bfr*)(ws + O_WC1) + ((size_t)j * 256 + nt * 128) * 2048, 2048, 127};
    bfr* CH = (bfr*)(ws + O_CH) + (size_t)j * 2048 * 256;
    const float* bias = (const float*)(ws + O_BIAS1) + j * 256;
    gemm_tile_g(smem, 64, A, B, [&](f32x4(&acc)[4][4], int wr, int wc, int fr, int fq) {
#pragma unroll
      for (int m = 0; m < 4; ++m) {
        const int row = mt * 128 + wr * 64 + m * 16 + fr;
#pragma unroll
        for (int n = 0; n < 4; ++n) {
          const int col = nt * 128 + wc * 64 + n * 16 + fq * 4;
          const float4 bb = *(const float4*)(bias + col);
          *(uint2*)(CH + (size_t)row * 256 + col) = make_uint2(pack2(gelu_tanh(acc[m][n][0] + bb.x), gelu_tanh(acc[m][n][1] + bb.y)),
                                                               pack2(gelu_tanh(acc[m][n][2] + bb.z), gelu_tanh(acc[m][n][3] + bb.w)));
        }
      }
    });
  }
  {
    bfr(*tt)[66] = (bfr(*)[66])smem;
    for (int item = VB; item < 1024; item += NVB) {
      const int tl = item & 31, hk = (item >> 5) & 1, which = (item >> 6) & 1, b = item >> 7;
      const bfr* src = PROJ + (size_t)(b * SEQ + tl * 64) * PW0 + (which ? C_VW : C_VS) + hk * 64;
      bfr* dst = (bfr*)(ws + (which ? O_VWT : O_VST)) + (size_t)((b * 2 + hk) * 64) * SEQ + tl * 64;
      for (int e = tid; e < 64 * 32; e += 256) {
        const int row = e >> 5, c2 = (e & 31) * 2;
        const unsigned u = *(const unsigned*)(src + (size_t)row * PW0 + c2);
        tt[row][c2] = (bfr)(u & 0xffffu); tt[row][c2 + 1] = (bfr)(u >> 16);
      }
      __syncthreads();
      for (int e = tid; e < 64 * 32; e += 256) {
        const int d = e >> 5, t2 = (e & 31) * 2;
        const unsigned u = (unsigned)tt[t2][d] | ((unsigned)tt[t2 + 1][d] << 16);
        *(unsigned*)(dst + (size_t)d * SEQ + t2) = u;
      }
      __syncthreads();
    }
  }
  const float* ropec = (const float*)(ws + O_ROPE);
  const float* ropes = ropec + 65536;
  bfr* QR = (bfr*)(ws + O_QR);
  bfr* KSR = (bfr*)(ws + O_KSR);
  bfr* KWR = (bfr*)(ws + O_KWR);
  bfr* MIX = (bfr*)(ws + O_MIX);
  const float* cw = p.in[I_CONVW];
  for (int item = VB; item < NT / 8; item += NVB) {
    for (int e = tid; e < 8 * 48; e += 256) {
      const int tt = e / 48, u = e % 48;
      const int tok = item * 8 + tt, t = tok & (SEQ - 1);
      const int hh = u >> 2, i0 = (u & 3) * 8;
      const bfr* src; bfr* dst;
      if (hh < 8) { src = PROJ + (size_t)tok * PW0 + C_Q + hh * 64; dst = QR + (size_t)tok * 512 + hh * 64; }
      else if (hh < 10) { src = PROJ + (size_t)tok * PW0 + C_KS + (hh - 8) * 64; dst = KSR + (size_t)tok * 128 + (hh - 8) * 64; }
      else { src = PROJ + (size_t)tok * PW0 + C_KW + (hh - 10) * 64; dst = KWR + (size_t)tok * 128 + (hh - 10) * 64; }
      const uint4 x1 = *(const uint4*)(src + i0), x2 = *(const uint4*)(src + 32 + i0);
      const float4 c0 = *(const float4*)(ropec + t * 32 + i0), c1 = *(const float4*)(ropec + t * 32 + i0 + 4);
      const float4 s0 = *(const float4*)(ropes + t * 32 + i0), s1 = *(const float4*)(ropes + t * 32 + i0 + 4);
      const float a[8] = {lo2f(x1.x), hi2f(x1.x), lo2f(x1.y), hi2f(x1.y), lo2f(x1.z), hi2f(x1.z), lo2f(x1.w), hi2f(x1.w)};
      const float bq[8] = {lo2f(x2.x), hi2f(x2.x), lo2f(x2.y), hi2f(x2.y), lo2f(x2.z), hi2f(x2.z), lo2f(x2.w), hi2f(x2.w)};
      const float cc[8] = {c0.x, c0.y, c0.z, c0.w, c1.x, c1.y, c1.z, c1.w};
      const float ss[8] = {s0.x, s0.y, s0.z, s0.w, s1.x, s1.y, s1.z, s1.w};
      float o1[8], o2[8];
#pragma unroll
      for (int i = 0; i < 8; ++i) { o1[i] = a[i] * cc[i] - bq[i] * ss[i]; o2[i] = bq[i] * cc[i] + a[i] * ss[i]; }
      *(uint4*)(dst + i0) = make_uint4(pack2(o1[0], o1[1]), pack2(o1[2], o1[3]), pack2(o1[4], o1[5]), pack2(o1[6], o1[7]));
      *(uint4*)(dst + 32 + i0) = make_uint4(pack2(o2[0], o2[1]), pack2(o2[2], o2[3]), pack2(o2[4], o2[5]), pack2(o2[6], o2[7]));
    }
    for (int e = tid; e < 8 * 64; e += 256) {
      const int tt = e >> 6, ch = (e & 63) * 8;
      const int tok = item * 8 + tt, t = tok & (SEQ - 1);
      const bfr* pr = PROJ + (size_t)tok * PW0;
      float u0[8], u1[8], u2[8], bgv[8];
      {
        const uint4 cg = *(const uint4*)(pr + C_CG + ch), xb = *(const uint4*)(pr + C_XB + ch), bg = *(const uint4*)(pr + C_BG + ch);
        u0[0] = lo2f(cg.x) * lo2f(xb.x); u0[1] = hi2f(cg.x) * hi2f(xb.x); u0[2] = lo2f(cg.y) * lo2f(xb.y); u0[3] = hi2f(cg.y) * hi2f(xb.y);
        u0[4] = lo2f(cg.z) * lo2f(xb.z); u0[5] = hi2f(cg.z) * hi2f(xb.z); u0[6] = lo2f(cg.w) * lo2f(xb.w); u0[7] = hi2f(cg.w) * hi2f(xb.w);
        bgv[0] = lo2f(bg.x); bgv[1] = hi2f(bg.x); bgv[2] = lo2f(bg.y); bgv[3] = hi2f(bg.y);
        bgv[4] = lo2f(bg.z); bgv[5] = hi2f(bg.z); bgv[6] = lo2f(bg.w); bgv[7] = hi2f(bg.w);
      }
#pragma unroll
      for (int i = 0; i < 8; ++i) { u1[i] = 0.f; u2[i] = 0.f; }
      if (t >= 1) {
        const uint4 cg = *(const uint4*)(pr - PW0 + C_CG + ch), xb = *(const uint4*)(pr - PW0 + C_XB + ch);
        u1[0] = lo2f(cg.x) * lo2f(xb.x); u1[1] = hi2f(cg.x) * hi2f(xb.x); u1[2] = lo2f(cg.y) * lo2f(xb.y); u1[3] = hi2f(cg.y) * hi2f(xb.y);
        u1[4] = lo2f(cg.z) * lo2f(xb.z); u1[5] = hi2f(cg.z) * hi2f(xb.z); u1[6] = lo2f(cg.w) * lo2f(xb.w); u1[7] = hi2f(cg.w) * hi2f(xb.w);
      }
      if (t >= 2) {
        const uint4 cg = *(const uint4*)(pr - 2 * PW0 + C_CG + ch), xb = *(const uint4*)(pr - 2 * PW0 + C_XB + ch);
        u2[0] = lo2f(cg.x) * lo2f(xb.x); u2[1] = hi2f(cg.x) * hi2f(xb.x); u2[2] = lo2f(cg.y) * lo2f(xb.y); u2[3] = hi2f(cg.y) * hi2f(xb.y);
        u2[4] = lo2f(cg.z) * lo2f(xb.z); u2[5] = hi2f(cg.z) * hi2f(xb.z); u2[6] = lo2f(cg.w) * lo2f(xb.w); u2[7] = hi2f(cg.w) * hi2f(xb.w);
      }
      float y[8];
#pragma unroll
      for (int i = 0; i < 8; ++i) y[i] = bgv[i] * (cw[2 * 512 + ch + i] * u0[i] + cw[1 * 512 + ch + i] * u1[i] + cw[0 * 512 + ch + i] * u2[i]);
      *(uint4*)(MIX + (size_t)tok * 1024 + 512 + ch) = make_uint4(pack2(y[0], y[1]), pack2(y[2], y[3]), pack2(y[4], y[5]), pack2(y[6], y[7]));
    }
  }
}

DI void cmp2_phase(const Params& p, char* smem) {
  char* ws = p.ws;
  for (int tile = VB; tile < 32; tile += NVB) {
    const int j = tile >> 4, mt = tile & 15;
    RowsContig A{(const bfr*)(ws + O_CH) + ((size_t)j * 2048 + mt * 128) * 256, 256, 127};
    RowsContig B{(const bfr*)(ws + O_WC2) + (size_t)j * 128 * 256, 256, 127};
    bfr* KC = (bfr*)(ws + O_KCVC) + (size_t)j * 2048 * 64;
    gemm_tile(smem, 8, A, B, [&](f32x4(&acc)[4][4], int wr, int wc, int fr, int fq) {
      if (wc == 0) {
#pragma unroll
        for (int m = 0; m < 4; ++m)
#pragma unroll
          for (int n = 0; n < 4; ++n)
#pragma unroll
            for (int jj = 0; jj < 4; ++jj) {
              const int row = mt * 128 + wr * 64 + m * 16 + fq * 4 + jj, col = n * 16 + fr;
              const bfr hv = f2bf(acc[m][n][jj]);
              KC[(size_t)row * 64 + col] = hv;
              if (j == 1 && row < 2032) {
                const int hk = row & 1, bn = row >> 1, bb = bn / 127, cc = bn % 127;
                ((bfr*)(ws + O_VCT))[((size_t)((bb * 2 + hk) * 64 + col)) * 128 + cc] = hv;
              }
            }
      }
    });
  }
}

DI void cmp_attn_phase(const Params& p, char* smem) {
  char* ws = p.ws;
  const bfr* PROJ = (const bfr*)(ws + O_PROJ);
  const bfr* KC = (const bfr*)(ws + O_KCVC);
  const bfr* VC = KC + 2048 * 64;
  bfr* OCMP = (bfr*)(ws + O_OCMP);
  unsigned* SEL = (unsigned*)(ws + O_SEL);
  const int tid = tid_opaque();
  for (int item = VB; item < NT / 32; item += NVB) {
    const int tok = item * 32 + (tid >> 3), head = tid & 7, hkv = head >> 2;
    const int b = tok >> 11, t = tok & (SEQ - 1);
    const int nv = t >= 31 ? ((t - 31) >> 4) + 1 : 0;
    unsigned q[32];
    {
      const uint4* qp = (const uint4*)(PROJ + (size_t)tok * PW0 + C_Q + head * 64);
#pragma unroll
      for (int i = 0; i < 8; ++i) { const uint4 u = qp[i]; q[i * 4] = u.x; q[i * 4 + 1] = u.y; q[i * 4 + 2] = u.z; q[i * 4 + 3] = u.w; }
    }
    const bfr* kb = KC + ((size_t)(b * 127) * 2 + hkv) * 64;
    const bfr* vb = VC + ((size_t)(b * 127) * 2 + hkv) * 64;
    auto dotk = [&](int c) {
      const uint4* kp = (const uint4*)(kb + (size_t)c * 128);
      float a = 0.f;
#pragma unroll
      for (int i = 0; i < 8; ++i) {
        const uint4 u = kp[i];
        a = dot2(q[i * 4], u.x, a); a = dot2(q[i * 4 + 1], u.y, a); a = dot2(q[i * 4 + 2], u.z, a); a = dot2(q[i * 4 + 3], u.w, a);
      }
      return a * 0.125f;
    };
    float mx = -1e30f;
    for (int c = 0; c < nv; ++c) mx = fmaxf(mx, dotk(c));
    float o[64];
#pragma unroll
    for (int i = 0; i < 64; ++i) o[i] = 0.f;
    float l = 0.f;
    for (int c = 0; c < nv; ++c) {
      const float pe = __expf(dotk(c) - mx);
      l += pe;
      const uint4* vp = (const uint4*)(vb + (size_t)c * 128);
#pragma unroll
      for (int i = 0; i < 8; ++i) {
        const uint4 u = vp[i];
        o[i * 8 + 0] += pe * lo2f(u.x); o[i * 8 + 1] += pe * hi2f(u.x);
        o[i * 8 + 2] += pe * lo2f(u.y); o[i * 8 + 3] += pe * hi2f(u.y);
        o[i * 8 + 4] += pe * lo2f(u.z); o[i * 8 + 5] += pe * hi2f(u.z);
        o[i * 8 + 6] += pe * lo2f(u.w); o[i * 8 + 7] += pe * hi2f(u.w);
      }
    }
    const float invl = nv > 0 ? 1.f / l : 0.f;
    {
      const float gl = bf2f(PROJ[(size_t)tok * PW0 + C_GL + head * 3 + 0]);
      const float g0 = sigmoidf_(gl) * invl;
      uint4* op = (uint4*)(OCMP + (size_t)tok * 512 + head * 64);
#pragma unroll
      for (int i = 0; i < 8; ++i) {
        uint4 u;
        u.x = pack2(o[i * 8 + 0] * g0, o[i * 8 + 1] * g0); u.y = pack2(o[i * 8 + 2] * g0, o[i * 8 + 3] * g0);
        u.z = pack2(o[i * 8 + 4] * g0, o[i * 8 + 5] * g0); u.w = pack2(o[i * 8 + 6] * g0, o[i * 8 + 7] * g0);
        op[i] = u;
      }
    }
    const int cur = t >> 6;
    float tv0 = -1.f, tv1 = -1.f, tv2 = -1.f, tv3 = -1.f, tv4 = -1.f;
    int ti0 = -1, ti1 = -1, ti2 = -1, ti3 = -1, ti4 = -1;
    float part = 0.f;
    int curmax = cur;
#pragma unroll
    for (int o2 = 32; o2 > 0; o2 >>= 1) curmax = max(curmax, __shfl_xor(curmax, o2));
#pragma unroll 1
    for (int j = 0; j <= curmax + 1 && j <= 32; ++j) {
      float e[4];
#pragma unroll
      for (int oo = 0; oo < 4; ++oo) {
        const int c = j * 4 + oo;
        float pe = 0.f;
        if (c < nv) pe = __expf(dotk(c) - mx) * invl;
        pe += __shfl_xor(pe, 1);
        pe += __shfl_xor(pe, 2);
        e[oo] = pe;
      }
      if (j >= 1) {
        const float val = part + e[0];
        const int jb = j - 1;
        if (jb >= 1 && jb <= cur - 2) {
          if (val > tv4) {
            tv4 = val; ti4 = jb;
            if (tv4 > tv3) { float tf = tv3; tv3 = tv4; tv4 = tf; int tii = ti3; ti3 = ti4; ti4 = tii; }
            if (tv3 > tv2) { float tf = tv2; tv2 = tv3; tv3 = tf; int tii = ti2; ti2 = ti3; ti3 = tii; }
            if (tv2 > tv1) { float tf = tv1; tv1 = tv2; tv2 = tf; int tii = ti1; ti1 = ti2; ti2 = tii; }
            if (tv1 > tv0) { float tf = tv0; tv0 = tv1; tv1 = tf; int tii = ti0; ti0 = ti1; ti1 = tii; }
          }
        }
      }
      part = e[0] + 2.f * (e[1] + e[2] + e[3]);
    }
    unsigned mask = 1u | (1u << cur);
    if (cur >= 1) mask |= 1u << (cur - 1);
    if (ti0 >= 0) mask |= 1u << ti0;
    if (ti1 >= 0) mask |= 1u << ti1;
    if (ti2 >= 0) mask |= 1u << ti2;
    if (ti3 >= 0) mask |= 1u << ti3;
    if (ti4 >= 0) mask |= 1u << ti4;
    if ((head & 3) == 0) SEL[tok * 2 + hkv] = mask;
  }
}

DI void slcwin_phase(const Params& p, char* smem) {
  char* ws = p.ws;
  const bfr* PROJ = (const bfr*)(ws + O_PROJ);
  const bfr* QR = (const bfr*)(ws + O_QR);
  const bfr* KSR = (const bfr*)(ws + O_KSR);
  const bfr* KWR = (const bfr*)(ws + O_KWR);
  const bfr* OCMP = (const bfr*)(ws + O_OCMP);
  const unsigned* SEL = (const unsigned*)(ws + O_SEL);
  bfr* MIX = (bfr*)(ws + O_MIX);
  const int tid = tid_opaque(), lane = tid & 63, wid = tid >> 6;
  for (int item = VB; item < 512; item += NVB) {
    const int tile = 31 - (item >> 4), bh = item & 15, b = bh >> 1, hkv = bh & 1;
    const int t = tile * 64 + lane, tok = b * SEQ + t, head = hkv * 4 + wid;
    unsigned q[32];
    {
      const uint4* qp = (const uint4*)(QR + (size_t)tok * 512 + head * 64);
#pragma unroll
      for (int i = 0; i < 8; ++i) { const uint4 u = qp[i]; q[i * 4] = u.x; q[i * 4 + 1] = u.y; q[i * 4 + 2] = u.z; q[i * 4 + 3] = u.w; }
    }
    const unsigned sel = SEL[tok * 2 + hkv];
#pragma unroll 1
    for (int pass = 0; pass < 2; ++pass) {
      const bfr* Kb = (pass == 0 ? KSR : KWR) + (size_t)b * SEQ * 128 + hkv * 64;
      const bfr* Vb = PROJ + (size_t)b * SEQ * PW0 + (pass == 0 ? C_VS : C_VW) + hkv * 64;
      float o[64];
#pragma unroll
      for (int i = 0; i < 64; ++i) o[i] = 0.f;
      float m = -1e30f, l = 0.f;
      const int jlo = pass == 0 ? 0 : (tile >= 8 ? tile - 8 : 0);
#pragma unroll 1
      for (int j = jlo; j <= tile; ++j) {
        const bool lane_ok = pass == 0 ? ((sel >> j) & 1u) != 0 : true;
        if (pass == 0 && !__any(lane_ok)) continue;
#pragma unroll 1
        for (int kb = 0; kb < 64; kb += 4) {
          float s[4];
#pragma unroll
          for (int kk = 0; kk < 4; ++kk) {
            const int key = j * 64 + kb + kk;
            const uint4* kp = (const uint4*)(Kb + (size_t)key * 128);
            float a = 0.f;
#pragma unroll
            for (int i = 0; i < 8; ++i) {
              const uint4 u = kp[i];
              a = dot2(q[i * 4], u.x, a); a = dot2(q[i * 4 + 1], u.y, a); a = dot2(q[i * 4 + 2], u.z, a); a = dot2(q[i * 4 + 3], u.w, a);
            }
            bool ok = lane_ok && key <= t;
            if (pass == 1) ok = ok && (t - key < 512);
            s[kk] = ok ? a * 0.125f : -1e30f;
          }
          const float cm = fmaxf(fmaxf(s[0], s[1]), fmaxf(s[2], s[3]));
          const float mn = fmaxf(m, cm);
          const float corr = __expf(m - mn);
          m = mn;
          float pe[4];
#pragma unroll
          for (int kk = 0; kk < 4; ++kk) pe[kk] = s[kk] > -1e29f ? __expf(s[kk] - mn) : 0.f;
          l = l * corr + (pe[0] + pe[1] + pe[2] + pe[3]);
#pragma unroll
          for (int i = 0; i < 64; ++i) o[i] *= corr;
#pragma unroll
          for (int kk = 0; kk < 4; ++kk) {
            const int key = j * 64 + kb + kk;
            const uint4* vp = (const uint4*)(Vb + (size_t)key * PW0);
#pragma unroll
            for (int i = 0; i < 8; ++i) {
              const uint4 u = vp[i];
              o[i * 8 + 0] += pe[kk] * lo2f(u.x); o[i * 8 + 1] += pe[kk] * hi2f(u.x);
              o[i * 8 + 2] += pe[kk] * lo2f(u.y); o[i * 8 + 3] += pe[kk] * hi2f(u.y);
              o[i * 8 + 4] += pe[kk] * lo2f(u.z); o[i * 8 + 5] += pe[kk] * hi2f(u.z);
              o[i * 8 + 6] += pe[kk] * lo2f(u.w); o[i * 8 + 7] += pe[kk] * hi2f(u.w);
            }
          }
        }
      }
      const float gate = sigmoidf_(bf2f(PROJ[(size_t)tok * PW0 + C_GL + head * 3 + 1 + pass]));
      const float gsc = gate * (l > 0.f ? 1.f / l : 0.f);
      uint4* op = (uint4*)(MIX + (size_t)tok * 1024 + head * 64);
      const uint4* cp = pass == 0 ? (const uint4*)(OCMP + (size_t)tok * 512 + head * 64) : (const uint4*)op;
#pragma unroll
      for (int i = 0; i < 8; ++i) {
        const uint4 c = cp[i];
        uint4 u;
        u.x = pack2(o[i * 8 + 0] * gsc + lo2f(c.x), o[i * 8 + 1] * gsc + hi2f(c.x));
        u.y = pack2(o[i * 8 + 2] * gsc + lo2f(c.y), o[i * 8 + 3] * gsc + hi2f(c.y));
        u.z = pack2(o[i * 8 + 4] * gsc + lo2f(c.z), o[i * 8 + 5] * gsc + hi2f(c.z));
        u.w = pack2(o[i * 8 + 6] * gsc + lo2f(c.w), o[i * 8 + 7] * gsc + hi2f(c.w));
        op[i] = u;
      }
    }
  }
}

using f32x16 = __attribute__((ext_vector_type(16))) float;
#define MFMA32(a, b, c) __builtin_amdgcn_mfma_f32_32x32x16_bf16((a), (b), (c), 0, 0, 0)
struct AttnLds { bfr k[2][64][72]; bfr vt[2][64][68]; };
static_assert(sizeof(AttnLds) <= 49152, "attn lds");
DI int crow16(int i, int h2) { return (i & 3) + 8 * (i >> 2) + 4 * h2; }

DI void attn_sw_phase(const Params& p, char* smem) {
  char* ws = p.ws;
  AttnLds& L = *(AttnLds*)smem;
  const bfr* PROJ = (const bfr*)(ws + O_PROJ);
  const bfr* QR = (const bfr*)(ws + O_QR);
  const bfr* OCMP = (const bfr*)(ws + O_OCMP);
  const unsigned* SEL = (const unsigned*)(ws + O_SEL);
  bfr* MIX = (bfr*)(ws + O_MIX);
  const int tid = tid_opaque(), lane = tid & 63, wid = tid >> 6, r = lane & 31, h2 = lane >> 5;
  const float CS = 0.125f * 1.4426950408889634f;
  const int lrow = tid >> 3, lc8 = (tid & 7) * 8;
  for (int item = VB; item < 1024; item += NVB) {
    const int qt = item < 512 ? 63 - (item >> 4) : ((item - 512) >> 4);
    const int bh = item & 15, b = bh >> 1, hkv = bh & 1;
    const int cur = qt >> 1;
    const int tokl = qt * 32 + wid * 8 + (r >> 2), g = r & 3, head = hkv * 4 + g, tok = b * SEQ + tokl;
    bf16x8 qf[4];
#pragma unroll
    for (int s = 0; s < 4; ++s) qf[s] = *(const bf16x8*)(QR + (size_t)tok * 512 + head * 64 + 16 * s + 8 * h2);
    const unsigned sel = SEL[tok * 2 + hkv];
    const int nslc = cur + 1, wlo = cur > 8 ? cur - 8 : 0, T = nslc + (cur - wlo + 1);
    const bfr* KS = (const bfr*)(ws + O_KSR) + (size_t)b * SEQ * 128 + hkv * 64;
    const bfr* KW = (const bfr*)(ws + O_KWR) + (size_t)b * SEQ * 128 + hkv * 64;
    const bfr* VS = (const bfr*)(ws + O_VST) + (size_t)((b * 2 + hkv) * 64) * SEQ;
    const bfr* VW = (const bfr*)(ws + O_VWT) + (size_t)((b * 2 + hkv) * 64) * SEQ;
    uint4 rk0, rk1, rv0, rv1;
    auto gload = [&](int tt) {
      const int pass = tt >= nslc, j = pass ? wlo + tt - nslc : tt;
      const bfr* kb = (pass ? KW : KS) + (size_t)(j * 64) * 128 + lc8;
      const bfr* vb = (pass ? VW : VS) + j * 64 + lc8;
      rk0 = *(const uint4*)(kb + (size_t)lrow * 128); rk1 = *(const uint4*)(kb + (size_t)(lrow + 32) * 128);
      rv0 = *(const uint4*)(vb + (size_t)lrow * SEQ); rv1 = *(const uint4*)(vb + (size_t)(lrow + 32) * SEQ);
    };
    auto lstore = [&](int buf) {
      *(uint4*)&L.k[buf][lrow][lc8] = rk0; *(uint4*)&L.k[buf][lrow + 32][lc8] = rk1;
      *(uint2*)&L.vt[buf][lrow][lc8] = make_uint2(rv0.x, rv0.y); *(uint2*)&L.vt[buf][lrow][lc8 + 4] = make_uint2(rv0.z, rv0.w);
      *(uint2*)&L.vt[buf][lrow + 32][lc8] = make_uint2(rv1.x, rv1.y); *(uint2*)&L.vt[buf][lrow + 32][lc8 + 4] = make_uint2(rv1.z, rv1.w);
    };
    gload(0); lstore(0);
    __syncthreads();
    float m = -1e30f, l = 0.f;
    f32x16 o0, o1;
#pragma unroll
    for (int i = 0; i < 16; ++i) { o0[i] = 0.f; o1[i] = 0.f; }
#pragma unroll 1
    for (int tt = 0; tt < T; ++tt) {
      const int buf = tt & 1;
      if (tt + 1 < T) gload(tt + 1);
      const int pass = tt >= nslc, j = pass ? wlo + tt - nslc : tt;
      const bool rowok = pass ? true : ((sel >> j) & 1u) != 0u;
      if (__any(rowok)) {
        f32x16 s0, s1;
#pragma unroll
        for (int i = 0; i < 16; ++i) { s0[i] = 0.f; s1[i] = 0.f; }
#pragma unroll
        for (int s = 0; s < 4; ++s) {
          const bf16x8 k0 = *(const bf16x8*)&L.k[buf][r][16 * s + 8 * h2];
          const bf16x8 k1 = *(const bf16x8*)&L.k[buf][32 + r][16 * s + 8 * h2];
          s0 = MFMA32(k0, qf[s], s0);
          s1 = MFMA32(k1, qf[s], s1);
        }
        if (!rowok) {
#pragma unroll
          for (int i = 0; i < 16; ++i) { s0[i] = -1e30f; s1[i] = -1e30f; }
        }
        if (j == cur) {
          const int lim = tokl - j * 64;
#pragma unroll
          for (int i = 0; i < 16; ++i) {
            if (crow16(i, h2) > lim) s0[i] = -1e30f;
            if (32 + crow16(i, h2) > lim) s1[i] = -1e30f;
          }
        }
        if (pass && cur >= 8 && j == cur - 8) {
          const int lo = tokl - 512 - j * 64;
#pragma unroll
          for (int i = 0; i < 16; ++i) {
            if (crow16(i, h2) <= lo) s0[i] = -1e30f;
            if (32 + crow16(i, h2) <= lo) s1[i] = -1e30f;
          }
        }
        float mx = -1e30f;
#pragma unroll
        for (int i = 0; i < 16; ++i) mx = fmaxf(mx, fmaxf(s0[i], s1[i]));
        mx = fmaxf(mx, __shfl_xor(mx, 32));
        const float mnew = fmaxf(m, mx);
        const float mu = fmaxf(mnew, -1e20f);
        const float corr = __builtin_amdgcn_exp2f((m - mu) * CS);
        m = mnew;
        const float muc = mu * CS;
        float ps = 0.f;
#pragma unroll
        for (int i = 0; i < 16; ++i) {
          s0[i] = __builtin_amdgcn_exp2f(fmaf(s0[i], CS, -muc));
          s1[i] = __builtin_amdgcn_exp2f(fmaf(s1[i], CS, -muc));
          ps += s0[i] + s1[i];
        }
        l = l * corr + ps;
#pragma unroll
        for (int i = 0; i < 16; ++i) { o0[i] *= corr; o1[i] *= corr; }
#pragma unroll
        for (int kb = 0; kb < 2; ++kb) {
#pragma unroll
          for (int s = 0; s < 2; ++s) {
            uint4 pk;
            if (kb == 0) {
              pk.x = pack2(s0[8 * s + 0], s0[8 * s + 1]); pk.y = pack2(s0[8 * s + 2], s0[8 * s + 3]);
              pk.z = pack2(s0[8 * s + 4], s0[8 * s + 5]); pk.w = pack2(s0[8 * s + 6], s0[8 * s + 7]);
            } else {
              pk.x = pack2(s1[8 * s + 0], s1[8 * s + 1]); pk.y = pack2(s1[8 * s + 2], s1[8 * s + 3]);
              pk.z = pack2(s1[8 * s + 4], s1[8 * s + 5]); pk.w = pack2(s1[8 * s + 6], s1[8 * s + 7]);
            }
            const bf16x8 pf = __builtin_bit_cast(bf16x8, pk);
            const int kc = kb * 32 + 16 * s + 4 * h2;
            const uint2 a0 = *(const uint2*)&L.vt[buf][r][kc];
            const uint2 a1 = *(const uint2*)&L.vt[buf][r][kc + 8];
            const uint2 c0 = *(const uint2*)&L.vt[buf][32 + r][kc];
            const uint2 c1 = *(const uint2*)&L.vt[buf][32 + r][kc + 8];
            const bf16x8 v0 = __builtin_bit_cast(bf16x8, make_uint4(a0.x, a0.y, a1.x, a1.y));
            const bf16x8 v1 = __builtin_bit_cast(bf16x8, make_uint4(c0.x, c0.y, c1.x, c1.y));
            o0 = MFMA32(v0, pf, o0);
            o1 = MFMA32(v1, pf, o1);
          }
        }
      }
      if (tt == nslc - 1 || tt == T - 1) {
        const float lt = l + __shfl_xor(l, 32);
        const float gate = sigmoidf_(bf2f(PROJ[(size_t)tok * PW0 + C_GL + head * 3 + 1 + pass]));
        const float sc = lt > 0.f ? gate / lt : 0.f;
        bfr* mixp = MIX + (size_t)tok * 1024 + head * 64;
        const bfr* addp = pass ? (const bfr*)mixp : OCMP + (size_t)tok * 512 + head * 64;
#pragma unroll
        for (int q4 = 0; q4 < 4; ++q4) {
          const int d0 = 8 * q4 + 4 * h2;
          const uint2 c = *(const uint2*)(addp + d0);
          uint2 u;
          u.x = pack2(o0[q4 * 4 + 0] * sc + lo2f(c.x), o0[q4 * 4 + 1] * sc + hi2f(c.x));
          u.y = pack2(o0[q4 * 4 + 2] * sc + lo2f(c.y), o0[q4 * 4 + 3] * sc + hi2f(c.y));
          *(uint2*)(mixp + d0) = u;
          const uint2 c2 = *(const uint2*)(addp + 32 + d0);
          u.x = pack2(o1[q4 * 4 + 0] * sc + lo2f(c2.x), o1[q4 * 4 + 1] * sc + hi2f(c2.x));
          u.y = pack2(o1[q4 * 4 + 2] * sc + lo2f(c2.y), o1[q4 * 4 + 3] * sc + hi2f(c2.y));
          *(uint2*)(mixp + 32 + d0) = u;
        }
#pragma unroll
        for (int i = 0; i < 16; ++i) { o0[i] = 0.f; o1[i] = 0.f; }
        m = -1e30f; l = 0.f;
      }
      if (tt + 1 < T) lstore(buf ^ 1);
      __syncthreads();
    }
  }
}

struct CmpLds { bfr k[128][72]; bfr vt[64][132]; };
static_assert(sizeof(CmpLds) <= 49152, "cmp lds");
DI float quad_sum(float x) {
  const float y = x + __int_as_float(__builtin_amdgcn_update_dpp(0, __float_as_int(x), 0xB1, 0xF, 0xF, true));
  return y + __int_as_float(__builtin_amdgcn_update_dpp(0, __float_as_int(y), 0x4E, 0xF, 0xF, true));
}

DI void cmp_attn_mfma_phase(const Params& p, char* smem) {
  char* ws = p.ws;
  CmpLds& L = *(CmpLds*)smem;
  const bfr* PROJ = (const bfr*)(ws + O_PROJ);
  const bfr* KC = (const bfr*)(ws + O_KCVC);
  const bfr* VCT = (const bfr*)(ws + O_VCT);
  bfr* OCMP = (bfr*)(ws + O_OCMP);
  unsigned* SEL = (unsigned*)(ws + O_SEL);
  const int tid = tid_opaque(), lane = tid & 63, wid = tid >> 6, r = lane & 31, h2 = lane >> 5;
  const float CS = 0.125f * 1.4426950408889634f;
  for (int item = VB; item < 1024; item += NVB) {
    const int qt = 63 - (item >> 4), bh = item & 15, b = bh >> 1, hkv = bh & 1;
    __syncthreads();
    {
      const bfr* kb = KC + ((size_t)(b * 127) * 2 + hkv) * 64;
      const bfr* vb = VCT + (size_t)((b * 2 + hkv) * 64) * 128;
#pragma unroll
      for (int i = 0; i < 4; ++i) {
        const int id = tid + i * 256;
        const int kr = id >> 3, kc = (id & 7) * 8;
        *(uint4*)&L.k[kr][kc] = *(const uint4*)(kb + (size_t)kr * 128 + kc);
        const int vr = id >> 4, vc = (id & 15) * 8;
        const uint4 v = *(const uint4*)(vb + (size_t)vr * 128 + vc);
        *(uint2*)&L.vt[vr][vc] = make_uint2(v.x, v.y);
        *(uint2*)&L.vt[vr][vc + 4] = make_uint2(v.z, v.w);
      }
    }
    __syncthreads();
    const int tokl = qt * 32 + wid * 8 + (r >> 2), g = r & 3, head = hkv * 4 + g, tok = b * SEQ + tokl;
    const int nv = tokl >= 31 ? ((tokl - 31) >> 4) + 1 : 0;
    bf16x8 qf[4];
#pragma unroll
    for (int s = 0; s < 4; ++s) qf[s] = *(const bf16x8*)(PROJ + (size_t)tok * PW0 + C_Q + head * 64 + 16 * s + 8 * h2);
    float m = -1e30f, l = 0.f;
#pragma unroll 1
    for (int kb4 = 0; kb4 < 4; ++kb4) {
      f32x16 sc;
#pragma unroll
      for (int i = 0; i < 16; ++i) sc[i] = 0.f;
#pragma unroll
      for (int s = 0; s < 4; ++s) {
        const bf16x8 kf = *(const bf16x8*)&L.k[kb4 * 32 + r][16 * s + 8 * h2];
        sc = MFMA32(kf, qf[s], sc);
      }
      float mx = -1e30f;
#pragma unroll
      for (int i = 0; i < 16; ++i) {
        if (kb4 * 32 + crow16(i, h2) >= nv) sc[i] = -1e30f;
        mx = fmaxf(mx, sc[i]);
      }
      const float mn = fmaxf(m, mx), mu = fmaxf(mn, -1e20f);
      float ps = 0.f;
#pragma unroll
      for (int i = 0; i < 16; ++i) ps += __builtin_amdgcn_exp2f((sc[i] - mu) * CS);
      l = l * __builtin_amdgcn_exp2f((m - mu) * CS) + ps;
      m = mn;
    }
    {
      const float mo = __shfl_xor(m, 32), lo = __shfl_xor(l, 32);
      const float mt = fmaxf(m, mo), mu = fmaxf(mt, -1e20f);
      l = l * __builtin_amdgcn_exp2f((m - mu) * CS) + lo * __builtin_amdgcn_exp2f((mo - mu) * CS);
      m = mu;
    }
    const float invl = l > 0.f ? 1.f / l : 0.f;
    const float muc = m * CS;
    f32x16 o0, o1;
#pragma unroll
    for (int i = 0; i < 16; ++i) { o0[i] = 0.f; o1[i] = 0.f; }
    float part[16], first[16];
#pragma unroll
    for (int kb4 = 0; kb4 < 4; ++kb4) {
      f32x16 sc;
#pragma unroll
      for (int i = 0; i < 16; ++i) sc[i] = 0.f;
#pragma unroll
      for (int s = 0; s < 4; ++s) {
        const bf16x8 kf = *(const bf16x8*)&L.k[kb4 * 32 + r][16 * s + 8 * h2];
        sc = MFMA32(kf, qf[s], sc);
      }
#pragma unroll
      for (int i = 0; i < 16; ++i) {
        const float pv = __builtin_amdgcn_exp2f(fmaf(sc[i], CS, -muc)) * invl;
        sc[i] = (kb4 * 32 + crow16(i, h2) >= nv) ? 0.f : pv;
      }
#pragma unroll
      for (int s = 0; s < 2; ++s) {
        uint4 pk;
        pk.x = pack2(sc[8 * s + 0], sc[8 * s + 1]); pk.y = pack2(sc[8 * s + 2], sc[8 * s + 3]);
        pk.z = pack2(sc[8 * s + 4], sc[8 * s + 5]); pk.w = pack2(sc[8 * s + 6], sc[8 * s + 7]);
        const bf16x8 pf = __builtin_bit_cast(bf16x8, pk);
        const int kc = kb4 * 32 + 16 * s + 4 * h2;
        const uint2 a0 = *(const uint2*)&L.vt[r][kc];
        const uint2 a1 = *(const uint2*)&L.vt[r][kc + 8];
        const uint2 c0 = *(const uint2*)&L.vt[32 + r][kc];
        const uint2 c1 = *(const uint2*)&L.vt[32 + r][kc + 8];
        o0 = MFMA32(__builtin_bit_cast(bf16x8, make_uint4(a0.x, a0.y, a1.x, a1.y)), pf, o0);
        o1 = MFMA32(__builtin_bit_cast(bf16x8, make_uint4(c0.x, c0.y, c1.x, c1.y)), pf, o1);
      }
#pragma unroll
      for (int q4 = 0; q4 < 4; ++q4) {
        const float e0 = quad_sum(sc[q4 * 4 + 0]), e1 = quad_sum(sc[q4 * 4 + 1]);
        const float e2 = quad_sum(sc[q4 * 4 + 2]), e3 = quad_sum(sc[q4 * 4 + 3]);
        part[kb4 * 4 + q4] = e0 + 2.f * (e1 + e2 + e3);
        first[kb4 * 4 + q4] = e0;
      }
      __builtin_amdgcn_sched_barrier(0);
    }
    {
      const float g0 = sigmoidf_(bf2f(PROJ[(size_t)tok * PW0 + C_GL + head * 3 + 0]));
      bfr* op = OCMP + (size_t)tok * 512 + head * 64;
#pragma unroll
      for (int q4 = 0; q4 < 4; ++q4) {
        const int d0 = 8 * q4 + 4 * h2;
        uint2 u;
        u.x = pack2(o0[q4 * 4 + 0] * g0, o0[q4 * 4 + 1] * g0); u.y = pack2(o0[q4 * 4 + 2] * g0, o0[q4 * 4 + 3] * g0);
        *(uint2*)(op + d0) = u;
        u.x = pack2(o1[q4 * 4 + 0] * g0, o1[q4 * 4 + 1] * g0); u.y = pack2(o1[q4 * 4 + 2] * g0, o1[q4 * 4 + 3] * g0);
        *(uint2*)(op + 32 + d0) = u;
      }
    }
    float val[16], oth[16];
    const float h2f = (float)h2;
    {
      float recv[17];
#pragma unroll
      for (int gi = 0; gi < 16; ++gi) recv[gi] = __shfl_xor(first[gi], 32);
      recv[16] = 0.f;
#pragma unroll
      for (int gi = 0; gi < 16; ++gi) val[gi] = part[gi] + (recv[gi] * (1.f - h2f) + recv[gi + 1] * h2f);
#pragma unroll
      for (int gi = 0; gi < 16; ++gi) oth[gi] = __shfl_xor(val[gi], 32);
    }
    const int cur = tokl >> 6;
    float cv[32];
#pragma unroll
    for (int gi = 0; gi < 16; ++gi) {
      cv[2 * gi] = val[gi] * (1.f - h2f) + oth[gi] * h2f;
      cv[2 * gi + 1] = val[gi] * h2f + oth[gi] * (1.f - h2f);
    }
    unsigned mask = 1u | (1u << cur);
    if (cur >= 1) mask |= 1u << (cur - 1);
    unsigned chosen = 0u;
#pragma unroll 1
    for (int rnd = 0; rnd < 5; ++rnd) {
      float best = -1.f; int bi = -1;
#pragma unroll
      for (int j = 1; j < 31; ++j) {
        const bool el = (j <= cur - 2) && !((chosen >> j) & 1u) && (cv[j] > best);
        best = el ? cv[j] : best;
        bi = el ? j : bi;
      }
      if (bi >= 0) chosen |= 1u << bi;
    }
    mask |= chosen;
    if (g == 0 && h2 == 0) SEL[tok * 2 + hkv] = mask;
  }
}

struct RowsGather {
  const bfr* base; const int* list; int i0; int cnt; int ld;
  const bfr* rp[2];
  DI void init(int lr) {
#pragma unroll
    for (int i = 0; i < 2; ++i) {
      int ii = i0 + lr + 64 * i; if (ii > cnt - 1) ii = cnt - 1;
      rp[i] = base + (size_t)(list[ii] >> 1) * ld;
    }
  }
  DI uint4 load(int sel, int k) const { return *(const uint4*)(rp[sel] + k); }
  DI const bfr* ptr(int sel, int k) const { return rp[sel] + k; }
};

DI void moe1_phase(const Params& p, char* smem, int layer) {
  char* ws = p.ws;
  const int* cnt = (const int*)(ws + O_CNT) + layer * 16 * 64;
  const int* LIST = (const int*)(ws + O_LIST);
  const bfr* HB = (const bfr*)(ws + O_HB);
  bfr* HMID = (bfr*)(ws + O_HMID);
  int c[16], mtiles = 0;
#pragma unroll
  for (int e = 0; e < 16; ++e) { c[e] = cnt[e * 64]; mtiles += (c[e] + 127) >> 7; }
  const int ntiles = mtiles * 8;
  for (int tile = VB; tile < ntiles; tile += NVB) {
    int mg = tile >> 3; const int nt = tile & 7;
    int e = 0, off = 0, ce = 0;
#pragma unroll
    for (int k = 0; k < 16; ++k) {
      const int mk = (c[k] + 127) >> 7;
      if (k == e && mg >= mk) { mg -= mk; off += c[k]; e = k + 1; }
    }
#pragma unroll
    for (int k = 0; k < 16; ++k) if (k == e) ce = c[k];
    const int mt = mg;
    RowsGather A{HB, LIST + (size_t)e * NT, mt * 128, ce, 1024};
    RowsContig B{(const bfr*)(ws + O_WGU) + ((size_t)(layer * 16 + e) * 1024 + nt * 128) * 1024, 1024, 127};
    gemm_tile_g(smem, 32, A, B, [&](f32x4(&acc)[4][4], int wr, int wc, int fr, int fq) {
#pragma unroll
      for (int m = 0; m < 4; ++m) {
        const int i = mt * 128 + wr * 64 + m * 16 + fr;
        if (i < ce) {
#pragma unroll
          for (int n2 = 0; n2 < 2; ++n2) {
            const int col = nt * 64 + wc * 32 + n2 * 16 + fq * 4;
            float h[4];
#pragma unroll
            for (int j = 0; j < 4; ++j) { const float g = acc[m][n2 * 2][j], u = acc[m][n2 * 2 + 1][j]; h[j] = g / (1.f + __expf(-g)) * u; }
            *(uint2*)(HMID + (size_t)(off + i) * 512 + col) = make_uint2(pack2(h[0], h[1]), pack2(h[2], h[3]));
          }
        }
      }
    });
  }
}

DI void moe2_phase(const Params& p, char* smem, int layer) {
  char* ws = p.ws;
  const int* cnt = (const int*)(ws + O_CNT) + layer * 16 * 64;
  const int* LIST = (const int*)(ws + O_LIST);
  const float* TOPW = (const float*)(ws + O_TOPW);
  const bfr* HMID = (const bfr*)(ws + O_HMID);
  bfr* MO = (bfr*)(ws + O_MOEOUT);
  int c[16], mtiles = 0;
#pragma unroll
  for (int e = 0; e < 16; ++e) { c[e] = cnt[e * 64]; mtiles += (c[e] + 127) >> 7; }
  const int ntiles = mtiles * 8;
  for (int tile = VB; tile < ntiles; tile += NVB) {
    int mg = tile >> 3; const int nt = tile & 7;
    int e = 0, off = 0, ce = 0;
#pragma unroll
    for (int k = 0; k < 16; ++k) {
      const int mk = (c[k] + 127) >> 7;
      if (k == e && mg >= mk) { mg -= mk; off += c[k]; e = k + 1; }
    }
#pragma unroll
    for (int k = 0; k < 16; ++k) if (k == e) ce = c[k];
    const int mt = mg;
    const int rows_here = ce - mt * 128;
    RowsContig A{HMID + (size_t)(off + mt * 128) * 512, 512, (rows_here < 128 ? rows_here : 128) - 1};
    RowsContig B{(const bfr*)(ws + O_WDN) + ((size_t)(layer * 16 + e) * 1024 + nt * 128) * 512, 512, 127};
    const int* lst = LIST + (size_t)e * NT;
    gemm_tile_g(smem, 16, A, B, [&](f32x4(&acc)[4][4], int wr, int wc, int fr, int fq) {
#pragma unroll
      for (int m = 0; m < 4; ++m) {
        const int i = mt * 128 + wr * 64 + m * 16 + fr;
        if (i < ce) {
          const int en = lst[i];
          const float w = TOPW[en];
          bfr* dst = MO + ((size_t)(en & 1) * NT + (en >> 1)) * 1024 + nt * 128 + wc * 64 + fq * 4;
#pragma unroll
          for (int n = 0; n < 4; ++n)
            *(uint2*)(dst + n * 16) = make_uint2(pack2(acc[m][n][0] * w, acc[m][n][1] * w), pack2(acc[m][n][2] * w, acc[m][n][3] * w));
        }
      }
    });
  }
}

struct ALora {
  const bfr* proj; const float* mu; int tok0; int colbase; int mode;
  const bfr* rp[2]; bool hp[2];
  DI void init(int lr) {
#pragma unroll
    for (int i = 0; i < 2; ++i) { const int tok = tok0 + lr + 64 * i; rp[i] = proj + (size_t)tok * PW1 + colbase; hp[i] = (tok & (SEQ - 1)) != 0; }
  }
  DI uint4 load(int sel, int k) const {
    const uint4 c = *(const uint4*)(rp[sel] + k);
    uint4 pv = make_uint4(0, 0, 0, 0);
    if (hp[sel]) pv = *(const uint4*)(rp[sel] - PW1 + k);
    const float4 m0 = *(const float4*)(mu + colbase + k), m1 = *(const float4*)(mu + colbase + k + 4);
    float v[8];
    v[0] = lo2f(c.x) + (lo2f(pv.x) - lo2f(c.x)) * m0.x; v[1] = hi2f(c.x) + (hi2f(pv.x) - hi2f(c.x)) * m0.y;
    v[2] = lo2f(c.y) + (lo2f(pv.y) - lo2f(c.y)) * m0.z; v[3] = hi2f(c.y) + (hi2f(pv.y) - hi2f(c.y)) * m0.w;
    v[4] = lo2f(c.z) + (lo2f(pv.z) - lo2f(c.z)) * m1.x; v[5] = hi2f(c.z) + (hi2f(pv.z) - hi2f(c.z)) * m1.y;
    v[6] = lo2f(c.w) + (lo2f(pv.w) - lo2f(c.w)) * m1.z; v[7] = hi2f(c.w) + (hi2f(pv.w) - hi2f(c.w)) * m1.w;
#pragma unroll
    for (int i = 0; i < 8; ++i) v[i] = mode == 0 ? tanhf(v[i]) : (mode == 2 ? sigmoidf_(v[i]) : v[i]);
    return make_uint4(pack2(v[0], v[1]), pack2(v[2], v[3]), pack2(v[4], v[5]), pack2(v[6], v[7]));
  }
};
DI void rwkv_lora_pool_phase(const Params& p, char* smem) {
  char* ws = p.ws;
  const bfr* PROJ = (const bfr*)(ws + O_PROJ);
  float* W = (float*)(ws + O_RW_W);
  bfr* AS = (bfr*)(ws + O_RW_AS);
  bfr* G = (bfr*)(ws + O_RW_G);
  bfr* MIX = (bfr*)(ws + O_MIX);
  for (int item = VB; item < 1024; item += NVB) {
    const int mt = item >> 3, sub = ((item & 7) + ((item >> 9) & 1) * 4) & 7, tok0 = mt * 128;
    if (sub < 4) {
      const int cp = sub;
      {
        ALora A{PROJ, p.in[I_MU], tok0, 1536, 0};
        RowsContig B{(const bfr*)(ws + O_W2T) + (size_t)cp * 128 * 64, 64, 127};
        const float* w0 = p.in[I_W0];
        gemm_tile(smem, 2, A, B, [&](f32x4(&acc)[4][4], int wr, int wc, int fr, int fq) {
#pragma unroll
          for (int n = 0; n < 4; ++n) {
            const int col = cp * 128 + wc * 64 + n * 16 + fr;
            const float w0v = w0[col];
#pragma unroll
            for (int m = 0; m < 4; ++m)
#pragma unroll
              for (int j = 0; j < 4; ++j) {
                const int tok = tok0 + wr * 64 + m * 16 + fq * 4 + j;
                const float z = -(w0v + acc[m][n][j]);
                const float sp = fmaxf(z, 0.f) + log1pf(__expf(-fabsf(z)));
                W[(size_t)tok * 512 + col] = __expf(-__expf(-sp - 0.5f));
              }
          }
        });
      }
      {
        ALora A{PROJ, p.in[I_MU], tok0, 1600, 1};
        RowsContig B{(const bfr*)(ws + O_A2T) + (size_t)cp * 128 * 64, 64, 127};
        const float* a0 = p.in[I_A0];
        gemm_tile(smem, 2, A, B, [&](f32x4(&acc)[4][4], int wr, int wc, int fr, int fq) {
#pragma unroll
          for (int n = 0; n < 4; ++n) {
            const int col = cp * 128 + wc * 64 + n * 16 + fr;
            const float a0v = a0[col];
#pragma unroll
            for (int m = 0; m < 4; ++m)
#pragma unroll
              for (int j = 0; j < 4; ++j) {
                const int tok = tok0 + wr * 64 + m * 16 + fq * 4 + j;
                AS[(size_t)tok * 512 + col] = f2bf(sigmoidf_(a0v + acc[m][n][j]));
              }
          }
        });
      }
      {
        ALora A{PROJ, p.in[I_MU], tok0, 1664, 2};
        RowsContig B{(const bfr*)(ws + O_G2T) + (size_t)cp * 128 * 128, 128, 127};
        gemm_tile(smem, 4, A, B, [&](f32x4(&acc)[4][4], int wr, int wc, int fr, int fq) {
#pragma unroll
          for (int n = 0; n < 4; ++n) {
            const int col = cp * 128 + wc * 64 + n * 16 + fr;
#pragma unroll
            for (int m = 0; m < 4; ++m)
#pragma unroll
              for (int j = 0; j < 4; ++j) {
                const int tok = tok0 + wr * 64 + m * 16 + fq * 4 + j;
                G[(size_t)tok * 512 + col] = f2bf(acc[m][n][j]);
              }
          }
        });
      }
    } else {
      bfr* POOLED = (bfr*)(ws + O_POOLED);
      const int tid = tid_opaque();
      for (int e = tid; e < 32 * 64; e += 256) {
        const int tok = tok0 + (sub - 4) * 32 + (e >> 6), ch = (e & 63) * 8, gi = ch >> 7;
        const int t = tok & (SEQ - 1), win = 2 << gi, n = (t + 1 < win) ? t + 1 : win;
        const bfr* rp = PROJ + (size_t)tok * PW1 + 1792 + ch;
        const uint4 c = *(const uint4*)rp;
        const float a[8] = {lo2f(c.x), hi2f(c.x), lo2f(c.y), hi2f(c.y), lo2f(c.z), hi2f(c.z), lo2f(c.w), hi2f(c.w)};
        float sm[8];
#pragma unroll
        for (int i = 0; i < 8; ++i) sm[i] = a[i];
#pragma unroll
        for (int d0 = 1; d0 < 16; d0 += 5) {
          uint4 u[5];
#pragma unroll
          for (int q = 0; q < 5; ++q) {
            const int d = d0 + q;
            u[q] = make_uint4(0, 0, 0, 0);
            if (d < n) u[q] = *(const uint4*)(rp - (size_t)d * PW1);
          }
#pragma unroll
          for (int q = 0; q < 5; ++q) {
            sm[0] += lo2f(u[q].x); sm[1] += hi2f(u[q].x); sm[2] += lo2f(u[q].y); sm[3] += hi2f(u[q].y);
            sm[4] += lo2f(u[q].z); sm[5] += hi2f(u[q].z); sm[6] += lo2f(u[q].w); sm[7] += hi2f(u[q].w);
          }
        }
        const float inv = 1.f / (float)n;
#pragma unroll
        for (int i = 0; i < 8; ++i) sm[i] = sm[i] * inv - a[i];
        *(uint4*)(POOLED + (size_t)tok * 512 + ch) = make_uint4(pack2(sm[0], sm[1]), pack2(sm[2], sm[3]), pack2(sm[4], sm[5]), pack2(sm[6], sm[7]));
      }
    }
  }
}

DI void pool_gemm_tiles(const Params& p, char* smem, int first, int stride) {
  char* ws = p.ws;
  bfr* MIX = (bfr*)(ws + O_MIX);
  for (int tile = first; tile < 512; tile += stride) {
    const int mt = tile >> 2, gi = tile & 3, tok0 = mt * 128;
    RowsContig A{(const bfr*)(ws + O_POOLED) + (size_t)tok0 * 512 + gi * 128, 512, 127};
    RowsContig B{(const bfr*)(ws + O_PWT) + (size_t)gi * 128 * 128, 128, 127};
    const float* ps = p.in[I_POOLS] + gi * 128;
    gemm_tile(smem, 4, A, B, [&](f32x4(&acc)[4][4], int wr, int wc, int fr, int fq) {
#pragma unroll
      for (int n = 0; n < 4; ++n) {
        const int col = wc * 64 + n * 16 + fr;
        const float sc = ps[col];
#pragma unroll
        for (int m = 0; m < 4; ++m)
#pragma unroll
          for (int j = 0; j < 4; ++j) {
            const int tok = tok0 + wr * 64 + m * 16 + fq * 4 + j;
            MIX[(size_t)tok * 1024 + 512 + gi * 128 + col] = f2bf(acc[m][n][j] * sc);
          }
      }
    });
  }
}

constexpr int CHUNK = 128, NCH = SEQ / CHUNK;
DI void scanA_phase(const Params& p, char* smem) {
  char* ws = p.ws;
  const int tid = tid_opaque(), lane = tid & 63, wid = tid >> 6;
  const int ul = wid >> 1, isP = wid & 1;
  float* st = (float*)smem + wid * (8 * 384);
  const bfr* PROJ = (const bfr*)(ws + O_PROJ);
  const float* W = (const float*)(ws + O_RW_W);
  const bfr* AS = (const bfr*)(ws + O_RW_AS);
  bfr* QT = (bfr*)(ws + O_RW_Q); bfr* YL = (bfr*)(ws + O_RW_Y);
  float* RK = (float*)(ws + O_RK);
  float* CHP = (float*)(ws + O_CHP); float* CHL = (float*)(ws + O_CHL);
  const float* mu = p.in[I_MU];
  for (int item = VB; item < 512; item += NVB) {
    const int unit = item * 2 + ul;
    const int chain = unit >> 4, chunk = unit & 15, b = chain >> 3, h = chain & 7;
    const int c = h * 64 + lane;
    const int tok_base = b * SEQ + chunk * CHUNK;
    const float mu_r = mu[c], mu_k = mu[512 + c], mu_v = mu[1024 + c];
    const float kkp = p.in[I_KK][c], kap = p.in[I_KA][c], rkp = p.in[I_RKP][c];
    float S[64];
    int diag = isP ? lane : -1;
    asm volatile("" : "+v"(diag));
#pragma unroll
    for (int j = 0; j < 64; ++j) S[j] = (j == diag) ? 1.f : 0.f;
    bfr qr[9], qk[9], qv[9], qa[8]; float qw[8];
    auto issue = [&](int sub) {
      const int tl = chunk * CHUNK + sub * 8, tok0 = tok_base + sub * 8;
      const bfr* pr = PROJ + (size_t)tok0 * PW1 + c;
      qr[0] = 0; qk[0] = 0; qv[0] = 0;
      if (tl > 0) { qr[0] = pr[-PW1]; qk[0] = pr[512 - PW1]; qv[0] = pr[1024 - PW1]; }
#pragma unroll
      for (int s8 = 0; s8 < 8; ++s8) {
        qr[s8 + 1] = pr[(size_t)s8 * PW1]; qk[s8 + 1] = pr[(size_t)s8 * PW1 + 512]; qv[s8 + 1] = pr[(size_t)s8 * PW1 + 1024];
        qa[s8] = AS[(size_t)(tok0 + s8) * 512 + c]; qw[s8] = W[(size_t)(tok0 + s8) * 512 + c];
      }
    };
    issue(0);
#pragma unroll 1
    for (int sub = 0; sub < CHUNK / 8; ++sub) {
#pragma unroll
      for (int s = 0; s < 8; ++s) {
        const int tok = tok_base + sub * 8 + s;
        const float rc = bf2f(qr[s + 1]), rpv = bf2f(qr[s]);
        const float kc = bf2f(qk[s + 1]), kpv = bf2f(qk[s]);
        const float vc = bf2f(qv[s + 1]), vpv = bf2f(qv[s]);
        const float r = rc + (rpv - rc) * mu_r, k = kc + (kpv - kc) * mu_k, v = vc + (vpv - vc) * mu_v;
        const float as = bf2f(qa[s]);
        const float km = k * (1.f + (as - 1.f) * kap);
        float kk = k * kkp;
        float nrm = kk * kk, rk = r * km * rkp;
#pragma unroll
        for (int o2 = 32; o2 > 0; o2 >>= 1) { nrm += __shfl_xor(nrm, o2); rk += __shfl_xor(rk, o2); }
        kk *= 1.f / fmaxf(sqrtf(nrm), 1e-12f);
        float* d = st + s * 384;
        d[lane] = r;
        d[64 + lane] = qw[s];
        d[128 + lane] = km;
        d[192 + lane] = v;
        d[256 + lane] = -kk;
        d[320 + lane] = kk * as;
        if (!isP && lane == 0) RK[tok * 8 + h] = rk;
      }
      if (sub + 1 < CHUNK / 8) issue(sub + 1);
      __builtin_amdgcn_fence(__ATOMIC_RELEASE, "wavefront");
      __builtin_amdgcn_wave_barrier();
#pragma unroll 1
      for (int s = 0; s < 8; ++s) {
        const float* d = st + s * 384;
        float sa0 = 0.f, sa1 = 0.f, sa2 = 0.f, sa3 = 0.f;
#pragma unroll
        for (int j4 = 0; j4 < 16; ++j4) {
          const float4 a4 = *(const float4*)(d + 256 + j4 * 4);
          sa0 = fmaf(S[j4 * 4], a4.x, sa0); sa1 = fmaf(S[j4 * 4 + 1], a4.y, sa1); sa2 = fmaf(S[j4 * 4 + 2], a4.z, sa2); sa3 = fmaf(S[j4 * 4 + 3], a4.w, sa3);
        }
        const float sa = (sa0 + sa1) + (sa2 + sa3);
        const float vi = isP ? 0.f : d[192 + lane];
        float y0 = 0.f, y1 = 0.f, y2 = 0.f, y3 = 0.f;
#pragma unroll
        for (int j4 = 0; j4 < 16; ++j4) {
          if ((j4 & 3) == 0) asm volatile("" ::: "memory");
          const float4 w4 = *(const float4*)(d + 64 + j4 * 4);
          const float4 b4 = *(const float4*)(d + 320 + j4 * 4);
          const float4 k4 = *(const float4*)(d + 128 + j4 * 4);
          const float4 r4 = *(const float4*)(d + j4 * 4);
          S[j4 * 4 + 0] = S[j4 * 4 + 0] * w4.x + (sa * b4.x + vi * k4.x);
          S[j4 * 4 + 1] = S[j4 * 4 + 1] * w4.y + (sa * b4.y + vi * k4.y);
          S[j4 * 4 + 2] = S[j4 * 4 + 2] * w4.z + (sa * b4.z + vi * k4.z);
          S[j4 * 4 + 3] = S[j4 * 4 + 3] * w4.w + (sa * b4.w + vi * k4.w);
          y0 = fmaf(S[j4 * 4], r4.x, y0); y1 = fmaf(S[j4 * 4 + 1], r4.y, y1); y2 = fmaf(S[j4 * 4 + 2], r4.z, y2); y3 = fmaf(S[j4 * 4 + 3], r4.w, y3);
        }
        const float y = (y0 + y1) + (y2 + y3);
        const size_t o = (size_t)(tok_base + sub * 8 + s) * 512 + c;
        if (isP) QT[o] = f2bf(y);
        else YL[o] = f2bf(y);
      }
      __builtin_amdgcn_fence(__ATOMIC_RELEASE, "wavefront");
      __builtin_amdgcn_wave_barrier();
    }
    float4* dp = (float4*)((isP ? CHP : CHL) + ((size_t)unit * 64 + lane) * 64);
#pragma unroll
    for (int j4 = 0; j4 < 16; ++j4) dp[j4] = make_float4(S[j4 * 4], S[j4 * 4 + 1], S[j4 * 4 + 2], S[j4 * 4 + 3]);
  }
}

DI void scanB_phase(const Params& p, char* smem) {
  char* ws = p.ws;
  const int tid = tid_opaque();
  float* Ss = (float*)smem;
  float* Ps = Ss + 64 * 65;
  const float* CHP = (const float*)(ws + O_CHP);
  float* CHL = (float*)(ws + O_CHL);
  const int i = tid >> 2, qd = tid & 3;
#if POOL_IN_SCANB
  if (NVB > 128) {
    if (VB >= 64) { pool_gemm_tiles(p, smem, VB - 64, NVB - 64); return; }
  } else {
    pool_gemm_tiles(p, smem, VB, NVB);
    __syncthreads();
  }
#endif
  if (NVB > 128 && VB >= 64) {
    conv_run(p, smem, NC_PREP + (VB - 64), NC_ALL, NVB - 64);
    return;
  }
  for (int chain = VB; chain < 64; chain += NVB) {
    for (int e = tid; e < 64 * 65; e += 256) Ss[e] = 0.f;
    float4 pn0, pn1, pn2, pn3, ln0, ln1, ln2, ln3;
    {
      const float4* pp = (const float4*)(CHP + ((size_t)(chain * NCH)) * 4096) + tid;
      pn0 = pp[0]; pn1 = pp[256]; pn2 = pp[512]; pn3 = pp[768];
      const float4* lp = (const float4*)(CHL + ((size_t)(chain * NCH)) * 4096 + i * 64 + qd * 16);
      ln0 = lp[0]; ln1 = lp[1]; ln2 = lp[2]; ln3 = lp[3];
    }
    __syncthreads();
    for (int c = 0; c < NCH - 1; ++c) {
      const size_t ub = ((size_t)(chain * NCH + c)) * 4096;
      ((float4*)Ps)[tid] = pn0; ((float4*)Ps)[tid + 256] = pn1; ((float4*)Ps)[tid + 512] = pn2; ((float4*)Ps)[tid + 768] = pn3;
      float acc[16];
      acc[0] = ln0.x; acc[1] = ln0.y; acc[2] = ln0.z; acc[3] = ln0.w; acc[4] = ln1.x; acc[5] = ln1.y; acc[6] = ln1.z; acc[7] = ln1.w;
      acc[8] = ln2.x; acc[9] = ln2.y; acc[10] = ln2.z; acc[11] = ln2.w; acc[12] = ln3.x; acc[13] = ln3.y; acc[14] = ln3.z; acc[15] = ln3.w;
      if (c + 1 < NCH - 1) {
        const float4* pp = (const float4*)(CHP + ub + 4096) + tid;
        pn0 = pp[0]; pn1 = pp[256]; pn2 = pp[512]; pn3 = pp[768];
        const float4* lp = (const float4*)(CHL + ub + 4096 + i * 64 + qd * 16);
        ln0 = lp[0]; ln1 = lp[1]; ln2 = lp[2]; ln3 = lp[3];
      }
      __syncthreads();
      if (c > 0) {
#pragma unroll 4
        for (int k = 0; k < 64; ++k) {
          const float sv = Ss[i * 65 + k];
          const float4* pr = (const float4*)(Ps + k * 64 + qd * 16);
#pragma unroll
          for (int u = 0; u < 4; ++u) {
            const float4 v = pr[u];
            acc[u * 4] += sv * v.x; acc[u * 4 + 1] += sv * v.y; acc[u * 4 + 2] += sv * v.z; acc[u * 4 + 3] += sv * v.w;
          }
        }
      }
      __syncthreads();
#pragma unroll
      for (int u = 0; u < 16; ++u) Ss[i * 65 + qd * 16 + u] = acc[u];
      {
        float4* lp = (float4*)(CHL + ub + i * 64 + qd * 16);
#pragma unroll
        for (int u = 0; u < 4; ++u) lp[u] = make_float4(acc[u * 4], acc[u * 4 + 1], acc[u * 4 + 2], acc[u * 4 + 3]);
      }
      __syncthreads();
    }
  }
}

DI void scanC_phase(const Params& p, char* smem) {
  char* ws = p.ws;
  const int tid = tid_opaque(), lane = tid & 63, wid = tid >> 6;
  float* st = (float*)smem + wid * (8 * 64);
  const bfr* PROJ = (const bfr*)(ws + O_PROJ);
  const bfr* Q = (const bfr*)(ws + O_RW_Q); const bfr* YL = (const bfr*)(ws + O_RW_Y);
  const bfr* G = (const bfr*)(ws + O_RW_G);
  const float* RK = (const float*)(ws + O_RK);
  const float* CHL = (const float*)(ws + O_CHL);
  bfr* MIX = (bfr*)(ws + O_MIX);
  for (int unit = VB; unit < 64 * NCH; unit += NVB) {
    const int chain = unit >> 4, chunk = unit & 15, b = chain >> 3, h = chain & 7;
    const int c = h * 64 + lane;
    const int tl0 = chunk * CHUNK + wid * 32;
    const size_t base = ((size_t)b * SEQ + tl0) * 512 + c;
    const float mu_v = p.in[I_MU][1024 + c];
    float S[64];
    if (chunk > 0) {
      const float4* sp = (const float4*)(CHL + ((size_t)(unit - 1) * 64 + lane) * 64);
#pragma unroll
      for (int j4 = 0; j4 < 16; ++j4) { const float4 v = sp[j4]; S[j4 * 4] = v.x; S[j4 * 4 + 1] = v.y; S[j4 * 4 + 2] = v.z; S[j4 * 4 + 3] = v.w; }
    } else {
#pragma unroll
      for (int j = 0; j < 64; ++j) S[j] = 0.f;
    }
    const float lnw = p.in[I_LNW][c], lnb = p.in[I_LNB][c];
#pragma unroll 1
    for (int sub = 0; sub < 4; ++sub) {
      const int tl = tl0 + sub * 8, tok0 = b * SEQ + tl;
      float qv[8], yv[8], vv[9], gv[8], rkv[8];
      {
        const bfr* pr = PROJ + (size_t)tok0 * PW1 + 1024 + c;
        vv[0] = tl > 0 ? bf2f(pr[-PW1]) : 0.f;
#pragma unroll
        for (int s8 = 0; s8 < 8; ++s8) {
          const size_t o = base + (size_t)(sub * 8 + s8) * 512;
          qv[s8] = bf2f(Q[o]); yv[s8] = bf2f(YL[o]); gv[s8] = bf2f(G[o]);
          vv[s8 + 1] = bf2f(pr[(size_t)s8 * PW1]);
          rkv[s8] = RK[(tok0 + s8) * 8 + h];
        }
      }
#pragma unroll
      for (int s8 = 0; s8 < 8; ++s8) st[s8 * 64 + lane] = qv[s8];
      __builtin_amdgcn_fence(__ATOMIC_RELEASE, "wavefront");
      __builtin_amdgcn_wave_barrier();
#pragma unroll
      for (int s8 = 0; s8 < 8; ++s8) {
        float y = yv[s8];
        const float* d = st + s8 * 64;
#pragma unroll
        for (int j4 = 0; j4 < 16; ++j4) {
          const float4 q4 = *(const float4*)(d + j4 * 4);
          y += S[j4 * 4] * q4.x + S[j4 * 4 + 1] * q4.y + S[j4 * 4 + 2] * q4.z + S[j4 * 4 + 3] * q4.w;
        }
        const float mean = wave_sum(y) * (1.f / 64.f);
        const float dlt = y - mean;
        const float var = wave_sum(dlt * dlt) * (1.f / 64.f);
        const float yn = dlt * rsqrtf(var + 64e-5f) * lnw + lnb;
        const float v = vv[s8 + 1] + (vv[s8] - vv[s8 + 1]) * mu_v;
        const float outv = (yn + rkv[s8] * v) * gv[s8];
        MIX[(size_t)(tok0 + s8) * 1024 + c] = f2bf(outv);
      }
      __builtin_amdgcn_fence(__ATOMIC_RELEASE, "wavefront");
      __builtin_amdgcn_wave_barrier();
    }
  }
}

#ifndef REP_PREP
#define REP_PREP 1
#endif
#ifndef REP_PROJ0
#define REP_PROJ0 1
#endif
#ifndef REP_CMPA
#define REP_CMPA 1
#endif
#ifndef REP_SLC
#define REP_SLC 1
#endif
#ifndef REP_MOE1
#define REP_MOE1 1
#endif
#ifndef REP_MOE2
#define REP_MOE2 1
#endif
#ifndef REP_POST0
#define REP_POST0 1
#endif
#ifndef REP_RPREP
#define REP_RPREP 1
#endif
#ifndef REP_SCANB
#define REP_SCANB 1
#endif
#ifndef POOL_IN_SCANB
#define POOL_IN_SCANB 0
#endif
#ifndef REP_POOLG
#define REP_POOLG 1
#endif
#ifndef REP_SCANA
#define REP_SCANA 1
#endif
#ifndef REP_SCANAB
#define REP_SCANAB 1
#endif
#ifndef REP_SCANC
#define REP_SCANC 1
#endif
#ifndef REP_SYNC
#define REP_SYNC 1
#endif
extern __shared__ __attribute__((aligned(16))) char dyn_smem[];
DI char* smem_half() { int h = __builtin_amdgcn_readfirstlane((int)(threadIdx.x >> 8)); asm volatile("" : "+s"(h) :: "memory"); return dyn_smem + h * 49152; }
__global__ void __launch_bounds__(512, 2) fwd_megakernel(Params p) {
  cg::grid_group grid = cg::this_grid();
  __shared__ uint4 xb_words;
  char* ws = p.ws;
  const float* MOD = (const float*)(ws + O_MOD);
  const float* MOD1 = MOD + 8 * 6144;
  float* X = p.out;
  if (threadIdx.x == 0) xb_words = make_uint4(0u, 0u, 0u, 0u);
#ifndef TIMEPH
#define TIMEPH -1
#endif
  unsigned long long t_start = 0, t_mark = 0;
  if (TIMEPH >= 0) t_start = __builtin_amdgcn_s_memrealtime();

  for (int rep = 0; rep < REP_PREP; ++rep)
  {
    for (int item = VB; item < PREP_TOTAL; item += NVB) prep_item(p, smem_half(), item);
    conv_run(p, smem_half(), VB, NVB > 128 ? NC_PREP : NC_ALL, NVB);
  }
  grid.sync();
  const XcdBarrier xb = xcd_barrier_post((unsigned*)(ws + O_BAR), (volatile LAS unsigned*)&xb_words);
#ifndef TIMEPH
#define TIMEPH -1
#endif
  int gs_count = 0;
  if (TIMEPH == 0) t_mark = __builtin_amdgcn_s_memrealtime();
#define GSYNC() do { xcd_barrier(xb); if (TIMEPH >= 0) { ++gs_count; if (gs_count == TIMEPH) t_mark = __builtin_amdgcn_s_memrealtime(); } } while (0)
#ifndef XB_EXTRA_REL
#define XB_EXTRA_REL true
#endif
#ifndef XB_EXTRA_ACQ
#define XB_EXTRA_ACQ true
#endif
  for (int rep = 1; rep < REP_SYNC; ++rep) xcd_barrier<XB_EXTRA_REL, XB_EXTRA_ACQ>(xb);
  norm_phase<0, false>(p, smem_half(), p.in[I_X], nullptr, p.in[I_NMIX], MOD, 0, 1024, 0, 0);
  GSYNC();
  for (int rep = 0; rep < REP_PROJ0; ++rep) gemm_proj_phase<4>(p, dyn_smem, (const bfr*)(ws + O_WEIN), PW0, (bfr*)(ws + O_PROJ));
  GSYNC();
  for (int rep = 0; rep < REP_POST0; ++rep) post0_phase(p, smem_half());
  GSYNC();
  cmp2_phase(p, smem_half());
  GSYNC();
  for (int rep = 0; rep < REP_CMPA; ++rep) cmp_attn_mfma_phase(p, smem_half());
  GSYNC();
  for (int rep = 0; rep < REP_SLC; ++rep) attn_sw_phase(p, smem_half());
  GSYNC();
  gemm_out_phase(p, dyn_smem, (const bfr*)(ws + O_WEOUT), p.in[I_X], X, MOD + 2048);
  GSYNC();
  norm_router_phase(p, dyn_smem, X, p.in[I_NFFN], MOD, 3072, 4096, 0);
  GSYNC();
  for (int rep = 0; rep < REP_MOE1; ++rep) moe1_phase(p, smem_half(), 0);
  GSYNC();
  for (int rep = 0; rep < REP_MOE2; ++rep) moe2_phase(p, smem_half(), 0);
  GSYNC();
  norm_phase<1, false>(p, smem_half(), X, X, p.in[I_NMIX] + 1024, MOD1, 0, 1024, 5120 - 6144 * 8, 1);
  GSYNC();
  gemm_proj_phase<3>(p, dyn_smem, (const bfr*)(ws + O_WOIN), PW1, (bfr*)(ws + O_PROJ));
  GSYNC();
  for (int rep = 0; rep < REP_RPREP; ++rep) rwkv_lora_pool_phase(p, smem_half());
  GSYNC();
  for (int rep = 0; rep < REP_SCANA; ++rep) scanA_phase(p, smem_half());
  GSYNC();
  for (int rep = 0; rep < REP_SCANAB; ++rep) {
    if (rep > 0) { scanA_phase(p, smem_half()); GSYNC(); }
    scanB_phase(p, smem_half());
    GSYNC();
  }
  for (int rep = 0; rep < REP_SCANC; ++rep) scanC_phase(p, smem_half());
#if !POOL_IN_SCANB
  __syncthreads();
  for (int rep = 0; rep < REP_POOLG; ++rep) pool_gemm_tiles(p, smem_half(), VB, NVB);
#endif
  GSYNC();
  gemm_out_phase(p, dyn_smem, (const bfr*)(ws + O_WOOUT), X, X, MOD1 + 2048);
  GSYNC();
  norm_router_phase(p, dyn_smem, X, p.in[I_NFFN] + 1024, MOD1, 3072, 4096, 1);
  GSYNC();
  moe1_phase(p, smem_half(), 1);
  GSYNC();
  moe2_phase(p, smem_half(), 1);
  GSYNC();
  norm_phase<2, false>(p, smem_half(), X, X, p.in[I_FN], MOD1, 0, 0, 5120, 1);
  if (TIMEPH >= 0 && blockIdx.x == 0 && threadIdx.x == 0) {
    const unsigned long long dt = t_mark - t_start, t0 = __builtin_amdgcn_s_memrealtime();
    while (__builtin_amdgcn_s_memrealtime() - t0 < dt) __builtin_amdgcn_s_sleep(8);
  }
}

constexpr int DYN_LDS = 2 * 49152;
extern "C" void kernel_launch(void* const* d_in, const int* in_sizes, int n_in,
                              void* d_out, int out_size, void* d_ws, size_t ws_size,
                              hipStream_t stream) {
  static int grid_blocks = 0;
  if (!grid_blocks) {
    int dev = 0, cus = 0, per_cu = 0;
    (void)hipGetDevice(&dev);
    (void)hipDeviceGetAttribute(&cus, hipDeviceAttributeMultiprocessorCount, dev);
    (void)hipFuncSetAttribute((const void*)fwd_megakernel, hipFuncAttributeMaxDynamicSharedMemorySize, DYN_LDS);
    (void)hipOccupancyMaxActiveBlocksPerMultiprocessor(&per_cu, fwd_megakernel, 512, DYN_LDS);
    if (per_cu > 1) per_cu = 1;
    if (per_cu < 1) per_cu = 1;
    grid_blocks = cus * per_cu;
    fprintf(stderr, "cus=%d per_cu=%d grid=%d ws=%zu need=%zu\n", cus, per_cu, grid_blocks, ws_size, (size_t)WS_NEED);
  }
  if (ws_size < WS_NEED || n_in < 33) { fprintf(stderr, "workspace too small\n"); return; }
  Params p{};
  for (int i = 0; i < 33; ++i) p.in[i] = (const float*)d_in[i];
  p.out = (float*)d_out;
  p.ws = (char*)d_ws;
  p.ws_size = (unsigned long long)ws_size;
  void* args[] = {&p};
  hipError_t e = hipLaunchCooperativeKernel((void*)fwd_megakernel, dim3(grid_blocks), dim3(512), args, DYN_LDS, stream);
  if (e != hipSuccess) fprintf(stderr, "cooperative launch failed: %s (grid %d)\n", hipGetErrorString(e), grid_blocks);
}
```

```cpp
#include <hip/hip_runtime.h>
#include <hip/hip_cooperative_groups.h>
#include <cstdio>
namespace cg = cooperative_groups;

typedef unsigned short bfr;
using bf16x8 = __attribute__((ext_vector_type(8))) short;
using f32x4 = __attribute__((ext_vector_type(4))) float;
typedef __attribute__((ext_vector_type(2))) __bf16 bf2v;
#define DI __device__ __forceinline__

constexpr int NT = 16384;
constexpr int SEQ = 2048;
constexpr int DM = 1024;
constexpr int PW0 = 3072;
constexpr int PW1 = 2304;
constexpr int C_Q = 0, C_KC = 512, C_VC = 640, C_KS = 768, C_VS = 896, C_KW = 1024, C_VW = 1152;
constexpr int C_XB = 1280, C_BG = 1792, C_CG = 2304, C_GL = 2816;

constexpr size_t al256(size_t x) { return (x + 255) & ~size_t(255); }
constexpr size_t MB = 1024 * 1024;
constexpr size_t O_MOD = 0;
constexpr size_t O_ROPE = O_MOD + al256(2 * 8 * 6144 * 4);
constexpr size_t O_BIAS1 = O_ROPE + al256(2048 * 32 * 2 * 4);
constexpr size_t O_BAR = O_BIAS1 + al256(2 * 256 * 4);
constexpr size_t O_CNT = O_BAR + al256(3456 * 4);
constexpr size_t O_TOPW = O_CNT + al256(2 * 16 * 64 * 4);
constexpr size_t O_LIST = O_TOPW + al256((size_t)NT * 2 * 4);
constexpr size_t O_SEL = O_LIST + al256((size_t)16 * NT * 4);
constexpr size_t O_KCVC = O_SEL + al256((size_t)NT * 2 * 4);
constexpr size_t O_RK = O_KCVC + al256(2 * 2048 * 64 * 4);
constexpr size_t O_VCT = O_RK + al256((size_t)NT * 8 * 4);
constexpr size_t O_CH = O_VCT + al256(8 * 2 * 64 * 128 * 2);
constexpr size_t O_WEIN = O_CH + al256(2 * 2048 * 256 * 2);
constexpr size_t O_WEOUT = O_WEIN + al256((size_t)PW0 * 1024 * 2);
constexpr size_t O_WOIN = O_WEOUT + al256(1024 * 1024 * 2);
constexpr size_t O_WOOUT = O_WOIN + al256((size_t)PW1 * 1024 * 2);
constexpr size_t O_WC1 = O_WOOUT + al256(1024 * 1024 * 2);
constexpr size_t O_WC2 = O_WC1 + al256(2 * 256 * 2048 * 2);
constexpr size_t O_W2T = O_WC2 + al256(2 * 128 * 256 * 2);
constexpr size_t O_A2T = O_W2T + al256(512 * 64 * 2);
constexpr size_t O_G2T = O_A2T + al256(512 * 64 * 2);
constexpr size_t O_PWT = O_G2T + al256(512 * 128 * 2);
constexpr size_t O_WGU = O_PWT + al256(4 * 128 * 128 * 2);
constexpr size_t O_WDN = O_WGU + 64 * MB;
constexpr size_t O_HB = O_WDN + 32 * MB;
constexpr size_t O_MIX = O_HB + 32 * MB;
constexpr size_t O_E = O_MIX + 32 * MB;
constexpr size_t SZ_E = al256((size_t)NT * PW0 * 2);
constexpr size_t O_F = O_E + SZ_E;
constexpr size_t WS_NEED = O_F + 48 * MB;
constexpr size_t O_HMID = O_MIX;
constexpr size_t O_PROJ = O_E;
constexpr size_t O_MOEOUT = O_E;
constexpr size_t O_CHP = O_WGU;
constexpr size_t O_CHL = O_WGU + 16 * MB;
constexpr size_t O_QR = O_F;
constexpr size_t O_KSR = O_F + 16 * MB;
constexpr size_t O_KWR = O_F + 20 * MB;
constexpr size_t O_OCMP = O_F + 24 * MB;
constexpr size_t O_VST = O_F + 40 * MB;
constexpr size_t O_VWT = O_F + 44 * MB;
constexpr size_t O_RW_W = O_HB;
constexpr size_t O_RW_Q = O_F;
constexpr size_t O_RW_Y = O_F + 16 * MB;
constexpr size_t O_RW_AS = O_F + 32 * MB;
constexpr size_t O_RW_G = O_WDN;
constexpr size_t O_POOLED = O_E + 76 * MB;

struct Params {
  const float* in[33];
  float* out;
  char* ws;
  unsigned long long ws_size;
};

enum { I_X = 0, I_C, I_ADAW, I_ADAB, I_NMIX, I_NFFN, I_EWIN, I_CPOS, I_CW1, I_CW2, I_CONVW, I_EWOUT, I_OWIN, I_MU, I_W0, I_W2,
       I_A0, I_A2, I_G2, I_KK, I_KA, I_RKP, I_LNW, I_LNB, I_POOLW, I_POOLS, I_OWOUT, I_RTW, I_RTB, I_MG, I_MU_, I_MD, I_FN };

DI int tid_opaque() { int t = threadIdx.x & 255; asm volatile("" : "+v"(t) :: "memory"); __builtin_assume(t >= 0 && t < 256); return t; }
#define VB ((int)(blockIdx.x * 2 + __builtin_amdgcn_readfirstlane((int)(threadIdx.x >> 8))))
#define NVB ((int)(gridDim.x * 2))
DI float bf2f(bfr u) { return __uint_as_float(((unsigned)u) << 16); }
DI bfr f2bf(float x) { unsigned u = __float_as_uint(x); u += 0x7fffu + ((u >> 16) & 1u); return (bfr)(u >> 16); }
typedef __attribute__((ext_vector_type(2))) float f32x2_;
DI unsigned pack2(float a, float b) { f32x2_ x = {a, b}; return __builtin_bit_cast(unsigned, __builtin_convertvector(x, bf2v)); }
DI float lo2f(unsigned u) { return __uint_as_float(u << 16); }
DI float hi2f(unsigned u) { return __uint_as_float(u & 0xffff0000u); }
DI float wave_sum(float v) {
#pragma unroll
  for (int o = 32; o > 0; o >>= 1) v += __shfl_xor(v, o);
  return v;
}
DI float sigmoidf_(float x) { return 1.f / (1.f + __expf(-x)); }
DI float dot2(unsigned a, unsigned b, float c) {
  return __builtin_amdgcn_fdot2_f32_bf16(__builtin_bit_cast(bf2v, a), __builtin_bit_cast(bf2v, b), c, false);
}

#define XB_TMO      128
#define XB_XCNT(j)  (256  + 64 * (j))
#define XB_XSUB(j)  (1280 + 64 * (j))
#define XB_XGEN(j)  (2304 + 64 * (j))
#define XB_TOP      3328
#define XB_TOPGEN   3392
#define XCD_BAR_WORDS 3456
#define XB_SPIN_CAP (1u << 22)
#define LAS __attribute__((address_space(3)))
DI unsigned xb_ld(unsigned* p) { return __hip_atomic_load(p, __ATOMIC_RELAXED, __HIP_MEMORY_SCOPE_AGENT); }
DI unsigned xb_add(unsigned* p, unsigned v) { return __hip_atomic_fetch_add(p, v, __ATOMIC_RELAXED, __HIP_MEMORY_SCOPE_AGENT); }
DI unsigned xb_xcc_id() { return (unsigned)__builtin_amdgcn_s_getreg((3 << 11) | 20) & 0xFu; }
#define XB_SPIN(cond, bar) do { unsigned _sp = 0; while (cond) { __builtin_amdgcn_s_sleep(1); \
    if ((++_sp & 255u) == 0u) { if (xb_ld(&(bar)[XB_TMO])) break; if (_sp > XB_SPIN_CAP) { atomicAdd(&(bar)[XB_TMO], 1u); break; } } } } while (0)
struct XcdBarrier { unsigned* bar; unsigned x; volatile LAS unsigned* st; };
DI XcdBarrier xcd_barrier_post(unsigned* bar, volatile LAS unsigned* st) {
  XcdBarrier b; b.bar = bar; b.x = (unsigned)__builtin_amdgcn_readfirstlane((int)xb_xcc_id()); b.st = st;
  if (threadIdx.x == 0) (void)xb_add(&bar[XB_XCNT(b.x)], 1u);
  return b;
}
DI void xcd_barrier_complete(unsigned* bar, unsigned x, unsigned& nloc, unsigned& nx) {
  const unsigned G = gridDim.x * gridDim.y * gridDim.z;
  unsigned sum, cnt, mine, sp = 0u;
  for (;;) {
    sum = 0u; cnt = 0u; mine = 0u;
#pragma unroll
    for (unsigned j = 0; j < 16; ++j) { const unsigned c = xb_ld(&bar[XB_XCNT(j)]); sum += c; cnt += (c > 0u) ? 1u : 0u; mine = (j == x) ? c : mine; }
    if (sum == G) break;
    __builtin_amdgcn_s_sleep(1);
    if ((++sp & 255u) == 0u) { if (xb_ld(&bar[XB_TMO])) break; if (sp > XB_SPIN_CAP) { atomicAdd(&bar[XB_TMO], 1u); break; } }
  }
  nloc = mine > 0u ? mine : 1u; nx = cnt > 0u ? cnt : 1u;
}
template <bool REL = true, bool ACQ = true>
DI void xcd_barrier(const XcdBarrier& b) {
  asm volatile("s_waitcnt vmcnt(0)" ::: "memory");
  __syncthreads();
  if (threadIdx.x == 0) {
    unsigned* bar = b.bar;
    unsigned bx = b.x;
    asm volatile("" : "+s"(bx));
    __builtin_amdgcn_s_waitcnt(0);
    unsigned nloc = b.st[0], nx = b.st[1];
    if (nloc == 0u) { xcd_barrier_complete(bar, bx, nloc, nx); b.st[0] = nloc; b.st[1] = nx; }
    const unsigned old = xb_add(&bar[XB_XSUB(bx)], 1u);
    const unsigned gen = old / nloc;
    if (old + 1u == (gen + 1u) * nloc) {
      if (REL) __builtin_amdgcn_fence(__ATOMIC_RELEASE, "agent");
      asm volatile("s_waitcnt vmcnt(0)" ::: "memory");
      const unsigned og = xb_add(&bar[XB_TOP], 1u);
      const unsigned tg = og / nx;
      if (og + 1u == (tg + 1u) * nx) xb_add(&bar[XB_TOPGEN], 1u);
      else XB_SPIN(xb_ld(&bar[XB_TOPGEN]) == tg, bar);
      if (ACQ) __builtin_amdgcn_fence(__ATOMIC_ACQUIRE, "agent");
      xb_add(&bar[XB_XGEN(bx)], 1u);
      asm volatile("s_waitcnt vmcnt(0)" ::: "memory");
    } else {
      XB_SPIN(xb_ld(&bar[XB_XGEN(bx)]) == gen, bar);
      if (ACQ) __builtin_amdgcn_fence(__ATOMIC_ACQUIRE, "agent");
      asm volatile("s_waitcnt vmcnt(0)" ::: "memory");
    }
  }
  __syncthreads();
}

struct GemmLds { bfr a[2][128][40]; bfr b[2][128][40]; };
static_assert(sizeof(GemmLds) == 40960, "lds");

template <class AF, class BF, class Epi>
DI void gemm_tile(char* smem, int nk, AF af, BF bfn, Epi&& epi) {
  GemmLds& L = *(GemmLds*)smem;
  const int tid = tid_opaque(), lane = tid & 63, wid = tid >> 6, wr = wid >> 1, wc = wid & 1, fr = lane & 15, fq = lane >> 4;
  const int lr = tid >> 2, lk = (tid & 3) * 8;
  af.init(lr);
  bfn.init(lr);
  f32x4 acc[4][4];
#pragma unroll
  for (int m = 0; m < 4; ++m)
#pragma unroll
    for (int n = 0; n < 4; ++n) acc[m][n] = f32x4{0.f, 0.f, 0.f, 0.f};
  uint4 ra0, ra1, rb0, rb1;
  ra0 = af.load(0, lk); ra1 = af.load(1, lk);
  rb0 = bfn.load(0, lk); rb1 = bfn.load(1, lk);
  *(uint4*)&L.a[0][lr][lk] = ra0; *(uint4*)&L.a[0][lr + 64][lk] = ra1;
  *(uint4*)&L.b[0][lr][lk] = rb0; *(uint4*)&L.b[0][lr + 64][lk] = rb1;
  __syncthreads();
  for (int kt = 0; kt < nk; ++kt) {
    const int cur = kt & 1;
    if (kt + 1 < nk) {
      const int k = (kt + 1) * 32 + lk;
      ra0 = af.load(0, k); ra1 = af.load(1, k);
      rb0 = bfn.load(0, k); rb1 = bfn.load(1, k);
    }
    __builtin_amdgcn_sched_barrier(0);
    bf16x8 fa[4], fb[4];
#pragma unroll
    for (int m = 0; m < 4; ++m) fa[m] = *(const bf16x8*)&L.a[cur][wr * 64 + m * 16 + fr][fq * 8];
#pragma unroll
    for (int n = 0; n < 4; ++n) fb[n] = *(const bf16x8*)&L.b[cur][wc * 64 + n * 16 + fr][fq * 8];
#pragma unroll
    for (int m = 0; m < 4; ++m)
#pragma unroll
      for (int n = 0; n < 4; ++n) acc[m][n] = __builtin_amdgcn_mfma_f32_16x16x32_bf16(fa[m], fb[n], acc[m][n], 0, 0, 0);
    __builtin_amdgcn_sched_barrier(0);
    if (kt + 1 < nk) {
      *(uint4*)&L.a[cur ^ 1][lr][lk] = ra0; *(uint4*)&L.a[cur ^ 1][lr + 64][lk] = ra1;
      *(uint4*)&L.b[cur ^ 1][lr][lk] = rb0; *(uint4*)&L.b[cur ^ 1][lr + 64][lk] = rb1;
    }
    __syncthreads();
  }
  epi(acc, wr, wc, fr, fq);
}

struct RowsContig {
  const bfr* base; int ld; int maxrow;
  const bfr* rp[2];
  DI void init(int lr) {
#pragma unroll
    for (int i = 0; i < 2; ++i) { const int r = lr + 64 * i; rp[i] = base + (size_t)(r < maxrow ? r : maxrow) * ld; }
  }
  DI uint4 load(int sel, int k) const { return *(const uint4*)(rp[sel] + k); }
  DI const bfr* ptr(int sel, int k) const { return rp[sel] + k; }
};

#ifndef KLOOP2
#define KLOOP2 1
#endif
struct RowsContigW {
  const bfr* base; int ld; int maxrow;
  const bfr* rp[2];
  DI void init(int lr) {
#pragma unroll
    for (int i = 0; i < 2; ++i) { const int r = lr + 64 * i; rp[i] = base + (size_t)(r < maxrow ? r : maxrow) * ld; }
  }
  DI const bfr* ptr(int sel, int k) const { return rp[sel] + (k & 1023); }
};
struct GemmLdsG { bfr a[3][128][32]; bfr b[3][128][32]; };
static_assert(sizeof(GemmLdsG) == 49152, "glds lds");
template <class AF, class BF, class Epi>
DI void gemm_tile_g(char* smem, int nk, AF af, BF bfn, Epi&& epi) {
  GemmLdsG& L = *(GemmLdsG*)smem;
  const int tid = tid_opaque(), lane = tid & 63, wid = tid >> 6, wr = wid >> 1, wc = wid & 1, fr = lane & 15, fq = lane >> 4;
  const int lr = tid >> 2;
  const int lk = ((tid & 3) ^ (2 * ((lr >> 3) & 1))) * 8;
  af.init(lr);
  bfn.init(lr);
  f32x4 acc[4][4];
#pragma unroll
  for (int m = 0; m < 4; ++m)
#pragma unroll
    for (int n = 0; n < 4; ++n) acc[m][n] = f32x4{0.f, 0.f, 0.f, 0.f};
  typedef __attribute__((address_space(3))) unsigned lds_u32;
  auto stage = [&](int buf, int kt) {
    const int k = kt * 32 + lk;
    char* la = (char*)&L.a[buf][0][0] + tid * 16;
    char* lb = (char*)&L.b[buf][0][0] + tid * 16;
    __builtin_amdgcn_global_load_lds((const unsigned*)af.ptr(0, k), (lds_u32*)la, 16, 0, 0);
    __builtin_amdgcn_global_load_lds((const unsigned*)af.ptr(1, k), (lds_u32*)(la + 4096), 16, 0, 0);
    __builtin_amdgcn_global_load_lds((const unsigned*)bfn.ptr(0, k), (lds_u32*)lb, 16, 0, 0);
    __builtin_amdgcn_global_load_lds((const unsigned*)bfn.ptr(1, k), (lds_u32*)(lb + 4096), 16, 0, 0);
  };
  const int cs = (fq ^ (2 * (fr >> 3))) * 8;
  stage(0, 0);
  stage(1, 1);
  int cur = 0;
  for (int kt = 0; kt < nk; ++kt) {
    if (kt + 1 < nk) asm volatile("s_waitcnt vmcnt(4)" ::: "memory");
    else asm volatile("s_waitcnt vmcnt(0)" ::: "memory");
    __builtin_amdgcn_s_barrier();
    asm volatile("" ::: "memory");
    if (kt + 2 < nk) stage(cur == 0 ? 2 : cur - 1, kt + 2);
    bf16x8 fa[4], fb[4];
#pragma unroll
    for (int m = 0; m < 4; ++m) fa[m] = *(const bf16x8*)&L.a[cur][wr * 64 + m * 16 + fr][cs];
#pragma unroll
    for (int n = 0; n < 4; ++n) fb[n] = *(const bf16x8*)&L.b[cur][wc * 64 + n * 16 + fr][cs];
#pragma unroll
    for (int m = 0; m < 4; ++m)
#pragma unroll
      for (int n = 0; n < 4; ++n) acc[m][n] = __builtin_amdgcn_mfma_f32_16x16x32_bf16(fb[n], fa[m], acc[m][n], 0, 0, 0);
    cur = cur == 2 ? 0 : cur + 1;
  }
  asm volatile("s_waitcnt lgkmcnt(0)" ::: "memory");
  __builtin_amdgcn_s_barrier();
  asm volatile("" ::: "memory");
  epi(acc, wr, wc, fr, fq);
}

DI int tid512_opaque() { int t = threadIdx.x; asm volatile("" : "+v"(t) :: "memory"); __builtin_assume(t >= 0 && t < 512); return t; }
struct GemmLds256 { bfr a[3][256][32]; bfr b[3][256][32]; };
static_assert(sizeof(GemmLds256) == 98304, "lds256");
struct Rows256 {
  const bfr* base; int ld; int maxrow;
  const bfr* rp[2];
  DI void init(int lr) {
#pragma unroll
    for (int i = 0; i < 2; ++i) { const int r = lr + 128 * i; rp[i] = base + (size_t)(r < maxrow ? r : maxrow) * ld; }
  }
  DI const bfr* ptr(int sel, int k) const { return rp[sel] + k; }
};
template <int NS, class AF, class BF, class Epi>
DI void gemm_tile_256(char* smem_all, int nk, AF af, BF bfn, Epi&& epi) {
  GemmLds256& L = *(GemmLds256*)smem_all;
  const int tid = tid512_opaque(), lane = tid & 63, wid = tid >> 6, wr = wid >> 2, wc = wid & 3, fr = lane & 15, fq = lane >> 4;
  const int lr = tid >> 2;
  const int lk = ((tid & 3) ^ (2 * ((lr >> 3) & 1))) * 8;
  af.init(lr);
  bfn.init(lr);
  f32x4 acc[8][NS];
#pragma unroll
  for (int m = 0; m < 8; ++m)
#pragma unroll
    for (int n = 0; n < NS; ++n) acc[m][n] = f32x4{0.f, 0.f, 0.f, 0.f};
  typedef __attribute__((address_space(3))) unsigned lds_u32;
  auto stage = [&](int buf, int kt) {
    const int k = kt * 32 + lk;
    char* la = (char*)&L.a[buf][0][0] + tid * 16;
    char* lb = (char*)&L.b[buf][0][0] + tid * 16;
    __builtin_amdgcn_global_load_lds((const unsigned*)af.ptr(0, k), (lds_u32*)la, 16, 0, 0);
    __builtin_amdgcn_global_load_lds((const unsigned*)af.ptr(1, k), (lds_u32*)(la + 8192), 16, 0, 0);
    __builtin_amdgcn_global_load_lds((const unsigned*)bfn.ptr(0, k), (lds_u32*)lb, 16, 0, 0);
    __builtin_amdgcn_global_load_lds((const unsigned*)bfn.ptr(1, k), (lds_u32*)(lb + 8192), 16, 0, 0);
  };
  const int cs = (fq ^ (2 * (fr >> 3))) * 8;
  stage(0, 0);
  stage(1, 1);
  int cur = 0;
  for (int kt = 0; kt < nk; ++kt) {
    if (kt + 1 < nk) asm volatile("s_waitcnt vmcnt(4)" ::: "memory");
    else asm volatile("s_waitcnt vmcnt(0)" ::: "memory");
    __builtin_amdgcn_s_barrier();
    asm volatile("" ::: "memory");
    if (kt + 2 < nk) stage(cur == 0 ? 2 : cur - 1, kt + 2);
    bf16x8 fb[NS];
#pragma unroll
    for (int n = 0; n < NS; ++n) fb[n] = *(const bf16x8*)&L.b[cur][wc * (NS * 16) + n * 16 + fr][cs];
#pragma unroll
    for (int mh = 0; mh < 2; ++mh) {
      bf16x8 fa[4];
#pragma unroll
      for (int m = 0; m < 4; ++m) fa[m] = *(const bf16x8*)&L.a[cur][wr * 128 + (mh * 4 + m) * 16 + fr][cs];
#pragma unroll
      for (int m = 0; m < 4; ++m)
#pragma unroll
        for (int n = 0; n < NS; ++n) acc[mh * 4 + m][n] = __builtin_amdgcn_mfma_f32_16x16x32_bf16(fb[n], fa[m], acc[mh * 4 + m][n], 0, 0, 0);
    }
    cur = cur == 2 ? 0 : cur + 1;
  }
  asm volatile("s_waitcnt lgkmcnt(0)" ::: "memory");
  __builtin_amdgcn_s_barrier();
  asm volatile("" ::: "memory");
  epi(acc, wr, wc, fr, fq);
}

DI int remap_col(int mode, int n) {
  if (mode == 1) return n < 1280 ? n : (n < 1304 ? C_GL + (n - 1280) : n - 24);
  if (mode == 2) return ((n >> 4) << 5) + (n & 15);
  if (mode == 3) return ((n >> 4) << 5) + 16 + (n & 15);
  return n;
}

DI void conv_tile(char* smem, const float* __restrict__ src, int ldsrc, int Ndim, int k0, int n0, bfr* dst, int ldd, int mode) {
  float(*t)[65] = (float(*)[65])smem;
  const int tid = tid_opaque();
  {
    const int n = tid & 63, kq = tid >> 6;
    const int nn = n0 + n;
#pragma unroll
    for (int i = 0; i < 16; ++i) {
      const int k = i * 4 + kq;
      t[k][n] = (nn < Ndim) ? src[(size_t)(k0 + k) * ldsrc + nn] : 0.f;
    }
  }
  __syncthreads();
  {
    const int nl = tid >> 2, kc = (tid & 3) * 16;
    const int nn = n0 + nl;
    if (nn < Ndim) {
      const int dr = remap_col(mode, nn);
      unsigned w[8];
#pragma unroll
      for (int i = 0; i < 8; ++i) w[i] = pack2(t[kc + 2 * i][nl], t[kc + 2 * i + 1][nl]);
      uint4* d = (uint4*)(dst + (size_t)dr * ldd + k0 + kc);
      d[0] = make_uint4(w[0], w[1], w[2], w[3]);
      d[1] = make_uint4(w[4], w[5], w[6], w[7]);
    }
  }
  __syncthreads();
}

constexpr int PREP_MOD = 192, PREP_ROPE = 256, PREP_MISC = 4;
constexpr int T_EIN = 16 * 45, T_SQ = 256, T_OIN = 16 * 36, T_C1 = 128, T_C2 = 4, T_G = 128, T_D = 128;
constexpr int PREP_CONV0 = PREP_MOD + PREP_ROPE + PREP_MISC;
constexpr int T_LORA = 8 + 8 + 16 + 16;
constexpr int PREP_TOTAL = PREP_CONV0;

struct ConvJob { const float* src; bfr* dst; int ldsrc, Ndim, k0, n0, ldd, mode; };
constexpr int J_EIN = 16 * 23, J_SQ = 16 * 8, J_OIN = 16 * 18, J_C1 = 32 * 2, J_C2 = 4, J_LORA = 4 + 4 + 8 + 8, J_G = 16 * 4, J_D = 8 * 8;
constexpr int NC_MISC = J_EIN + J_SQ + J_OIN + J_SQ + 2 * J_C1 + 2 * J_C2 + J_LORA;
constexpr int NC_EXP = 2 * J_G + J_D;
constexpr int NC_PREP = NC_MISC + 16 * NC_EXP;
constexpr int NC_ALL = NC_MISC + 32 * NC_EXP;
static_assert(NC_MISC % 2 == 0 && NC_EXP % 2 == 0, "paired halves need even job counts");
DI ConvJob conv_decode(const Params& p, int item) {
  char* ws = p.ws;
  ConvJob j;
  if (item < J_EIN) { j = ConvJob{p.in[I_EWIN], (bfr*)(ws + O_WEIN), 2840, 2840, (item / 23) * 64, (item % 23) * 128, 1024, 1}; return j; }
  item -= J_EIN;
  if (item < J_SQ) { j = ConvJob{p.in[I_EWOUT], (bfr*)(ws + O_WEOUT), 1024, 1024, (item / 8) * 64, (item % 8) * 128, 1024, 0}; return j; }
  item -= J_SQ;
  if (item < J_OIN) { j = ConvJob{p.in[I_OWIN], (bfr*)(ws + O_WOIN), 2304, 2304, (item / 18) * 64, (item % 18) * 128, 1024, 0}; return j; }
  item -= J_OIN;
  if (item < J_SQ) { j = ConvJob{p.in[I_OWOUT], (bfr*)(ws + O_WOOUT), 1024, 1024, (item / 8) * 64, (item % 8) * 128, 1024, 0}; return j; }
  item -= J_SQ;
  if (item < 2 * J_C1) {
    const int jj = item / J_C1, tt = item % J_C1;
    j = ConvJob{p.in[I_CW1] + (size_t)jj * 2048 * 256, (bfr*)(ws + O_WC1) + (size_t)jj * 256 * 2048, 256, 256, (tt / 2) * 64, (tt % 2) * 128, 2048, 0}; return j;
  }
  item -= 2 * J_C1;
  if (item < 2 * J_C2) {
    const int jj = item / J_C2, tt = item % J_C2;
    j = ConvJob{p.in[I_CW2] + (size_t)jj * 256 * 64, (bfr*)(ws + O_WC2) + (size_t)jj * 128 * 256, 64, 64, tt * 64, 0, 256, 0}; return j;
  }
  item -= 2 * J_C2;
  if (item < J_LORA) {
    if (item < 4) j = ConvJob{p.in[I_W2], (bfr*)(ws + O_W2T), 512, 512, 0, item * 128, 64, 0};
    else if (item < 8) j = ConvJob{p.in[I_A2], (bfr*)(ws + O_A2T), 512, 512, 0, (item - 4) * 128, 64, 0};
    else if (item < 16) { const int t2 = item - 8; j = ConvJob{p.in[I_G2], (bfr*)(ws + O_G2T), 512, 512, (t2 >> 2) * 64, (t2 & 3) * 128, 128, 0}; }
    else { const int t2 = item - 16, gi = t2 >> 1; j = ConvJob{p.in[I_POOLW] + gi * 128 * 128, (bfr*)(ws + O_PWT) + gi * 128 * 128, 128, 128, (t2 & 1) * 64, 0, 128, 0}; }
    return j;
  }
  item -= J_LORA;
  const int le = item / NC_EXP, tt = item % NC_EXP;
  if (tt < J_G) j = ConvJob{p.in[I_MG] + (size_t)le * 1024 * 512, (bfr*)(ws + O_WGU) + (size_t)le * 1024 * 1024, 512, 512, (tt / 4) * 64, (tt % 4) * 128, 1024, 2};
  else if (tt < 2 * J_G) { const int t2 = tt - J_G; j = ConvJob{p.in[I_MU_] + (size_t)le * 1024 * 512, (bfr*)(ws + O_WGU) + (size_t)le * 1024 * 1024, 512, 512, (t2 / 4) * 64, (t2 % 4) * 128, 1024, 3}; }
  else { const int t2 = tt - 2 * J_G; j = ConvJob{p.in[I_MD] + (size_t)le * 512 * 1024, (bfr*)(ws + O_WDN) + (size_t)le * 1024 * 512, 1024, 1024, (t2 / 8) * 64, (t2 % 8) * 128, 512, 0}; }
  return j;
}
DI void conv_run(const Params& p, char* smem, int first, int end, int stride) {
  float(*t)[129] = (float(*)[129])smem;
  const int tid = tid_opaque();
  const int lk = tid >> 5, ln = (tid & 31) * 4;
  float4 r[8];
  auto gload = [&](const ConvJob& j) {
#pragma unroll
    for (int ps = 0; ps < 8; ++ps) {
      r[ps] = make_float4(0.f, 0.f, 0.f, 0.f);
      if (j.n0 + ln < j.Ndim) r[ps] = *(const float4*)(j.src + (size_t)(j.k0 + lk + 8 * ps) * j.ldsrc + j.n0 + ln);
    }
  };
  int ci = first;
  ConvJob cur{};
  if (ci < end) { cur = conv_decode(p, ci); gload(cur); }
  for (; ci < end; ci += stride) {
#pragma unroll
    for (int ps = 0; ps < 8; ++ps) {
      t[lk + 8 * ps][ln] = r[ps].x; t[lk + 8 * ps][ln + 1] = r[ps].y; t[lk + 8 * ps][ln + 2] = r[ps].z; t[lk + 8 * ps][ln + 3] = r[ps].w;
    }
    __syncthreads();
    ConvJob nxt = cur;
    if (ci + stride < end) { nxt = conv_decode(p, ci + stride); gload(nxt); }
    {
      const int nl = tid >> 1, kc = (tid & 1) * 32;
      const int nn = cur.n0 + nl;
      if (nn < cur.Ndim) {
        const int dr = remap_col(cur.mode, nn);
        unsigned w[16];
#pragma unroll
        for (int i = 0; i < 16; ++i) w[i] = pack2(t[kc + 2 * i][nl], t[kc + 2 * i + 1][nl]);
        uint4* d = (uint4*)(cur.dst + (size_t)dr * cur.ldd + cur.k0 + kc);
        d[0] = make_uint4(w[0], w[1], w[2], w[3]);
        d[1] = make_uint4(w[4], w[5], w[6], w[7]);
        d[2] = make_uint4(w[8], w[9], w[10], w[11]);
        d[3] = make_uint4(w[12], w[13], w[14], w[15]);
      }
    }
    __syncthreads();
    cur = nxt;
  }
}

DI void prep_item(const Params& p, char* smem, int item) {
  const int tid = tid_opaque();
  char* ws = p.ws;
  if (item < PREP_MOD) {
    const int layer = item / 96, cch = item % 96;
    float* cond = (float*)smem;
    float* red = (float*)(smem + 32768);
    const float* c = p.in[I_C];
    for (int i = tid; i < 8192; i += 256) {
      const int b = i >> 10, k = i & 1023;
      const float v = c[i];
      cond[k * 8 + b] = v / (1.f + __expf(-v));
    }
    __syncthreads();
    const int col = cch * 64 + (tid & 63), kg = tid >> 6;
    const float* w = p.in[I_ADAW] + (size_t)layer * 1024 * 6144 + col;
    float acc[8] = {0, 0, 0, 0, 0, 0, 0, 0};
#pragma unroll 8
    for (int k = kg * 256; k < kg * 256 + 256; ++k) {
      const float wv = w[(size_t)k * 6144];
      const float4 c0 = *(const float4*)&cond[k * 8], c1 = *(const float4*)&cond[k * 8 + 4];
      acc[0] += c0.x * wv; acc[1] += c0.y * wv; acc[2] += c0.z * wv; acc[3] += c0.w * wv;
      acc[4] += c1.x * wv; acc[5] += c1.y * wv; acc[6] += c1.z * wv; acc[7] += c1.w * wv;
    }
#pragma unroll
    for (int b = 0; b < 8; ++b) red[(kg * 8 + b) * 64 + (tid & 63)] = acc[b];
    __syncthreads();
    for (int i = tid; i < 512; i += 256) {
      const int b = i >> 6, cc = i & 63;
      const float s = red[(0 * 8 + b) * 64 + cc] + red[(1 * 8 + b) * 64 + cc] + red[(2 * 8 + b) * 64 + cc] + red[(3 * 8 + b) * 64 + cc];
      const int cg_ = cch * 64 + cc;
      ((float*)(ws + O_MOD))[(layer * 8 + b) * 6144 + cg_] = s + p.in[I_ADAB][layer * 6144 + cg_];
    }
    __syncthreads();
    return;
  }
  item -= PREP_MOD;
  if (item < PREP_ROPE) {
    const int e = item * 256 + tid;
    const int t = e >> 5, i = e & 31;
    const float inv = powf(10000.f, -(float)i / 32.f);
    const float ang = (float)t * inv;
    float* rp = (float*)(ws + O_ROPE);
    rp[e] = cosf(ang);
    rp[65536 + e] = sinf(ang);
    return;
  }
  item -= PREP_ROPE;
  if (item < PREP_MISC) {
    if (item == 3) return;
    if (item < 2) {
      const int j = item, n = tid;
      const float* pos = p.in[I_CPOS] + j * 2048;
      const float* w1 = p.in[I_CW1] + (size_t)j * 2048 * 256 + n;
      float s = 0.f;
      for (int k = 0; k < 2048; ++k) s += pos[k] * w1[(size_t)k * 256];
      ((float*)(ws + O_BIAS1))[j * 256 + n] = s;
    } else {
      int* cnt = (int*)(ws + O_CNT);
      for (int i = tid; i < 2 * 16 * 64; i += 256) cnt[i] = 0;
      uint4* vct = (uint4*)(ws + O_VCT);
      for (int i = tid; i < 8 * 2 * 64 * 128 * 2 / 16; i += 256) vct[i] = make_uint4(0, 0, 0, 0);
      unsigned* barw = (unsigned*)(ws + O_BAR);
      for (int i = tid; i < XCD_BAR_WORDS; i += 256) barw[i] = 0u;
      uint4 z = make_uint4(0, 0, 0, 0);
      uint4* wpad = (uint4*)(ws + O_WEIN + (size_t)2840 * 1024 * 2);
      for (int i = tid; i < (PW0 - 2840) * 1024 * 2 / 16; i += 256) wpad[i] = z;
      for (int j = 0; j < 2; ++j) {
        uint4* cp = (uint4*)(ws + O_WC2 + ((size_t)j * 128 + 64) * 256 * 2);
        for (int i = tid; i < 64 * 256 * 2 / 16; i += 256) cp[i] = z;
      }
    }
    return;
  }
}

template <int MODE, bool ROUTER>
DI void norm_phase(const Params& p, char* smem, const float* xin, float* xout, const float* nw, const float* modl,
                   int sh_off, int sc_off, int g_off, int layer) {
  char* ws = p.ws;
  const int tid = tid_opaque(), lane = tid & 63, wid = tid >> 6;
  bfr* HB = (bfr*)(ws + O_HB);
  const bfr* MO0 = (const bfr*)(ws + O_MOEOUT);
  const bfr* MO1 = MO0 + (size_t)NT * 1024;
  for (int chunk = VB; chunk < NT / 32; chunk += NVB) {
    const int b = (chunk * 32) >> 11;
#pragma unroll 1
    for (int it = 0; it < 4; ++it) {
      float v[2][16];
      float ss[2];
#pragma unroll
      for (int rr = 0; rr < 2; ++rr) {
        const int row = chunk * 32 + (it * 2 + rr) * 4 + wid;
        ss[rr] = 0.f;
#pragma unroll
        for (int i = 0; i < 2; ++i) {
          const int c = (i * 64 + lane) * 8;
          float4 x0 = *(const float4*)(xin + (size_t)row * 1024 + c), x1 = *(const float4*)(xin + (size_t)row * 1024 + c + 4);
          if (MODE >= 1) {
            const float4 g0 = *(const float4*)(modl + b * 6144 + g_off + c), g1 = *(const float4*)(modl + b * 6144 + g_off + c + 4);
            const uint4 m0 = *(const uint4*)(MO0 + (size_t)row * 1024 + c);
            const uint4 m1 = *(const uint4*)(MO1 + (size_t)row * 1024 + c);
            x0.x += g0.x * (lo2f(m0.x) + lo2f(m1.x)); x0.y += g0.y * (hi2f(m0.x) + hi2f(m1.x));
            x0.z += g0.z * (lo2f(m0.y) + lo2f(m1.y)); x0.w += g0.w * (hi2f(m0.y) + hi2f(m1.y));
            x1.x += g1.x * (lo2f(m0.z) + lo2f(m1.z)); x1.y += g1.y * (hi2f(m0.z) + hi2f(m1.z));
            x1.z += g1.z * (lo2f(m0.w) + lo2f(m1.w)); x1.w += g1.w * (hi2f(m0.w) + hi2f(m1.w));
            if (MODE == 1) { *(float4*)(xout + (size_t)row * 1024 + c) = x0; *(float4*)(xout + (size_t)row * 1024 + c + 4) = x1; }
          }
          v[rr][i * 8 + 0] = x0.x; v[rr][i * 8 + 1] = x0.y; v[rr][i * 8 + 2] = x0.z; v[rr][i * 8 + 3] = x0.w;
          v[rr][i * 8 + 4] = x1.x; v[rr][i * 8 + 5] = x1.y; v[rr][i * 8 + 6] = x1.z; v[rr][i * 8 + 7] = x1.w;
          ss[rr] += x0.x * x0.x + x0.y * x0.y + x0.z * x0.z + x0.w * x0.w + x1.x * x1.x + x1.y * x1.y + x1.z * x1.z + x1.w * x1.w;
        }
      }
      const float rstd0 = rsqrtf(wave_sum(ss[0]) * (1.f / 1024.f) + 1e-6f);
      const float rstd1 = rsqrtf(wave_sum(ss[1]) * (1.f / 1024.f) + 1e-6f);
#pragma unroll
      for (int i = 0; i < 2; ++i) {
        const int c = (i * 64 + lane) * 8;
        const float4 w0 = *(const float4*)(nw + c), w1 = *(const float4*)(nw + c + 4);
        float wv[8] = {w0.x, w0.y, w0.z, w0.w, w1.x, w1.y, w1.z, w1.w};
        float shv[8] = {0.f, 0.f, 0.f, 0.f, 0.f, 0.f, 0.f, 0.f};
        if (MODE != 2) {
          const float4 sc0 = *(const float4*)(modl + b * 6144 + sc_off + c), sc1 = *(const float4*)(modl + b * 6144 + sc_off + c + 4);
          const float4 sh0 = *(const float4*)(modl + b * 6144 + sh_off + c), sh1 = *(const float4*)(modl + b * 6144 + sh_off + c + 4);
          wv[0] *= 1.f + sc0.x; wv[1] *= 1.f + sc0.y; wv[2] *= 1.f + sc0.z; wv[3] *= 1.f + sc0.w;
          wv[4] *= 1.f + sc1.x; wv[5] *= 1.f + sc1.y; wv[6] *= 1.f + sc1.z; wv[7] *= 1.f + sc1.w;
          shv[0] = sh0.x; shv[1] = sh0.y; shv[2] = sh0.z; shv[3] = sh0.w; shv[4] = sh1.x; shv[5] = sh1.y; shv[6] = sh1.z; shv[7] = sh1.w;
        }
#pragma unroll
        for (int rr = 0; rr < 2; ++rr) {
          const int row = chunk * 32 + (it * 2 + rr) * 4 + wid;
          const float rstd = rr ? rstd1 : rstd0;
          float o[8];
#pragma unroll
          for (int q = 0; q < 8; ++q) o[q] = v[rr][i * 8 + q] * rstd * wv[q] + shv[q];
          if (MODE == 2) {
            *(float4*)(xout + (size_t)row * 1024 + c) = make_float4(o[0], o[1], o[2], o[3]);
            *(float4*)(xout + (size_t)row * 1024 + c + 4) = make_float4(o[4], o[5], o[6], o[7]);
          } else {
            *(uint4*)(HB + (size_t)row * 1024 + c) = make_uint4(pack2(o[0], o[1]), pack2(o[2], o[3]), pack2(o[4], o[5]), pack2(o[6], o[7]));
          }
        }
      }
    }
  }
}

constexpr int NR = 2;
DI void norm_router_phase(const Params& p, char* smem_all, const float* xin, const float* nw, const float* modl, int sh_off, int sc_off, int layer) {
  char* ws = p.ws;
  const int tid = tid_opaque(), lane = tid & 63, wid = tid >> 6;
  bfr* HB = (bfr*)(ws + O_HB);
  float* rwl = (float*)smem_all;
  {
    const float* rwg = p.in[I_RTW];
    for (int idx = threadIdx.x; idx < 16384; idx += 512) {
      const int e3 = idx & 3, ln = (idx >> 2) & 63, eq = (idx >> 8) & 3, iq = idx >> 10;
      const int c = ((iq >> 3) * 64 + ln) * 8 + (iq & 7);
      rwl[idx] = rwg[c * 16 + eq * 4 + e3];
    }
  }
  char* smem = smem_all + 65536 + (threadIdx.x >> 8) * 4096;
  __syncthreads();
  int* lcnt = (int*)smem;
  int* lbase = lcnt + 16;
  int* lexp = lbase + 16;
  int* lrank = lexp + 64;
  for (int chunk = VB; chunk < NT / 32; chunk += NVB) {
    if (tid < 16) lcnt[tid] = 0;
    __syncthreads();
#pragma unroll 1
    for (int it2 = 0; it2 < 8 / NR; ++it2) {
      const int row0 = chunk * 32 + wid * 8 + it2 * NR;
      const int b = row0 >> 11;
      float v[NR][16];
      float ss[NR];
#pragma unroll
      for (int rr = 0; rr < NR; ++rr) {
        ss[rr] = 0.f;
#pragma unroll
        for (int i = 0; i < 2; ++i) {
          const float* xp = xin + (size_t)(row0 + rr) * 1024 + (i * 64 + lane) * 8;
          const float4 x0 = *(const float4*)xp, x1 = *(const float4*)(xp + 4);
          v[rr][i * 8 + 0] = x0.x; v[rr][i * 8 + 1] = x0.y; v[rr][i * 8 + 2] = x0.z; v[rr][i * 8 + 3] = x0.w;
          v[rr][i * 8 + 4] = x1.x; v[rr][i * 8 + 5] = x1.y; v[rr][i * 8 + 6] = x1.z; v[rr][i * 8 + 7] = x1.w;
          ss[rr] += x0.x * x0.x + x0.y * x0.y + x0.z * x0.z + x0.w * x0.w + x1.x * x1.x + x1.y * x1.y + x1.z * x1.z + x1.w * x1.w;
        }
      }
#pragma unroll
      for (int rr = 0; rr < NR; ++rr) ss[rr] = rsqrtf(wave_sum(ss[rr]) * (1.f / 1024.f) + 1e-6f);
#pragma unroll
      for (int i = 0; i < 2; ++i) {
        const int c = (i * 64 + lane) * 8;
        const float4 w0 = *(const float4*)(nw + c), w1 = *(const float4*)(nw + c + 4);
        const float4 sc0 = *(const float4*)(modl + b * 6144 + sc_off + c), sc1 = *(const float4*)(modl + b * 6144 + sc_off + c + 4);
        const float4 sh0 = *(const float4*)(modl + b * 6144 + sh_off + c), sh1 = *(const float4*)(modl + b * 6144 + sh_off + c + 4);
        const float wv[8] = {w0.x * (1.f + sc0.x), w0.y * (1.f + sc0.y), w0.z * (1.f + sc0.z), w0.w * (1.f + sc0.w),
                             w1.x * (1.f + sc1.x), w1.y * (1.f + sc1.y), w1.z * (1.f + sc1.z), w1.w * (1.f + sc1.w)};
        const float shv[8] = {sh0.x, sh0.y, sh0.z, sh0.w, sh1.x, sh1.y, sh1.z, sh1.w};
#pragma unroll
        for (int rr = 0; rr < NR; ++rr) {
#pragma unroll
          for (int q = 0; q < 8; ++q) v[rr][i * 8 + q] = v[rr][i * 8 + q] * ss[rr] * wv[q] + shv[q];
          *(uint4*)(HB + (size_t)(row0 + rr) * 1024 + c) = make_uint4(pack2(v[rr][i * 8 + 0], v[rr][i * 8 + 1]), pack2(v[rr][i * 8 + 2], v[rr][i * 8 + 3]),
                                                                          pack2(v[rr][i * 8 + 4], v[rr][i * 8 + 5]), pack2(v[rr][i * 8 + 6], v[rr][i * 8 + 7]));
        }
      }
      float* sgl = (float*)(smem + 1024) + wid * 64;
#pragma unroll 1
      for (int eh = 0; eh < 2; ++eh) {
        float lg[NR][8];
#pragma unroll
        for (int rr = 0; rr < NR; ++rr)
#pragma unroll
          for (int e = 0; e < 8; ++e) lg[rr][e] = 0.f;
#pragma unroll
        for (int i = 0; i < 4; ++i) {
#pragma unroll
          for (int q = 0; q < 4; ++q) {
            const int iq = (i >> 1) * 8 + (i & 1) * 4 + q;
            const float4 w0 = *(const float4*)(rwl + ((iq * 4 + eh * 2) * 64 + lane) * 4), w1 = *(const float4*)(rwl + ((iq * 4 + eh * 2 + 1) * 64 + lane) * 4);
#pragma unroll
            for (int rr = 0; rr < NR; ++rr) {
              const float h = v[rr][i * 4 + q];
              lg[rr][0] += h * w0.x; lg[rr][1] += h * w0.y; lg[rr][2] += h * w0.z; lg[rr][3] += h * w0.w;
              lg[rr][4] += h * w1.x; lg[rr][5] += h * w1.y; lg[rr][6] += h * w1.z; lg[rr][7] += h * w1.w;
            }
          }
          __builtin_amdgcn_sched_barrier(0);
        }
#pragma unroll
        for (int rr = 0; rr < NR; ++rr)
#pragma unroll
          for (int e = 0; e < 8; ++e) {
            const float sv = 1.f / (1.f + __expf(-wave_sum(lg[rr][e])));
            if (lane == 0) sgl[rr * 16 + eh * 8 + e] = sv;
          }
      }
      __builtin_amdgcn_fence(__ATOMIC_RELEASE, "wavefront");
      __builtin_amdgcn_wave_barrier();
#pragma unroll
      for (int rr = 0; rr < NR; ++rr) {
        float bi[16], sgv[16];
#pragma unroll
        for (int e = 0; e < 16; ++e) { sgv[e] = sgl[rr * 16 + e]; bi[e] = sgv[e] + p.in[I_RTB][e]; }
        int tg = 0; float best = -3.0e38f;
#pragma unroll
        for (int g = 0; g < 4; ++g) {
          float m1 = -3.0e38f, m2 = -3.0e38f;
#pragma unroll
          for (int j = 0; j < 4; ++j) {
            const float x = bi[g * 4 + j];
            if (x > m1) { m2 = m1; m1 = x; } else if (x > m2) { m2 = x; }
          }
          const float gs = m1 + m2;
          if (gs > best) { best = gs; tg = g; }
        }
        int i0 = -1, i1 = -1; float b0 = -3.0e38f, b1 = -3.0e38f, s0 = 0.f, s1 = 0.f;
#pragma unroll
        for (int e = 0; e < 16; ++e) {
          if ((e >> 2) == tg) {
            const float x = bi[e];
            if (x > b0) { b1 = b0; i1 = i0; s1 = s0; b0 = x; i0 = e; s0 = sgv[e]; }
            else if (x > b1) { b1 = x; i1 = e; s1 = sgv[e]; }
          }
        }
        if (lane == 0) {
          const int row = row0 + rr;
          const float inv = 1.f / (s0 + s1);
          float* topw = (float*)(ws + O_TOPW);
          topw[row * 2 + 0] = s0 * inv;
          topw[row * 2 + 1] = s1 * inv;
          const int a = (wid * 8 + it2 * NR + rr) * 2;
          lexp[a] = i0; lrank[a] = atomicAdd(&lcnt[i0], 1);
          lexp[a + 1] = i1; lrank[a + 1] = atomicAdd(&lcnt[i1], 1);
        }
      }
    }
    __syncthreads();
    int* cnt = (int*)(ws + O_CNT) + layer * 16 * 64;
    if (tid < 16) lbase[tid] = atomicAdd(&cnt[tid * 64], lcnt[tid]);
    __syncthreads();
    if (tid < 64) {
      const int e = lexp[tid];
      const int slot = lbase[e] + lrank[tid];
      ((int*)(ws + O_LIST))[(size_t)e * NT + slot] = (chunk * 32 + (tid >> 1)) * 2 + (tid & 1);
    }
    __syncthreads();
  }
}

template <int NS>
DI void gemm_proj_phase(const Params& p, char* smem_all, const bfr* Wt, int ncols_pad, bfr* out) {
  const bfr* HB = (const bfr*)(p.ws + O_HB);
  constexpr int TN = NS * 64;
  const int n_nt = ncols_pad / TN;
  const int ntiles = (NT / 256) * n_nt;
  for (int tile = blockIdx.x; tile < ntiles; tile += gridDim.x) {
    const int mt = tile / n_nt, nt = tile % n_nt;
    Rows256 A{HB + (size_t)mt * 256 * 1024, 1024, 255};
    Rows256 B{Wt + (size_t)nt * TN * 1024, 1024, TN - 1};
    gemm_tile_256<NS>(smem_all, 32, A, B, [&](f32x4(&acc)[8][NS], int wr, int wc, int fr, int fq) {
#pragma unroll
      for (int m = 0; m < 8; ++m) {
        const int row = mt * 256 + wr * 128 + m * 16 + fr;
#pragma unroll
        for (int n = 0; n < NS; ++n) {
          const int col = nt * TN + wc * (NS * 16) + n * 16 + fq * 4;
          *(uint2*)(out + (size_t)row * ncols_pad + col) = make_uint2(pack2(acc[m][n][0], acc[m][n][1]), pack2(acc[m][n][2], acc[m][n][3]));
        }
      }
    });
  }
}

DI void gemm_out_phase(const Params& p, char* smem_all, const bfr* Wt, const float* xin, float* xout, const float* gate  ) {
  const bfr* MIX = (const bfr*)(p.ws + O_MIX);
  const int ntiles = (NT / 256) * 4;
  for (int tile = blockIdx.x; tile < ntiles; tile += gridDim.x) {
    const int mt = tile / 4, nt = tile % 4;
    Rows256 A{MIX + (size_t)mt * 256 * 1024, 1024, 255};
    Rows256 B{Wt + (size_t)nt * 256 * 1024, 1024, 255};
    const int b = (mt * 256) >> 11;
    gemm_tile_256<4>(smem_all, 32, A, B, [&](f32x4(&acc)[8][4], int wr, int wc, int fr, int fq) {
#pragma unroll
      for (int n = 0; n < 4; ++n) {
        const int col = nt * 256 + wc * 64 + n * 16 + fq * 4;
        const float4 g = *(const float4*)(gate + b * 6144 + col);
#pragma unroll
        for (int m = 0; m < 8; ++m) {
          const int row = mt * 256 + wr * 128 + m * 16 + fr;
          const float4 xi = *(const float4*)(xin + (size_t)row * 1024 + col);
          float4 o;
          o.x = xi.x + g.x * acc[m][n][0]; o.y = xi.y + g.y * acc[m][n][1]; o.z = xi.z + g.z * acc[m][n][2]; o.w = xi.w + g.w * acc[m][n][3];
          *(float4*)(xout + (size_t)row * 1024 + col) = o;
        }
      }
    });
  }
}

struct RowsCmp {
  const bfr* proj; int colbase; int mt;
  const bfr* rp[2];
  DI void init(int lr) {
#pragma unroll
    for (int i = 0; i < 2; ++i) {
      int rr = mt * 128 + lr + 64 * i; if (rr > 2031) rr = 2031;
      const int h = rr & 1, bn = rr >> 1, b = bn / 127, nc = bn % 127;
      rp[i] = proj + (size_t)(b * SEQ + nc * 16) * PW0 + colbase + h * 64;
    }
  }
  DI uint4 load(int sel, int k) const { return *(const uint4*)(rp[sel] + (k >> 6) * PW0 + (k & 63)); }
  DI const bfr* ptr(int sel, int k) const { return rp[sel] + (k >> 6) * PW0 + (k & 63); }
};

DI float gelu_tanh(float x) {
  const float u = 0.7978845608028654f * (x + 0.044715f * x * x * x);
  return 0.5f * x * (1.f + tanhf(u));
}

DI void post0_phase(const Params& p, char* smem) {
  char* ws = p.ws;
  const bfr* PROJ = (const bfr*)(ws + O_PROJ);
  const int tid = tid_opaque();
  for (int tile = VB; tile < 64; tile += NVB) {
    const int j = tile >> 5, mt = (tile >> 1) & 15, nt = tile & 1;
    RowsCmp A{PROJ, j ? C_VC : C_KC, mt};
    RowsContig B{(const bfr*)(ws + O_WC1) + ((size_t)j * 256 + nt * 128) * 2048, 2048, 127};
    bfr* CH = (bfr*)(ws + O_CH) + (size_t)j * 2048 * 256;
    const float* bias = (const float*)(ws + O_BIAS1) + j * 256;
    gemm_tile_g(smem, 64, A, B, [&](f32x4(&acc)[4][4], int wr, int wc, int fr, int fq) {
#pragma unroll
      for (int m = 0; m < 4; ++m) {
        const int row = mt * 128 + wr * 64 + m * 16 + fr;
#pragma unroll
        for (int n = 0; n < 4; ++n) {
          const int col = nt * 128 + wc * 64 + n * 16 + fq * 4;
          const float4 bb = *(const float4*)(bias + col);
          *(uint2*)(CH + (size_t)row * 256 + col) = make_uint2(pack2(gelu_tanh(acc[m][n][0] + bb.x), gelu_tanh(acc[m][n][1] + bb.y)),
                                                               pack2(gelu_tanh(acc[m][n][2] + bb.z), gelu_tanh(acc[m][n][3] + bb.w)));
        }
      }
    });
  }
  {
    bfr(*tt)[66] = (bfr(*)[66])smem;
    for (int item = VB; item < 1024; item += NVB) {
      const int tl = item & 31, hk = (item >> 5) & 1, which = (item >> 6) & 1, b = item >> 7;
      const bfr* src = PROJ + (size_t)(b * SEQ + tl * 64) * PW0 + (which ? C_VW : C_VS) + hk * 64;
      bfr* dst = (bfr*)(ws + (which ? O_VWT : O_VST)) + (size_t)((b * 2 + hk) * 64) * SEQ + tl * 64;
      for (int e = tid; e < 64 * 32; e += 256) {
        const int row = e >> 5, c2 = (e & 31) * 2;
        const unsigned u = *(const unsigned*)(src + (size_t)row * PW0 + c2);
        tt[row][c2] = (bfr)(u & 0xffffu); tt[row][c2 + 1] = (bfr)(u >> 16);
      }
      __syncthreads();
      for (int e = tid; e < 64 * 32; e += 256) {
        const int d = e >> 5, t2 = (e & 31) * 2;
        const unsigned u = (unsigned)tt[t2][d] | ((unsigned)tt[t2 + 1][d] << 16);
        *(unsigned*)(dst + (size_t)d * SEQ + t2) = u;
      }
      __syncthreads();
    }
  }
  const float* ropec = (const float*)(ws + O_ROPE);
  const float* ropes = ropec + 65536;
  bfr* QR = (bfr*)(ws + O_QR);
  bfr* KSR = (bfr*)(ws + O_KSR);
  bfr* KWR = (bfr*)(ws + O_KWR);
  bfr* MIX = (bfr*)(ws + O_MIX);
  const float* cw = p.in[I_CONVW];
  for (int item = VB; item < NT / 8; item += NVB) {
    for (int e = tid; e < 8 * 48; e += 256) {
      const int tt = e / 48, u = e % 48;
      const int tok = item * 8 + tt, t = tok & (SEQ - 1);
      const int hh = u >> 2, i0 = (u & 3) * 8;
      const bfr* src; bfr* dst;
      if (hh < 8) { src = PROJ + (size_t)tok * PW0 + C_Q + hh * 64; dst = QR + (size_t)tok * 512 + hh * 64; }
      else if (hh < 10) { src = PROJ + (size_t)tok * PW0 + C_KS + (hh - 8) * 64; dst = KSR + (size_t)tok * 128 + (hh - 8) * 64; }
      else { src = PROJ + (size_t)tok * PW0 + C_KW + (hh - 10) * 64; dst = KWR + (size_t)tok * 128 + (hh - 10) * 64; }
      const uint4 x1 = *(const uint4*)(src + i0), x2 = *(const uint4*)(src + 32 + i0);
      const float4 c0 = *(const float4*)(ropec + t * 32 + i0), c1 = *(const float4*)(ropec + t * 32 + i0 + 4);
      const float4 s0 = *(const float4*)(ropes + t * 32 + i0), s1 = *(const float4*)(ropes + t * 32 + i0 + 4);
      const float a[8] = {lo2f(x1.x), hi2f(x1.x), lo2f(x1.y), hi2f(x1.y), lo2f(x1.z), hi2f(x1.z), lo2f(x1.w), hi2f(x1.w)};
      const float bq[8] = {lo2f(x2.x), hi2f(x2.x), lo2f(x2.y), hi2f(x2.y), lo2f(x2.z), hi2f(x2.z), lo2f(x2.w), hi2f(x2.w)};
      const float cc[8] = {c0.x, c0.y, c0.z, c0.w, c1.x, c1.y, c1.z, c1.w};
      const float ss[8] = {s0.x, s0.y, s0.z, s0.w, s1.x, s1.y, s1.z, s1.w};
      float o1[8], o2[8];
#pragma unroll
      for (int i = 0; i < 8; ++i) { o1[i] = a[i] * cc[i] - bq[i] * ss[i]; o2[i] = bq[i] * cc[i] + a[i] * ss[i]; }
      *(uint4*)(dst + i0) = make_uint4(pack2(o1[0], o1[1]), pack2(o1[2], o1[3]), pack2(o1[4], o1[5]), pack2(o1[6], o1[7]));
      *(uint4*)(dst + 32 + i0) = make_uint4(pack2(o2[0], o2[1]), pack2(o2[2], o2[3]), pack2(o2[4], o2[5]), pack2(o2[6], o2[7]));
    }
    for (int e = tid; e < 8 * 64; e += 256) {
      const int tt = e >> 6, ch = (e & 63) * 8;
      const int tok = item * 8 + tt, t = tok & (SEQ - 1);
      const bfr* pr = PROJ + (size_t)tok * PW0;
      float u0[8], u1[8], u2[8], bgv[8];
      {
        const uint4 cg = *(const uint4*)(pr + C_CG + ch), xb = *(const uint4*)(pr + C_XB + ch), bg = *(const uint4*)(pr + C_BG + ch);
        u0[0] = lo2f(cg.x) * lo2f(xb.x); u0[1] = hi2f(cg.x) * hi2f(xb.x); u0[2] = lo2f(cg.y) * lo2f(xb.y); u0[3] = hi2f(cg.y) * hi2f(xb.y);
        u0[4] = lo2f(cg.z) * lo2f(xb.z); u0[5] = hi2f(cg.z) * hi2f(xb.z); u0[6] = lo2f(cg.w) * lo2f(xb.w); u0[7] = hi2f(cg.w) * hi2f(xb.w);
        bgv[0] = lo2f(bg.x); bgv[1] = hi2f(bg.x); bgv[2] = lo2f(bg.y); bgv[3] = hi2f(bg.y);
        bgv[4] = lo2f(bg.z); bgv[5] = hi2f(bg.z); bgv[6] = lo2f(bg.w); bgv[7] = hi2f(bg.w);
      }
#pragma unroll
      for (int i = 0; i < 8; ++i) { u1[i] = 0.f; u2[i] = 0.f; }
      if (t >= 1) {
        const uint4 cg = *(const uint4*)(pr - PW0 + C_CG + ch), xb = *(const uint4*)(pr - PW0 + C_XB + ch);
        u1[0] = lo2f(cg.x) * lo2f(xb.x); u1[1] = hi2f(cg.x) * hi2f(xb.x); u1[2] = lo2f(cg.y) * lo2f(xb.y); u1[3] = hi2f(cg.y) * hi2f(xb.y);
        u1[4] = lo2f(cg.z) * lo2f(xb.z); u1[5] = hi2f(cg.z) * hi2f(xb.z); u1[6] = lo2f(cg.w) * lo2f(xb.w); u1[7] = hi2f(cg.w) * hi2f(xb.w);
      }
      if (t >= 2) {
        const uint4 cg = *(const uint4*)(pr - 2 * PW0 + C_CG + ch), xb = *(const uint4*)(pr - 2 * PW0 + C_XB + ch);
        u2[0] = lo2f(cg.x) * lo2f(xb.x); u2[1] = hi2f(cg.x) * hi2f(xb.x); u2[2] = lo2f(cg.y) * lo2f(xb.y); u2[3] = hi2f(cg.y) * hi2f(xb.y);
        u2[4] = lo2f(cg.z) * lo2f(xb.z); u2[5] = hi2f(cg.z) * hi2f(xb.z); u2[6] = lo2f(cg.w) * lo2f(xb.w); u2[7] = hi2f(cg.w) * hi2f(xb.w);
      }
      float y[8];
#pragma unroll
      for (int i = 0; i < 8; ++i) y[i] = bgv[i] * (cw[2 * 512 + ch + i] * u0[i] + cw[1 * 512 + ch + i] * u1[i] + cw[0 * 512 + ch + i] * u2[i]);
      *(uint4*)(MIX + (size_t)tok * 1024 + 512 + ch) = make_uint4(pack2(y[0], y[1]), pack2(y[2], y[3]), pack2(y[4], y[5]), pack2(y[6], y[7]));
    }
  }
}

DI void cmp2_phase(const Params& p, char* smem) {
  char* ws = p.ws;
  for (int tile = VB; tile < 32; tile += NVB) {
    const int j = tile >> 4, mt = tile & 15;
    RowsContig A{(const bfr*)(ws + O_CH) + ((size_t)j * 2048 + mt * 128) * 256, 256, 127};
    RowsContig B{(const bfr*)(ws + O_WC2) + (size_t)j * 128 * 256, 256, 127};
    bfr* KC = (bfr*)(ws + O_KCVC) + (size_t)j * 2048 * 64;
    gemm_tile(smem, 8, A, B, [&](f32x4(&acc)[4][4], int wr, int wc, int fr, int fq) {
      if (wc == 0) {
#pragma unroll
        for (int m = 0; m < 4; ++m)
#pragma unroll
          for (int n = 0; n < 4; ++n)
#pragma unroll
            for (int jj = 0; jj < 4; ++jj) {
              const int row = mt * 128 + wr * 64 + m * 16 + fq * 4 + jj, col = n * 16 + fr;
              const bfr hv = f2bf(acc[m][n][jj]);
              KC[(size_t)row * 64 + col] = hv;
              if (j == 1 && row < 2032) {
                const int hk = row & 1, bn = row >> 1, bb = bn / 127, cc = bn % 127;
                ((bfr*)(ws + O_VCT))[((size_t)((bb * 2 + hk) * 64 + col)) * 128 + cc] = hv;
              }
            }
      }
    });
  }
}

DI void cmp_attn_phase(const Params& p, char* smem) {
  char* ws = p.ws;
  const bfr* PROJ = (const bfr*)(ws + O_PROJ);
  const bfr* KC = (const bfr*)(ws + O_KCVC);
  const bfr* VC = KC + 2048 * 64;
  bfr* OCMP = (bfr*)(ws + O_OCMP);
  unsigned* SEL = (unsigned*)(ws + O_SEL);
  const int tid = tid_opaque();
  for (int item = VB; item < NT / 32; item += NVB) {
    const int tok = item * 32 + (tid >> 3), head = tid & 7, hkv = head >> 2;
    const int b = tok >> 11, t = tok & (SEQ - 1);
    const int nv = t >= 31 ? ((t - 31) >> 4) + 1 : 0;
    unsigned q[32];
    {
      const uint4* qp = (const uint4*)(PROJ + (size_t)tok * PW0 + C_Q + head * 64);
#pragma unroll
      for (int i = 0; i < 8; ++i) { const uint4 u = qp[i]; q[i * 4] = u.x; q[i * 4 + 1] = u.y; q[i * 4 + 2] = u.z; q[i * 4 + 3] = u.w; }
    }
    const bfr* kb = KC + ((size_t)(b * 127) * 2 + hkv) * 64;
    const bfr* vb = VC + ((size_t)(b * 127) * 2 + hkv) * 64;
    auto dotk = [&](int c) {
      const uint4* kp = (const uint4*)(kb + (size_t)c * 128);
      float a = 0.f;
#pragma unroll
      for (int i = 0; i < 8; ++i) {
        const uint4 u = kp[i];
        a = dot2(q[i * 4], u.x, a); a = dot2(q[i * 4 + 1], u.y, a); a = dot2(q[i * 4 + 2], u.z, a); a = dot2(q[i * 4 + 3], u.w, a);
      }
      return a * 0.125f;
    };
    float mx = -1e30f;
    for (int c = 0; c < nv; ++c) mx = fmaxf(mx, dotk(c));
    float o[64];
#pragma unroll
    for (int i = 0; i < 64; ++i) o[i] = 0.f;
    float l = 0.f;
    for (int c = 0; c < nv; ++c) {
      const float pe = __expf(dotk(c) - mx);
      l += pe;
      const uint4* vp = (const uint4*)(vb + (size_t)c * 128);
#pragma unroll
      for (int i = 0; i < 8; ++i) {
        const uint4 u = vp[i];
        o[i * 8 + 0] += pe * lo2f(u.x); o[i * 8 + 1] += pe * hi2f(u.x);
        o[i * 8 + 2] += pe * lo2f(u.y); o[i * 8 + 3] += pe * hi2f(u.y);
        o[i * 8 + 4] += pe * lo2f(u.z); o[i * 8 + 5] += pe * hi2f(u.z);
        o[i * 8 + 6] += pe * lo2f(u.w); o[i * 8 + 7] += pe * hi2f(u.w);
      }
    }
    const float invl = nv > 0 ? 1.f / l : 0.f;
    {
      const float gl = bf2f(PROJ[(size_t)tok * PW0 + C_GL + head * 3 + 0]);
      const float g0 = sigmoidf_(gl) * invl;
      uint4* op = (uint4*)(OCMP + (size_t)tok * 512 + head * 64);
#pragma unroll
      for (int i = 0; i < 8; ++i) {
        uint4 u;
        u.x = pack2(o[i * 8 + 0] * g0, o[i * 8 + 1] * g0); u.y = pack2(o[i * 8 + 2] * g0, o[i * 8 + 3] * g0);
        u.z = pack2(o[i * 8 + 4] * g0, o[i * 8 + 5] * g0); u.w = pack2(o[i * 8 + 6] * g0, o[i * 8 + 7] * g0);
        op[i] = u;
      }
    }
    const int cur = t >> 6;
    float tv0 = -1.f, tv1 = -1.f, tv2 = -1.f, tv3 = -1.f, tv4 = -1.f;
    int ti0 = -1, ti1 = -1, ti2 = -1, ti3 = -1, ti4 = -1;
    float part = 0.f;
    int curmax = cur;
#pragma unroll
    for (int o2 = 32; o2 > 0; o2 >>= 1) curmax = max(curmax, __shfl_xor(curmax, o2));
#pragma unroll 1
    for (int j = 0; j <= curmax + 1 && j <= 32; ++j) {
      float e[4];
#pragma unroll
      for (int oo = 0; oo < 4; ++oo) {
        const int c = j * 4 + oo;
        float pe = 0.f;
        if (c < nv) pe = __expf(dotk(c) - mx) * invl;
        pe += __shfl_xor(pe, 1);
        pe += __shfl_xor(pe, 2);
        e[oo] = pe;
      }
      if (j >= 1) {
        const float val = part + e[0];
        const int jb = j - 1;
        if (jb >= 1 && jb <= cur - 2) {
          if (val > tv4) {
            tv4 = val; ti4 = jb;
            if (tv4 > tv3) { float tf = tv3; tv3 = tv4; tv4 = tf; int tii = ti3; ti3 = ti4; ti4 = tii; }
            if (tv3 > tv2) { float tf = tv2; tv2 = tv3; tv3 = tf; int tii = ti2; ti2 = ti3; ti3 = tii; }
            if (tv2 > tv1) { float tf = tv1; tv1 = tv2; tv2 = tf; int tii = ti1; ti1 = ti2; ti2 = tii; }
            if (tv1 > tv0) { float tf = tv0; tv0 = tv1; tv1 = tf; int tii = ti0; ti0 = ti1; ti1 = tii; }
          }
        }
      }
      part = e[0] + 2.f * (e[1] + e[2] + e[3]);
    }
    unsigned mask = 1u | (1u << cur);
    if (cur >= 1) mask |= 1u << (cur - 1);
    if (ti0 >= 0) mask |= 1u << ti0;
    if (ti1 >= 0) mask |= 1u << ti1;
    if (ti2 >= 0) mask |= 1u << ti2;
    if (ti3 >= 0) mask |= 1u << ti3;
    if (ti4 >= 0) mask |= 1u << ti4;
    if ((head & 3) == 0) SEL[tok * 2 + hkv] = mask;
  }
}

DI void slcwin_phase(const Params& p, char* smem) {
  char* ws = p.ws;
  const bfr* PROJ = (const bfr*)(ws + O_PROJ);
  const bfr* QR = (const bfr*)(ws + O_QR);
  const bfr* KSR = (const bfr*)(ws + O_KSR);
  const bfr* KWR = (const bfr*)(ws + O_KWR);
  const bfr* OCMP = (const bfr*)(ws + O_OCMP);
  const unsigned* SEL = (const unsigned*)(ws + O_SEL);
  bfr* MIX = (bfr*)(ws + O_MIX);
  const int tid = tid_opaque(), lane = tid & 63, wid = tid >> 6;
  for (int item = VB; item < 512; item += NVB) {
    const int tile = 31 - (item >> 4), bh = item & 15, b = bh >> 1, hkv = bh & 1;
    const int t = tile * 64 + lane, tok = b * SEQ + t, head = hkv * 4 + wid;
    unsigned q[32];
    {
      const uint4* qp = (const uint4*)(QR + (size_t)tok * 512 + head * 64);
#pragma unroll
      for (int i = 0; i < 8; ++i) { const uint4 u = qp[i]; q[i * 4] = u.x; q[i * 4 + 1] = u.y; q[i * 4 + 2] = u.z; q[i * 4 + 3] = u.w; }
    }
    const unsigned sel = SEL[tok * 2 + hkv];
#pragma unroll 1
    for (int pass = 0; pass < 2; ++pass) {
      const bfr* Kb = (pass == 0 ? KSR : KWR) + (size_t)b * SEQ * 128 + hkv * 64;
      const bfr* Vb = PROJ + (size_t)b * SEQ * PW0 + (pass == 0 ? C_VS : C_VW) + hkv * 64;
      float o[64];
#pragma unroll
      for (int i = 0; i < 64; ++i) o[i] = 0.f;
      float m = -1e30f, l = 0.f;
      const int jlo = pass == 0 ? 0 : (tile >= 8 ? tile - 8 : 0);
#pragma unroll 1
      for (int j = jlo; j <= tile; ++j) {
        const bool lane_ok = pass == 0 ? ((sel >> j) & 1u) != 0 : true;
        if (pass == 0 && !__any(lane_ok)) continue;
#pragma unroll 1
        for (int kb = 0; kb < 64; kb += 4) {
          float s[4];
#pragma unroll
          for (int kk = 0; kk < 4; ++kk) {
            const int key = j * 64 + kb + kk;
            const uint4* kp = (const uint4*)(Kb + (size_t)key * 128);
            float a = 0.f;
#pragma unroll
            for (int i = 0; i < 8; ++i) {
              const uint4 u = kp[i];
              a = dot2(q[i * 4], u.x, a); a = dot2(q[i * 4 + 1], u.y, a); a = dot2(q[i * 4 + 2], u.z, a); a = dot2(q[i * 4 + 3], u.w, a);
            }
            bool ok = lane_ok && key <= t;
            if (pass == 1) ok = ok && (t - key < 512);
            s[kk] = ok ? a * 0.125f : -1e30f;
          }
          const float cm = fmaxf(fmaxf(s[0], s[1]), fmaxf(s[2], s[3]));
          const float mn = fmaxf(m, cm);
          const float corr = __expf(m - mn);
          m = mn;
          float pe[4];
#pragma unroll
          for (int kk = 0; kk < 4; ++kk) pe[kk] = s[kk] > -1e29f ? __expf(s[kk] - mn) : 0.f;
          l = l * corr + (pe[0] + pe[1] + pe[2] + pe[3]);
#pragma unroll
          for (int i = 0; i < 64; ++i) o[i] *= corr;
#pragma unroll
          for (int kk = 0; kk < 4; ++kk) {
            const int key = j * 64 + kb + kk;
            const uint4* vp = (const uint4*)(Vb + (size_t)key * PW0);
#pragma unroll
            for (int i = 0; i < 8; ++i) {
              const uint4 u = vp[i];
              o[i * 8 + 0] += pe[kk] * lo2f(u.x); o[i * 8 + 1] += pe[kk] * hi2f(u.x);
              o[i * 8 + 2] += pe[kk] * lo2f(u.y); o[i * 8 + 3] += pe[kk] * hi2f(u.y);
              o[i * 8 + 4] += pe[kk] * lo2f(u.z); o[i * 8 + 5] += pe[kk] * hi2f(u.z);
              o[i * 8 + 6] += pe[kk] * lo2f(u.w); o[i * 8 + 7] += pe[kk] * hi2f(u.w);
            }
          }
        }
      }
      const float gate = sigmoidf_(bf2f(PROJ[(size_t)tok * PW0 + C_GL + head * 3 + 1 + pass]));
      const float gsc = gate * (l > 0.f ? 1.f / l : 0.f);
      uint4* op = (uint4*)(MIX + (size_t)tok * 1024 + head * 64);
      const uint4* cp = pass == 0 ? (const uint4*)(OCMP + (size_t)tok * 512 + head * 64) : (const uint4*)op;
#pragma unroll
      for (int i = 0; i < 8; ++i) {
        const uint4 c = cp[i];
        uint4 u;
        u.x = pack2(o[i * 8 + 0] * gsc + lo2f(c.x), o[i * 8 + 1] * gsc + hi2f(c.x));
        u.y = pack2(o[i * 8 + 2] * gsc + lo2f(c.y), o[i * 8 + 3] * gsc + hi2f(c.y));
        u.z = pack2(o[i * 8 + 4] * gsc + lo2f(c.z), o[i * 8 + 5] * gsc + hi2f(c.z));
        u.w = pack2(o[i * 8 + 6] * gsc + lo2f(c.w), o[i * 8 + 7] * gsc + hi2f(c.w));
        op[i] = u;
      }
    }
  }
}

using f32x16 = __attribute__((ext_vector_type(16))) float;
#define MFMA32(a, b, c) __builtin_amdgcn_mfma_f32_32x32x16_bf16((a), (b), (c), 0, 0, 0)
struct AttnLds { bfr k[2][64][72]; bfr vt[2][64][68]; };
static_assert(sizeof(AttnLds) <= 49152, "attn lds");
DI int crow16(int i, int h2) { return (i & 3) + 8 * (i >> 2) + 4 * h2; }

DI void attn_sw_phase(const Params& p, char* smem) {
  char* ws = p.ws;
  AttnLds& L = *(AttnLds*)smem;
  const bfr* PROJ = (const bfr*)(ws + O_PROJ);
  const bfr* QR = (const bfr*)(ws + O_QR);
  const bfr* OCMP = (const bfr*)(ws + O_OCMP);
  const unsigned* SEL = (const unsigned*)(ws + O_SEL);
  bfr* MIX = (bfr*)(ws + O_MIX);
  const int tid = tid_opaque(), lane = tid & 63, wid = tid >> 6, r = lane & 31, h2 = lane >> 5;
  const float CS = 0.125f * 1.4426950408889634f;
  const int lrow = tid >> 3, lc8 = (tid & 7) * 8;
  for (int item = VB; item < 1024; item += NVB) {
    const int qt = item < 512 ? 63 - (item >> 4) : ((item - 512) >> 4);
    const int bh = item & 15, b = bh >> 1, hkv = bh & 1;
    const int cur = qt >> 1;
    const int tokl = qt * 32 + wid * 8 + (r >> 2), g = r & 3, head = hkv * 4 + g, tok = b * SEQ + tokl;
    bf16x8 qf[4];
#pragma unroll
    for (int s = 0; s < 4; ++s) qf[s] = *(const bf16x8*)(QR + (size_t)tok * 512 + head * 64 + 16 * s + 8 * h2);
    const unsigned sel = SEL[tok * 2 + hkv];
    const int nslc = cur + 1, wlo = cur > 8 ? cur - 8 : 0, T = nslc + (cur - wlo + 1);
    const bfr* KS = (const bfr*)(ws + O_KSR) + (size_t)b * SEQ * 128 + hkv * 64;
    const bfr* KW = (const bfr*)(ws + O_KWR) + (size_t)b * SEQ * 128 + hkv * 64;
    const bfr* VS = (const bfr*)(ws + O_VST) + (size_t)((b * 2 + hkv) * 64) * SEQ;
    const bfr* VW = (const bfr*)(ws + O_VWT) + (size_t)((b * 2 + hkv) * 64) * SEQ;
    uint4 rk0, rk1, rv0, rv1;
    auto gload = [&](int tt) {
      const int pass = tt >= nslc, j = pass ? wlo + tt - nslc : tt;
      const bfr* kb = (pass ? KW : KS) + (size_t)(j * 64) * 128 + lc8;
      const bfr* vb = (pass ? VW : VS) + j * 64 + lc8;
      rk0 = *(const uint4*)(kb + (size_t)lrow * 128); rk1 = *(const uint4*)(kb + (size_t)(lrow + 32) * 128);
      rv0 = *(const uint4*)(vb + (size_t)lrow * SEQ); rv1 = *(const uint4*)(vb + (size_t)(lrow + 32) * SEQ);
    };
    auto lstore = [&](int buf) {
      *(uint4*)&L.k[buf][lrow][lc8] = rk0; *(uint4*)&L.k[buf][lrow + 32][lc8] = rk1;
      *(uint2*)&L.vt[buf][lrow][lc8] = make_uint2(rv0.x, rv0.y); *(uint2*)&L.vt[buf][lrow][lc8 + 4] = make_uint2(rv0.z, rv0.w);
      *(uint2*)&L.vt[buf][lrow + 32][lc8] = make_uint2(rv1.x, rv1.y); *(uint2*)&L.vt[buf][lrow + 32][lc8 + 4] = make_uint2(rv1.z, rv1.w);
    };
    gload(0); lstore(0);
    __syncthreads();
    float m = -1e30f, l = 0.f;
    f32x16 o0, o1;
#pragma unroll
    for (int i = 0; i < 16; ++i) { o0[i] = 0.f; o1[i] = 0.f; }
#pragma unroll 1
    for (int tt = 0; tt < T; ++tt) {
      const int buf = tt & 1;
      if (tt + 1 < T) gload(tt + 1);
      const int pass = tt >= nslc, j = pass ? wlo + tt - nslc : tt;
      const bool rowok = pass ? true : ((sel >> j) & 1u) != 0u;
      if (__any(rowok)) {
        f32x16 s0, s1;
#pragma unroll
        for (int i = 0; i < 16; ++i) { s0[i] = 0.f; s1[i] = 0.f; }
#pragma unroll
        for (int s = 0; s < 4; ++s) {
          const bf16x8 k0 = *(const bf16x8*)&L.k[buf][r][16 * s + 8 * h2];
          const bf16x8 k1 = *(const bf16x8*)&L.k[buf][32 + r][16 * s + 8 * h2];
          s0 = MFMA32(k0, qf[s], s0);
          s1 = MFMA32(k1, qf[s], s1);
        }
        if (!rowok) {
#pragma unroll
          for (int i = 0; i < 16; ++i) { s0[i] = -1e30f; s1[i] = -1e30f; }
        }
        if (j == cur) {
          const int lim = tokl - j * 64;
#pragma unroll
          for (int i = 0; i < 16; ++i) {
            if (crow16(i, h2) > lim) s0[i] = -1e30f;
            if (32 + crow16(i, h2) > lim) s1[i] = -1e30f;
          }
        }
        if (pass && cur >= 8 && j == cur - 8) {
          const int lo = tokl - 512 - j * 64;
#pragma unroll
          for (int i = 0; i < 16; ++i) {
            if (crow16(i, h2) <= lo) s0[i] = -1e30f;
            if (32 + crow16(i, h2) <= lo) s1[i] = -1e30f;
          }
        }
        float mx = -1e30f;
#pragma unroll
        for (int i = 0; i < 16; ++i) mx = fmaxf(mx, fmaxf(s0[i], s1[i]));
        mx = fmaxf(mx, __shfl_xor(mx, 32));
        const float mnew = fmaxf(m, mx);
        const float mu = fmaxf(mnew, -1e20f);
        const float corr = __builtin_amdgcn_exp2f((m - mu) * CS);
        m = mnew;
        const float muc = mu * CS;
        float ps = 0.f;
#pragma unroll
        for (int i = 0; i < 16; ++i) {
          s0[i] = __builtin_amdgcn_exp2f(fmaf(s0[i], CS, -muc));
          s1[i] = __builtin_amdgcn_exp2f(fmaf(s1[i], CS, -muc));
          ps += s0[i] + s1[i];
        }
        l = l * corr + ps;
#pragma unroll
        for (int i = 0; i < 16; ++i) { o0[i] *= corr; o1[i] *= corr; }
#pragma unroll
        for (int kb = 0; kb < 2; ++kb) {
#pragma unroll
          for (int s = 0; s < 2; ++s) {
            uint4 pk;
            if (kb == 0) {
              pk.x = pack2(s0[8 * s + 0], s0[8 * s + 1]); pk.y = pack2(s0[8 * s + 2], s0[8 * s + 3]);
              pk.z = pack2(s0[8 * s + 4], s0[8 * s + 5]); pk.w = pack2(s0[8 * s + 6], s0[8 * s + 7]);
            } else {
              pk.x = pack2(s1[8 * s + 0], s1[8 * s + 1]); pk.y = pack2(s1[8 * s + 2], s1[8 * s + 3]);
              pk.z = pack2(s1[8 * s + 4], s1[8 * s + 5]); pk.w = pack2(s1[8 * s + 6], s1[8 * s + 7]);
            }
            const bf16x8 pf = __builtin_bit_cast(bf16x8, pk);
            const int kc = kb * 32 + 16 * s + 4 * h2;
            const uint2 a0 = *(const uint2*)&L.vt[buf][r][kc];
            const uint2 a1 = *(const uint2*)&L.vt[buf][r][kc + 8];
            const uint2 c0 = *(const uint2*)&L.vt[buf][32 + r][kc];
            const uint2 c1 = *(const uint2*)&L.vt[buf][32 + r][kc + 8];
            const bf16x8 v0 = __builtin_bit_cast(bf16x8, make_uint4(a0.x, a0.y, a1.x, a1.y));
            const bf16x8 v1 = __builtin_bit_cast(bf16x8, make_uint4(c0.x, c0.y, c1.x, c1.y));
            o0 = MFMA32(v0, pf, o0);
            o1 = MFMA32(v1, pf, o1);
          }
        }
      }
      if (tt == nslc - 1 || tt == T - 1) {
        const float lt = l + __shfl_xor(l, 32);
        const float gate = sigmoidf_(bf2f(PROJ[(size_t)tok * PW0 + C_GL + head * 3 + 1 + pass]));
        const float sc = lt > 0.f ? gate / lt : 0.f;
        bfr* mixp = MIX + (size_t)tok * 1024 + head * 64;
        const bfr* addp = pass ? (const bfr*)mixp : OCMP + (size_t)tok * 512 + head * 64;
#pragma unroll
        for (int q4 = 0; q4 < 4; ++q4) {
          const int d0 = 8 * q4 + 4 * h2;
          const uint2 c = *(const uint2*)(addp + d0);
          uint2 u;
          u.x = pack2(o0[q4 * 4 + 0] * sc + lo2f(c.x), o0[q4 * 4 + 1] * sc + hi2f(c.x));
          u.y = pack2(o0[q4 * 4 + 2] * sc + lo2f(c.y), o0[q4 * 4 + 3] * sc + hi2f(c.y));
          *(uint2*)(mixp + d0) = u;
          const uint2 c2 = *(const uint2*)(addp + 32 + d0);
          u.x = pack2(o1[q4 * 4 + 0] * sc + lo2f(c2.x), o1[q4 * 4 + 1] * sc + hi2f(c2.x));
          u.y = pack2(o1[q4 * 4 + 2] * sc + lo2f(c2.y), o1[q4 * 4 + 3] * sc + hi2f(c2.y));
          *(uint2*)(mixp + 32 + d0) = u;
        }
#pragma unroll
        for (int i = 0; i < 16; ++i) { o0[i] = 0.f; o1[i] = 0.f; }
        m = -1e30f; l = 0.f;
      }
      if (tt + 1 < T) lstore(buf ^ 1);
      __syncthreads();
    }
  }
}

struct CmpLds { bfr k[128][72]; bfr vt[64][132]; };
static_assert(sizeof(CmpLds) <= 49152, "cmp lds");
DI float quad_sum(float x) {
  const float y = x + __int_as_float(__builtin_amdgcn_update_dpp(0, __float_as_int(x), 0xB1, 0xF, 0xF, true));
  return y + __int_as_float(__builtin_amdgcn_update_dpp(0, __float_as_int(y), 0x4E, 0xF, 0xF, true));
}

DI void cmp_attn_mfma_phase(const Params& p, char* smem) {
  char* ws = p.ws;
  CmpLds& L = *(CmpLds*)smem;
  const bfr* PROJ = (const bfr*)(ws + O_PROJ);
  const bfr* KC = (const bfr*)(ws + O_KCVC);
  const bfr* VCT = (const bfr*)(ws + O_VCT);
  bfr* OCMP = (bfr*)(ws + O_OCMP);
  unsigned* SEL = (unsigned*)(ws + O_SEL);
  const int tid = tid_opaque(), lane = tid & 63, wid = tid >> 6, r = lane & 31, h2 = lane >> 5;
  const float CS = 0.125f * 1.4426950408889634f;
  for (int item = VB; item < 1024; item += NVB) {
    const int qt = 63 - (item >> 4), bh = item & 15, b = bh >> 1, hkv = bh & 1;
    __syncthreads();
    {
      const bfr* kb = KC + ((size_t)(b * 127) * 2 + hkv) * 64;
      const bfr* vb = VCT + (size_t)((b * 2 + hkv) * 64) * 128;
#pragma unroll
      for (int i = 0; i < 4; ++i) {
        const int id = tid + i * 256;
        const int kr = id >> 3, kc = (id & 7) * 8;
        *(uint4*)&L.k[kr][kc] = *(const uint4*)(kb + (size_t)kr * 128 + kc);
        const int vr = id >> 4, vc = (id & 15) * 8;
        const uint4 v = *(const uint4*)(vb + (size_t)vr * 128 + vc);
        *(uint2*)&L.vt[vr][vc] = make_uint2(v.x, v.y);
        *(uint2*)&L.vt[vr][vc + 4] = make_uint2(v.z, v.w);
      }
    }
    __syncthreads();
    const int tokl = qt * 32 + wid * 8 + (r >> 2), g = r & 3, head = hkv * 4 + g, tok = b * SEQ + tokl;
    const int nv = tokl >= 31 ? ((tokl - 31) >> 4) + 1 : 0;
    bf16x8 qf[4];
#pragma unroll
    for (int s = 0; s < 4; ++s) qf[s] = *(const bf16x8*)(PROJ + (size_t)tok * PW0 + C_Q + head * 64 + 16 * s + 8 * h2);
    float m = -1e30f, l = 0.f;
#pragma unroll 1
    for (int kb4 = 0; kb4 < 4; ++kb4) {
      f32x16 sc;
#pragma unroll
      for (int i = 0; i < 16; ++i) sc[i] = 0.f;
#pragma unroll
      for (int s = 0; s < 4; ++s) {
        const bf16x8 kf = *(const bf16x8*)&L.k[kb4 * 32 + r][16 * s + 8 * h2];
        sc = MFMA32(kf, qf[s], sc);
      }
      float mx = -1e30f;
#pragma unroll
      for (int i = 0; i < 16; ++i) {
        if (kb4 * 32 + crow16(i, h2) >= nv) sc[i] = -1e30f;
        mx = fmaxf(mx, sc[i]);
      }
      const float mn = fmaxf(m, mx), mu = fmaxf(mn, -1e20f);
      float ps = 0.f;
#pragma unroll
      for (int i = 0; i < 16; ++i) ps += __builtin_amdgcn_exp2f((sc[i] - mu) * CS);
      l = l * __builtin_amdgcn_exp2f((m - mu) * CS) + ps;
      m = mn;
    }
    {
      const float mo = __shfl_xor(m, 32), lo = __shfl_xor(l, 32);
      const float mt = fmaxf(m, mo), mu = fmaxf(mt, -1e20f);
      l = l * __builtin_amdgcn_exp2f((m - mu) * CS) + lo * __builtin_amdgcn_exp2f((mo - mu) * CS);
      m = mu;
    }
    const float invl = l > 0.f ? 1.f / l : 0.f;
    const float muc = m * CS;
    f32x16 o0, o1;
#pragma unroll
    for (int i = 0; i < 16; ++i) { o0[i] = 0.f; o1[i] = 0.f; }
    float part[16], first[16];
#pragma unroll
    for (int kb4 = 0; kb4 < 4; ++kb4) {
      f32x16 sc;
#pragma unroll
      for (int i = 0; i < 16; ++i) sc[i] = 0.f;
#pragma unroll
      for (int s = 0; s < 4; ++s) {
        const bf16x8 kf = *(const bf16x8*)&L.k[kb4 * 32 + r][16 * s + 8 * h2];
        sc = MFMA32(kf, qf[s], sc);
      }
#pragma unroll
      for (int i = 0; i < 16; ++i) {
        const float pv = __builtin_amdgcn_exp2f(fmaf(sc[i], CS, -muc)) * invl;
        sc[i] = (kb4 * 32 + crow16(i, h2) >= nv) ? 0.f : pv;
      }
#pragma unroll
      for (int s = 0; s < 2; ++s) {
        uint4 pk;
        pk.x = pack2(sc[8 * s + 0], sc[8 * s + 1]); pk.y = pack2(sc[8 * s + 2], sc[8 * s + 3]);
        pk.z = pack2(sc[8 * s + 4], sc[8 * s + 5]); pk.w = pack2(sc[8 * s + 6], sc[8 * s + 7]);
        const bf16x8 pf = __builtin_bit_cast(bf16x8, pk);
        const int kc = kb4 * 32 + 16 * s + 4 * h2;
        const uint2 a0 = *(const uint2*)&L.vt[r][kc];
        const uint2 a1 = *(const uint2*)&L.vt[r][kc + 8];
        const uint2 c0 = *(const uint2*)&L.vt[32 + r][kc];
        const uint2 c1 = *(const uint2*)&L.vt[32 + r][kc + 8];
        o0 = MFMA32(__builtin_bit_cast(bf16x8, make_uint4(a0.x, a0.y, a1.x, a1.y)), pf, o0);
        o1 = MFMA32(__builtin_bit_cast(bf16x8, make_uint4(c0.x, c0.y, c1.x, c1.y)), pf, o1);
      }
#pragma unroll
      for (int q4 = 0; q4 < 4; ++q4) {
        const float e0 = quad_sum(sc[q4 * 4 + 0]), e1 = quad_sum(sc[q4 * 4 + 1]);
        const float e2 = quad_sum(sc[q4 * 4 + 2]), e3 = quad_sum(sc[q4 * 4 + 3]);
        part[kb4 * 4 + q4] = e0 + 2.f * (e1 + e2 + e3);
        first[kb4 * 4 + q4] = e0;
      }
      __builtin_amdgcn_sched_barrier(0);
    }
    {
      const float g0 = sigmoidf_(bf2f(PROJ[(size_t)tok * PW0 + C_GL + head * 3 + 0]));
      bfr* op = OCMP + (size_t)tok * 512 + head * 64;
#pragma unroll
      for (int q4 = 0; q4 < 4; ++q4) {
        const int d0 = 8 * q4 + 4 * h2;
        uint2 u;
        u.x = pack2(o0[q4 * 4 + 0] * g0, o0[q4 * 4 + 1] * g0); u.y = pack2(o0[q4 * 4 + 2] * g0, o0[q4 * 4 + 3] * g0);
        *(uint2*)(op + d0) = u;
        u.x = pack2(o1[q4 * 4 + 0] * g0, o1[q4 * 4 + 1] * g0); u.y = pack2(o1[q4 * 4 + 2] * g0, o1[q4 * 4 + 3] * g0);
        *(uint2*)(op + 32 + d0) = u;
      }
    }
    float val[16], oth[16];
    const float h2f = (float)h2;
    {
      float recv[17];
#pragma unroll
      for (int gi = 0; gi < 16; ++gi) recv[gi] = __shfl_xor(first[gi], 32);
      recv[16] = 0.f;
#pragma unroll
      for (int gi = 0; gi < 16; ++gi) val[gi] = part[gi] + (recv[gi] * (1.f - h2f) + recv[gi + 1] * h2f);
#pragma unroll
      for (int gi = 0; gi < 16; ++gi) oth[gi] = __shfl_xor(val[gi], 32);
    }
    const int cur = tokl >> 6;
    float cv[32];
#pragma unroll
    for (int gi = 0; gi < 16; ++gi) {
      cv[2 * gi] = val[gi] * (1.f - h2f) + oth[gi] * h2f;
      cv[2 * gi + 1] = val[gi] * h2f + oth[gi] * (1.f - h2f);
    }
    unsigned mask = 1u | (1u << cur);
    if (cur >= 1) mask |= 1u << (cur - 1);
    unsigned chosen = 0u;
#pragma unroll 1
    for (int rnd = 0; rnd < 5; ++rnd) {
      float best = -1.f; int bi = -1;
#pragma unroll
      for (int j = 1; j < 31; ++j) {
        const bool el = (j <= cur - 2) && !((chosen >> j) & 1u) && (cv[j] > best);
        best = el ? cv[j] : best;
        bi = el ? j : bi;
      }
      if (bi >= 0) chosen |= 1u << bi;
    }
    mask |= chosen;
    if (g == 0 && h2 == 0) SEL[tok * 2 + hkv] = mask;
  }
}

struct RowsGather {
  const bfr* base; const int* list; int i0; int cnt; int ld;
  const bfr* rp[2];
  DI void init(int lr) {
#pragma unroll
    for (int i = 0; i < 2; ++i) {
      int ii = i0 + lr + 64 * i; if (ii > cnt - 1) ii = cnt - 1;
      rp[i] = base + (size_t)(list[ii] >> 1) * ld;
    }
  }
  DI uint4 load(int sel, int k) const { return *(const uint4*)(rp[sel] + k); }
  DI const bfr* ptr(int sel, int k) const { return rp[sel] + k; }
};

struct Rows256Gather {
  const bfr* base; const int* list; int i0; int cnt; int ld;
  const bfr* rp[2];
  DI void init(int lr) {
#pragma unroll
    for (int i = 0; i < 2; ++i) {
      int ii = i0 + lr + 128 * i; if (ii > cnt - 1) ii = cnt - 1;
      rp[i] = base + (size_t)(list[ii] >> 1) * ld;
    }
  }
  DI const bfr* ptr(int sel, int k) const { return rp[sel] + k; }
};

DI void moe1_phase(const Params& p, char* smem_all, int layer) {
  char* ws = p.ws;
  const int* cnt = (const int*)(ws + O_CNT) + layer * 16 * 64;
  const int* LIST = (const int*)(ws + O_LIST);
  const bfr* HB = (const bfr*)(ws + O_HB);
  bfr* HMID = (bfr*)(ws + O_HMID);
  int c[16], mtiles = 0;
#pragma unroll
  for (int e = 0; e < 16; ++e) { c[e] = cnt[e * 64]; mtiles += (c[e] + 255) >> 8; }
  const int ntiles = mtiles * 4;
  for (int tile = blockIdx.x; tile < ntiles; tile += gridDim.x) {
    int mg = tile >> 2; const int nt = tile & 3;
    int e = 0, off = 0, ce = 0;
#pragma unroll
    for (int k = 0; k < 16; ++k) {
      const int mk = (c[k] + 255) >> 8;
      if (k == e && mg >= mk) { mg -= mk; off += c[k]; e = k + 1; }
    }
#pragma unroll
    for (int k = 0; k < 16; ++k) if (k == e) ce = c[k];
    const int mt = mg;
    Rows256Gather A{HB, LIST + (size_t)e * NT, mt * 256, ce, 1024};
    Rows256 B{(const bfr*)(ws + O_WGU) + ((size_t)(layer * 16 + e) * 1024 + nt * 256) * 1024, 1024, 255};
    gemm_tile_256<4>(smem_all, 32, A, B, [&](f32x4(&acc)[8][4], int wr, int wc, int fr, int fq) {
#pragma unroll
      for (int m = 0; m < 8; ++m) {
        const int i = mt * 256 + wr * 128 + m * 16 + fr;
        if (i < ce) {
#pragma unroll
          for (int n2 = 0; n2 < 2; ++n2) {
            const int col = nt * 128 + wc * 32 + n2 * 16 + fq * 4;
            float h[4];
#pragma unroll
            for (int j = 0; j < 4; ++j) { const float g = acc[m][n2 * 2][j], u = acc[m][n2 * 2 + 1][j]; h[j] = g / (1.f + __expf(-g)) * u; }
            *(uint2*)(HMID + (size_t)(off + i) * 512 + col) = make_uint2(pack2(h[0], h[1]), pack2(h[2], h[3]));
          }
        }
      }
    });
  }
}

DI void moe2_phase(const Params& p, char* smem_all, int layer) {
  char* ws = p.ws;
  const int* cnt = (const int*)(ws + O_CNT) + layer * 16 * 64;
  const int* LIST = (const int*)(ws + O_LIST);
  const float* TOPW = (const float*)(ws + O_TOPW);
  const bfr* HMID = (const bfr*)(ws + O_HMID);
  bfr* MO = (bfr*)(ws + O_MOEOUT);
  int c[16], mtiles = 0;
#pragma unroll
  for (int e = 0; e < 16; ++e) { c[e] = cnt[e * 64]; mtiles += (c[e] + 255) >> 8; }
  const int ntiles = mtiles * 4;
  for (int tile = blockIdx.x; tile < ntiles; tile += gridDim.x) {
    int mg = tile >> 2; const int nt = tile & 3;
    int e = 0, off = 0, ce = 0;
#pragma unroll
    for (int k = 0; k < 16; ++k) {
      const int mk = (c[k] + 255) >> 8;
      if (k == e && mg >= mk) { mg -= mk; off += c[k]; e = k + 1; }
    }
#pragma unroll
    for (int k = 0; k < 16; ++k) if (k == e) ce = c[k];
    const int mt = mg;
    const int rows_here = ce - mt * 256;
    Rows256 A{HMID + (size_t)(off + mt * 256) * 512, 512, (rows_here < 256 ? rows_here : 256) - 1};
    Rows256 B{(const bfr*)(ws + O_WDN) + ((size_t)(layer * 16 + e) * 1024 + nt * 256) * 512, 512, 255};
    const int* lst = LIST + (size_t)e * NT;
    gemm_tile_256<4>(smem_all, 16, A, B, [&](f32x4(&acc)[8][4], int wr, int wc, int fr, int fq) {
#pragma unroll
      for (int m = 0; m < 8; ++m) {
        const int i = mt * 256 + wr * 128 + m * 16 + fr;
        if (i < ce) {
          const int en = lst[i];
          const float w = TOPW[en];
          bfr* dst = MO + ((size_t)(en & 1) * NT + (en >> 1)) * 1024 + nt * 256 + wc * 64 + fq * 4;
#pragma unroll
          for (int n = 0; n < 4; ++n)
            *(uint2*)(dst + n * 16) = make_uint2(pack2(acc[m][n][0] * w, acc[m][n][1] * w), pack2(acc[m][n][2] * w, acc[m][n][3] * w));
        }
      }
    });
  }
}

struct ALora {
  const bfr* proj; const float* mu; int tok0; int colbase; int mode;
  const bfr* rp[2]; bool hp[2];
  DI void init(int lr) {
#pragma unroll
    for (int i = 0; i < 2; ++i) { const int tok = tok0 + lr + 64 * i; rp[i] = proj + (size_t)tok * PW1 + colbase; hp[i] = (tok & (SEQ - 1)) != 0; }
  }
  DI uint4 load(int sel, int k) const {
    const uint4 c = *(const uint4*)(rp[sel] + k);
    uint4 pv = make_uint4(0, 0, 0, 0);
    if (hp[sel]) pv = *(const uint4*)(rp[sel] - PW1 + k);
    const float4 m0 = *(const float4*)(mu + colbase + k), m1 = *(const float4*)(mu + colbase + k + 4);
    float v[8];
    v[0] = lo2f(c.x) + (lo2f(pv.x) - lo2f(c.x)) * m0.x; v[1] = hi2f(c.x) + (hi2f(pv.x) - hi2f(c.x)) * m0.y;
    v[2] = lo2f(c.y) + (lo2f(pv.y) - lo2f(c.y)) * m0.z; v[3] = hi2f(c.y) + (hi2f(pv.y) - hi2f(c.y)) * m0.w;
    v[4] = lo2f(c.z) + (lo2f(pv.z) - lo2f(c.z)) * m1.x; v[5] = hi2f(c.z) + (hi2f(pv.z) - hi2f(c.z)) * m1.y;
    v[6] = lo2f(c.w) + (lo2f(pv.w) - lo2f(c.w)) * m1.z; v[7] = hi2f(c.w) + (hi2f(pv.w) - hi2f(c.w)) * m1.w;
#pragma unroll
    for (int i = 0; i < 8; ++i) v[i] = mode == 0 ? tanhf(v[i]) : (mode == 2 ? sigmoidf_(v[i]) : v[i]);
    return make_uint4(pack2(v[0], v[1]), pack2(v[2], v[3]), pack2(v[4], v[5]), pack2(v[6], v[7]));
  }
};
DI void rwkv_lora_pool_phase(const Params& p, char* smem) {
  char* ws = p.ws;
  const bfr* PROJ = (const bfr*)(ws + O_PROJ);
  float* W = (float*)(ws + O_RW_W);
  bfr* AS = (bfr*)(ws + O_RW_AS);
  bfr* G = (bfr*)(ws + O_RW_G);
  bfr* MIX = (bfr*)(ws + O_MIX);
  for (int item = VB; item < 1024; item += NVB) {
    const int mt = item >> 3, sub = ((item & 7) + ((item >> 9) & 1) * 4) & 7, tok0 = mt * 128;
    if (sub < 4) {
      const int cp = sub;
      {
        ALora A{PROJ, p.in[I_MU], tok0, 1536, 0};
        RowsContig B{(const bfr*)(ws + O_W2T) + (size_t)cp * 128 * 64, 64, 127};
        const float* w0 = p.in[I_W0];
        gemm_tile(smem, 2, A, B, [&](f32x4(&acc)[4][4], int wr, int wc, int fr, int fq) {
#pragma unroll
          for (int n = 0; n < 4; ++n) {
            const int col = cp * 128 + wc * 64 + n * 16 + fr;
            const float w0v = w0[col];
#pragma unroll
            for (int m = 0; m < 4; ++m)
#pragma unroll
              for (int j = 0; j < 4; ++j) {
                const int tok = tok0 + wr * 64 + m * 16 + fq * 4 + j;
                const float z = -(w0v + acc[m][n][j]);
                const float sp = fmaxf(z, 0.f) + log1pf(__expf(-fabsf(z)));
                W[(size_t)tok * 512 + col] = __expf(-__expf(-sp - 0.5f));
              }
          }
        });
      }
      {
        ALora A{PROJ, p.in[I_MU], tok0, 1600, 1};
        RowsContig B{(const bfr*)(ws + O_A2T) + (size_t)cp * 128 * 64, 64, 127};
        const float* a0 = p.in[I_A0];
        gemm_tile(smem, 2, A, B, [&](f32x4(&acc)[4][4], int wr, int wc, int fr, int fq) {
#pragma unroll
          for (int n = 0; n < 4; ++n) {
            const int col = cp * 128 + wc * 64 + n * 16 + fr;
            const float a0v = a0[col];
#pragma unroll
            for (int m = 0; m < 4; ++m)
#pragma unroll
              for (int j = 0; j < 4; ++j) {
                const int tok = tok0 + wr * 64 + m * 16 + fq * 4 + j;
                AS[(size_t)tok * 512 + col] = f2bf(sigmoidf_(a0v + acc[m][n][j]));
              }
          }
        });
      }
      {
        ALora A{PROJ, p.in[I_MU], tok0, 1664, 2};
        RowsContig B{(const bfr*)(ws + O_G2T) + (size_t)cp * 128 * 128, 128, 127};
        gemm_tile(smem, 4, A, B, [&](f32x4(&acc)[4][4], int wr, int wc, int fr, int fq) {
#pragma unroll
          for (int n = 0; n < 4; ++n) {
            const int col = cp * 128 + wc * 64 + n * 16 + fr;
#pragma unroll
            for (int m = 0; m < 4; ++m)
#pragma unroll
              for (int j = 0; j < 4; ++j) {
                const int tok = tok0 + wr * 64 + m * 16 + fq * 4 + j;
                G[(size_t)tok * 512 + col] = f2bf(acc[m][n][j]);
              }
          }
        });
      }
    } else {
      bfr* POOLED = (bfr*)(ws + O_POOLED);
      const int tid = tid_opaque();
      for (int e = tid; e < 32 * 64; e += 256) {
        const int tok = tok0 + (sub - 4) * 32 + (e >> 6), ch = (e & 63) * 8, gi = ch >> 7;
        const int t = tok & (SEQ - 1), win = 2 << gi, n = (t + 1 < win) ? t + 1 : win;
        const bfr* rp = PROJ + (size_t)tok * PW1 + 1792 + ch;
        const uint4 c = *(const uint4*)rp;
        const float a[8] = {lo2f(c.x), hi2f(c.x), lo2f(c.y), hi2f(c.y), lo2f(c.z), hi2f(c.z), lo2f(c.w), hi2f(c.w)};
        float sm[8];
#pragma unroll
        for (int i = 0; i < 8; ++i) sm[i] = a[i];
#pragma unroll
        for (int d0 = 1; d0 < 16; d0 += 5) {
          uint4 u[5];
#pragma unroll
          for (int q = 0; q < 5; ++q) {
            const int d = d0 + q;
            u[q] = make_uint4(0, 0, 0, 0);
            if (d < n) u[q] = *(const uint4*)(rp - (size_t)d * PW1);
          }
#pragma unroll
          for (int q = 0; q < 5; ++q) {
            sm[0] += lo2f(u[q].x); sm[1] += hi2f(u[q].x); sm[2] += lo2f(u[q].y); sm[3] += hi2f(u[q].y);
            sm[4] += lo2f(u[q].z); sm[5] += hi2f(u[q].z); sm[6] += lo2f(u[q].w); sm[7] += hi2f(u[q].w);
          }
        }
        const float inv = 1.f / (float)n;
#pragma unroll
        for (int i = 0; i < 8; ++i) sm[i] = sm[i] * inv - a[i];
        *(uint4*)(POOLED + (size_t)tok * 512 + ch) = make_uint4(pack2(sm[0], sm[1]), pack2(sm[2], sm[3]), pack2(sm[4], sm[5]), pack2(sm[6], sm[7]));
      }
    }
  }
}

DI void pool_gemm_tiles(const Params& p, char* smem, int first, int stride) {
  char* ws = p.ws;
  bfr* MIX = (bfr*)(ws + O_MIX);
  for (int tile = first; tile < 512; tile += stride) {
    const int mt = tile >> 2, gi = tile & 3, tok0 = mt * 128;
    RowsContig A{(const bfr*)(ws + O_POOLED) + (size_t)tok0 * 512 + gi * 128, 512, 127};
    RowsContig B{(const bfr*)(ws + O_PWT) + (size_t)gi * 128 * 128, 128, 127};
    const float* ps = p.in[I_POOLS] + gi * 128;
    gemm_tile(smem, 4, A, B, [&](f32x4(&acc)[4][4], int wr, int wc, int fr, int fq) {
#pragma unroll
      for (int n = 0; n < 4; ++n) {
        const int col = wc * 64 + n * 16 + fr;
        const float sc = ps[col];
#pragma unroll
        for (int m = 0; m < 4; ++m)
#pragma unroll
          for (int j = 0; j < 4; ++j) {
            const int tok = tok0 + wr * 64 + m * 16 + fq * 4 + j;
            MIX[(size_t)tok * 1024 + 512 + gi * 128 + col] = f2bf(acc[m][n][j] * sc);
          }
      }
    });
  }
}

constexpr int CHUNK = 128, NCH = SEQ / CHUNK;
DI void scanA_phase(const Params& p, char* smem) {
  char* ws = p.ws;
  const int tid = tid_opaque(), lane = tid & 63, wid = tid >> 6;
  const int ul = wid >> 1, isP = wid & 1;
  float* st = (float*)smem + wid * (8 * 384);
  const bfr* PROJ = (const bfr*)(ws + O_PROJ);
  const float* W = (const float*)(ws + O_RW_W);
  const bfr* AS = (const bfr*)(ws + O_RW_AS);
  bfr* QT = (bfr*)(ws + O_RW_Q); bfr* YL = (bfr*)(ws + O_RW_Y);
  float* RK = (float*)(ws + O_RK);
  float* CHP = (float*)(ws + O_CHP); float* CHL = (float*)(ws + O_CHL);
  const float* mu = p.in[I_MU];
  for (int item = VB; item < 512; item += NVB) {
    const int unit = item * 2 + ul;
    const int chain = unit >> 4, chunk = unit & 15, b = chain >> 3, h = chain & 7;
    const int c = h * 64 + lane;
    const int tok_base = b * SEQ + chunk * CHUNK;
    const float mu_r = mu[c], mu_k = mu[512 + c], mu_v = mu[1024 + c];
    const float kkp = p.in[I_KK][c], kap = p.in[I_KA][c], rkp = p.in[I_RKP][c];
    float S[64];
    int diag = isP ? lane : -1;
    asm volatile("" : "+v"(diag));
#pragma unroll
    for (int j = 0; j < 64; ++j) S[j] = (j == diag) ? 1.f : 0.f;
    bfr qr[9], qk[9], qv[9], qa[8]; float qw[8];
    auto issue = [&](int sub) {
      const int tl = chunk * CHUNK + sub * 8, tok0 = tok_base + sub * 8;
      const bfr* pr = PROJ + (size_t)tok0 * PW1 + c;
      qr[0] = 0; qk[0] = 0; qv[0] = 0;
      if (tl > 0) { qr[0] = pr[-PW1]; qk[0] = pr[512 - PW1]; qv[0] = pr[1024 - PW1]; }
#pragma unroll
      for (int s8 = 0; s8 < 8; ++s8) {
        qr[s8 + 1] = pr[(size_t)s8 * PW1]; qk[s8 + 1] = pr[(size_t)s8 * PW1 + 512]; qv[s8 + 1] = pr[(size_t)s8 * PW1 + 1024];
        qa[s8] = AS[(size_t)(tok0 + s8) * 512 + c]; qw[s8] = W[(size_t)(tok0 + s8) * 512 + c];
      }
    };
    issue(0);
#pragma unroll 1
    for (int sub = 0; sub < CHUNK / 8; ++sub) {
#pragma unroll
      for (int s = 0; s < 8; ++s) {
        const int tok = tok_base + sub * 8 + s;
        const float rc = bf2f(qr[s + 1]), rpv = bf2f(qr[s]);
        const float kc = bf2f(qk[s + 1]), kpv = bf2f(qk[s]);
        const float vc = bf2f(qv[s + 1]), vpv = bf2f(qv[s]);
        const float r = rc + (rpv - rc) * mu_r, k = kc + (kpv - kc) * mu_k, v = vc + (vpv - vc) * mu_v;
        const float as = bf2f(qa[s]);
        const float km = k * (1.f + (as - 1.f) * kap);
        float kk = k * kkp;
        float nrm = kk * kk, rk = r * km * rkp;
#pragma unroll
        for (int o2 = 32; o2 > 0; o2 >>= 1) { nrm += __shfl_xor(nrm, o2); rk += __shfl_xor(rk, o2); }
        kk *= 1.f / fmaxf(sqrtf(nrm), 1e-12f);
        float* d = st + s * 384;
        d[lane] = r;
        d[64 + lane] = qw[s];
        d[128 + lane] = km;
        d[192 + lane] = v;
        d[256 + lane] = -kk;
        d[320 + lane] = kk * as;
        if (!isP && lane == 0) RK[tok * 8 + h] = rk;
      }
      if (sub + 1 < CHUNK / 8) issue(sub + 1);
      __builtin_amdgcn_fence(__ATOMIC_RELEASE, "wavefront");
      __builtin_amdgcn_wave_barrier();
#pragma unroll 1
      for (int s = 0; s < 8; ++s) {
        const float* d = st + s * 384;
        float sa0 = 0.f, sa1 = 0.f, sa2 = 0.f, sa3 = 0.f;
#pragma unroll
        for (int j4 = 0; j4 < 16; ++j4) {
          const float4 a4 = *(const float4*)(d + 256 + j4 * 4);
          sa0 = fmaf(S[j4 * 4], a4.x, sa0); sa1 = fmaf(S[j4 * 4 + 1], a4.y, sa1); sa2 = fmaf(S[j4 * 4 + 2], a4.z, sa2); sa3 = fmaf(S[j4 * 4 + 3], a4.w, sa3);
        }
        const float sa = (sa0 + sa1) + (sa2 + sa3);
        const float vi = isP ? 0.f : d[192 + lane];
        float y0 = 0.f, y1 = 0.f, y2 = 0.f, y3 = 0.f;
#pragma unroll
        for (int j4 = 0; j4 < 16; ++j4) {
          if ((j4 & 3) == 0) asm volatile("" ::: "memory");
          const float4 w4 = *(const float4*)(d + 64 + j4 * 4);
          const float4 b4 = *(const float4*)(d + 320 + j4 * 4);
          const float4 k4 = *(const float4*)(d + 128 + j4 * 4);
          const float4 r4 = *(const float4*)(d + j4 * 4);
          S[j4 * 4 + 0] = S[j4 * 4 + 0] * w4.x + (sa * b4.x + vi * k4.x);
          S[j4 * 4 + 1] = S[j4 * 4 + 1] * w4.y + (sa * b4.y + vi * k4.y);
          S[j4 * 4 + 2] = S[j4 * 4 + 2] * w4.z + (sa * b4.z + vi * k4.z);
          S[j4 * 4 + 3] = S[j4 * 4 + 3] * w4.w + (sa * b4.w + vi * k4.w);
          y0 = fmaf(S[j4 * 4], r4.x, y0); y1 = fmaf(S[j4 * 4 + 1], r4.y, y1); y2 = fmaf(S[j4 * 4 + 2], r4.z, y2); y3 = fmaf(S[j4 * 4 + 3], r4.w, y3);
        }
        const float y = (y0 + y1) + (y2 + y3);
        const size_t o = (size_t)(tok_base + sub * 8 + s) * 512 + c;
        if (isP) QT[o] = f2bf(y);
        else YL[o] = f2bf(y);
      }
      __builtin_amdgcn_fence(__ATOMIC_RELEASE, "wavefront");
      __builtin_amdgcn_wave_barrier();
    }
    float4* dp = (float4*)((isP ? CHP : CHL) + ((size_t)unit * 64 + lane) * 64);
#pragma unroll
    for (int j4 = 0; j4 < 16; ++j4) dp[j4] = make_float4(S[j4 * 4], S[j4 * 4 + 1], S[j4 * 4 + 2], S[j4 * 4 + 3]);
  }
}

DI void scanB_phase(const Params& p, char* smem) {
  char* ws = p.ws;
  const int tid = tid_opaque();
  float* Ss = (float*)smem;
  float* Ps = Ss + 64 * 65;
  const float* CHP = (const float*)(ws + O_CHP);
  float* CHL = (float*)(ws + O_CHL);
  const int i = tid >> 2, qd = tid & 3;
#if POOL_IN_SCANB
  if (NVB > 128) {
    if (VB >= 64) { pool_gemm_tiles(p, smem, VB - 64, NVB - 64); return; }
  } else {
    pool_gemm_tiles(p, smem, VB, NVB);
    __syncthreads();
  }
#endif
  if (NVB > 128 && VB >= 64) {
    conv_run(p, smem, NC_PREP + (VB - 64), NC_ALL, NVB - 64);
    return;
  }
  for (int chain = VB; chain < 64; chain += NVB) {
    for (int e = tid; e < 64 * 65; e += 256) Ss[e] = 0.f;
    float4 pn0, pn1, pn2, pn3, ln0, ln1, ln2, ln3;
    {
      const float4* pp = (const float4*)(CHP + ((size_t)(chain * NCH)) * 4096) + tid;
      pn0 = pp[0]; pn1 = pp[256]; pn2 = pp[512]; pn3 = pp[768];
      const float4* lp = (const float4*)(CHL + ((size_t)(chain * NCH)) * 4096 + i * 64 + qd * 16);
      ln0 = lp[0]; ln1 = lp[1]; ln2 = lp[2]; ln3 = lp[3];
    }
    __syncthreads();
    for (int c = 0; c < NCH - 1; ++c) {
      const size_t ub = ((size_t)(chain * NCH + c)) * 4096;
      ((float4*)Ps)[tid] = pn0; ((float4*)Ps)[tid + 256] = pn1; ((float4*)Ps)[tid + 512] = pn2; ((float4*)Ps)[tid + 768] = pn3;
      float acc[16];
      acc[0] = ln0.x; acc[1] = ln0.y; acc[2] = ln0.z; acc[3] = ln0.w; acc[4] = ln1.x; acc[5] = ln1.y; acc[6] = ln1.z; acc[7] = ln1.w;
      acc[8] = ln2.x; acc[9] = ln2.y; acc[10] = ln2.z; acc[11] = ln2.w; acc[12] = ln3.x; acc[13] = ln3.y; acc[14] = ln3.z; acc[15] = ln3.w;
      if (c + 1 < NCH - 1) {
        const float4* pp = (const float4*)(CHP + ub + 4096) + tid;
        pn0 = pp[0]; pn1 = pp[256]; pn2 = pp[512]; pn3 = pp[768];
        const float4* lp = (const float4*)(CHL + ub + 4096 + i * 64 + qd * 16);
        ln0 = lp[0]; ln1 = lp[1]; ln2 = lp[2]; ln3 = lp[3];
      }
      __syncthreads();
      if (c > 0) {
#pragma unroll 4
        for (int k = 0; k < 64; ++k) {
          const float sv = Ss[i * 65 + k];
          const float4* pr = (const float4*)(Ps + k * 64 + qd * 16);
#pragma unroll
          for (int u = 0; u < 4; ++u) {
            const float4 v = pr[u];
            acc[u * 4] += sv * v.x; acc[u * 4 + 1] += sv * v.y; acc[u * 4 + 2] += sv * v.z; acc[u * 4 + 3] += sv * v.w;
          }
        }
      }
      __syncthreads();
#pragma unroll
      for (int u = 0; u < 16; ++u) Ss[i * 65 + qd * 16 + u] = acc[u];
      {
        float4* lp = (float4*)(CHL + ub + i * 64 + qd * 16);
#pragma unroll
        for (int u = 0; u < 4; ++u) lp[u] = make_float4(acc[u * 4], acc[u * 4 + 1], acc[u * 4 + 2], acc[u * 4 + 3]);
      }
      __syncthreads();
    }
  }
}

DI void scanC_phase(const Params& p, char* smem) {
  char* ws = p.ws;
  const int tid = tid_opaque(), lane = tid & 63, wid = tid >> 6;
  float* st = (float*)smem + wid * (8 * 64);
  const bfr* PROJ = (const bfr*)(ws + O_PROJ);
  const bfr* Q = (const bfr*)(ws + O_RW_Q); const bfr* YL = (const bfr*)(ws + O_RW_Y);
  const bfr* G = (const bfr*)(ws + O_RW_G);
  const float* RK = (const float*)(ws + O_RK);
  const float* CHL = (const float*)(ws + O_CHL);
  bfr* MIX = (bfr*)(ws + O_MIX);
  for (int unit = VB; unit < 64 * NCH; unit += NVB) {
    const int chain = unit >> 4, chunk = unit & 15, b = chain >> 3, h = chain & 7;
    const int c = h * 64 + lane;
    const int tl0 = chunk * CHUNK + wid * 32;
    const size_t base = ((size_t)b * SEQ + tl0) * 512 + c;
    const float mu_v = p.in[I_MU][1024 + c];
    float S[64];
    if (chunk > 0) {
      const float4* sp = (const float4*)(CHL + ((size_t)(unit - 1) * 64 + lane) * 64);
#pragma unroll
      for (int j4 = 0; j4 < 16; ++j4) { const float4 v = sp[j4]; S[j4 * 4] = v.x; S[j4 * 4 + 1] = v.y; S[j4 * 4 + 2] = v.z; S[j4 * 4 + 3] = v.w; }
    } else {
#pragma unroll
      for (int j = 0; j < 64; ++j) S[j] = 0.f;
    }
    const float lnw = p.in[I_LNW][c], lnb = p.in[I_LNB][c];
#pragma unroll 1
    for (int sub = 0; sub < 4; ++sub) {
      const int tl = tl0 + sub * 8, tok0 = b * SEQ + tl;
      float qv[8], yv[8], vv[9], gv[8], rkv[8];
      {
        const bfr* pr = PROJ + (size_t)tok0 * PW1 + 1024 + c;
        vv[0] = tl > 0 ? bf2f(pr[-PW1]) : 0.f;
#pragma unroll
        for (int s8 = 0; s8 < 8; ++s8) {
          const size_t o = base + (size_t)(sub * 8 + s8) * 512;
          qv[s8] = bf2f(Q[o]); yv[s8] = bf2f(YL[o]); gv[s8] = bf2f(G[o]);
          vv[s8 + 1] = bf2f(pr[(size_t)s8 * PW1]);
          rkv[s8] = RK[(tok0 + s8) * 8 + h];
        }
      }
#pragma unroll
      for (int s8 = 0; s8 < 8; ++s8) st[s8 * 64 + lane] = qv[s8];
      __builtin_amdgcn_fence(__ATOMIC_RELEASE, "wavefront");
      __builtin_amdgcn_wave_barrier();
#pragma unroll
      for (int s8 = 0; s8 < 8; ++s8) {
        float y = yv[s8];
        const float* d = st + s8 * 64;
#pragma unroll
        for (int j4 = 0; j4 < 16; ++j4) {
          const float4 q4 = *(const float4*)(d + j4 * 4);
          y += S[j4 * 4] * q4.x + S[j4 * 4 + 1] * q4.y + S[j4 * 4 + 2] * q4.z + S[j4 * 4 + 3] * q4.w;
        }
        const float mean = wave_sum(y) * (1.f / 64.f);
        const float dlt = y - mean;
        const float var = wave_sum(dlt * dlt) * (1.f / 64.f);
        const float yn = dlt * rsqrtf(var + 64e-5f) * lnw + lnb;
        const float v = vv[s8 + 1] + (vv[s8] - vv[s8 + 1]) * mu_v;
        const float outv = (yn + rkv[s8] * v) * gv[s8];
        MIX[(size_t)(tok0 + s8) * 1024 + c] = f2bf(outv);
      }
      __builtin_amdgcn_fence(__ATOMIC_RELEASE, "wavefront");
      __builtin_amdgcn_wave_barrier();
    }
  }
}

#ifndef REP_PREP
#define REP_PREP 1
#endif
#ifndef REP_PROJ0
#define REP_PROJ0 1
#endif
#ifndef REP_CMPA
#define REP_CMPA 1
#endif
#ifndef REP_SLC
#define REP_SLC 1
#endif
#ifndef REP_MOE1
#define REP_MOE1 1
#endif
#ifndef REP_MOE2
#define REP_MOE2 1
#endif
#ifndef REP_POST0
#define REP_POST0 1
#endif
#ifndef REP_RPREP
#define REP_RPREP 1
#endif
#ifndef REP_SCANB
#define REP_SCANB 1
#endif
#ifndef POOL_IN_SCANB
#define POOL_IN_SCANB 0
#endif
#ifndef REP_POOLG
#define REP_POOLG 1
#endif
#ifndef REP_SCANA
#define REP_SCANA 1
#endif
#ifndef REP_SCANAB
#define REP_SCANAB 1
#endif
#ifndef REP_SCANC
#define REP_SCANC 1
#endif
#ifndef REP_SYNC
#define REP_SYNC 1
#endif
extern __shared__ __attribute__((aligned(16))) char dyn_smem[];
DI char* smem_half() { int h = __builtin_amdgcn_readfirstlane((int)(threadIdx.x >> 8)); asm volatile("" : "+s"(h) :: "memory"); return dyn_smem + h * 49152; }
__global__ void __launch_bounds__(512, 2) fwd_megakernel(Params p) {
  cg::grid_group grid = cg::this_grid();
  __shared__ uint4 xb_words;
  char* ws = p.ws;
  const float* MOD = (const float*)(ws + O_MOD);
  const float* MOD1 = MOD + 8 * 6144;
  float* X = p.out;
  if (threadIdx.x == 0) xb_words = make_uint4(0u, 0u, 0u, 0u);
#ifndef TIMEPH
#define TIMEPH -1
#endif
  unsigned long long t_start = 0, t_mark = 0;
  if (TIMEPH >= 0) t_start = __builtin_amdgcn_s_memrealtime();

  for (int rep = 0; rep < REP_PREP; ++rep)
  {
    for (int item = VB; item < PREP_TOTAL; item += NVB) prep_item(p, smem_half(), item);
    conv_run(p, smem_half(), VB, NVB > 128 ? NC_PREP : NC_ALL, NVB);
  }
  grid.sync();
  const XcdBarrier xb = xcd_barrier_post((unsigned*)(ws + O_BAR), (volatile LAS unsigned*)&xb_words);
#ifndef TIMEPH
#define TIMEPH -1
#endif
  int gs_count = 0;
  if (TIMEPH == 0) t_mark = __builtin_amdgcn_s_memrealtime();
#define GSYNC() do { xcd_barrier(xb); if (TIMEPH >= 0) { ++gs_count; if (gs_count == TIMEPH) t_mark = __builtin_amdgcn_s_memrealtime(); } } while (0)
#ifndef XB_EXTRA_REL
#define XB_EXTRA_REL true
#endif
#ifndef XB_EXTRA_ACQ
#define XB_EXTRA_ACQ true
#endif
  for (int rep = 1; rep < REP_SYNC; ++rep) xcd_barrier<XB_EXTRA_REL, XB_EXTRA_ACQ>(xb);
  norm_phase<0, false>(p, smem_half(), p.in[I_X], nullptr, p.in[I_NMIX], MOD, 0, 1024, 0, 0);
  GSYNC();
  for (int rep = 0; rep < REP_PROJ0; ++rep) gemm_proj_phase<4>(p, dyn_smem, (const bfr*)(ws + O_WEIN), PW0, (bfr*)(ws + O_PROJ));
  GSYNC();
  for (int rep = 0; rep < REP_POST0; ++rep) post0_phase(p, smem_half());
  GSYNC();
  cmp2_phase(p, smem_half());
  GSYNC();
  for (int rep = 0; rep < REP_CMPA; ++rep) cmp_attn_mfma_phase(p, smem_half());
  GSYNC();
  for (int rep = 0; rep < REP_SLC; ++rep) attn_sw_phase(p, smem_half());
  GSYNC();
  gemm_out_phase(p, dyn_smem, (const bfr*)(ws + O_WEOUT), p.in[I_X], X, MOD + 2048);
  GSYNC();
  norm_router_phase(p, dyn_smem, X, p.in[I_NFFN], MOD, 3072, 4096, 0);
  GSYNC();
  for (int rep = 0; rep < REP_MOE1; ++rep) moe1_phase(p, dyn_smem, 0);
  GSYNC();
  for (int rep = 0; rep < REP_MOE2; ++rep) moe2_phase(p, dyn_smem, 0);
  GSYNC();
  norm_phase<1, false>(p, smem_half(), X, X, p.in[I_NMIX] + 1024, MOD1, 0, 1024, 5120 - 6144 * 8, 1);
  GSYNC();
  gemm_proj_phase<3>(p, dyn_smem, (const bfr*)(ws + O_WOIN), PW1, (bfr*)(ws + O_PROJ));
  GSYNC();
  for (int rep = 0; rep < REP_RPREP; ++rep) rwkv_lora_pool_phase(p, smem_half());
  GSYNC();
  for (int rep = 0; rep < REP_SCANA; ++rep) scanA_phase(p, smem_half());
  GSYNC();
  for (int rep = 0; rep < REP_SCANAB; ++rep) {
    if (rep > 0) { scanA_phase(p, smem_half()); GSYNC(); }
    scanB_phase(p, smem_half());
    GSYNC();
  }
  for (int rep = 0; rep < REP_SCANC; ++rep) scanC_phase(p, smem_half());
#if !POOL_IN_SCANB
  __syncthreads();
  for (int rep = 0; rep < REP_POOLG; ++rep) pool_gemm_tiles(p, smem_half(), VB, NVB);
#endif
  GSYNC();
  gemm_out_phase(p, dyn_smem, (const bfr*)(ws + O_WOOUT), X, X, MOD1 + 2048);
  GSYNC();
  norm_router_phase(p, dyn_smem, X, p.in[I_NFFN] + 1024, MOD1, 3072, 4096, 1);
  GSYNC();
  moe1_phase(p, dyn_smem, 1);
  GSYNC();
  moe2_phase(p, dyn_smem, 1);
  GSYNC();
  norm_phase<2, false>(p, smem_half(), X, X, p.in[I_FN], MOD1, 0, 0, 5120, 1);
  if (TIMEPH >= 0 && blockIdx.x == 0 && threadIdx.x == 0) {
    const unsigned long long dt = t_mark - t_start, t0 = __builtin_amdgcn_s_memrealtime();
    while (__builtin_amdgcn_s_memrealtime() - t0 < dt) __builtin_amdgcn_s_sleep(8);
  }
}

constexpr int DYN_LDS = 2 * 49152;
extern "C" void kernel_launch(void* const* d_in, const int* in_sizes, int n_in,
                              void* d_out, int out_size, void* d_ws, size_t ws_size,
                              hipStream_t stream) {
  static int grid_blocks = 0;
  if (!grid_blocks) {
    int dev = 0, cus = 0, per_cu = 0;
    (void)hipGetDevice(&dev);
    (void)hipDeviceGetAttribute(&cus, hipDeviceAttributeMultiprocessorCount, dev);
    (void)hipFuncSetAttribute((const void*)fwd_megakernel, hipFuncAttributeMaxDynamicSharedMemorySize, DYN_LDS);
    (void)hipOccupancyMaxActiveBlocksPerMultiprocessor(&per_cu, fwd_megakernel, 512, DYN_LDS);
    if (per_cu > 1) per_cu = 1;
    if (per_cu < 1) per_cu = 1;
    grid_blocks = cus * per_cu;
    fprintf(stderr, "cus=%d per_cu=%d grid=%d ws=%zu need=%zu\n", cus, per_cu, grid_blocks, ws_size, (size_t)WS_NEED);
  }
  if (ws_size < WS_NEED || n_in < 33) { fprintf(stderr, "workspace too small\n"); return; }
  Params p{};
  for (int i = 0; i < 33; ++i) p.in[i] = (const float*)d_in[i];
  p.out = (float*)d_out;
  p.ws = (char*)d_ws;
  p.ws_size = (unsigned long long)ws_size;
  void* args[] = {&p};
  hipError_t e = hipLaunchCooperativeKernel((void*)fwd_megakernel, dim3(grid_blocks), dim3(512), args, DYN_LDS, stream);
  if (e != hipSuccess) fprintf(stderr, "cooperative launch failed: %s (grid %d)\n", hipGetErrorString(e), grid_blocks);
}
```

```cpp
#include <hip/hip_runtime.h>
#include <hip/hip_cooperative_groups.h>
#include <cstdio>
namespace cg = cooperative_groups;

typedef unsigned short bfr;
using bf16x8 = __attribute__((ext_vector_type(8))) short;
using f32x4 = __attribute__((ext_vector_type(4))) float;
typedef __attribute__((ext_vector_type(2))) __bf16 bf2v;
#define DI __device__ __forceinline__

constexpr int NT = 16384;
constexpr int SEQ = 2048;
constexpr int DM = 1024;
constexpr int PW0 = 3072;
constexpr int PW1 = 2304;
constexpr int C_Q = 0, C_KC = 512, C_VC = 640, C_KS = 768, C_VS = 896, C_KW = 1024, C_VW = 1152;
constexpr int C_XB = 1280, C_BG = 1792, C_CG = 2304, C_GL = 2816;

constexpr size_t al256(size_t x) { return (x + 255) & ~size_t(255); }
constexpr size_t MB = 1024 * 1024;
constexpr size_t O_MOD = 0;
constexpr size_t O_ROPE = O_MOD + al256(2 * 8 * 6144 * 4);
constexpr size_t O_BIAS1 = O_ROPE + al256(2048 * 32 * 2 * 4);
constexpr size_t O_BAR = O_BIAS1 + al256(2 * 256 * 4);
constexpr size_t O_CNT = O_BAR + al256(3456 * 4);
constexpr size_t O_TOPW = O_CNT + al256(2 * 16 * 64 * 4);
constexpr size_t O_LIST = O_TOPW + al256((size_t)NT * 2 * 4);
constexpr size_t O_SEL = O_LIST + al256((size_t)16 * NT * 4);
constexpr size_t O_KCVC = O_SEL + al256((size_t)NT * 2 * 4);
constexpr size_t O_RK = O_KCVC + al256(2 * 2048 * 64 * 4);
constexpr size_t O_VCT = O_RK + al256((size_t)NT * 8 * 4);
constexpr size_t O_CH = O_VCT + al256(8 * 2 * 64 * 128 * 2);
constexpr size_t O_WEIN = O_CH + al256(2 * 2048 * 256 * 2);
constexpr size_t O_WEOUT = O_WEIN + al256((size_t)PW0 * 1024 * 2);
constexpr size_t O_WOIN = O_WEOUT + al256(1024 * 1024 * 2);
constexpr size_t O_WOOUT = O_WOIN + al256((size_t)PW1 * 1024 * 2);
constexpr size_t O_WC1 = O_WOOUT + al256(1024 * 1024 * 2);
constexpr size_t O_WC2 = O_WC1 + al256(2 * 256 * 2048 * 2);
constexpr size_t O_W2T = O_WC2 + al256(2 * 128 * 256 * 2);
constexpr size_t O_A2T = O_W2T + al256(512 * 64 * 2);
constexpr size_t O_G2T = O_A2T + al256(512 * 64 * 2);
constexpr size_t O_PWT = O_G2T + al256(512 * 128 * 2);
constexpr size_t O_WGU = O_PWT + al256(4 * 128 * 128 * 2);
constexpr size_t O_WDN = O_WGU + 64 * MB;
constexpr size_t O_HB = O_WDN + 32 * MB;
constexpr size_t O_MIX = O_HB + 32 * MB;
constexpr size_t O_E = O_MIX + 32 * MB;
constexpr size_t SZ_E = al256((size_t)NT * PW0 * 2);
constexpr size_t O_F = O_E + SZ_E;
constexpr size_t O_SCR = O_F + 48 * MB;
constexpr size_t WS_NEED = O_SCR + 8 * MB;
constexpr size_t O_HMID = O_MIX;
constexpr size_t O_PROJ = O_E;
constexpr size_t O_MOEOUT = O_E;
constexpr size_t O_CHP = O_WGU;
constexpr size_t O_CHL = O_WGU + 16 * MB;
constexpr size_t O_QR = O_F;
constexpr size_t O_KSR = O_F + 16 * MB;
constexpr size_t O_KWR = O_F + 20 * MB;
constexpr size_t O_OCMP = O_F + 24 * MB;
constexpr size_t O_VST = O_F + 40 * MB;
constexpr size_t O_VWT = O_F + 44 * MB;
constexpr size_t O_RW_W = O_HB;
constexpr size_t O_RW_Q = O_F;
constexpr size_t O_RW_Y = O_F + 16 * MB;
constexpr size_t O_RW_AS = O_F + 32 * MB;
constexpr size_t O_RW_G = O_WDN;
constexpr size_t O_POOLED = O_E + 76 * MB;

struct Params {
  const float* in[33];
  float* out;
  char* ws;
  unsigned long long ws_size;
};

enum { I_X = 0, I_C, I_ADAW, I_ADAB, I_NMIX, I_NFFN, I_EWIN, I_CPOS, I_CW1, I_CW2, I_CONVW, I_EWOUT, I_OWIN, I_MU, I_W0, I_W2,
       I_A0, I_A2, I_G2, I_KK, I_KA, I_RKP, I_LNW, I_LNB, I_POOLW, I_POOLS, I_OWOUT, I_RTW, I_RTB, I_MG, I_MU_, I_MD, I_FN };

DI int tid_opaque() { int t = threadIdx.x & 255; asm volatile("" : "+v"(t) :: "memory"); __builtin_assume(t >= 0 && t < 256); return t; }
#define VB ((int)(blockIdx.x * 2 + __builtin_amdgcn_readfirstlane((int)(threadIdx.x >> 8))))
#define NVB ((int)(gridDim.x * 2))
DI float bf2f(bfr u) { return __uint_as_float(((unsigned)u) << 16); }
DI bfr f2bf(float x) { unsigned u = __float_as_uint(x); u += 0x7fffu + ((u >> 16) & 1u); return (bfr)(u >> 16); }
typedef __attribute__((ext_vector_type(2))) float f32x2_;
DI unsigned pack2(float a, float b) { f32x2_ x = {a, b}; return __builtin_bit_cast(unsigned, __builtin_convertvector(x, bf2v)); }
DI float lo2f(unsigned u) { return __uint_as_float(u << 16); }
DI float hi2f(unsigned u) { return __uint_as_float(u & 0xffff0000u); }
DI float dpp_add_(float x, float y) { return x + y; }
template <int CTRL> DI float dpp_mov(float x) { return __int_as_float(__builtin_amdgcn_update_dpp(0, __float_as_int(x), CTRL, 0xF, 0xF, true)); }
DI float wave_sum(float v) {
  v += dpp_mov<0xB1>(v);
  v += dpp_mov<0x4E>(v);
  v += dpp_mov<0x141>(v);
  v += dpp_mov<0x140>(v);
  const float r0 = __int_as_float(__builtin_amdgcn_readlane(__float_as_int(v), 0));
  const float r1 = __int_as_float(__builtin_amdgcn_readlane(__float_as_int(v), 16));
  const float r2 = __int_as_float(__builtin_amdgcn_readlane(__float_as_int(v), 32));
  const float r3 = __int_as_float(__builtin_amdgcn_readlane(__float_as_int(v), 48));
  return (r0 + r1) + (r2 + r3);
}
DI float sigmoidf_(float x) { return 1.f / (1.f + __expf(-x)); }
DI float dot2(unsigned a, unsigned b, float c) {
  return __builtin_amdgcn_fdot2_f32_bf16(__builtin_bit_cast(bf2v, a), __builtin_bit_cast(bf2v, b), c, false);
}

#define XB_TMO      128
#define XB_XCNT(j)  (256  + 64 * (j))
#define XB_XSUB(j)  (1280 + 64 * (j))
#define XB_XGEN(j)  (2304 + 64 * (j))
#define XB_TOP      3328
#define XB_TOPGEN   3392
#define XCD_BAR_WORDS 3456
#define XB_SPIN_CAP (1u << 22)
#define LAS __attribute__((address_space(3)))
DI unsigned xb_ld(unsigned* p) { return __hip_atomic_load(p, __ATOMIC_RELAXED, __HIP_MEMORY_SCOPE_AGENT); }
DI unsigned xb_add(unsigned* p, unsigned v) { return __hip_atomic_fetch_add(p, v, __ATOMIC_RELAXED, __HIP_MEMORY_SCOPE_AGENT); }
DI unsigned xb_xcc_id() { return (unsigned)__builtin_amdgcn_s_getreg((3 << 11) | 20) & 0xFu; }
#define XB_SPIN(cond, bar) do { unsigned _sp = 0; while (cond) { __builtin_amdgcn_s_sleep(1); \
    if ((++_sp & 255u) == 0u) { if (xb_ld(&(bar)[XB_TMO])) break; if (_sp > XB_SPIN_CAP) { atomicAdd(&(bar)[XB_TMO], 1u); break; } } } } while (0)
struct XcdBarrier { unsigned* bar; unsigned x; volatile LAS unsigned* st; };
DI XcdBarrier xcd_barrier_post(unsigned* bar, volatile LAS unsigned* st) {
  XcdBarrier b; b.bar = bar; b.x = (unsigned)__builtin_amdgcn_readfirstlane((int)xb_xcc_id()); b.st = st;
  if (threadIdx.x == 0) (void)xb_add(&bar[XB_XCNT(b.x)], 1u);
  return b;
}
DI void xcd_barrier_complete(unsigned* bar, unsigned x, unsigned& nloc, unsigned& nx) {
  const unsigned G = gridDim.x * gridDim.y * gridDim.z;
  unsigned sum, cnt, mine, sp = 0u;
  for (;;) {
    sum = 0u; cnt = 0u; mine = 0u;
#pragma unroll
    for (unsigned j = 0; j < 16; ++j) { const unsigned c = xb_ld(&bar[XB_XCNT(j)]); sum += c; cnt += (c > 0u) ? 1u : 0u; mine = (j == x) ? c : mine; }
    if (sum == G) break;
    __builtin_amdgcn_s_sleep(1);
    if ((++sp & 255u) == 0u) { if (xb_ld(&bar[XB_TMO])) break; if (sp > XB_SPIN_CAP) { atomicAdd(&bar[XB_TMO], 1u); break; } }
  }
  nloc = mine > 0u ? mine : 1u; nx = cnt > 0u ? cnt : 1u;
}
template <bool REL = true, bool ACQ = true>
DI void xcd_barrier(const XcdBarrier& b) {
  asm volatile("s_waitcnt vmcnt(0)" ::: "memory");
  __syncthreads();
  if (threadIdx.x == 0) {
    unsigned* bar = b.bar;
    unsigned bx = b.x;
    asm volatile("" : "+s"(bx));
    __builtin_amdgcn_s_waitcnt(0);
    unsigned nloc = b.st[0], nx = b.st[1];
    if (nloc == 0u) { xcd_barrier_complete(bar, bx, nloc, nx); b.st[0] = nloc; b.st[1] = nx; }
    const unsigned old = xb_add(&bar[XB_XSUB(bx)], 1u);
    const unsigned gen = old / nloc;
    if (old + 1u == (gen + 1u) * nloc) {
      if (REL) __builtin_amdgcn_fence(__ATOMIC_RELEASE, "agent");
      asm volatile("s_waitcnt vmcnt(0)" ::: "memory");
      const unsigned og = xb_add(&bar[XB_TOP], 1u);
      const unsigned tg = og / nx;
      if (og + 1u == (tg + 1u) * nx) xb_add(&bar[XB_TOPGEN], 1u);
      else XB_SPIN(xb_ld(&bar[XB_TOPGEN]) == tg, bar);
      if (ACQ) __builtin_amdgcn_fence(__ATOMIC_ACQUIRE, "agent");
      xb_add(&bar[XB_XGEN(bx)], 1u);
      asm volatile("s_waitcnt vmcnt(0)" ::: "memory");
    } else {
      XB_SPIN(xb_ld(&bar[XB_XGEN(bx)]) == gen, bar);
      if (ACQ) __builtin_amdgcn_fence(__ATOMIC_ACQUIRE, "agent");
      asm volatile("s_waitcnt vmcnt(0)" ::: "memory");
    }
  }
  __syncthreads();
}

struct GemmLds { bfr a[2][128][40]; bfr b[2][128][40]; };
static_assert(sizeof(GemmLds) == 40960, "lds");

template <bool TR = false, class AF, class BF, class Epi>
DI void gemm_tile(char* smem, int nk, AF af, BF bfn, Epi&& epi) {
  GemmLds& L = *(GemmLds*)smem;
  const int tid = tid_opaque(), lane = tid & 63, wid = tid >> 6, wr = wid >> 1, wc = wid & 1, fr = lane & 15, fq = lane >> 4;
  const int lr = tid >> 2, lk = (tid & 3) * 8;
  af.init(lr);
  bfn.init(lr);
  f32x4 acc[4][4];
#pragma unroll
  for (int m = 0; m < 4; ++m)
#pragma unroll
    for (int n = 0; n < 4; ++n) acc[m][n] = f32x4{0.f, 0.f, 0.f, 0.f};
  uint4 ra0, ra1, rb0, rb1;
  ra0 = af.load(0, lk); ra1 = af.load(1, lk);
  rb0 = bfn.load(0, lk); rb1 = bfn.load(1, lk);
  *(uint4*)&L.a[0][lr][lk] = ra0; *(uint4*)&L.a[0][lr + 64][lk] = ra1;
  *(uint4*)&L.b[0][lr][lk] = rb0; *(uint4*)&L.b[0][lr + 64][lk] = rb1;
  __syncthreads();
  for (int kt = 0; kt < nk; ++kt) {
    const int cur = kt & 1;
    if (kt + 1 < nk) {
      const int k = (kt + 1) * 32 + lk;
      ra0 = af.load(0, k); ra1 = af.load(1, k);
      rb0 = bfn.load(0, k); rb1 = bfn.load(1, k);
    }
    __builtin_amdgcn_sched_barrier(0);
    bf16x8 fa[4], fb[4];
#pragma unroll
    for (int m = 0; m < 4; ++m) fa[m] = *(const bf16x8*)&L.a[cur][wr * 64 + m * 16 + fr][fq * 8];
#pragma unroll
    for (int n = 0; n < 4; ++n) fb[n] = *(const bf16x8*)&L.b[cur][wc * 64 + n * 16 + fr][fq * 8];
#pragma unroll
    for (int m = 0; m < 4; ++m)
#pragma unroll
      for (int n = 0; n < 4; ++n) acc[m][n] = TR ? __builtin_amdgcn_mfma_f32_16x16x32_bf16(fb[n], fa[m], acc[m][n], 0, 0, 0)
                                                 : __builtin_amdgcn_mfma_f32_16x16x32_bf16(fa[m], fb[n], acc[m][n], 0, 0, 0);
    __builtin_amdgcn_sched_barrier(0);
    if (kt + 1 < nk) {
      *(uint4*)&L.a[cur ^ 1][lr][lk] = ra0; *(uint4*)&L.a[cur ^ 1][lr + 64][lk] = ra1;
      *(uint4*)&L.b[cur ^ 1][lr][lk] = rb0; *(uint4*)&L.b[cur ^ 1][lr + 64][lk] = rb1;
    }
    __syncthreads();
  }
  epi(acc, wr, wc, fr, fq);
}

struct RowsContig {
  const bfr* base; int ld; int maxrow;
  const bfr* rp[2];
  DI void init(int lr) {
#pragma unroll
    for (int i = 0; i < 2; ++i) { const int r = lr + 64 * i; rp[i] = base + (size_t)(r < maxrow ? r : maxrow) * ld; }
  }
  DI uint4 load(int sel, int k) const { return *(const uint4*)(rp[sel] + k); }
  DI const bfr* ptr(int sel, int k) const { return rp[sel] + k; }
};

#ifndef KLOOP2
#define KLOOP2 1
#endif
struct RowsContigW {
  const bfr* base; int ld; int maxrow;
  const bfr* rp[2];
  DI void init(int lr) {
#pragma unroll
    for (int i = 0; i < 2; ++i) { const int r = lr + 64 * i; rp[i] = base + (size_t)(r < maxrow ? r : maxrow) * ld; }
  }
  DI const bfr* ptr(int sel, int k) const { return rp[sel] + (k & 1023); }
};
struct GemmLdsG { bfr a[3][128][32]; bfr b[3][128][32]; };
static_assert(sizeof(GemmLdsG) == 49152, "glds lds");
template <class AF, class BF, class Epi>
DI void gemm_tile_g(char* smem, int nk, AF af, BF bfn, Epi&& epi) {
  GemmLdsG& L = *(GemmLdsG*)smem;
  const int tid = tid_opaque(), lane = tid & 63, wid = tid >> 6, wr = wid >> 1, wc = wid & 1, fr = lane & 15, fq = lane >> 4;
  const int lr = tid >> 2;
  const int lk = ((tid & 3) ^ (2 * ((lr >> 3) & 1))) * 8;
  af.init(lr);
  bfn.init(lr);
  f32x4 acc[4][4];
#pragma unroll
  for (int m = 0; m < 4; ++m)
#pragma unroll
    for (int n = 0; n < 4; ++n) acc[m][n] = f32x4{0.f, 0.f, 0.f, 0.f};
  typedef __attribute__((address_space(3))) unsigned lds_u32;
  auto stage = [&](int buf, int kt) {
    const int k = kt * 32 + lk;
    char* la = (char*)&L.a[buf][0][0] + tid * 16;
    char* lb = (char*)&L.b[buf][0][0] + tid * 16;
    __builtin_amdgcn_global_load_lds((const unsigned*)af.ptr(0, k), (lds_u32*)la, 16, 0, 0);
    __builtin_amdgcn_global_load_lds((const unsigned*)af.ptr(1, k), (lds_u32*)(la + 4096), 16, 0, 0);
    __builtin_amdgcn_global_load_lds((const unsigned*)bfn.ptr(0, k), (lds_u32*)lb, 16, 0, 0);
    __builtin_amdgcn_global_load_lds((const unsigned*)bfn.ptr(1, k), (lds_u32*)(lb + 4096), 16, 0, 0);
  };
  const int cs = (fq ^ (2 * (fr >> 3))) * 8;
  stage(0, 0);
  stage(1, 1);
  int cur = 0;
  for (int kt = 0; kt < nk; ++kt) {
    if (kt + 1 < nk) asm volatile("s_waitcnt vmcnt(4)" ::: "memory");
    else asm volatile("s_waitcnt vmcnt(0)" ::: "memory");
    __builtin_amdgcn_s_barrier();
    asm volatile("" ::: "memory");
    if (kt + 2 < nk) stage(cur == 0 ? 2 : cur - 1, kt + 2);
    bf16x8 fa[4], fb[4];
#pragma unroll
    for (int m = 0; m < 4; ++m) fa[m] = *(const bf16x8*)&L.a[cur][wr * 64 + m * 16 + fr][cs];
#pragma unroll
    for (int n = 0; n < 4; ++n) fb[n] = *(const bf16x8*)&L.b[cur][wc * 64 + n * 16 + fr][cs];
#pragma unroll
    for (int m = 0; m < 4; ++m)
#pragma unroll
      for (int n = 0; n < 4; ++n) acc[m][n] = __builtin_amdgcn_mfma_f32_16x16x32_bf16(fb[n], fa[m], acc[m][n], 0, 0, 0);
    cur = cur == 2 ? 0 : cur + 1;
  }
  asm volatile("s_waitcnt lgkmcnt(0)" ::: "memory");
  __builtin_amdgcn_s_barrier();
  asm volatile("" ::: "memory");
  epi(acc, wr, wc, fr, fq);
}

DI int tid512_opaque() { int t = threadIdx.x; asm volatile("" : "+v"(t) :: "memory"); __builtin_assume(t >= 0 && t < 512); return t; }
DI int xcd_first_tile() { const int g8 = gridDim.x >> 3; return (gridDim.x & 7) ? (int)blockIdx.x : (int)((blockIdx.x & 7) * g8 + (blockIdx.x >> 3)); }
struct GemmLds256 { bfr a[3][256][32]; bfr b[3][256][32]; };
static_assert(sizeof(GemmLds256) == 98304, "lds256");
struct Rows256 {
  const bfr* base; int ld; int maxrow;
  const bfr* rp[2];
  DI void init(int lr) {
#pragma unroll
    for (int i = 0; i < 2; ++i) { const int r = lr + 128 * i; rp[i] = base + (size_t)(r < maxrow ? r : maxrow) * ld; }
  }
  DI const bfr* ptr(int sel, int k) const { return rp[sel] + k; }
};
template <int NS, class AF, class BF, class Epi>
DI void gemm_tile_256(char* smem_all, int nk, AF af, BF bfn, Epi&& epi) {
  GemmLds256& L = *(GemmLds256*)smem_all;
  const int tid = tid512_opaque(), lane = tid & 63, wid = tid >> 6, wr = wid >> 2, wc = wid & 3, fr = lane & 15, fq = lane >> 4;
  const int lr = tid >> 2;
  const int lk = ((tid & 3) ^ (2 * ((lr >> 3) & 1))) * 8;
  af.init(lr);
  bfn.init(lr);
  f32x4 acc[8][NS];
#pragma unroll
  for (int m = 0; m < 8; ++m)
#pragma unroll
    for (int n = 0; n < NS; ++n) acc[m][n] = f32x4{0.f, 0.f, 0.f, 0.f};
  typedef __attribute__((address_space(3))) unsigned lds_u32;
  auto stage = [&](int buf, int kt) {
    const int k = kt * 32 + lk;
    char* la = (char*)&L.a[buf][0][0] + tid * 16;
    char* lb = (char*)&L.b[buf][0][0] + tid * 16;
    __builtin_amdgcn_global_load_lds((const unsigned*)af.ptr(0, k), (lds_u32*)la, 16, 0, 0);
    __builtin_amdgcn_global_load_lds((const unsigned*)af.ptr(1, k), (lds_u32*)(la + 8192), 16, 0, 0);
    __builtin_amdgcn_global_load_lds((const unsigned*)bfn.ptr(0, k), (lds_u32*)lb, 16, 0, 0);
    __builtin_amdgcn_global_load_lds((const unsigned*)bfn.ptr(1, k), (lds_u32*)(lb + 8192), 16, 0, 0);
  };
  const int cs = (fq ^ (2 * (fr >> 3))) * 8;
  stage(0, 0);
  stage(1, 1);
  int cur = 0;
  for (int kt = 0; kt < nk; ++kt) {
    if (kt + 1 < nk) asm volatile("s_waitcnt vmcnt(4)" ::: "memory");
    else asm volatile("s_waitcnt vmcnt(0)" ::: "memory");
    __builtin_amdgcn_s_barrier();
    asm volatile("" ::: "memory");
    if (kt + 2 < nk) stage(cur == 0 ? 2 : cur - 1, kt + 2);
    bf16x8 fb[NS];
#pragma unroll
    for (int n = 0; n < NS; ++n) fb[n] = *(const bf16x8*)&L.b[cur][wc * (NS * 16) + n * 16 + fr][cs];
#pragma unroll
    for (int mh = 0; mh < 2; ++mh) {
      bf16x8 fa[4];
#pragma unroll
      for (int m = 0; m < 4; ++m) fa[m] = *(const bf16x8*)&L.a[cur][wr * 128 + (mh * 4 + m) * 16 + fr][cs];
#pragma unroll
      for (int m = 0; m < 4; ++m)
#pragma unroll
        for (int n = 0; n < NS; ++n) acc[mh * 4 + m][n] = __builtin_amdgcn_mfma_f32_16x16x32_bf16(fb[n], fa[m], acc[mh * 4 + m][n], 0, 0, 0);
    }
    cur = cur == 2 ? 0 : cur + 1;
  }
  asm volatile("s_waitcnt lgkmcnt(0)" ::: "memory");
  __builtin_amdgcn_s_barrier();
  asm volatile("" ::: "memory");
  epi(acc, wr, wc, fr, fq);
}

DI int remap_col(int mode, int n) {
  if (mode == 1) return n < 1280 ? n : (n < 1304 ? C_GL + (n - 1280) : n - 24);
  if (mode == 2) return ((n >> 4) << 5) + (n & 15);
  if (mode == 3) return ((n >> 4) << 5) + 16 + (n & 15);
  return n;
}

DI void conv_tile(char* smem, const float* __restrict__ src, int ldsrc, int Ndim, int k0, int n0, bfr* dst, int ldd, int mode) {
  float(*t)[65] = (float(*)[65])smem;
  const int tid = tid_opaque();
  {
    const int n = tid & 63, kq = tid >> 6;
    const int nn = n0 + n;
#pragma unroll
    for (int i = 0; i < 16; ++i) {
      const int k = i * 4 + kq;
      t[k][n] = (nn < Ndim) ? src[(size_t)(k0 + k) * ldsrc + nn] : 0.f;
    }
  }
  __syncthreads();
  {
    const int nl = tid >> 2, kc = (tid & 3) * 16;
    const int nn = n0 + nl;
    if (nn < Ndim) {
      const int dr = remap_col(mode, nn);
      unsigned w[8];
#pragma unroll
      for (int i = 0; i < 8; ++i) w[i] = pack2(t[kc + 2 * i][nl], t[kc + 2 * i + 1][nl]);
      uint4* d = (uint4*)(dst + (size_t)dr * ldd + k0 + kc);
      d[0] = make_uint4(w[0], w[1], w[2], w[3]);
      d[1] = make_uint4(w[4], w[5], w[6], w[7]);
    }
  }
  __syncthreads();
}

constexpr int PREP_MOD = 192, PREP_ROPE = 256, PREP_MISC = 4;
constexpr int T_EIN = 16 * 45, T_SQ = 256, T_OIN = 16 * 36, T_C1 = 128, T_C2 = 4, T_G = 128, T_D = 128;
constexpr int PREP_CONV0 = PREP_MOD + PREP_ROPE + PREP_MISC;
constexpr int T_LORA = 8 + 8 + 16 + 16;
constexpr int PREP_TOTAL = PREP_CONV0;

struct ConvJob { const float* src; bfr* dst; int ldsrc, Ndim, k0, n0, ldd, mode; };
constexpr int J_EIN = 16 * 23, J_SQ = 16 * 8, J_OIN = 16 * 18, J_C1 = 32 * 2, J_C2 = 4, J_LORA = 4 + 4 + 8 + 8, J_G = 16 * 4, J_D = 8 * 8;
constexpr int NC_MISC = J_EIN + J_SQ + J_OIN + J_SQ + 2 * J_C1 + 2 * J_C2 + J_LORA;
constexpr int NC_EXP = 2 * J_G + J_D;
constexpr int NC_PREP = NC_MISC + 16 * NC_EXP;
constexpr int NC_ALL = NC_MISC + 32 * NC_EXP;
static_assert(NC_MISC % 2 == 0 && NC_EXP % 2 == 0, "paired halves need even job counts");
DI ConvJob conv_decode(const Params& p, int item) {
  char* ws = p.ws;
  ConvJob j;
  if (item < J_EIN) { j = ConvJob{p.in[I_EWIN], (bfr*)(ws + O_WEIN), 2840, 2840, (item / 23) * 64, (item % 23) * 128, 1024, 1}; return j; }
  item -= J_EIN;
  if (item < J_SQ) { j = ConvJob{p.in[I_EWOUT], (bfr*)(ws + O_WEOUT), 1024, 1024, (item / 8) * 64, (item % 8) * 128, 1024, 0}; return j; }
  item -= J_SQ;
  if (item < J_OIN) { j = ConvJob{p.in[I_OWIN], (bfr*)(ws + O_WOIN), 2304, 2304, (item / 18) * 64, (item % 18) * 128, 1024, 0}; return j; }
  item -= J_OIN;
  if (item < J_SQ) { j = ConvJob{p.in[I_OWOUT], (bfr*)(ws + O_WOOUT), 1024, 1024, (item / 8) * 64, (item % 8) * 128, 1024, 0}; return j; }
  item -= J_SQ;
  if (item < 2 * J_C1) {
    const int jj = item / J_C1, tt = item % J_C1;
    j = ConvJob{p.in[I_CW1] + (size_t)jj * 2048 * 256, (bfr*)(ws + O_WC1) + (size_t)jj * 256 * 2048, 256, 256, (tt / 2) * 64, (tt % 2) * 128, 2048, 0}; return j;
  }
  item -= 2 * J_C1;
  if (item < 2 * J_C2) {
    const int jj = item / J_C2, tt = item % J_C2;
    j = ConvJob{p.in[I_CW2] + (size_t)jj * 256 * 64, (bfr*)(ws + O_WC2) + (size_t)jj * 128 * 256, 64, 64, tt * 64, 0, 256, 0}; return j;
  }
  item -= 2 * J_C2;
  if (item < J_LORA) {
    if (item < 4) j = ConvJob{p.in[I_W2], (bfr*)(ws + O_W2T), 512, 512, 0, item * 128, 64, 0};
    else if (item < 8) j = ConvJob{p.in[I_A2], (bfr*)(ws + O_A2T), 512, 512, 0, (item - 4) * 128, 64, 0};
    else if (item < 16) { const int t2 = item - 8; j = ConvJob{p.in[I_G2], (bfr*)(ws + O_G2T), 512, 512, (t2 >> 2) * 64, (t2 & 3) * 128, 128, 0}; }
    else { const int t2 = item - 16, gi = t2 >> 1; j = ConvJob{p.in[I_POOLW] + gi * 128 * 128, (bfr*)(ws + O_PWT) + gi * 128 * 128, 128, 128, (t2 & 1) * 64, 0, 128, 0}; }
    return j;
  }
  item -= J_LORA;
  const int le = item / NC_EXP, tt = item % NC_EXP;
  if (tt < J_G) j = ConvJob{p.in[I_MG] + (size_t)le * 1024 * 512, (bfr*)(ws + O_WGU) + (size_t)le * 1024 * 1024, 512, 512, (tt / 4) * 64, (tt % 4) * 128, 1024, 2};
  else if (tt < 2 * J_G) { const int t2 = tt - J_G; j = ConvJob{p.in[I_MU_] + (size_t)le * 1024 * 512, (bfr*)(ws + O_WGU) + (size_t)le * 1024 * 1024, 512, 512, (t2 / 4) * 64, (t2 % 4) * 128, 1024, 3}; }
  else { const int t2 = tt - 2 * J_G; j = ConvJob{p.in[I_MD] + (size_t)le * 512 * 1024, (bfr*)(ws + O_WDN) + (size_t)le * 1024 * 512, 1024, 1024, (t2 / 8) * 64, (t2 % 8) * 128, 512, 0}; }
  return j;
}
DI void conv_run(const Params& p, char* smem, int first, int end, int stride) {
  float(*t)[129] = (float(*)[129])smem;
  const int tid = tid_opaque();
  const int lk = tid >> 5, ln = (tid & 31) * 4;
  float4 r[8];
  auto gload = [&](const ConvJob& j) {
#pragma unroll
    for (int ps = 0; ps < 8; ++ps) {
      r[ps] = make_float4(0.f, 0.f, 0.f, 0.f);
      if (j.n0 + ln < j.Ndim) {
        typedef float f4v __attribute__((ext_vector_type(4)));
        const f4v t4 = __builtin_nontemporal_load((const f4v*)(j.src + (size_t)(j.k0 + lk + 8 * ps) * j.ldsrc + j.n0 + ln));
        r[ps] = make_float4(t4.x, t4.y, t4.z, t4.w);
      }
    }
  };
  int ci = first;
  ConvJob cur{};
  if (ci < end) { cur = conv_decode(p, ci); gload(cur); }
  for (; ci < end; ci += stride) {
#pragma unroll
    for (int ps = 0; ps < 8; ++ps) {
      t[lk + 8 * ps][ln] = r[ps].x; t[lk + 8 * ps][ln + 1] = r[ps].y; t[lk + 8 * ps][ln + 2] = r[ps].z; t[lk + 8 * ps][ln + 3] = r[ps].w;
    }
    __syncthreads();
    ConvJob nxt = cur;
    if (ci + stride < end) { nxt = conv_decode(p, ci + stride); gload(nxt); }
    {
      const int nl = tid >> 1, kc = (tid & 1) * 32;
      const int nn = cur.n0 + nl;
      if (nn < cur.Ndim) {
        const int dr = remap_col(cur.mode, nn);
        unsigned w[16];
#pragma unroll
        for (int i = 0; i < 16; ++i) w[i] = pack2(t[kc + 2 * i][nl], t[kc + 2 * i + 1][nl]);
        uint4* d = (uint4*)(cur.dst + (size_t)dr * cur.ldd + cur.k0 + kc);
        d[0] = make_uint4(w[0], w[1], w[2], w[3]);
        d[1] = make_uint4(w[4], w[5], w[6], w[7]);
        d[2] = make_uint4(w[8], w[9], w[10], w[11]);
        d[3] = make_uint4(w[12], w[13], w[14], w[15]);
      }
    }
    __syncthreads();
    cur = nxt;
  }
}

DI void prep_item(const Params& p, char* smem, int item) {
  const int tid = tid_opaque();
  char* ws = p.ws;
  if (item < PREP_MOD) {
    const int layer = item / 96, cch = item % 96;
    float* cond = (float*)smem;
    float* red = (float*)(smem + 32768);
    const float* c = p.in[I_C];
    for (int i = tid; i < 8192; i += 256) {
      const int b = i >> 10, k = i & 1023;
      const float v = c[i];
      cond[k * 8 + b] = v / (1.f + __expf(-v));
    }
    __syncthreads();
    const int col = cch * 64 + (tid & 63), kg = tid >> 6;
    const float* w = p.in[I_ADAW] + (size_t)layer * 1024 * 6144 + col;
    float acc[8] = {0, 0, 0, 0, 0, 0, 0, 0};
#pragma unroll 32
    for (int k = kg * 256; k < kg * 256 + 256; ++k) {
      const float wv = w[(size_t)k * 6144];
      const float4 c0 = *(const float4*)&cond[k * 8], c1 = *(const float4*)&cond[k * 8 + 4];
      acc[0] += c0.x * wv; acc[1] += c0.y * wv; acc[2] += c0.z * wv; acc[3] += c0.w * wv;
      acc[4] += c1.x * wv; acc[5] += c1.y * wv; acc[6] += c1.z * wv; acc[7] += c1.w * wv;
    }
#pragma unroll
    for (int b = 0; b < 8; ++b) red[(kg * 8 + b) * 64 + (tid & 63)] = acc[b];
    __syncthreads();
    for (int i = tid; i < 512; i += 256) {
      const int b = i >> 6, cc = i & 63;
      const float s = red[(0 * 8 + b) * 64 + cc] + red[(1 * 8 + b) * 64 + cc] + red[(2 * 8 + b) * 64 + cc] + red[(3 * 8 + b) * 64 + cc];
      const int cg_ = cch * 64 + cc;
      ((float*)(ws + O_MOD))[(layer * 8 + b) * 6144 + cg_] = s + p.in[I_ADAB][layer * 6144 + cg_];
    }
    __syncthreads();
    return;
  }
  item -= PREP_MOD;
  if (item < PREP_ROPE) {
    const int e = item * 256 + tid;
    const int t = e >> 5, i = e & 31;
    const float inv = powf(10000.f, -(float)i / 32.f);
    const float ang = (float)t * inv;
    float* rp = (float*)(ws + O_ROPE);
    rp[e] = cosf(ang);
    rp[65536 + e] = sinf(ang);
    return;
  }
  item -= PREP_ROPE;
  if (item < PREP_MISC) {
    if (item == 3) return;
    if (item < 2) {
      const int j = item, n = tid;
      const float* pos = p.in[I_CPOS] + j * 2048;
      const float* w1 = p.in[I_CW1] + (size_t)j * 2048 * 256 + n;
      float s = 0.f;
      for (int k = 0; k < 2048; ++k) s += pos[k] * w1[(size_t)k * 256];
      ((float*)(ws + O_BIAS1))[j * 256 + n] = s;
    } else {
      int* cnt = (int*)(ws + O_CNT);
      for (int i = tid; i < 2 * 16 * 64; i += 256) cnt[i] = 0;
      uint4* vct = (uint4*)(ws + O_VCT);
      for (int i = tid; i < 8 * 2 * 64 * 128 * 2 / 16; i += 256) vct[i] = make_uint4(0, 0, 0, 0);
      unsigned* barw = (unsigned*)(ws + O_BAR);
      for (int i = tid; i < XCD_BAR_WORDS; i += 256) barw[i] = 0u;
      uint4 z = make_uint4(0, 0, 0, 0);
      uint4* wpad = (uint4*)(ws + O_WEIN + (size_t)2840 * 1024 * 2);
      for (int i = tid; i < (PW0 - 2840) * 1024 * 2 / 16; i += 256) wpad[i] = z;
      for (int j = 0; j < 2; ++j) {
        uint4* cp = (uint4*)(ws + O_WC2 + ((size_t)j * 128 + 64) * 256 * 2);
        for (int i = tid; i < 64 * 256 * 2 / 16; i += 256) cp[i] = z;
      }
    }
    return;
  }
}

template <int MODE, bool ROUTER>
DI void norm_phase(const Params& p, char* smem, const float* xin, float* xout, const float* nw, const float* modl,
                   int sh_off, int sc_off, int g_off, int layer) {
  char* ws = p.ws;
  const int tid = tid_opaque(), lane = tid & 63, wid = tid >> 6;
  bfr* HB = (bfr*)(ws + O_HB);
  const bfr* MO0 = (const bfr*)(ws + O_MOEOUT);
  const bfr* MO1 = MO0 + (size_t)NT * 1024;
  for (int chunk = VB; chunk < NT / 32; chunk += NVB) {
    const int b = (chunk * 32) >> 11;
#pragma unroll 1
    for (int it = 0; it < 4; ++it) {
      float v[2][16];
      float ss[2];
#pragma unroll
      for (int rr = 0; rr < 2; ++rr) {
        const int row = chunk * 32 + (it * 2 + rr) * 4 + wid;
        ss[rr] = 0.f;
#pragma unroll
        for (int i = 0; i < 2; ++i) {
          const int c = (i * 64 + lane) * 8;
          float4 x0, x1;
          if (MODE >= 1) {
            const uint4 xu = *(const uint4*)((const bfr*)xin + (size_t)row * 1024 + c);
            x0 = make_float4(lo2f(xu.x), hi2f(xu.x), lo2f(xu.y), hi2f(xu.y)); x1 = make_float4(lo2f(xu.z), hi2f(xu.z), lo2f(xu.w), hi2f(xu.w));
          } else { x0 = *(const float4*)(xin + (size_t)row * 1024 + c); x1 = *(const float4*)(xin + (size_t)row * 1024 + c + 4); }
          if (MODE >= 1) {
            const float4 g0 = *(const float4*)(modl + b * 6144 + g_off + c), g1 = *(const float4*)(modl + b * 6144 + g_off + c + 4);
            const uint4 m0 = *(const uint4*)(MO0 + (size_t)row * 1024 + c);
            const uint4 m1 = *(const uint4*)(MO1 + (size_t)row * 1024 + c);
            x0.x += g0.x * (lo2f(m0.x) + lo2f(m1.x)); x0.y += g0.y * (hi2f(m0.x) + hi2f(m1.x));
            x0.z += g0.z * (lo2f(m0.y) + lo2f(m1.y)); x0.w += g0.w * (hi2f(m0.y) + hi2f(m1.y));
            x1.x += g1.x * (lo2f(m0.z) + lo2f(m1.z)); x1.y += g1.y * (hi2f(m0.z) + hi2f(m1.z));
            x1.z += g1.z * (lo2f(m0.w) + lo2f(m1.w)); x1.w += g1.w * (hi2f(m0.w) + hi2f(m1.w));
            if (MODE == 1) *(uint4*)((bfr*)xout + (size_t)row * 1024 + c) = make_uint4(pack2(x0.x, x0.y), pack2(x0.z, x0.w), pack2(x1.x, x1.y), pack2(x1.z, x1.w));
          }
          v[rr][i * 8 + 0] = x0.x; v[rr][i * 8 + 1] = x0.y; v[rr][i * 8 + 2] = x0.z; v[rr][i * 8 + 3] = x0.w;
          v[rr][i * 8 + 4] = x1.x; v[rr][i * 8 + 5] = x1.y; v[rr][i * 8 + 6] = x1.z; v[rr][i * 8 + 7] = x1.w;
          ss[rr] += x0.x * x0.x + x0.y * x0.y + x0.z * x0.z + x0.w * x0.w + x1.x * x1.x + x1.y * x1.y + x1.z * x1.z + x1.w * x1.w;
        }
      }
      const float rstd0 = rsqrtf(wave_sum(ss[0]) * (1.f / 1024.f) + 1e-6f);
      const float rstd1 = rsqrtf(wave_sum(ss[1]) * (1.f / 1024.f) + 1e-6f);
#pragma unroll
      for (int i = 0; i < 2; ++i) {
        const int c = (i * 64 + lane) * 8;
        const float4 w0 = *(const float4*)(nw + c), w1 = *(const float4*)(nw + c + 4);
        float wv[8] = {w0.x, w0.y, w0.z, w0.w, w1.x, w1.y, w1.z, w1.w};
        float shv[8] = {0.f, 0.f, 0.f, 0.f, 0.f, 0.f, 0.f, 0.f};
        if (MODE != 2) {
          const float4 sc0 = *(const float4*)(modl + b * 6144 + sc_off + c), sc1 = *(const float4*)(modl + b * 6144 + sc_off + c + 4);
          const float4 sh0 = *(const float4*)(modl + b * 6144 + sh_off + c), sh1 = *(const float4*)(modl + b * 6144 + sh_off + c + 4);
          wv[0] *= 1.f + sc0.x; wv[1] *= 1.f + sc0.y; wv[2] *= 1.f + sc0.z; wv[3] *= 1.f + sc0.w;
          wv[4] *= 1.f + sc1.x; wv[5] *= 1.f + sc1.y; wv[6] *= 1.f + sc1.z; wv[7] *= 1.f + sc1.w;
          shv[0] = sh0.x; shv[1] = sh0.y; shv[2] = sh0.z; shv[3] = sh0.w; shv[4] = sh1.x; shv[5] = sh1.y; shv[6] = sh1.z; shv[7] = sh1.w;
        }
#pragma unroll
        for (int rr = 0; rr < 2; ++rr) {
          const int row = chunk * 32 + (it * 2 + rr) * 4 + wid;
          const float rstd = rr ? rstd1 : rstd0;
          float o[8];
#pragma unroll
          for (int q = 0; q < 8; ++q) o[q] = v[rr][i * 8 + q] * rstd * wv[q] + shv[q];
          if (MODE == 2) {
            *(float4*)(xout + (size_t)row * 1024 + c) = make_float4(o[0], o[1], o[2], o[3]);
            *(float4*)(xout + (size_t)row * 1024 + c + 4) = make_float4(o[4], o[5], o[6], o[7]);
          } else {
            *(uint4*)(HB + (size_t)row * 1024 + c) = make_uint4(pack2(o[0], o[1]), pack2(o[2], o[3]), pack2(o[4], o[5]), pack2(o[6], o[7]));
          }
        }
      }
    }
  }
}

constexpr int NR = 2;
DI void norm_router_phase(const Params& p, char* smem_all, const float* xin, const float* nw, const float* modl, int sh_off, int sc_off, int layer) {
  char* ws = p.ws;
  const int tid = tid_opaque(), lane = tid & 63, wid = tid >> 6;
  bfr* HB = (bfr*)(ws + O_HB);
  float* rwl = (float*)smem_all;
  {
    const float* rwg = p.in[I_RTW];
    for (int idx = threadIdx.x; idx < 16384; idx += 512) {
      const int e3 = idx & 3, ln = (idx >> 2) & 63, eq = (idx >> 8) & 3, iq = idx >> 10;
      const int c = ((iq >> 3) * 64 + ln) * 8 + (iq & 7);
      rwl[idx] = rwg[c * 16 + eq * 4 + e3];
    }
  }
  char* smem = smem_all + 65536 + (threadIdx.x >> 8) * 4096;
  __syncthreads();
  int* lcnt = (int*)smem;
  int* lbase = lcnt + 16;
  int* lexp = lbase + 16;
  int* lrank = lexp + 64;
  for (int chunk = VB; chunk < NT / 32; chunk += NVB) {
    if (tid < 16) lcnt[tid] = 0;
    __syncthreads();
#pragma unroll 1
    for (int it2 = 0; it2 < 8 / NR; ++it2) {
      const int row0 = chunk * 32 + wid * 8 + it2 * NR;
      const int b = row0 >> 11;
      float v[NR][16];
      float ss[NR];
#pragma unroll
      for (int rr = 0; rr < NR; ++rr) {
        ss[rr] = 0.f;
#pragma unroll
        for (int i = 0; i < 2; ++i) {
          const uint4 xu = *(const uint4*)((const bfr*)xin + (size_t)(row0 + rr) * 1024 + (i * 64 + lane) * 8);
          const float4 x0 = make_float4(lo2f(xu.x), hi2f(xu.x), lo2f(xu.y), hi2f(xu.y)), x1 = make_float4(lo2f(xu.z), hi2f(xu.z), lo2f(xu.w), hi2f(xu.w));
          v[rr][i * 8 + 0] = x0.x; v[rr][i * 8 + 1] = x0.y; v[rr][i * 8 + 2] = x0.z; v[rr][i * 8 + 3] = x0.w;
          v[rr][i * 8 + 4] = x1.x; v[rr][i * 8 + 5] = x1.y; v[rr][i * 8 + 6] = x1.z; v[rr][i * 8 + 7] = x1.w;
          ss[rr] += x0.x * x0.x + x0.y * x0.y + x0.z * x0.z + x0.w * x0.w + x1.x * x1.x + x1.y * x1.y + x1.z * x1.z + x1.w * x1.w;
        }
      }
#pragma unroll
      for (int rr = 0; rr < NR; ++rr) ss[rr] = rsqrtf(wave_sum(ss[rr]) * (1.f / 1024.f) + 1e-6f);
#pragma unroll
      for (int i = 0; i < 2; ++i) {
        const int c = (i * 64 + lane) * 8;
        const float4 w0 = *(const float4*)(nw + c), w1 = *(const float4*)(nw + c + 4);
        const float4 sc0 = *(const float4*)(modl + b * 6144 + sc_off + c), sc1 = *(const float4*)(modl + b * 6144 + sc_off + c + 4);
        const float4 sh0 = *(const float4*)(modl + b * 6144 + sh_off + c), sh1 = *(const float4*)(modl + b * 6144 + sh_off + c + 4);
        const float wv[8] = {w0.x * (1.f + sc0.x), w0.y * (1.f + sc0.y), w0.z * (1.f + sc0.z), w0.w * (1.f + sc0.w),
                             w1.x * (1.f + sc1.x), w1.y * (1.f + sc1.y), w1.z * (1.f + sc1.z), w1.w * (1.f + sc1.w)};
        const float shv[8] = {sh0.x, sh0.y, sh0.z, sh0.w, sh1.x, sh1.y, sh1.z, sh1.w};
#pragma unroll
        for (int rr = 0; rr < NR; ++rr) {
#pragma unroll
          for (int q = 0; q < 8; ++q) v[rr][i * 8 + q] = v[rr][i * 8 + q] * ss[rr] * wv[q] + shv[q];
          *(uint4*)(HB + (size_t)(row0 + rr) * 1024 + c) = make_uint4(pack2(v[rr][i * 8 + 0], v[rr][i * 8 + 1]), pack2(v[rr][i * 8 + 2], v[rr][i * 8 + 3]),
                                                                          pack2(v[rr][i * 8 + 4], v[rr][i * 8 + 5]), pack2(v[rr][i * 8 + 6], v[rr][i * 8 + 7]));
        }
      }
      float* sgl = (float*)(smem + 1024) + wid * 64;
#pragma unroll 1
      for (int eh = 0; eh < 2; ++eh) {
        float lg[NR][8];
#pragma unroll
        for (int rr = 0; rr < NR; ++rr)
#pragma unroll
          for (int e = 0; e < 8; ++e) lg[rr][e] = 0.f;
#pragma unroll
        for (int i = 0; i < 4; ++i) {
#pragma unroll
          for (int q = 0; q < 4; ++q) {
            const int iq = (i >> 1) * 8 + (i & 1) * 4 + q;
            const float4 w0 = *(const float4*)(rwl + ((iq * 4 + eh * 2) * 64 + lane) * 4), w1 = *(const float4*)(rwl + ((iq * 4 + eh * 2 + 1) * 64 + lane) * 4);
#pragma unroll
            for (int rr = 0; rr < NR; ++rr) {
              const float h = v[rr][i * 4 + q];
              lg[rr][0] += h * w0.x; lg[rr][1] += h * w0.y; lg[rr][2] += h * w0.z; lg[rr][3] += h * w0.w;
              lg[rr][4] += h * w1.x; lg[rr][5] += h * w1.y; lg[rr][6] += h * w1.z; lg[rr][7] += h * w1.w;
            }
          }
          __builtin_amdgcn_sched_barrier(0);
        }
#pragma unroll
        for (int rr = 0; rr < NR; ++rr)
#pragma unroll
          for (int e = 0; e < 8; ++e) {
            const float sv = 1.f / (1.f + __expf(-wave_sum(lg[rr][e])));
            if (lane == 0) sgl[rr * 16 + eh * 8 + e] = sv;
          }
      }
      __builtin_amdgcn_fence(__ATOMIC_RELEASE, "wavefront");
      __builtin_amdgcn_wave_barrier();
#pragma unroll
      for (int rr = 0; rr < NR; ++rr) {
        float bi[16], sgv[16];
#pragma unroll
        for (int e = 0; e < 16; ++e) { sgv[e] = sgl[rr * 16 + e]; bi[e] = sgv[e] + p.in[I_RTB][e]; }
        int tg = 0; float best = -3.0e38f;
#pragma unroll
        for (int g = 0; g < 4; ++g) {
          float m1 = -3.0e38f, m2 = -3.0e38f;
#pragma unroll
          for (int j = 0; j < 4; ++j) {
            const float x = bi[g * 4 + j];
            if (x > m1) { m2 = m1; m1 = x; } else if (x > m2) { m2 = x; }
          }
          const float gs = m1 + m2;
          if (gs > best) { best = gs; tg = g; }
        }
        int i0 = -1, i1 = -1; float b0 = -3.0e38f, b1 = -3.0e38f, s0 = 0.f, s1 = 0.f;
#pragma unroll
        for (int e = 0; e < 16; ++e) {
          if ((e >> 2) == tg) {
            const float x = bi[e];
            if (x > b0) { b1 = b0; i1 = i0; s1 = s0; b0 = x; i0 = e; s0 = sgv[e]; }
            else if (x > b1) { b1 = x; i1 = e; s1 = sgv[e]; }
          }
        }
        if (lane == 0) {
          const int row = row0 + rr;
          const float inv = 1.f / (s0 + s1);
          float* topw = (float*)(ws + O_TOPW);
          topw[row * 2 + 0] = s0 * inv;
          topw[row * 2 + 1] = s1 * inv;
          const int a = (wid * 8 + it2 * NR + rr) * 2;
          lexp[a] = i0; lrank[a] = atomicAdd(&lcnt[i0], 1);
          lexp[a + 1] = i1; lrank[a + 1] = atomicAdd(&lcnt[i1], 1);
        }
      }
    }
    __syncthreads();
    int* cnt = (int*)(ws + O_CNT) + layer * 16 * 64;
    if (tid < 16) lbase[tid] = atomicAdd(&cnt[tid * 64], lcnt[tid]);
    __syncthreads();
    if (tid < 64) {
      const int e = lexp[tid];
      const int slot = lbase[e] + lrank[tid];
      ((int*)(ws + O_LIST))[(size_t)e * NT + slot] = (chunk * 32 + (tid >> 1)) * 2 + (tid & 1);
    }
    __syncthreads();
  }
}

template <int NS>
DI void gemm_proj_phase(const Params& p, char* smem_all, const bfr* Wt, int ncols_pad, bfr* out) {
  const bfr* HB = (const bfr*)(p.ws + O_HB);
  constexpr int TN = NS * 64;
  const int n_nt = ncols_pad / TN;
  const int ntiles = (NT / 256) * n_nt;
  for (int tile = xcd_first_tile(); tile < ntiles; tile += gridDim.x) {
    const int mt = tile / n_nt, nt = tile % n_nt;
    Rows256 A{HB + (size_t)mt * 256 * 1024, 1024, 255};
    Rows256 B{Wt + (size_t)nt * TN * 1024, 1024, TN - 1};
    gemm_tile_256<NS>(smem_all, 32, A, B, [&](f32x4(&acc)[8][NS], int wr, int wc, int fr, int fq) {
#pragma unroll
      for (int m = 0; m < 8; ++m) {
        const int row = mt * 256 + wr * 128 + m * 16 + fr;
#pragma unroll
        for (int n = 0; n < NS; ++n) {
          const int col = nt * TN + wc * (NS * 16) + n * 16 + fq * 4;
          *(uint2*)(out + (size_t)row * ncols_pad + col) = make_uint2(pack2(acc[m][n][0], acc[m][n][1]), pack2(acc[m][n][2], acc[m][n][3]));
        }
      }
    });
  }
}

template <bool XIN_BF>
DI void gemm_out_phase(const Params& p, char* smem_all, const bfr* Wt, const float* xin, float* xout_, const float* gate  ) {
  bfr* xout = (bfr*)xout_;
  const bfr* MIX = (const bfr*)(p.ws + O_MIX);
  const int ntiles = (NT / 256) * 4;
  for (int tile = xcd_first_tile(); tile < ntiles; tile += gridDim.x) {
    const int mt = tile / 4, nt = tile % 4;
    Rows256 A{MIX + (size_t)mt * 256 * 1024, 1024, 255};
    Rows256 B{Wt + (size_t)nt * 256 * 1024, 1024, 255};
    const int b = (mt * 256) >> 11;
    gemm_tile_256<4>(smem_all, 32, A, B, [&](f32x4(&acc)[8][4], int wr, int wc, int fr, int fq) {
#pragma unroll
      for (int n = 0; n < 4; ++n) {
        const int col = nt * 256 + wc * 64 + n * 16 + fq * 4;
        const float4 g = *(const float4*)(gate + b * 6144 + col);
#pragma unroll
        for (int m = 0; m < 8; ++m) {
          const int row = mt * 256 + wr * 128 + m * 16 + fr;
          float4 xi;
          if (XIN_BF) { const uint2 xu = *(const uint2*)((const bfr*)xin + (size_t)row * 1024 + col); xi = make_float4(lo2f(xu.x), hi2f(xu.x), lo2f(xu.y), hi2f(xu.y)); }
          else xi = *(const float4*)(xin + (size_t)row * 1024 + col);
          float4 o;
          o.x = xi.x + g.x * acc[m][n][0]; o.y = xi.y + g.y * acc[m][n][1]; o.z = xi.z + g.z * acc[m][n][2]; o.w = xi.w + g.w * acc[m][n][3];
          *(uint2*)(xout + (size_t)row * 1024 + col) = make_uint2(pack2(o.x, o.y), pack2(o.z, o.w));
        }
      }
    });
  }
}

struct RowsCmp {
  const bfr* proj; int colbase; int mt;
  const bfr* rp[2];
  DI void init(int lr) {
#pragma unroll
    for (int i = 0; i < 2; ++i) {
      int rr = mt * 128 + lr + 64 * i; if (rr > 2031) rr = 2031;
      const int h = rr & 1, bn = rr >> 1, b = bn / 127, nc = bn % 127;
      rp[i] = proj + (size_t)(b * SEQ + nc * 16) * PW0 + colbase + h * 64;
    }
  }
  DI uint4 load(int sel, int k) const { return *(const uint4*)(rp[sel] + (k >> 6) * PW0 + (k & 63)); }
  DI const bfr* ptr(int sel, int k) const { return rp[sel] + (k >> 6) * PW0 + (k & 63); }
};

DI float gelu_tanh(float x) {
  const float u = 0.7978845608028654f * (x + 0.044715f * x * x * x);
  return 0.5f * x * (1.f + tanhf(u));
}

DI void cmp2_tile(const Params& p, char* smem, int j, int mt, bool do_store) {
  char* ws = p.ws;
  RowsContig A{(const bfr*)(ws + O_CH) + ((size_t)j * 2048 + mt * 128) * 256, 256, 127};
  RowsContig B{(const bfr*)(ws + O_WC2) + (size_t)j * 128 * 256, 256, 127};
  bfr* KC = (bfr*)(ws + O_KCVC) + (size_t)j * 2048 * 64;
  gemm_tile(smem, 8, A, B, [&](f32x4(&acc)[4][4], int wr, int wc, int fr, int fq) {
    if (wc == 0 && do_store) {
#pragma unroll
      for (int m = 0; m < 4; ++m)
#pragma unroll
        for (int n = 0; n < 4; ++n)
#pragma unroll
          for (int jj = 0; jj < 4; ++jj) {
            const int row = mt * 128 + wr * 64 + m * 16 + fq * 4 + jj, col = n * 16 + fr;
            const bfr hv = f2bf(acc[m][n][jj]);
            KC[(size_t)row * 64 + col] = hv;
            if (j == 1 && row < 2032) {
              const int hk = row & 1, bn = row >> 1, bb = bn / 127, cc = bn % 127;
              ((bfr*)(ws + O_VCT))[((size_t)((bb * 2 + hk) * 64 + col)) * 128 + cc] = hv;
            }
          }
    }
  });
}

DI void post0_phase(const Params& p, char* smem) {
  char* ws = p.ws;
  const bfr* PROJ = (const bfr*)(ws + O_PROJ);
  const int tid = tid_opaque();
  const bool split = NVB > 128;
  const int ev0 = split ? VB - 64 : VB, evs = split ? NVB - 64 : NVB;
  for (int tile = VB; tile < 64; tile += NVB) {
    const int j = tile >> 5, mt = (tile >> 1) & 15, nt = tile & 1;
    RowsCmp A{PROJ, j ? C_VC : C_KC, mt};
    RowsContig B{(const bfr*)(ws + O_WC1) + ((size_t)j * 256 + nt * 128) * 2048, 2048, 127};
    bfr* CH = (bfr*)(ws + O_CH) + (size_t)j * 2048 * 256;
    const float* bias = (const float*)(ws + O_BIAS1) + j * 256;
    gemm_tile_g(smem, 64, A, B, [&](f32x4(&acc)[4][4], int wr, int wc, int fr, int fq) {
#pragma unroll
      for (int m = 0; m < 4; ++m) {
        const int row = mt * 128 + wr * 64 + m * 16 + fr;
#pragma unroll
        for (int n = 0; n < 4; ++n) {
          const int col = nt * 128 + wc * 64 + n * 16 + fq * 4;
          const float4 bb = *(const float4*)(bias + col);
          *(uint2*)(CH + (size_t)row * 256 + col) = make_uint2(pack2(gelu_tanh(acc[m][n][0] + bb.x), gelu_tanh(acc[m][n][1] + bb.y)),
                                                               pack2(gelu_tanh(acc[m][n][2] + bb.z), gelu_tanh(acc[m][n][3] + bb.w)));
        }
      }
    });
    __threadfence();
    __syncthreads();
    cmp2_tile(p, smem, j, mt, nt == 0);
  }
  {
    bfr(*tt)[66] = (bfr(*)[66])smem;
    for (int item = ev0; item < 1024 && item >= 0; item += evs) {
      const int tl = item & 31, hk = (item >> 5) & 1, which = (item >> 6) & 1, b = item >> 7;
      const bfr* src = PROJ + (size_t)(b * SEQ + tl * 64) * PW0 + (which ? C_VW : C_VS) + hk * 64;
      bfr* dst = (bfr*)(ws + (which ? O_VWT : O_VST)) + (size_t)((b * 2 + hk) * 64) * SEQ + tl * 64;
      for (int e = tid; e < 64 * 32; e += 256) {
        const int row = e >> 5, c2 = (e & 31) * 2;
        const unsigned u = *(const unsigned*)(src + (size_t)row * PW0 + c2);
        tt[row][c2] = (bfr)(u & 0xffffu); tt[row][c2 + 1] = (bfr)(u >> 16);
      }
      __syncthreads();
      for (int e = tid; e < 64 * 32; e += 256) {
        const int d = e >> 5, t2 = (e & 31) * 2;
        const unsigned u = (unsigned)tt[t2][d] | ((unsigned)tt[t2 + 1][d] << 16);
        *(unsigned*)(dst + (size_t)d * SEQ + t2) = u;
      }
      __syncthreads();
    }
  }
  const float* ropec = (const float*)(ws + O_ROPE);
  const float* ropes = ropec + 65536;
  bfr* QR = (bfr*)(ws + O_QR);
  bfr* KSR = (bfr*)(ws + O_KSR);
  bfr* KWR = (bfr*)(ws + O_KWR);
  bfr* MIX = (bfr*)(ws + O_MIX);
  const float* cw = p.in[I_CONVW];
  float cwr[24];
  {
    const int ch = (tid & 63) * 8;
#pragma unroll
    for (int i = 0; i < 8; ++i) { cwr[i] = cw[2 * 512 + ch + i]; cwr[8 + i] = cw[1 * 512 + ch + i]; cwr[16 + i] = cw[0 * 512 + ch + i]; }
  }
  for (int item = ev0; item < NT / 8 && item >= 0; item += evs) {
    for (int e = tid; e < 8 * 48; e += 256) {
      const int tt = e / 48, u = e % 48;
      const int tok = item * 8 + tt, t = tok & (SEQ - 1);
      const int hh = u >> 2, i0 = (u & 3) * 8;
      const bfr* src; bfr* dst;
      if (hh < 8) { src = PROJ + (size_t)tok * PW0 + C_Q + hh * 64; dst = QR + (size_t)tok * 512 + hh * 64; }
      else if (hh < 10) { src = PROJ + (size_t)tok * PW0 + C_KS + (hh - 8) * 64; dst = KSR + (size_t)tok * 128 + (hh - 8) * 64; }
      else { src = PROJ + (size_t)tok * PW0 + C_KW + (hh - 10) * 64; dst = KWR + (size_t)tok * 128 + (hh - 10) * 64; }
      const uint4 x1 = *(const uint4*)(src + i0), x2 = *(const uint4*)(src + 32 + i0);
      const float4 c0 = *(const float4*)(ropec + t * 32 + i0), c1 = *(const float4*)(ropec + t * 32 + i0 + 4);
      const float4 s0 = *(const float4*)(ropes + t * 32 + i0), s1 = *(const float4*)(ropes + t * 32 + i0 + 4);
      const float a[8] = {lo2f(x1.x), hi2f(x1.x), lo2f(x1.y), hi2f(x1.y), lo2f(x1.z), hi2f(x1.z), lo2f(x1.w), hi2f(x1.w)};
      const float bq[8] = {lo2f(x2.x), hi2f(x2.x), lo2f(x2.y), hi2f(x2.y), lo2f(x2.z), hi2f(x2.z), lo2f(x2.w), hi2f(x2.w)};
      const float cc[8] = {c0.x, c0.y, c0.z, c0.w, c1.x, c1.y, c1.z, c1.w};
      const float ss[8] = {s0.x, s0.y, s0.z, s0.w, s1.x, s1.y, s1.z, s1.w};
      float o1[8], o2[8];
#pragma unroll
      for (int i = 0; i < 8; ++i) { o1[i] = a[i] * cc[i] - bq[i] * ss[i]; o2[i] = bq[i] * cc[i] + a[i] * ss[i]; }
      *(uint4*)(dst + i0) = make_uint4(pack2(o1[0], o1[1]), pack2(o1[2], o1[3]), pack2(o1[4], o1[5]), pack2(o1[6], o1[7]));
      *(uint4*)(dst + 32 + i0) = make_uint4(pack2(o2[0], o2[1]), pack2(o2[2], o2[3]), pack2(o2[4], o2[5]), pack2(o2[6], o2[7]));
    }
    for (int e = tid; e < 8 * 64; e += 256) {
      const int tt = e >> 6, ch = (e & 63) * 8;
      const int tok = item * 8 + tt, t = tok & (SEQ - 1);
      const bfr* pr = PROJ + (size_t)tok * PW0;
      float u0[8], u1[8], u2[8], bgv[8];
      {
        const uint4 cg = *(const uint4*)(pr + C_CG + ch), xb = *(const uint4*)(pr + C_XB + ch), bg = *(const uint4*)(pr + C_BG + ch);
        u0[0] = lo2f(cg.x) * lo2f(xb.x); u0[1] = hi2f(cg.x) * hi2f(xb.x); u0[2] = lo2f(cg.y) * lo2f(xb.y); u0[3] = hi2f(cg.y) * hi2f(xb.y);
        u0[4] = lo2f(cg.z) * lo2f(xb.z); u0[5] = hi2f(cg.z) * hi2f(xb.z); u0[6] = lo2f(cg.w) * lo2f(xb.w); u0[7] = hi2f(cg.w) * hi2f(xb.w);
        bgv[0] = lo2f(bg.x); bgv[1] = hi2f(bg.x); bgv[2] = lo2f(bg.y); bgv[3] = hi2f(bg.y);
        bgv[4] = lo2f(bg.z); bgv[5] = hi2f(bg.z); bgv[6] = lo2f(bg.w); bgv[7] = hi2f(bg.w);
      }
#pragma unroll
      for (int i = 0; i < 8; ++i) { u1[i] = 0.f; u2[i] = 0.f; }
      if (t >= 1) {
        const uint4 cg = *(const uint4*)(pr - PW0 + C_CG + ch), xb = *(const uint4*)(pr - PW0 + C_XB + ch);
        u1[0] = lo2f(cg.x) * lo2f(xb.x); u1[1] = hi2f(cg.x) * hi2f(xb.x); u1[2] = lo2f(cg.y) * lo2f(xb.y); u1[3] = hi2f(cg.y) * hi2f(xb.y);
        u1[4] = lo2f(cg.z) * lo2f(xb.z); u1[5] = hi2f(cg.z) * hi2f(xb.z); u1[6] = lo2f(cg.w) * lo2f(xb.w); u1[7] = hi2f(cg.w) * hi2f(xb.w);
      }
      if (t >= 2) {
        const uint4 cg = *(const uint4*)(pr - 2 * PW0 + C_CG + ch), xb = *(const uint4*)(pr - 2 * PW0 + C_XB + ch);
        u2[0] = lo2f(cg.x) * lo2f(xb.x); u2[1] = hi2f(cg.x) * hi2f(xb.x); u2[2] = lo2f(cg.y) * lo2f(xb.y); u2[3] = hi2f(cg.y) * hi2f(xb.y);
        u2[4] = lo2f(cg.z) * lo2f(xb.z); u2[5] = hi2f(cg.z) * hi2f(xb.z); u2[6] = lo2f(cg.w) * lo2f(xb.w); u2[7] = hi2f(cg.w) * hi2f(xb.w);
      }
      float y[8];
#pragma unroll
      for (int i = 0; i < 8; ++i) y[i] = bgv[i] * (cwr[i] * u0[i] + cwr[8 + i] * u1[i] + cwr[16 + i] * u2[i]);
      *(uint4*)(MIX + (size_t)tok * 1024 + 512 + ch) = make_uint4(pack2(y[0], y[1]), pack2(y[2], y[3]), pack2(y[4], y[5]), pack2(y[6], y[7]));
    }
  }
}


DI void cmp_attn_phase(const Params& p, char* smem) {
  char* ws = p.ws;
  const bfr* PROJ = (const bfr*)(ws + O_PROJ);
  const bfr* KC = (const bfr*)(ws + O_KCVC);
  const bfr* VC = KC + 2048 * 64;
  bfr* OCMP = (bfr*)(ws + O_OCMP);
  unsigned* SEL = (unsigned*)(ws + O_SEL);
  const int tid = tid_opaque();
  for (int item = VB; item < NT / 32; item += NVB) {
    const int tok = item * 32 + (tid >> 3), head = tid & 7, hkv = head >> 2;
    const int b = tok >> 11, t = tok & (SEQ - 1);
    const int nv = t >= 31 ? ((t - 31) >> 4) + 1 : 0;
    unsigned q[32];
    {
      const uint4* qp = (const uint4*)(PROJ + (size_t)tok * PW0 + C_Q + head * 64);
#pragma unroll
      for (int i = 0; i < 8; ++i) { const uint4 u = qp[i]; q[i * 4] = u.x; q[i * 4 + 1] = u.y; q[i * 4 + 2] = u.z; q[i * 4 + 3] = u.w; }
    }
    const bfr* kb = KC + ((size_t)(b * 127) * 2 + hkv) * 64;
    const bfr* vb = VC + ((size_t)(b * 127) * 2 + hkv) * 64;
    auto dotk = [&](int c) {
      const uint4* kp = (const uint4*)(kb + (size_t)c * 128);
      float a = 0.f;
#pragma unroll
      for (int i = 0; i < 8; ++i) {
        const uint4 u = kp[i];
        a = dot2(q[i * 4], u.x, a); a = dot2(q[i * 4 + 1], u.y, a); a = dot2(q[i * 4 + 2], u.z, a); a = dot2(q[i * 4 + 3], u.w, a);
      }
      return a * 0.125f;
    };
    float mx = -1e30f;
    for (int c = 0; c < nv; ++c) mx = fmaxf(mx, dotk(c));
    float o[64];
#pragma unroll
    for (int i = 0; i < 64; ++i) o[i] = 0.f;
    float l = 0.f;
    for (int c = 0; c < nv; ++c) {
      const float pe = __expf(dotk(c) - mx);
      l += pe;
      const uint4* vp = (const uint4*)(vb + (size_t)c * 128);
#pragma unroll
      for (int i = 0; i < 8; ++i) {
        const uint4 u = vp[i];
        o[i * 8 + 0] += pe * lo2f(u.x); o[i * 8 + 1] += pe * hi2f(u.x);
        o[i * 8 + 2] += pe * lo2f(u.y); o[i * 8 + 3] += pe * hi2f(u.y);
        o[i * 8 + 4] += pe * lo2f(u.z); o[i * 8 + 5] += pe * hi2f(u.z);
        o[i * 8 + 6] += pe * lo2f(u.w); o[i * 8 + 7] += pe * hi2f(u.w);
      }
    }
    const float invl = nv > 0 ? 1.f / l : 0.f;
    {
      const float gl = bf2f(PROJ[(size_t)tok * PW0 + C_GL + head * 3 + 0]);
      const float g0 = sigmoidf_(gl) * invl;
      uint4* op = (uint4*)(OCMP + (size_t)tok * 512 + head * 64);
#pragma unroll
      for (int i = 0; i < 8; ++i) {
        uint4 u;
        u.x = pack2(o[i * 8 + 0] * g0, o[i * 8 + 1] * g0); u.y = pack2(o[i * 8 + 2] * g0, o[i * 8 + 3] * g0);
        u.z = pack2(o[i * 8 + 4] * g0, o[i * 8 + 5] * g0); u.w = pack2(o[i * 8 + 6] * g0, o[i * 8 + 7] * g0);
        op[i] = u;
      }
    }
    const int cur = t >> 6;
    float tv0 = -1.f, tv1 = -1.f, tv2 = -1.f, tv3 = -1.f, tv4 = -1.f;
    int ti0 = -1, ti1 = -1, ti2 = -1, ti3 = -1, ti4 = -1;
    float part = 0.f;
    int curmax = cur;
#pragma unroll
    for (int o2 = 32; o2 > 0; o2 >>= 1) curmax = max(curmax, __shfl_xor(curmax, o2));
#pragma unroll 1
    for (int j = 0; j <= curmax + 1 && j <= 32; ++j) {
      float e[4];
#pragma unroll
      for (int oo = 0; oo < 4; ++oo) {
        const int c = j * 4 + oo;
        float pe = 0.f;
        if (c < nv) pe = __expf(dotk(c) - mx) * invl;
        pe += __shfl_xor(pe, 1);
        pe += __shfl_xor(pe, 2);
        e[oo] = pe;
      }
      if (j >= 1) {
        const float val = part + e[0];
        const int jb = j - 1;
        if (jb >= 1 && jb <= cur - 2) {
          if (val > tv4) {
            tv4 = val; ti4 = jb;
            if (tv4 > tv3) { float tf = tv3; tv3 = tv4; tv4 = tf; int tii = ti3; ti3 = ti4; ti4 = tii; }
            if (tv3 > tv2) { float tf = tv2; tv2 = tv3; tv3 = tf; int tii = ti2; ti2 = ti3; ti3 = tii; }
            if (tv2 > tv1) { float tf = tv1; tv1 = tv2; tv2 = tf; int tii = ti1; ti1 = ti2; ti2 = tii; }
            if (tv1 > tv0) { float tf = tv0; tv0 = tv1; tv1 = tf; int tii = ti0; ti0 = ti1; ti1 = tii; }
          }
        }
      }
      part = e[0] + 2.f * (e[1] + e[2] + e[3]);
    }
    unsigned mask = 1u | (1u << cur);
    if (cur >= 1) mask |= 1u << (cur - 1);
    if (ti0 >= 0) mask |= 1u << ti0;
    if (ti1 >= 0) mask |= 1u << ti1;
    if (ti2 >= 0) mask |= 1u << ti2;
    if (ti3 >= 0) mask |= 1u << ti3;
    if (ti4 >= 0) mask |= 1u << ti4;
    if ((head & 3) == 0) SEL[tok * 2 + hkv] = mask;
  }
}

DI void slcwin_phase(const Params& p, char* smem) {
  char* ws = p.ws;
  const bfr* PROJ = (const bfr*)(ws + O_PROJ);
  const bfr* QR = (const bfr*)(ws + O_QR);
  const bfr* KSR = (const bfr*)(ws + O_KSR);
  const bfr* KWR = (const bfr*)(ws + O_KWR);
  const bfr* OCMP = (const bfr*)(ws + O_OCMP);
  const unsigned* SEL = (const unsigned*)(ws + O_SEL);
  bfr* MIX = (bfr*)(ws + O_MIX);
  const int tid = tid_opaque(), lane = tid & 63, wid = tid >> 6;
  for (int item = VB; item < 512; item += NVB) {
    const int tile = 31 - (item >> 4), bh = item & 15, b = bh >> 1, hkv = bh & 1;
    const int t = tile * 64 + lane, tok = b * SEQ + t, head = hkv * 4 + wid;
    unsigned q[32];
    {
      const uint4* qp = (const uint4*)(QR + (size_t)tok * 512 + head * 64);
#pragma unroll
      for (int i = 0; i < 8; ++i) { const uint4 u = qp[i]; q[i * 4] = u.x; q[i * 4 + 1] = u.y; q[i * 4 + 2] = u.z; q[i * 4 + 3] = u.w; }
    }
    const unsigned sel = SEL[tok * 2 + hkv];
#pragma unroll 1
    for (int pass = 0; pass < 2; ++pass) {
      const bfr* Kb = (pass == 0 ? KSR : KWR) + (size_t)b * SEQ * 128 + hkv * 64;
      const bfr* Vb = PROJ + (size_t)b * SEQ * PW0 + (pass == 0 ? C_VS : C_VW) + hkv * 64;
      float o[64];
#pragma unroll
      for (int i = 0; i < 64; ++i) o[i] = 0.f;
      float m = -1e30f, l = 0.f;
      const int jlo = pass == 0 ? 0 : (tile >= 8 ? tile - 8 : 0);
#pragma unroll 1
      for (int j = jlo; j <= tile; ++j) {
        const bool lane_ok = pass == 0 ? ((sel >> j) & 1u) != 0 : true;
        if (pass == 0 && !__any(lane_ok)) continue;
#pragma unroll 1
        for (int kb = 0; kb < 64; kb += 4) {
          float s[4];
#pragma unroll
          for (int kk = 0; kk < 4; ++kk) {
            const int key = j * 64 + kb + kk;
            const uint4* kp = (const uint4*)(Kb + (size_t)key * 128);
            float a = 0.f;
#pragma unroll
            for (int i = 0; i < 8; ++i) {
              const uint4 u = kp[i];
              a = dot2(q[i * 4], u.x, a); a = dot2(q[i * 4 + 1], u.y, a); a = dot2(q[i * 4 + 2], u.z, a); a = dot2(q[i * 4 + 3], u.w, a);
            }
            bool ok = lane_ok && key <= t;
            if (pass == 1) ok = ok && (t - key < 512);
            s[kk] = ok ? a * 0.125f : -1e30f;
          }
          const float cm = fmaxf(fmaxf(s[0], s[1]), fmaxf(s[2], s[3]));
          const float mn = fmaxf(m, cm);
          const float corr = __expf(m - mn);
          m = mn;
          float pe[4];
#pragma unroll
          for (int kk = 0; kk < 4; ++kk) pe[kk] = s[kk] > -1e29f ? __expf(s[kk] - mn) : 0.f;
          l = l * corr + (pe[0] + pe[1] + pe[2] + pe[3]);
#pragma unroll
          for (int i = 0; i < 64; ++i) o[i] *= corr;
#pragma unroll
          for (int kk = 0; kk < 4; ++kk) {
            const int key = j * 64 + kb + kk;
            const uint4* vp = (const uint4*)(Vb + (size_t)key * PW0);
#pragma unroll
            for (int i = 0; i < 8; ++i) {
              const uint4 u = vp[i];
              o[i * 8 + 0] += pe[kk] * lo2f(u.x); o[i * 8 + 1] += pe[kk] * hi2f(u.x);
              o[i * 8 + 2] += pe[kk] * lo2f(u.y); o[i * 8 + 3] += pe[kk] * hi2f(u.y);
              o[i * 8 + 4] += pe[kk] * lo2f(u.z); o[i * 8 + 5] += pe[kk] * hi2f(u.z);
              o[i * 8 + 6] += pe[kk] * lo2f(u.w); o[i * 8 + 7] += pe[kk] * hi2f(u.w);
            }
          }
        }
      }
      const float gate = sigmoidf_(bf2f(PROJ[(size_t)tok * PW0 + C_GL + head * 3 + 1 + pass]));
      const float gsc = gate * (l > 0.f ? 1.f / l : 0.f);
      uint4* op = (uint4*)(MIX + (size_t)tok * 1024 + head * 64);
      const uint4* cp = pass == 0 ? (const uint4*)(OCMP + (size_t)tok * 512 + head * 64) : (const uint4*)op;
#pragma unroll
      for (int i = 0; i < 8; ++i) {
        const uint4 c = cp[i];
        uint4 u;
        u.x = pack2(o[i * 8 + 0] * gsc + lo2f(c.x), o[i * 8 + 1] * gsc + hi2f(c.x));
        u.y = pack2(o[i * 8 + 2] * gsc + lo2f(c.y), o[i * 8 + 3] * gsc + hi2f(c.y));
        u.z = pack2(o[i * 8 + 4] * gsc + lo2f(c.z), o[i * 8 + 5] * gsc + hi2f(c.z));
        u.w = pack2(o[i * 8 + 6] * gsc + lo2f(c.w), o[i * 8 + 7] * gsc + hi2f(c.w));
        op[i] = u;
      }
    }
  }
}

using f32x16 = __attribute__((ext_vector_type(16))) float;
#define MFMA32(a, b, c) __builtin_amdgcn_mfma_f32_32x32x16_bf16((a), (b), (c), 0, 0, 0)
struct AttnLds { bfr k[2][64][72]; bfr vt[2][64][68]; };
static_assert(sizeof(AttnLds) <= 49152, "attn lds");
DI int crow16(int i, int h2) { return (i & 3) + 8 * (i >> 2) + 4 * h2; }

DI void attn_sw_phase(const Params& p, char* smem) {
  char* ws = p.ws;
  AttnLds& L = *(AttnLds*)smem;
  const bfr* PROJ = (const bfr*)(ws + O_PROJ);
  const bfr* QR = (const bfr*)(ws + O_QR);
  const bfr* OCMP = (const bfr*)(ws + O_OCMP);
  const unsigned* SEL = (const unsigned*)(ws + O_SEL);
  bfr* MIX = (bfr*)(ws + O_MIX);
  const int tid = tid_opaque(), lane = tid & 63, wid = tid >> 6, r = lane & 31, h2 = lane >> 5;
  const float CS = 0.125f * 1.4426950408889634f;
  const int lrow = tid >> 3, lc8 = (tid & 7) * 8;
  for (int item = VB; item < 1024; item += NVB) {
    const int qt = item < 512 ? 63 - (item >> 4) : ((item - 512) >> 4);
    const int bh = item & 15, b = bh >> 1, hkv = bh & 1;
    const int cur = qt >> 1;
    const int tokl = qt * 32 + wid * 8 + (r >> 2), g = r & 3, head = hkv * 4 + g, tok = b * SEQ + tokl;
    bf16x8 qf[4];
#pragma unroll
    for (int s = 0; s < 4; ++s) qf[s] = *(const bf16x8*)(QR + (size_t)tok * 512 + head * 64 + 16 * s + 8 * h2);
    const unsigned sel = SEL[tok * 2 + hkv];
    const int nslc = cur + 1, wlo = cur > 8 ? cur - 8 : 0, T = nslc + (cur - wlo + 1);
    const bfr* KS = (const bfr*)(ws + O_KSR) + (size_t)b * SEQ * 128 + hkv * 64;
    const bfr* KW = (const bfr*)(ws + O_KWR) + (size_t)b * SEQ * 128 + hkv * 64;
    const bfr* VS = (const bfr*)(ws + O_VST) + (size_t)((b * 2 + hkv) * 64) * SEQ;
    const bfr* VW = (const bfr*)(ws + O_VWT) + (size_t)((b * 2 + hkv) * 64) * SEQ;
    uint4 rk0, rk1, rv0, rv1;
    auto gload = [&](int tt) {
      const int pass = tt >= nslc, j = pass ? wlo + tt - nslc : tt;
      const bfr* kb = (pass ? KW : KS) + (size_t)(j * 64) * 128 + lc8;
      const bfr* vb = (pass ? VW : VS) + j * 64 + lc8;
      rk0 = *(const uint4*)(kb + (size_t)lrow * 128); rk1 = *(const uint4*)(kb + (size_t)(lrow + 32) * 128);
      rv0 = *(const uint4*)(vb + (size_t)lrow * SEQ); rv1 = *(const uint4*)(vb + (size_t)(lrow + 32) * SEQ);
    };
    auto lstore = [&](int buf) {
      *(uint4*)&L.k[buf][lrow][lc8] = rk0; *(uint4*)&L.k[buf][lrow + 32][lc8] = rk1;
      *(uint2*)&L.vt[buf][lrow][lc8] = make_uint2(rv0.x, rv0.y); *(uint2*)&L.vt[buf][lrow][lc8 + 4] = make_uint2(rv0.z, rv0.w);
      *(uint2*)&L.vt[buf][lrow + 32][lc8] = make_uint2(rv1.x, rv1.y); *(uint2*)&L.vt[buf][lrow + 32][lc8 + 4] = make_uint2(rv1.z, rv1.w);
    };
    gload(0); lstore(0);
    __syncthreads();
    float m = -1e30f, l = 0.f;
    f32x16 o0, o1;
#pragma unroll
    for (int i = 0; i < 16; ++i) { o0[i] = 0.f; o1[i] = 0.f; }
#pragma unroll 1
    for (int tt = 0; tt < T; ++tt) {
      const int buf = tt & 1;
      if (tt + 1 < T) gload(tt + 1);
      const int pass = tt >= nslc, j = pass ? wlo + tt - nslc : tt;
      const bool rowok = pass ? true : ((sel >> j) & 1u) != 0u;
      if (__any(rowok)) {
        f32x16 s0, s1;
#pragma unroll
        for (int i = 0; i < 16; ++i) { s0[i] = 0.f; s1[i] = 0.f; }
#pragma unroll
        for (int s = 0; s < 4; ++s) {
          const bf16x8 k0 = *(const bf16x8*)&L.k[buf][r][16 * s + 8 * h2];
          const bf16x8 k1 = *(const bf16x8*)&L.k[buf][32 + r][16 * s + 8 * h2];
          s0 = MFMA32(k0, qf[s], s0);
          s1 = MFMA32(k1, qf[s], s1);
        }
        if (!rowok) {
#pragma unroll
          for (int i = 0; i < 16; ++i) { s0[i] = -1e30f; s1[i] = -1e30f; }
        }
        if (j == cur) {
          const int lim = tokl - j * 64;
#pragma unroll
          for (int i = 0; i < 16; ++i) {
            if (crow16(i, h2) > lim) s0[i] = -1e30f;
            if (32 + crow16(i, h2) > lim) s1[i] = -1e30f;
          }
        }
        if (pass && cur >= 8 && j == cur - 8) {
          const int lo = tokl - 512 - j * 64;
#pragma unroll
          for (int i = 0; i < 16; ++i) {
            if (crow16(i, h2) <= lo) s0[i] = -1e30f;
            if (32 + crow16(i, h2) <= lo) s1[i] = -1e30f;
          }
        }
        float mx = -1e30f;
#pragma unroll
        for (int i = 0; i < 16; ++i) mx = fmaxf(mx, fmaxf(s0[i], s1[i]));
        mx = fmaxf(mx, __shfl_xor(mx, 32));
        const float mnew = fmaxf(m, mx);
        const float mu = fmaxf(mnew, -1e20f);
        const float corr = __builtin_amdgcn_exp2f((m - mu) * CS);
        m = mnew;
        const float muc = mu * CS;
        float ps = 0.f;
#pragma unroll
        for (int i = 0; i < 16; ++i) {
          s0[i] = __builtin_amdgcn_exp2f(fmaf(s0[i], CS, -muc));
          s1[i] = __builtin_amdgcn_exp2f(fmaf(s1[i], CS, -muc));
          ps += s0[i] + s1[i];
        }
        l = l * corr + ps;
#pragma unroll
        for (int i = 0; i < 16; ++i) { o0[i] *= corr; o1[i] *= corr; }
#pragma unroll
        for (int kb = 0; kb < 2; ++kb) {
#pragma unroll
          for (int s = 0; s < 2; ++s) {
            uint4 pk;
            if (kb == 0) {
              pk.x = pack2(s0[8 * s + 0], s0[8 * s + 1]); pk.y = pack2(s0[8 * s + 2], s0[8 * s + 3]);
              pk.z = pack2(s0[8 * s + 4], s0[8 * s + 5]); pk.w = pack2(s0[8 * s + 6], s0[8 * s + 7]);
            } else {
              pk.x = pack2(s1[8 * s + 0], s1[8 * s + 1]); pk.y = pack2(s1[8 * s + 2], s1[8 * s + 3]);
              pk.z = pack2(s1[8 * s + 4], s1[8 * s + 5]); pk.w = pack2(s1[8 * s + 6], s1[8 * s + 7]);
            }
            const bf16x8 pf = __builtin_bit_cast(bf16x8, pk);
            const int kc = kb * 32 + 16 * s + 4 * h2;
            const uint2 a0 = *(const uint2*)&L.vt[buf][r][kc];
            const uint2 a1 = *(const uint2*)&L.vt[buf][r][kc + 8];
            const uint2 c0 = *(const uint2*)&L.vt[buf][32 + r][kc];
            const uint2 c1 = *(const uint2*)&L.vt[buf][32 + r][kc + 8];
            const bf16x8 v0 = __builtin_bit_cast(bf16x8, make_uint4(a0.x, a0.y, a1.x, a1.y));
            const bf16x8 v1 = __builtin_bit_cast(bf16x8, make_uint4(c0.x, c0.y, c1.x, c1.y));
            o0 = MFMA32(v0, pf, o0);
            o1 = MFMA32(v1, pf, o1);
          }
        }
      }
      if (tt == nslc - 1 || tt == T - 1) {
        const float lt = l + __shfl_xor(l, 32);
        const float gate = sigmoidf_(bf2f(PROJ[(size_t)tok * PW0 + C_GL + head * 3 + 1 + pass]));
        const float sc = lt > 0.f ? gate / lt : 0.f;
        bfr* mixp = MIX + (size_t)tok * 1024 + head * 64;
        const bfr* addp = pass ? (const bfr*)mixp : OCMP + (size_t)tok * 512 + head * 64;
#pragma unroll
        for (int q4 = 0; q4 < 4; ++q4) {
          const int d0 = 8 * q4 + 4 * h2;
          const uint2 c = *(const uint2*)(addp + d0);
          uint2 u;
          u.x = pack2(o0[q4 * 4 + 0] * sc + lo2f(c.x), o0[q4 * 4 + 1] * sc + hi2f(c.x));
          u.y = pack2(o0[q4 * 4 + 2] * sc + lo2f(c.y), o0[q4 * 4 + 3] * sc + hi2f(c.y));
          *(uint2*)(mixp + d0) = u;
          const uint2 c2 = *(const uint2*)(addp + 32 + d0);
          u.x = pack2(o1[q4 * 4 + 0] * sc + lo2f(c2.x), o1[q4 * 4 + 1] * sc + hi2f(c2.x));
          u.y = pack2(o1[q4 * 4 + 2] * sc + lo2f(c2.y), o1[q4 * 4 + 3] * sc + hi2f(c2.y));
          *(uint2*)(mixp + 32 + d0) = u;
        }
#pragma unroll
        for (int i = 0; i < 16; ++i) { o0[i] = 0.f; o1[i] = 0.f; }
        m = -1e30f; l = 0.f;
      }
      if (tt + 1 < T) lstore(buf ^ 1);
      __syncthreads();
    }
  }
}


struct CmpLds { bfr k[128][72]; bfr vt[64][132]; };
static_assert(sizeof(CmpLds) <= 49152, "cmp lds");
DI float quad_sum(float x) {
  const float y = x + __int_as_float(__builtin_amdgcn_update_dpp(0, __float_as_int(x), 0xB1, 0xF, 0xF, true));
  return y + __int_as_float(__builtin_amdgcn_update_dpp(0, __float_as_int(y), 0x4E, 0xF, 0xF, true));
}

DI void cmp_attn_mfma_phase(const Params& p, char* smem) {
  char* ws = p.ws;
  CmpLds& L = *(CmpLds*)smem;
  const bfr* PROJ = (const bfr*)(ws + O_PROJ);
  const bfr* KC = (const bfr*)(ws + O_KCVC);
  const bfr* VCT = (const bfr*)(ws + O_VCT);
  bfr* OCMP = (bfr*)(ws + O_OCMP);
  unsigned* SEL = (unsigned*)(ws + O_SEL);
  const int tid = tid_opaque(), lane = tid & 63, wid = tid >> 6, r = lane & 31, h2 = lane >> 5;
  const float CS = 0.125f * 1.4426950408889634f;
  for (int item = VB; item < 1024; item += NVB) {
    const int qt = 63 - (item >> 4), bh = item & 15, b = bh >> 1, hkv = bh & 1;
    __syncthreads();
    {
      const bfr* kb = KC + ((size_t)(b * 127) * 2 + hkv) * 64;
      const bfr* vb = VCT + (size_t)((b * 2 + hkv) * 64) * 128;
#pragma unroll
      for (int i = 0; i < 4; ++i) {
        const int id = tid + i * 256;
        const int kr = id >> 3, kc = (id & 7) * 8;
        *(uint4*)&L.k[kr][kc] = *(const uint4*)(kb + (size_t)kr * 128 + kc);
        const int vr = id >> 4, vc = (id & 15) * 8;
        const uint4 v = *(const uint4*)(vb + (size_t)vr * 128 + vc);
        *(uint2*)&L.vt[vr][vc] = make_uint2(v.x, v.y);
        *(uint2*)&L.vt[vr][vc + 4] = make_uint2(v.z, v.w);
      }
    }
    __syncthreads();
    const int tokl = qt * 32 + wid * 8 + (r >> 2), g = r & 3, head = hkv * 4 + g, tok = b * SEQ + tokl;
    const int nv = tokl >= 31 ? ((tokl - 31) >> 4) + 1 : 0;
    bf16x8 qf[4];
#pragma unroll
    for (int s = 0; s < 4; ++s) qf[s] = *(const bf16x8*)(PROJ + (size_t)tok * PW0 + C_Q + head * 64 + 16 * s + 8 * h2);
    float m = -1e30f, l = 0.f;
#pragma unroll 1
    for (int kb4 = 0; kb4 < 4; ++kb4) {
      f32x16 sc;
#pragma unroll
      for (int i = 0; i < 16; ++i) sc[i] = 0.f;
#pragma unroll
      for (int s = 0; s < 4; ++s) {
        const bf16x8 kf = *(const bf16x8*)&L.k[kb4 * 32 + r][16 * s + 8 * h2];
        sc = MFMA32(kf, qf[s], sc);
      }
      float mx = -1e30f;
#pragma unroll
      for (int i = 0; i < 16; ++i) {
        if (kb4 * 32 + crow16(i, h2) >= nv) sc[i] = -1e30f;
        mx = fmaxf(mx, sc[i]);
      }
      const float mn = fmaxf(m, mx), mu = fmaxf(mn, -1e20f);
      float ps = 0.f;
#pragma unroll
      for (int i = 0; i < 16; ++i) ps += __builtin_amdgcn_exp2f((sc[i] - mu) * CS);
      l = l * __builtin_amdgcn_exp2f((m - mu) * CS) + ps;
      m = mn;
    }
    {
      const float mo = __shfl_xor(m, 32), lo = __shfl_xor(l, 32);
      const float mt = fmaxf(m, mo), mu = fmaxf(mt, -1e20f);
      l = l * __builtin_amdgcn_exp2f((m - mu) * CS) + lo * __builtin_amdgcn_exp2f((mo - mu) * CS);
      m = mu;
    }
    const float invl = l > 0.f ? 1.f / l : 0.f;
    const float muc = m * CS;
    f32x16 o0, o1;
#pragma unroll
    for (int i = 0; i < 16; ++i) { o0[i] = 0.f; o1[i] = 0.f; }
    float part[16], first[16];
#pragma unroll
    for (int kb4 = 0; kb4 < 4; ++kb4) {
      f32x16 sc;
#pragma unroll
      for (int i = 0; i < 16; ++i) sc[i] = 0.f;
#pragma unroll
      for (int s = 0; s < 4; ++s) {
        const bf16x8 kf = *(const bf16x8*)&L.k[kb4 * 32 + r][16 * s + 8 * h2];
        sc = MFMA32(kf, qf[s], sc);
      }
#pragma unroll
      for (int i = 0; i < 16; ++i) {
        const float pv = __builtin_amdgcn_exp2f(fmaf(sc[i], CS, -muc)) * invl;
        sc[i] = (kb4 * 32 + crow16(i, h2) >= nv) ? 0.f : pv;
      }
#pragma unroll
      for (int s = 0; s < 2; ++s) {
        uint4 pk;
        pk.x = pack2(sc[8 * s + 0], sc[8 * s + 1]); pk.y = pack2(sc[8 * s + 2], sc[8 * s + 3]);
        pk.z = pack2(sc[8 * s + 4], sc[8 * s + 5]); pk.w = pack2(sc[8 * s + 6], sc[8 * s + 7]);
        const bf16x8 pf = __builtin_bit_cast(bf16x8, pk);
        const int kc = kb4 * 32 + 16 * s + 4 * h2;
        const uint2 a0 = *(const uint2*)&L.vt[r][kc];
        const uint2 a1 = *(const uint2*)&L.vt[r][kc + 8];
        const uint2 c0 = *(const uint2*)&L.vt[32 + r][kc];
        const uint2 c1 = *(const uint2*)&L.vt[32 + r][kc + 8];
        o0 = MFMA32(__builtin_bit_cast(bf16x8, make_uint4(a0.x, a0.y, a1.x, a1.y)), pf, o0);
        o1 = MFMA32(__builtin_bit_cast(bf16x8, make_uint4(c0.x, c0.y, c1.x, c1.y)), pf, o1);
      }
#pragma unroll
      for (int q4 = 0; q4 < 4; ++q4) {
        const float e0 = quad_sum(sc[q4 * 4 + 0]), e1 = quad_sum(sc[q4 * 4 + 1]);
        const float e2 = quad_sum(sc[q4 * 4 + 2]), e3 = quad_sum(sc[q4 * 4 + 3]);
        part[kb4 * 4 + q4] = e0 + 2.f * (e1 + e2 + e3);
        first[kb4 * 4 + q4] = e0;
      }
      __builtin_amdgcn_sched_barrier(0);
    }
    {
      const float g0 = sigmoidf_(bf2f(PROJ[(size_t)tok * PW0 + C_GL + head * 3 + 0]));
      bfr* op = OCMP + (size_t)tok * 512 + head * 64;
#pragma unroll
      for (int q4 = 0; q4 < 4; ++q4) {
        const int d0 = 8 * q4 + 4 * h2;
        uint2 u;
        u.x = pack2(o0[q4 * 4 + 0] * g0, o0[q4 * 4 + 1] * g0); u.y = pack2(o0[q4 * 4 + 2] * g0, o0[q4 * 4 + 3] * g0);
        *(uint2*)(op + d0) = u;
        u.x = pack2(o1[q4 * 4 + 0] * g0, o1[q4 * 4 + 1] * g0); u.y = pack2(o1[q4 * 4 + 2] * g0, o1[q4 * 4 + 3] * g0);
        *(uint2*)(op + 32 + d0) = u;
      }
    }
    float val[16], oth[16];
    const float h2f = (float)h2;
    {
      float recv[17];
#pragma unroll
      for (int gi = 0; gi < 16; ++gi) recv[gi] = __shfl_xor(first[gi], 32);
      recv[16] = 0.f;
#pragma unroll
      for (int gi = 0; gi < 16; ++gi) val[gi] = part[gi] + (recv[gi] * (1.f - h2f) + recv[gi + 1] * h2f);
#pragma unroll
      for (int gi = 0; gi < 16; ++gi) oth[gi] = __shfl_xor(val[gi], 32);
    }
    const int cur = tokl >> 6;
    float cv[32];
#pragma unroll
    for (int gi = 0; gi < 16; ++gi) {
      cv[2 * gi] = val[gi] * (1.f - h2f) + oth[gi] * h2f;
      cv[2 * gi + 1] = val[gi] * h2f + oth[gi] * (1.f - h2f);
    }
    unsigned mask = 1u | (1u << cur);
    if (cur >= 1) mask |= 1u << (cur - 1);
    unsigned chosen = 0u;
#pragma unroll 1
    for (int rnd = 0; rnd < 5; ++rnd) {
      float best = -1.f; int bi = -1;
#pragma unroll
      for (int j = 1; j < 31; ++j) {
        const bool el = (j <= cur - 2) && !((chosen >> j) & 1u) && (cv[j] > best);
        best = el ? cv[j] : best;
        bi = el ? j : bi;
      }
      if (bi >= 0) chosen |= 1u << bi;
    }
    mask |= chosen;
    if (g == 0 && h2 == 0) SEL[tok * 2 + hkv] = mask;
  }
}

DI void attn_all_phase(const Params& p, char* smem) {
  char* ws = p.ws;
  AttnLds& L = *(AttnLds*)smem;
  CmpLds& LC = *(CmpLds*)smem;
  const bfr* KC = (const bfr*)(ws + O_KCVC);
  const bfr* VCT = (const bfr*)(ws + O_VCT);
  const bfr* PROJ = (const bfr*)(ws + O_PROJ);
  const bfr* QR = (const bfr*)(ws + O_QR);
  const bfr* OCMP = (const bfr*)(ws + O_OCMP);
  const unsigned* SEL = (const unsigned*)(ws + O_SEL);
  bfr* MIX = (bfr*)(ws + O_MIX);
  const int tid0 = tid_opaque(), wid = __builtin_amdgcn_readfirstlane(tid0 >> 6);
  const float CS = 0.125f * 1.4426950408889634f;
  for (int item = VB; item < 1024; item += NVB) {
    int tid = tid0;
    asm volatile("" : "+v"(tid) :: "memory");
    const int lane = tid & 63, r = lane & 31, h2 = lane >> 5;
    const int lrow = tid >> 3, lc8 = (tid & 7) * 8;
    const int qt = item < 512 ? 63 - (item >> 4) : ((item - 512) >> 4);
    const int bh = item & 15, b = bh >> 1, hkv = bh & 1;
    const int cur = qt >> 1;
    unsigned sel;
    {
    __syncthreads();
      {
        const bfr* kb = KC + ((size_t)(b * 127) * 2 + hkv) * 64;
        const bfr* vb = VCT + (size_t)((b * 2 + hkv) * 64) * 128;
#pragma unroll
        for (int i = 0; i < 4; ++i) {
          const int id = tid + i * 256;
          const int kr = id >> 3, kc = (id & 7) * 8;
          *(uint4*)&LC.k[kr][kc] = *(const uint4*)(kb + (size_t)kr * 128 + kc);
          const int vr = id >> 4, vc = (id & 15) * 8;
          const uint4 v = *(const uint4*)(vb + (size_t)vr * 128 + vc);
          *(uint2*)&LC.vt[vr][vc] = make_uint2(v.x, v.y);
          *(uint2*)&LC.vt[vr][vc + 4] = make_uint2(v.z, v.w);
        }
      }
      __syncthreads();
      const int tokl = qt * 32 + wid * 8 + (r >> 2), g = r & 3, head = hkv * 4 + g, tok = b * SEQ + tokl;
      const int nv = tokl >= 31 ? ((tokl - 31) >> 4) + 1 : 0;
      bf16x8 qf[4];
#pragma unroll
      for (int s = 0; s < 4; ++s) qf[s] = *(const bf16x8*)(PROJ + (size_t)tok * PW0 + C_Q + head * 64 + 16 * s + 8 * h2);
      float m = -1e30f, l = 0.f;
#pragma unroll 1
      for (int kb4 = 0; kb4 < 4; ++kb4) {
        f32x16 sc;
#pragma unroll
        for (int i = 0; i < 16; ++i) sc[i] = 0.f;
#pragma unroll
        for (int s = 0; s < 4; ++s) {
          const bf16x8 kf = *(const bf16x8*)&LC.k[kb4 * 32 + r][16 * s + 8 * h2];
          sc = MFMA32(kf, qf[s], sc);
        }
        float mx = -1e30f;
#pragma unroll
        for (int i = 0; i < 16; ++i) {
          if (kb4 * 32 + crow16(i, h2) >= nv) sc[i] = -1e30f;
          mx = fmaxf(mx, sc[i]);
        }
        const float mn = fmaxf(m, mx), mu = fmaxf(mn, -1e20f);
        float ps = 0.f;
#pragma unroll
        for (int i = 0; i < 16; ++i) ps += __builtin_amdgcn_exp2f((sc[i] - mu) * CS);
        l = l * __builtin_amdgcn_exp2f((m - mu) * CS) + ps;
        m = mn;
      }
      {
        const float mo = __shfl_xor(m, 32), lo = __shfl_xor(l, 32);
        const float mt = fmaxf(m, mo), mu = fmaxf(mt, -1e20f);
        l = l * __builtin_amdgcn_exp2f((m - mu) * CS) + lo * __builtin_amdgcn_exp2f((mo - mu) * CS);
        m = mu;
      }
      const float invl = l > 0.f ? 1.f / l : 0.f;
      const float muc = m * CS;
      f32x16 o0, o1;
#pragma unroll
      for (int i = 0; i < 16; ++i) { o0[i] = 0.f; o1[i] = 0.f; }
      float part[16], first[16];
#pragma unroll
      for (int kb4 = 0; kb4 < 4; ++kb4) {
        f32x16 sc;
#pragma unroll
        for (int i = 0; i < 16; ++i) sc[i] = 0.f;
#pragma unroll
        for (int s = 0; s < 4; ++s) {
          const bf16x8 kf = *(const bf16x8*)&LC.k[kb4 * 32 + r][16 * s + 8 * h2];
          sc = MFMA32(kf, qf[s], sc);
        }
#pragma unroll
        for (int i = 0; i < 16; ++i) {
          const float pv = __builtin_amdgcn_exp2f(fmaf(sc[i], CS, -muc)) * invl;
          sc[i] = (kb4 * 32 + crow16(i, h2) >= nv) ? 0.f : pv;
        }
#pragma unroll
        for (int s = 0; s < 2; ++s) {
          uint4 pk;
          pk.x = pack2(sc[8 * s + 0], sc[8 * s + 1]); pk.y = pack2(sc[8 * s + 2], sc[8 * s + 3]);
          pk.z = pack2(sc[8 * s + 4], sc[8 * s + 5]); pk.w = pack2(sc[8 * s + 6], sc[8 * s + 7]);
          const bf16x8 pf = __builtin_bit_cast(bf16x8, pk);
          const int kc = kb4 * 32 + 16 * s + 4 * h2;
          const uint2 a0 = *(const uint2*)&LC.vt[r][kc];
          const uint2 a1 = *(const uint2*)&LC.vt[r][kc + 8];
          const uint2 c0 = *(const uint2*)&LC.vt[32 + r][kc];
          const uint2 c1 = *(const uint2*)&LC.vt[32 + r][kc + 8];
          o0 = MFMA32(__builtin_bit_cast(bf16x8, make_uint4(a0.x, a0.y, a1.x, a1.y)), pf, o0);
          o1 = MFMA32(__builtin_bit_cast(bf16x8, make_uint4(c0.x, c0.y, c1.x, c1.y)), pf, o1);
        }
#pragma unroll
        for (int q4 = 0; q4 < 4; ++q4) {
          const float e0 = quad_sum(sc[q4 * 4 + 0]), e1 = quad_sum(sc[q4 * 4 + 1]);
          const float e2 = quad_sum(sc[q4 * 4 + 2]), e3 = quad_sum(sc[q4 * 4 + 3]);
          part[kb4 * 4 + q4] = e0 + 2.f * (e1 + e2 + e3);
          first[kb4 * 4 + q4] = e0;
        }
        __builtin_amdgcn_sched_barrier(0);
      }
      {
        const float g0 = sigmoidf_(bf2f(PROJ[(size_t)tok * PW0 + C_GL + head * 3 + 0]));
        bfr* op = MIX + (size_t)tok * 1024 + head * 64;
#pragma unroll
        for (int q4 = 0; q4 < 4; ++q4) {
          const int d0 = 8 * q4 + 4 * h2;
          uint2 u;
          u.x = pack2(o0[q4 * 4 + 0] * g0, o0[q4 * 4 + 1] * g0); u.y = pack2(o0[q4 * 4 + 2] * g0, o0[q4 * 4 + 3] * g0);
          *(uint2*)(op + d0) = u;
          u.x = pack2(o1[q4 * 4 + 0] * g0, o1[q4 * 4 + 1] * g0); u.y = pack2(o1[q4 * 4 + 2] * g0, o1[q4 * 4 + 3] * g0);
          *(uint2*)(op + 32 + d0) = u;
        }
      }
      float val[16], oth[16];
      const float h2f = (float)h2;
      {
        float recv[17];
#pragma unroll
        for (int gi = 0; gi < 16; ++gi) recv[gi] = __shfl_xor(first[gi], 32);
        recv[16] = 0.f;
#pragma unroll
        for (int gi = 0; gi < 16; ++gi) val[gi] = part[gi] + (recv[gi] * (1.f - h2f) + recv[gi + 1] * h2f);
#pragma unroll
        for (int gi = 0; gi < 16; ++gi) oth[gi] = __shfl_xor(val[gi], 32);
      }
      const int cur = tokl >> 6;
      float cv[32];
#pragma unroll
      for (int gi = 0; gi < 16; ++gi) {
        cv[2 * gi] = val[gi] * (1.f - h2f) + oth[gi] * h2f;
        cv[2 * gi + 1] = val[gi] * h2f + oth[gi] * (1.f - h2f);
      }
      unsigned mask = 1u | (1u << cur);
      if (cur >= 1) mask |= 1u << (cur - 1);
      unsigned chosen = 0u;
#pragma unroll 1
      for (int rnd = 0; rnd < 5; ++rnd) {
        float best = -1.f; int bi = -1;
#pragma unroll
        for (int j = 1; j < 31; ++j) {
          const bool el = (j <= cur - 2) && !((chosen >> j) & 1u) && (cv[j] > best);
          best = el ? cv[j] : best;
          bi = el ? j : bi;
        }
        if (bi >= 0) chosen |= 1u << bi;
      }
      mask |= chosen;
      sel = mask;
    }
    __syncthreads();
    const int tokl = qt * 32 + wid * 8 + (r >> 2), g = r & 3, head = hkv * 4 + g, tok = b * SEQ + tokl;
    bf16x8 qf[4];
#pragma unroll
    for (int s = 0; s < 4; ++s) qf[s] = *(const bf16x8*)(QR + (size_t)tok * 512 + head * 64 + 16 * s + 8 * h2);
    const int nslc = cur + 1, wlo = cur > 8 ? cur - 8 : 0, T = nslc + (cur - wlo + 1);
    const bfr* KS = (const bfr*)(ws + O_KSR) + (size_t)b * SEQ * 128 + hkv * 64;
    const bfr* KW = (const bfr*)(ws + O_KWR) + (size_t)b * SEQ * 128 + hkv * 64;
    const bfr* VS = (const bfr*)(ws + O_VST) + (size_t)((b * 2 + hkv) * 64) * SEQ;
    const bfr* VW = (const bfr*)(ws + O_VWT) + (size_t)((b * 2 + hkv) * 64) * SEQ;
    uint4 rk0, rk1, rv0, rv1;
    auto gload = [&](int tt) {
      const int pass = tt >= nslc, j = pass ? wlo + tt - nslc : tt;
      const bfr* kb = (pass ? KW : KS) + (size_t)(j * 64) * 128 + lc8;
      const bfr* vb = (pass ? VW : VS) + j * 64 + lc8;
      rk0 = *(const uint4*)(kb + (size_t)lrow * 128); rk1 = *(const uint4*)(kb + (size_t)(lrow + 32) * 128);
      rv0 = *(const uint4*)(vb + (size_t)lrow * SEQ); rv1 = *(const uint4*)(vb + (size_t)(lrow + 32) * SEQ);
    };
    auto lstore = [&](int buf) {
      *(uint4*)&L.k[buf][lrow][lc8] = rk0; *(uint4*)&L.k[buf][lrow + 32][lc8] = rk1;
      *(uint2*)&L.vt[buf][lrow][lc8] = make_uint2(rv0.x, rv0.y); *(uint2*)&L.vt[buf][lrow][lc8 + 4] = make_uint2(rv0.z, rv0.w);
      *(uint2*)&L.vt[buf][lrow + 32][lc8] = make_uint2(rv1.x, rv1.y); *(uint2*)&L.vt[buf][lrow + 32][lc8 + 4] = make_uint2(rv1.z, rv1.w);
    };
    gload(0); lstore(0);
    __syncthreads();
    float m = -1e30f, l = 0.f;
    f32x16 o0, o1;
#pragma unroll
    for (int i = 0; i < 16; ++i) { o0[i] = 0.f; o1[i] = 0.f; }
#pragma unroll 1
    for (int tt = 0; tt < T; ++tt) {
      const int buf = tt & 1;
      if (tt + 1 < T) gload(tt + 1);
      const int pass = tt >= nslc, j = pass ? wlo + tt - nslc : tt;
      const bool rowok = pass ? true : ((sel >> j) & 1u) != 0u;
      if (__any(rowok)) {
        f32x16 s0, s1;
#pragma unroll
        for (int i = 0; i < 16; ++i) { s0[i] = 0.f; s1[i] = 0.f; }
#pragma unroll
        for (int s = 0; s < 4; ++s) {
          const bf16x8 k0 = *(const bf16x8*)&L.k[buf][r][16 * s + 8 * h2];
          const bf16x8 k1 = *(const bf16x8*)&L.k[buf][32 + r][16 * s + 8 * h2];
          s0 = MFMA32(k0, qf[s], s0);
          s1 = MFMA32(k1, qf[s], s1);
        }
        if (!rowok) {
#pragma unroll
          for (int i = 0; i < 16; ++i) { s0[i] = -1e30f; s1[i] = -1e30f; }
        }
        if (j == cur) {
          const int lim = tokl - j * 64;
#pragma unroll
          for (int i = 0; i < 16; ++i) {
            if (crow16(i, h2) > lim) s0[i] = -1e30f;
            if (32 + crow16(i, h2) > lim) s1[i] = -1e30f;
          }
        }
        if (pass && cur >= 8 && j == cur - 8) {
          const int lo = tokl - 512 - j * 64;
#pragma unroll
          for (int i = 0; i < 16; ++i) {
            if (crow16(i, h2) <= lo) s0[i] = -1e30f;
            if (32 + crow16(i, h2) <= lo) s1[i] = -1e30f;
          }
        }
        float mx = -1e30f;
#pragma unroll
        for (int i = 0; i < 16; ++i) mx = fmaxf(mx, fmaxf(s0[i], s1[i]));
        mx = fmaxf(mx, __shfl_xor(mx, 32));
        const float mnew = fmaxf(m, mx);
        const float mu = fmaxf(mnew, -1e20f);
        const float corr = __builtin_amdgcn_exp2f((m - mu) * CS);
        m = mnew;
        const float muc = mu * CS;
        float ps = 0.f;
#pragma unroll
        for (int i = 0; i < 16; ++i) {
          s0[i] = __builtin_amdgcn_exp2f(fmaf(s0[i], CS, -muc));
          s1[i] = __builtin_amdgcn_exp2f(fmaf(s1[i], CS, -muc));
          ps += s0[i] + s1[i];
        }
        l = l * corr + ps;
#pragma unroll
        for (int i = 0; i < 16; ++i) { o0[i] *= corr; o1[i] *= corr; }
#pragma unroll
        for (int kb = 0; kb < 2; ++kb) {
#pragma unroll
          for (int s = 0; s < 2; ++s) {
            uint4 pk;
            if (kb == 0) {
              pk.x = pack2(s0[8 * s + 0], s0[8 * s + 1]); pk.y = pack2(s0[8 * s + 2], s0[8 * s + 3]);
              pk.z = pack2(s0[8 * s + 4], s0[8 * s + 5]); pk.w = pack2(s0[8 * s + 6], s0[8 * s + 7]);
            } else {
              pk.x = pack2(s1[8 * s + 0], s1[8 * s + 1]); pk.y = pack2(s1[8 * s + 2], s1[8 * s + 3]);
              pk.z = pack2(s1[8 * s + 4], s1[8 * s + 5]); pk.w = pack2(s1[8 * s + 6], s1[8 * s + 7]);
            }
            const bf16x8 pf = __builtin_bit_cast(bf16x8, pk);
            const int kc = kb * 32 + 16 * s + 4 * h2;
            const uint2 a0 = *(const uint2*)&L.vt[buf][r][kc];
            const uint2 a1 = *(const uint2*)&L.vt[buf][r][kc + 8];
            const uint2 c0 = *(const uint2*)&L.vt[buf][32 + r][kc];
            const uint2 c1 = *(const uint2*)&L.vt[buf][32 + r][kc + 8];
            const bf16x8 v0 = __builtin_bit_cast(bf16x8, make_uint4(a0.x, a0.y, a1.x, a1.y));
            const bf16x8 v1 = __builtin_bit_cast(bf16x8, make_uint4(c0.x, c0.y, c1.x, c1.y));
            o0 = MFMA32(v0, pf, o0);
            o1 = MFMA32(v1, pf, o1);
          }
        }
      }
      if (tt == nslc - 1 || tt == T - 1) {
        const float lt = l + __shfl_xor(l, 32);
        const float gate = sigmoidf_(bf2f(PROJ[(size_t)tok * PW0 + C_GL + head * 3 + 1 + pass]));
        const float sc = lt > 0.f ? gate / lt : 0.f;
        bfr* mixp = MIX + (size_t)tok * 1024 + head * 64;
        const bfr* addp = (const bfr*)mixp;
#pragma unroll
        for (int q4 = 0; q4 < 4; ++q4) {
          const int d0 = 8 * q4 + 4 * h2;
          const uint2 c = *(const uint2*)(addp + d0);
          uint2 u;
          u.x = pack2(o0[q4 * 4 + 0] * sc + lo2f(c.x), o0[q4 * 4 + 1] * sc + hi2f(c.x));
          u.y = pack2(o0[q4 * 4 + 2] * sc + lo2f(c.y), o0[q4 * 4 + 3] * sc + hi2f(c.y));
          *(uint2*)(mixp + d0) = u;
          const uint2 c2 = *(const uint2*)(addp + 32 + d0);
          u.x = pack2(o1[q4 * 4 + 0] * sc + lo2f(c2.x), o1[q4 * 4 + 1] * sc + hi2f(c2.x));
          u.y = pack2(o1[q4 * 4 + 2] * sc + lo2f(c2.y), o1[q4 * 4 + 3] * sc + hi2f(c2.y));
          *(uint2*)(mixp + 32 + d0) = u;
        }
#pragma unroll
        for (int i = 0; i < 16; ++i) { o0[i] = 0.f; o1[i] = 0.f; }
        m = -1e30f; l = 0.f;
      }
      if (tt + 1 < T) lstore(buf ^ 1);
      __syncthreads();
    }
  }
}

struct RowsGather {
  const bfr* base; const int* list; int i0; int cnt; int ld;
  const bfr* rp[2];
  DI void init(int lr) {
#pragma unroll
    for (int i = 0; i < 2; ++i) {
      int ii = i0 + lr + 64 * i; if (ii > cnt - 1) ii = cnt - 1;
      rp[i] = base + (size_t)(list[ii] >> 1) * ld;
    }
  }
  DI uint4 load(int sel, int k) const { return *(const uint4*)(rp[sel] + k); }
  DI const bfr* ptr(int sel, int k) const { return rp[sel] + k; }
};

struct Rows256Gather {
  const bfr* base; const int* list; int i0; int cnt; int ld;
  const bfr* rp[2];
  DI void init(int lr) {
#pragma unroll
    for (int i = 0; i < 2; ++i) {
      int ii = i0 + lr + 128 * i; if (ii > cnt - 1) ii = cnt - 1;
      rp[i] = base + (size_t)(list[ii] >> 1) * ld;
    }
  }
  DI const bfr* ptr(int sel, int k) const { return rp[sel] + k; }
};

DI void moe_decode(const int (&c)[16], int tile, int& e, int& off, int& ce, int& mt, int& nt) {
  int mg = tile >> 2; nt = tile & 3;
  e = 0; off = 0; ce = 0;
#pragma unroll
  for (int k = 0; k < 16; ++k) {
    const int mk = (c[k] + 255) >> 8;
    if (k == e && mg >= mk) { mg -= mk; off += c[k]; e = k + 1; }
  }
#pragma unroll
  for (int k = 0; k < 16; ++k) if (k == e) ce = c[k];
  mt = mg;
}
template <int NS>
DI void moe1_tile(const Params& p, char* smem_all, int layer, const int (&c)[16], int tile, int half) {
  char* ws = p.ws;
  const int* LIST = (const int*)(ws + O_LIST);
  const bfr* HB = (const bfr*)(ws + O_HB);
  bfr* HMID = (bfr*)(ws + O_HMID);
  int e, off, ce, mt, nt;
  moe_decode(c, tile, e, off, ce, mt, nt);
  const int cb = nt * 256 + half * (NS * 64);
  Rows256Gather A{HB, LIST + (size_t)e * NT, mt * 256, ce, 1024};
  Rows256 B{(const bfr*)(ws + O_WGU) + ((size_t)(layer * 16 + e) * 1024 + cb) * 1024, 1024, NS * 64 - 1};
  gemm_tile_256<NS>(smem_all, 32, A, B, [&](f32x4(&acc)[8][NS], int wr, int wc, int fr, int fq) {
#pragma unroll
    for (int m = 0; m < 8; ++m) {
      const int i = mt * 256 + wr * 128 + m * 16 + fr;
      if (i < ce) {
#pragma unroll
        for (int n2 = 0; n2 < NS / 2; ++n2) {
          const int col = (cb >> 1) + wc * (NS * 8) + n2 * 16 + fq * 4;
          float h[4];
#pragma unroll
          for (int j = 0; j < 4; ++j) { const float g = acc[m][n2 * 2][j], u = acc[m][n2 * 2 + 1][j]; h[j] = g / (1.f + __expf(-g)) * u; }
          *(uint2*)(HMID + (size_t)(off + i) * 512 + col) = make_uint2(pack2(h[0], h[1]), pack2(h[2], h[3]));
        }
      }
    }
  });
}
template <int NS>
DI void moe2_tile(const Params& p, char* smem_all, int layer, const int (&c)[16], int tile, int half) {
  char* ws = p.ws;
  const int* LIST = (const int*)(ws + O_LIST);
  const float* TOPW = (const float*)(ws + O_TOPW);
  const bfr* HMID = (const bfr*)(ws + O_HMID);
  bfr* MO = (bfr*)(ws + O_MOEOUT);
  int e, off, ce, mt, nt;
  moe_decode(c, tile, e, off, ce, mt, nt);
  const int cb = nt * 256 + half * (NS * 64);
  const int rows_here = ce - mt * 256;
  Rows256 A{HMID + (size_t)(off + mt * 256) * 512, 512, (rows_here < 256 ? rows_here : 256) - 1};
  Rows256 B{(const bfr*)(ws + O_WDN) + ((size_t)(layer * 16 + e) * 1024 + cb) * 512, 512, NS * 64 - 1};
  const int* lst = LIST + (size_t)e * NT;
  gemm_tile_256<NS>(smem_all, 16, A, B, [&](f32x4(&acc)[8][NS], int wr, int wc, int fr, int fq) {
#pragma unroll
    for (int m = 0; m < 8; ++m) {
      const int i = mt * 256 + wr * 128 + m * 16 + fr;
      if (i < ce) {
        const int en = lst[i];
        const float w = TOPW[en];
        bfr* dst = MO + ((size_t)(en & 1) * NT + (en >> 1)) * 1024 + cb + wc * (NS * 16) + fq * 4;
#pragma unroll
        for (int n = 0; n < NS; ++n)
          *(uint2*)(dst + n * 16) = make_uint2(pack2(acc[m][n][0] * w, acc[m][n][1] * w), pack2(acc[m][n][2] * w, acc[m][n][3] * w));
      }
    }
  });
}
template <bool SECOND>
DI void moe_phase(const Params& p, char* smem_all, int layer) {
  const int* cnt = (const int*)(p.ws + O_CNT) + layer * 16 * 64;
  int c[16], mtiles = 0;
#pragma unroll
  for (int e = 0; e < 16; ++e) { c[e] = cnt[e * 64]; mtiles += (c[e] + 255) >> 8; }
  const int ntiles = mtiles * 4, G = gridDim.x;
  const int R = ntiles % G, full = ntiles - R;
  for (int tile = xcd_first_tile(); tile < full; tile += G) {
    if (SECOND) moe2_tile<4>(p, smem_all, layer, c, tile, 0); else moe1_tile<4>(p, smem_all, layer, c, tile, 0);
  }
  if (R > 0) {
    if (2 * R <= G) {
      const int piece = blockIdx.x;
      if (piece < 2 * R) {
        if (SECOND) moe2_tile<2>(p, smem_all, layer, c, full + (piece >> 1), piece & 1); else moe1_tile<2>(p, smem_all, layer, c, full + (piece >> 1), piece & 1);
      }
    } else {
      const int tile = full + blockIdx.x;
      if (tile < ntiles) { if (SECOND) moe2_tile<4>(p, smem_all, layer, c, tile, 0); else moe1_tile<4>(p, smem_all, layer, c, tile, 0); }
    }
  }
}
DI void moe1_phase(const Params& p, char* smem_all, int layer) { moe_phase<false>(p, smem_all, layer); }
DI void moe2_phase(const Params& p, char* smem_all, int layer) { moe_phase<true>(p, smem_all, layer); }

struct ALora {
  const bfr* proj; const float* mu; int tok0; int colbase; int mode;
  const bfr* rp[2]; bool hp[2];
  DI void init(int lr) {
#pragma unroll
    for (int i = 0; i < 2; ++i) { const int tok = tok0 + lr + 64 * i; rp[i] = proj + (size_t)tok * PW1 + colbase; hp[i] = (tok & (SEQ - 1)) != 0; }
  }
  DI uint4 load(int sel, int k) const {
    const uint4 c = *(const uint4*)(rp[sel] + k);
    uint4 pv = make_uint4(0, 0, 0, 0);
    if (hp[sel]) pv = *(const uint4*)(rp[sel] - PW1 + k);
    const float4 m0 = *(const float4*)(mu + colbase + k), m1 = *(const float4*)(mu + colbase + k + 4);
    float v[8];
    v[0] = lo2f(c.x) + (lo2f(pv.x) - lo2f(c.x)) * m0.x; v[1] = hi2f(c.x) + (hi2f(pv.x) - hi2f(c.x)) * m0.y;
    v[2] = lo2f(c.y) + (lo2f(pv.y) - lo2f(c.y)) * m0.z; v[3] = hi2f(c.y) + (hi2f(pv.y) - hi2f(c.y)) * m0.w;
    v[4] = lo2f(c.z) + (lo2f(pv.z) - lo2f(c.z)) * m1.x; v[5] = hi2f(c.z) + (hi2f(pv.z) - hi2f(c.z)) * m1.y;
    v[6] = lo2f(c.w) + (lo2f(pv.w) - lo2f(c.w)) * m1.z; v[7] = hi2f(c.w) + (hi2f(pv.w) - hi2f(c.w)) * m1.w;
#pragma unroll
    for (int i = 0; i < 8; ++i) v[i] = mode == 0 ? tanhf(v[i]) : (mode == 2 ? sigmoidf_(v[i]) : v[i]);
    return make_uint4(pack2(v[0], v[1]), pack2(v[2], v[3]), pack2(v[4], v[5]), pack2(v[6], v[7]));
  }
};
DI void rwkv_lora_pool_phase(const Params& p, char* smem) {
  char* ws = p.ws;
  const bfr* PROJ = (const bfr*)(ws + O_PROJ);
  float* W = (float*)(ws + O_RW_W);
  bfr* AS = (bfr*)(ws + O_RW_AS);
  bfr* G = (bfr*)(ws + O_RW_G);
  bfr* MIX = (bfr*)(ws + O_MIX);
  for (int item = VB; item < 1024; item += NVB) {
    const int mt = item >> 3, sub = ((item & 7) + ((item >> 9) & 1) * 4) & 7, tok0 = mt * 128;
    if (sub < 4) {
      const int cp = sub;
      {
        ALora A{PROJ, p.in[I_MU], tok0, 1536, 0};
        RowsContig B{(const bfr*)(ws + O_W2T) + (size_t)cp * 128 * 64, 64, 127};
        const float* w0 = p.in[I_W0];
        gemm_tile<true>(smem, 2, A, B, [&](f32x4(&acc)[4][4], int wr, int wc, int fr, int fq) {
#pragma unroll
          for (int n = 0; n < 4; ++n) {
            const int col = cp * 128 + wc * 64 + n * 16 + fq * 4;
            const float4 w0v = *(const float4*)(w0 + col);
            const float wv[4] = {w0v.x, w0v.y, w0v.z, w0v.w};
#pragma unroll
            for (int m = 0; m < 4; ++m) {
              const int tok = tok0 + wr * 64 + m * 16 + fr;
              float o[4];
#pragma unroll
              for (int j = 0; j < 4; ++j) {
                const float z = -(wv[j] + acc[m][n][j]);
                const float sp = fmaxf(z, 0.f) + log1pf(__expf(-fabsf(z)));
                o[j] = -__expf(-sp - 0.5f);
              }
              *(float4*)(W + (size_t)tok * 512 + col) = make_float4(o[0], o[1], o[2], o[3]);
            }
          }
        });
      }
      {
        ALora A{PROJ, p.in[I_MU], tok0, 1600, 1};
        RowsContig B{(const bfr*)(ws + O_A2T) + (size_t)cp * 128 * 64, 64, 127};
        const float* a0 = p.in[I_A0];
        gemm_tile<true>(smem, 2, A, B, [&](f32x4(&acc)[4][4], int wr, int wc, int fr, int fq) {
#pragma unroll
          for (int n = 0; n < 4; ++n) {
            const int col = cp * 128 + wc * 64 + n * 16 + fq * 4;
            const float4 a0v = *(const float4*)(a0 + col);
#pragma unroll
            for (int m = 0; m < 4; ++m) {
              const int tok = tok0 + wr * 64 + m * 16 + fr;
              *(uint2*)(AS + (size_t)tok * 512 + col) = make_uint2(pack2(sigmoidf_(a0v.x + acc[m][n][0]), sigmoidf_(a0v.y + acc[m][n][1])),
                                                                   pack2(sigmoidf_(a0v.z + acc[m][n][2]), sigmoidf_(a0v.w + acc[m][n][3])));
            }
          }
        });
      }
      {
        ALora A{PROJ, p.in[I_MU], tok0, 1664, 2};
        RowsContig B{(const bfr*)(ws + O_G2T) + (size_t)cp * 128 * 128, 128, 127};
        gemm_tile<true>(smem, 4, A, B, [&](f32x4(&acc)[4][4], int wr, int wc, int fr, int fq) {
#pragma unroll
          for (int n = 0; n < 4; ++n) {
            const int col = cp * 128 + wc * 64 + n * 16 + fq * 4;
#pragma unroll
            for (int m = 0; m < 4; ++m) {
              const int tok = tok0 + wr * 64 + m * 16 + fr;
              *(uint2*)(G + (size_t)tok * 512 + col) = make_uint2(pack2(acc[m][n][0], acc[m][n][1]), pack2(acc[m][n][2], acc[m][n][3]));
            }
          }
        });
      }
    } else {
      bfr* POOLED = (bfr*)(ws + O_POOLED);
      const int tid = tid_opaque();
      for (int e = tid; e < 32 * 64; e += 256) {
        const int tok = tok0 + (sub - 4) * 32 + (e >> 6), ch = (e & 63) * 8, gi = ch >> 7;
        const int t = tok & (SEQ - 1), win = 2 << gi, n = (t + 1 < win) ? t + 1 : win;
        const bfr* rp = PROJ + (size_t)tok * PW1 + 1792 + ch;
        const uint4 c = *(const uint4*)rp;
        const float a[8] = {lo2f(c.x), hi2f(c.x), lo2f(c.y), hi2f(c.y), lo2f(c.z), hi2f(c.z), lo2f(c.w), hi2f(c.w)};
        float sm[8];
#pragma unroll
        for (int i = 0; i < 8; ++i) sm[i] = a[i];
#pragma unroll
        for (int d0 = 1; d0 < 16; d0 += 5) {
          uint4 u[5];
#pragma unroll
          for (int q = 0; q < 5; ++q) {
            const int d = d0 + q;
            u[q] = make_uint4(0, 0, 0, 0);
            if (d < n) u[q] = *(const uint4*)(rp - (size_t)d * PW1);
          }
#pragma unroll
          for (int q = 0; q < 5; ++q) {
            sm[0] += lo2f(u[q].x); sm[1] += hi2f(u[q].x); sm[2] += lo2f(u[q].y); sm[3] += hi2f(u[q].y);
            sm[4] += lo2f(u[q].z); sm[5] += hi2f(u[q].z); sm[6] += lo2f(u[q].w); sm[7] += hi2f(u[q].w);
          }
        }
        const float inv = 1.f / (float)n;
#pragma unroll
        for (int i = 0; i < 8; ++i) sm[i] = sm[i] * inv - a[i];
        *(uint4*)(POOLED + (size_t)tok * 512 + ch) = make_uint4(pack2(sm[0], sm[1]), pack2(sm[2], sm[3]), pack2(sm[4], sm[5]), pack2(sm[6], sm[7]));
      }
    }
  }
}

DI void pool_gemm_tiles(const Params& p, char* smem, int first, int stride) {
  char* ws = p.ws;
  bfr* MIX = (bfr*)(ws + O_MIX);
  for (int tile = first; tile < 512; tile += stride) {
    const int mt = tile >> 2, gi = tile & 3, tok0 = mt * 128;
    RowsContig A{(const bfr*)(ws + O_POOLED) + (size_t)tok0 * 512 + gi * 128, 512, 127};
    RowsContig B{(const bfr*)(ws + O_PWT) + (size_t)gi * 128 * 128, 128, 127};
    const float* ps = p.in[I_POOLS] + gi * 128;
    gemm_tile<true>(smem, 4, A, B, [&](f32x4(&acc)[4][4], int wr, int wc, int fr, int fq) {
#pragma unroll
      for (int n = 0; n < 4; ++n) {
        const int col = wc * 64 + n * 16 + fq * 4;
        const float4 sc = *(const float4*)(ps + col);
#pragma unroll
        for (int m = 0; m < 4; ++m) {
          const int tok = tok0 + wr * 64 + m * 16 + fr;
          *(uint2*)(MIX + (size_t)tok * 1024 + 512 + gi * 128 + col) = make_uint2(pack2(acc[m][n][0] * sc.x, acc[m][n][1] * sc.y), pack2(acc[m][n][2] * sc.z, acc[m][n][3] * sc.w));
        }
      }
    });
  }
}

constexpr int CHUNK = 128, NCH = SEQ / CHUNK;
DI void scanA_phase(const Params& p, char* smem) {
  char* ws = p.ws;
  const int tid = tid_opaque(), lane = tid & 63, wid = tid >> 6;
  const int ul = wid >> 1, isP = wid & 1;
  float* st = (float*)smem + wid * (8 * 384);
  const bfr* PROJ = (const bfr*)(ws + O_PROJ);
  const float* W = (const float*)(ws + O_RW_W);
  const bfr* AS = (const bfr*)(ws + O_RW_AS);
  bfr* QT = (bfr*)(ws + O_RW_Q); bfr* YL = (bfr*)(ws + O_RW_Y);
  float* RK = (float*)(ws + O_RK);
  float* CHP = (float*)(ws + O_CHP); float* CHL = (float*)(ws + O_CHL);
  const float* mu = p.in[I_MU];
  for (int item = VB; item < 512; item += NVB) {
    const int unit = item * 2 + ul;
    const int chain = unit >> 4, chunk = unit & 15, b = chain >> 3, h = chain & 7;
    const int c = h * 64 + lane;
    const int tok_base = b * SEQ + chunk * CHUNK;
    const float mu_r = mu[c], mu_k = mu[512 + c], mu_v = mu[1024 + c];
    const float kkp = p.in[I_KK][c], kap = p.in[I_KA][c], rkp = p.in[I_RKP][c];
    float S[64];
    int diag = isP ? lane : -1;
    asm volatile("" : "+v"(diag));
#pragma unroll
    for (int j = 0; j < 64; ++j) S[j] = (j == diag) ? 1.f : 0.f;
    bfr qr[9], qk[9], qv[9], qa[8]; float qw[8];
    auto issue = [&](int sub) {
      const int tl = chunk * CHUNK + sub * 8, tok0 = tok_base + sub * 8;
      const bfr* pr = PROJ + (size_t)tok0 * PW1 + c;
      qr[0] = 0; qk[0] = 0; qv[0] = 0;
      if (tl > 0) { qr[0] = pr[-PW1]; qk[0] = pr[512 - PW1]; qv[0] = pr[1024 - PW1]; }
#pragma unroll
      for (int s8 = 0; s8 < 8; ++s8) {
        qr[s8 + 1] = pr[(size_t)s8 * PW1]; qk[s8 + 1] = pr[(size_t)s8 * PW1 + 512]; qv[s8 + 1] = pr[(size_t)s8 * PW1 + 1024];
        qa[s8] = AS[(size_t)(tok0 + s8) * 512 + c]; qw[s8] = W[(size_t)(tok0 + s8) * 512 + c];
      }
    };
    issue(0);
#pragma unroll 1
    for (int sub = 0; sub < CHUNK / 8; ++sub) {
#pragma unroll
      for (int s = 0; s < 8; ++s) {
        const int tok = tok_base + sub * 8 + s;
        const float rc = bf2f(qr[s + 1]), rpv = bf2f(qr[s]);
        const float kc = bf2f(qk[s + 1]), kpv = bf2f(qk[s]);
        const float vc = bf2f(qv[s + 1]), vpv = bf2f(qv[s]);
        const float r = rc + (rpv - rc) * mu_r, k = kc + (kpv - kc) * mu_k, v = vc + (vpv - vc) * mu_v;
        const float as = bf2f(qa[s]);
        const float km = k * (1.f + (as - 1.f) * kap);
        float kk = k * kkp;
        float nrm = kk * kk, rk = r * km * rkp;
        nrm = wave_sum(nrm); rk = wave_sum(rk);
        kk *= 1.f / fmaxf(sqrtf(nrm), 1e-12f);
        float* d = st + s * 384;
        d[lane] = r;
        d[64 + lane] = __expf(qw[s]);
        d[128 + lane] = km;
        d[192 + lane] = v;
        d[256 + lane] = -kk;
        d[320 + lane] = kk * as;
        if (!isP && lane == 0) RK[tok * 8 + h] = rk;
      }
      if (sub + 1 < CHUNK / 8) issue(sub + 1);
      __builtin_amdgcn_fence(__ATOMIC_RELEASE, "wavefront");
      __builtin_amdgcn_wave_barrier();
#pragma unroll 1
      for (int s = 0; s < 8; ++s) {
        const float* d = st + s * 384;
        float sa0 = 0.f, sa1 = 0.f, sa2 = 0.f, sa3 = 0.f;
#pragma unroll
        for (int j4 = 0; j4 < 16; ++j4) {
          const float4 a4 = *(const float4*)(d + 256 + j4 * 4);
          sa0 = fmaf(S[j4 * 4], a4.x, sa0); sa1 = fmaf(S[j4 * 4 + 1], a4.y, sa1); sa2 = fmaf(S[j4 * 4 + 2], a4.z, sa2); sa3 = fmaf(S[j4 * 4 + 3], a4.w, sa3);
        }
        const float sa = (sa0 + sa1) + (sa2 + sa3);
        const float vi = isP ? 0.f : d[192 + lane];
        float y0 = 0.f, y1 = 0.f, y2 = 0.f, y3 = 0.f;
#pragma unroll
        for (int j4 = 0; j4 < 16; ++j4) {
          if ((j4 & 3) == 0) asm volatile("" ::: "memory");
          const float4 w4 = *(const float4*)(d + 64 + j4 * 4);
          const float4 b4 = *(const float4*)(d + 320 + j4 * 4);
          const float4 k4 = *(const float4*)(d + 128 + j4 * 4);
          const float4 r4 = *(const float4*)(d + j4 * 4);
          S[j4 * 4 + 0] = S[j4 * 4 + 0] * w4.x + (sa * b4.x + vi * k4.x);
          S[j4 * 4 + 1] = S[j4 * 4 + 1] * w4.y + (sa * b4.y + vi * k4.y);
          S[j4 * 4 + 2] = S[j4 * 4 + 2] * w4.z + (sa * b4.z + vi * k4.z);
          S[j4 * 4 + 3] = S[j4 * 4 + 3] * w4.w + (sa * b4.w + vi * k4.w);
          y0 = fmaf(S[j4 * 4], r4.x, y0); y1 = fmaf(S[j4 * 4 + 1], r4.y, y1); y2 = fmaf(S[j4 * 4 + 2], r4.z, y2); y3 = fmaf(S[j4 * 4 + 3], r4.w, y3);
        }
        const float y = (y0 + y1) + (y2 + y3);
        const size_t o = (size_t)(tok_base + sub * 8 + s) * 512 + c;
        if (isP) QT[o] = f2bf(y);
        else YL[o] = f2bf(y);
      }
      __builtin_amdgcn_fence(__ATOMIC_RELEASE, "wavefront");
      __builtin_amdgcn_wave_barrier();
    }
    float4* dp = (float4*)((isP ? CHP : CHL) + ((size_t)unit * 64 + lane) * 64);
#pragma unroll
    for (int j4 = 0; j4 < 16; ++j4) dp[j4] = make_float4(S[j4 * 4], S[j4 * 4 + 1], S[j4 * 4 + 2], S[j4 * 4 + 3]);
  }
}

constexpr int SR = 72;
typedef bfr (*Mat)[SR];
#ifndef SCAN_MASK
#define SCAN_MASK 31
#endif
DI f32x16 mm_nt(Mat L, Mat R, int bm, int bn, int r, int h2, f32x16 acc) {
#pragma unroll
  for (int ks = 0; ks < 4; ++ks) {
    const bf16x8 a = *(const bf16x8*)&L[bm * 32 + r][16 * ks + 8 * h2];
    const bf16x8 b = *(const bf16x8*)&R[bn * 32 + r][16 * ks + 8 * h2];
    acc = MFMA32(a, b, acc);
  }
  return acc;
}
DI f32x16 zero16() { f32x16 z;
#pragma unroll
  for (int i = 0; i < 16; ++i) z[i] = 0.f;
  return z; }
DI void st_row(Mat B, const f32x16& acc, int bm, int bn, int r, int h2) {
#pragma unroll
  for (int i = 0; i < 16; ++i) B[bm * 32 + crow16(i, h2)][bn * 32 + r] = (bfr)(pack2(acc[i], 0.f) & 0xffffu);
}
DI void st_tr(Mat B, const f32x16& acc, int bm, int bn, int r, int h2) {
#pragma unroll
  for (int q4 = 0; q4 < 4; ++q4)
    *(uint2*)&B[bn * 32 + r][bm * 32 + 8 * q4 + 4 * h2] = make_uint2(pack2(acc[4 * q4], acc[4 * q4 + 1]), pack2(acc[4 * q4 + 2], acc[4 * q4 + 3]));
}

DI void st_row_pk(Mat B, const unsigned (&pk)[8], int bm, int bn, int r, int h2) {
#pragma unroll
  for (int q = 0; q < 8; ++q) {
    B[bm * 32 + crow16(2 * q, h2)][bn * 32 + r] = (bfr)(pk[q] & 0xffffu);
    B[bm * 32 + crow16(2 * q + 1, h2)][bn * 32 + r] = (bfr)(pk[q] >> 16);
  }
}
DI void st_tr_pk(Mat B, const unsigned (&pk)[8], int bm, int bn, int r, int h2) {
#pragma unroll
  for (int q4 = 0; q4 < 4; ++q4) *(uint2*)&B[bn * 32 + r][bm * 32 + 8 * q4 + 4 * h2] = make_uint2(pk[2 * q4], pk[2 * q4 + 1]);
}

DI void scanA_mm_phase(const Params& p, char* smem) {
  char* ws = p.ws;
  const int tid0 = tid_opaque(), wid = __builtin_amdgcn_readfirstlane(tid0 >> 6);
  const int bm = wid >> 1, bn = wid & 1;
  Mat B0 = (Mat)smem, B1 = B0 + 64, B2 = B1 + 64, B3 = B2 + 64, B4 = B3 + 64;
  float* segtot = (float*)(smem + 5 * 64 * SR * 2);
  float* gC = segtot + 256;
  const bfr* PROJ = (const bfr*)(ws + O_PROJ);
  const float* LW = (const float*)(ws + O_RW_W);
  const bfr* AS = (const bfr*)(ws + O_RW_AS);
  bfr* QT = (bfr*)(ws + O_RW_Q); bfr* YL = (bfr*)(ws + O_RW_Y);
  float* RK = (float*)(ws + O_RK);
  float* CHP = (float*)(ws + O_CHP); float* CHL = (float*)(ws + O_CHL);
  bfr* SCR = (bfr*)(ws + O_SCR) + (size_t)VB * (2 * 64 * 64);
  const float* mu = p.in[I_MU];
  for (int unit = VB; unit < 64 * NCH; unit += NVB) {
    int tid = tid0;
    asm volatile("" : "+v"(tid) :: "memory");
    const int lane = tid & 63, r = lane & 31, h2 = lane >> 5;
    const int chain = unit >> 4, chunk = unit & 15, b = chain >> 3, h = chain & 7;
    const int c = h * 64 + lane;
    const float mu_r = mu[c], mu_k = mu[512 + c], mu_v = mu[1024 + c];
    const float kkp = p.in[I_KK][c], kap = p.in[I_KA][c], rkp = p.in[I_RKP][c];
    f32x16 aPB = zero16(), aLB = zero16();
    Mat G0 = B0, G1 = B1, G2 = B2, G3 = B3;
#pragma unroll 1
    for (int sc = 0; sc < 2; ++sc) {
      const int tl0 = chunk * CHUNK + sc * 64;
      const int tok0 = b * SEQ + tl0;
      const int tb = tok0 + wid * 16, tlb = tl0 + wid * 16;
      __syncthreads();
      float gl[16];
      {
        float g = 0.f;
#pragma unroll
        for (int s = 0; s < 16; ++s) { g += LW[(size_t)(tb + s) * 512 + c]; gl[s] = g; }
        segtot[wid * 64 + lane] = g;
      }
      __syncthreads();
      float offs = 0.f, GC = 0.f;
#pragma unroll
      for (int q = 0; q < 4; ++q) { const float x = segtot[q * 64 + lane]; GC += x; offs += (q < wid) ? x : 0.f; }
      const float eGC = __expf(GC);
      if (wid == 0) gC[lane] = eGC;
      unsigned atp[8], btp[8], ktp[8];
      float hold_a = 0.f, hold_b = 0.f, hold_k = 0.f;
      {
        const bfr* pr0 = PROJ + (size_t)tb * PW1 + c;
        float rp = 0.f, kp = 0.f;
        if (tlb > 0) { rp = bf2f(pr0[-PW1]); kp = bf2f(pr0[512 - PW1]); }
#pragma unroll
        for (int s = 0; s < 16; ++s) {
          const bfr* pr = pr0 + (size_t)s * PW1;
          const float rc = bf2f(pr[0]), kc = bf2f(pr[512]);
          const float as = bf2f(AS[(size_t)(tb + s) * 512 + c]);
          const float rr = rc + (rp - rc) * mu_r, kk0 = kc + (kp - kc) * mu_k;
          rp = rc; kp = kc;
          const float km = kk0 * (1.f + (as - 1.f) * kap);
          float kk = kk0 * kkp;
          float nrm = kk * kk, rk = rr * km * rkp;
          nrm = wave_sum(nrm); rk = wave_sum(rk);
          kk *= 1.f / fmaxf(sqrtf(nrm), 1e-12f);
          const float Gt = offs + gl[s];
          const float lws = gl[s] - (s ? gl[s > 0 ? s - 1 : 0] : 0.f);
          const float ep = __expf(Gt), en = __expf(-Gt), em1 = __expf(Gt - lws);
          const float av = -kk * em1, bv = kk * as * en, kv = km * en, rv = rr * ep;
          const int t = wid * 16 + s;
          B0[t][lane] = (bfr)(pack2(bv, 0.f) & 0xffffu);
          B1[t][lane] = (bfr)(pack2(kv, 0.f) & 0xffffu);
          B2[t][lane] = (bfr)(pack2(av, 0.f) & 0xffffu);
          const bfr rvb = (bfr)(pack2(rv, 0.f) & 0xffffu);
          B3[t][lane] = rvb;
          if (s & 1) { atp[s >> 1] = pack2(hold_a, av); btp[s >> 1] = pack2(hold_b, bv); ktp[s >> 1] = pack2(hold_k, kv); }
          else { hold_a = av; hold_b = bv; hold_k = kv; }
          if ((s & 3) == 3) __builtin_amdgcn_sched_barrier(0);
          if (SCAN_MASK & 1) QT[(size_t)(tb + s) * 512 + c] = rvb;
          if ((SCAN_MASK & 16) && lane == 0) RK[(tb + s) * 8 + h] = rk;
        }
      }
      __syncthreads();
      f32x16 aN = mm_nt(B0, B2, bm, bn, r, h2, zero16());
      f32x16 aK = mm_nt(B1, B2, bm, bn, r, h2, zero16());
      f32x16 aBR = mm_nt(B0, B3, bm, bn, r, h2, zero16());
      f32x16 aKR = mm_nt(B1, B3, bm, bn, r, h2, zero16());
      f32x16 aT;
      unsigned pK[8], pBR[8], pKR[8];
      {
        const int tcol = bn * 32 + r;
#pragma unroll
        for (int i = 0; i < 16; ++i) {
          const int srow = bm * 32 + crow16(i, h2);
          if (!(srow < tcol)) { aN[i] = 0.f; aK[i] = 0.f; }
          if (!(srow <= tcol)) { aBR[i] = 0.f; aKR[i] = 0.f; }
          aT[i] = aN[i] + (srow == tcol ? 1.f : 0.f);
        }
#pragma unroll
        for (int q = 0; q < 8; ++q) { pK[q] = pack2(aK[2 * q], aK[2 * q + 1]); pBR[q] = pack2(aBR[2 * q], aBR[2 * q + 1]); pKR[q] = pack2(aKR[2 * q], aKR[2 * q + 1]); }
      }
      __syncthreads();
      Mat X = B0, XT = B1, TT = B2, Y = B3, YT = B4;
      st_row(X, aN, bm, bn, r, h2); st_tr(XT, aN, bm, bn, r, h2); st_tr(TT, aT, bm, bn, r, h2);
      __syncthreads();
#pragma unroll 1
      for (int it = 0; it < 5; ++it) {
        const f32x16 x2 = mm_nt(X, XT, bm, bn, r, h2, zero16());
        st_row(Y, x2, bm, bn, r, h2); st_tr(YT, x2, bm, bn, r, h2);
        __syncthreads();
        aT = mm_nt(Y, TT, bm, bn, r, h2, aT);
        __syncthreads();
        st_tr(TT, aT, bm, bn, r, h2);
        Mat t0 = X; X = Y; Y = t0; t0 = XT; XT = YT; YT = t0;
        __syncthreads();
      }
      Mat F0 = X, F1 = XT, F2 = Y, F3 = YT;
      st_row_pk(F0, pK, bm, bn, r, h2);
      {
        const uint4 w0 = make_uint4(atp[0], atp[1], atp[2], atp[3]), w1 = make_uint4(atp[4], atp[5], atp[6], atp[7]);
        *(uint4*)&F1[lane][wid * 16] = w0; *(uint4*)&F1[lane][wid * 16 + 8] = w1;
      }
      __syncthreads();
      const f32x16 aKT = mm_nt(F0, TT, bm, bn, r, h2, zero16());
      const f32x16 aAT = mm_nt(F1, TT, bm, bn, r, h2, zero16());
      __syncthreads();
      st_row(F1, aAT, bm, bn, r, h2);
      st_tr(F0, aKT, bm, bn, r, h2);
      st_tr_pk(TT, pBR, bm, bn, r, h2);
      st_tr_pk(F2, pKR, bm, bn, r, h2);
      {
        const bfr* pr0 = PROJ + (size_t)tb * PW1 + 1024 + c;
        float vp = 0.f;
        if (tlb > 0) vp = bf2f(pr0[-PW1]);
        float vv[16];
#pragma unroll
        for (int s = 0; s < 16; ++s) { const float vc = bf2f(pr0[(size_t)s * PW1]); vv[s] = vc + (vp - vc) * mu_v; vp = vc; }
        *(uint4*)&F3[lane][wid * 16] = make_uint4(pack2(vv[0], vv[1]), pack2(vv[2], vv[3]), pack2(vv[4], vv[5]), pack2(vv[6], vv[7]));
        *(uint4*)&F3[lane][wid * 16 + 8] = make_uint4(pack2(vv[8], vv[9]), pack2(vv[10], vv[11]), pack2(vv[12], vv[13]), pack2(vv[14], vv[15]));
      }
      __syncthreads();
      const f32x16 aUv = mm_nt(F3, F0, bm, bn, r, h2, zero16());
      const f32x16 aQ = mm_nt(F1, TT, bm, bn, r, h2, zero16());
      f32x16 aY = mm_nt(F3, F2, bm, bn, r, h2, zero16());
      if (SCAN_MASK & 1) {
#pragma unroll
        for (int q4 = 0; q4 < 4; ++q4) {
          bfr* qp = QT + (size_t)(tok0 + bn * 32 + r) * 512 + h * 64 + bm * 32 + 8 * q4 + 4 * h2;
          const uint2 sv = *(const uint2*)qp;
          *(uint2*)qp = make_uint2(pack2(aQ[4 * q4] + lo2f(sv.x), aQ[4 * q4 + 1] + hi2f(sv.x)), pack2(aQ[4 * q4 + 2] + lo2f(sv.y), aQ[4 * q4 + 3] + hi2f(sv.y)));
        }
      }
      __syncthreads();
      st_row(F0, aUv, bm, bn, r, h2);
      __syncthreads();
      aY = mm_nt(F0, TT, bm, bn, r, h2, aY);
      if (SCAN_MASK & 2) {
#pragma unroll
        for (int q4 = 0; q4 < 4; ++q4) {
          bfr* yp = YL + (size_t)(tok0 + bn * 32 + r) * 512 + h * 64 + bm * 32 + 8 * q4 + 4 * h2;
          *(uint2*)yp = make_uint2(pack2(aY[4 * q4], aY[4 * q4 + 1]), pack2(aY[4 * q4 + 2], aY[4 * q4 + 3]));
        }
      }
      __syncthreads();
      {
        unsigned wb[8], wk[8];
#pragma unroll
        for (int q = 0; q < 8; ++q) {
          wb[q] = pack2(lo2f(btp[q]) * eGC, hi2f(btp[q]) * eGC);
          wk[q] = pack2(lo2f(ktp[q]) * eGC, hi2f(ktp[q]) * eGC);
        }
        *(uint4*)&TT[lane][wid * 16] = make_uint4(wb[0], wb[1], wb[2], wb[3]); *(uint4*)&TT[lane][wid * 16 + 8] = make_uint4(wb[4], wb[5], wb[6], wb[7]);
        *(uint4*)&F2[lane][wid * 16] = make_uint4(wk[0], wk[1], wk[2], wk[3]); *(uint4*)&F2[lane][wid * 16 + 8] = make_uint4(wk[4], wk[5], wk[6], wk[7]);
      }
      __syncthreads();
      f32x16 aP = mm_nt(F1, TT, bm, bn, r, h2, zero16());
      f32x16 aL = mm_nt(F0, TT, bm, bn, r, h2, zero16());
      aL = mm_nt(F3, F2, bm, bn, r, h2, aL);
      {
        const float dg = gC[bn * 32 + r];
#pragma unroll
        for (int i = 0; i < 16; ++i) if (bm * 32 + crow16(i, h2) == bn * 32 + r) aP[i] += dg;
      }
      if (sc == 0) {
#pragma unroll
        for (int i = 0; i < 16; ++i) {
          const int row = bm * 32 + crow16(i, h2), col = bn * 32 + r;
          SCR[row * 64 + col] = (bfr)(pack2(aP[i], 0.f) & 0xffffu);
          SCR[4096 + row * 64 + col] = (bfr)(pack2(aL[i], 0.f) & 0xffffu);
        }
      }
      aPB = aP; aLB = aL;
      G0 = F0; G1 = F1; G2 = F2; G3 = F3;
    }
    {
      const int tok0 = b * SEQ + chunk * CHUNK + 64;
      __syncthreads();
#pragma unroll
      for (int i = 0; i < 2; ++i) {
        const int id = tid + i * 256, row = id >> 3, c8 = (id & 7) * 8;
        *(uint4*)&G0[row][c8] = *(const uint4*)(SCR + row * 64 + c8);
        *(uint4*)&G1[row][c8] = *(const uint4*)(SCR + 4096 + row * 64 + c8);
        *(uint4*)&G2[row][c8] = *(const uint4*)(QT + (size_t)(tok0 + row) * 512 + h * 64 + c8);
      }
      st_tr(G3, aPB, bm, bn, r, h2);
      __syncthreads();
      {
        const f32x16 cP = mm_nt(G0, G3, bm, bn, r, h2, zero16());
        if (SCAN_MASK & 4) {
#pragma unroll
          for (int i = 0; i < 16; ++i) CHP[((size_t)unit * 64 + bm * 32 + crow16(i, h2)) * 64 + bn * 32 + r] = cP[i];
        }
      }
      __builtin_amdgcn_sched_barrier(0);
      {
        const f32x16 cL = mm_nt(G1, G3, bm, bn, r, h2, aLB);
        if (SCAN_MASK & 8) {
#pragma unroll
          for (int i = 0; i < 16; ++i) CHL[((size_t)unit * 64 + bm * 32 + crow16(i, h2)) * 64 + bn * 32 + r] = cL[i];
        }
      }
      __builtin_amdgcn_sched_barrier(0);
      if (SCAN_MASK & 1) {
        const f32x16 cQ = mm_nt(G0, G2, bm, bn, r, h2, zero16());
#pragma unroll
        for (int q4 = 0; q4 < 4; ++q4) {
          const size_t o = (size_t)(tok0 + bn * 32 + r) * 512 + h * 64 + bm * 32 + 8 * q4 + 4 * h2;
          *(uint2*)(QT + o) = make_uint2(pack2(cQ[4 * q4], cQ[4 * q4 + 1]), pack2(cQ[4 * q4 + 2], cQ[4 * q4 + 3]));
        }
      }
      __builtin_amdgcn_sched_barrier(0);
      if (SCAN_MASK & 2) {
        const f32x16 cY = mm_nt(G1, G2, bm, bn, r, h2, zero16());
#pragma unroll
        for (int q4 = 0; q4 < 4; ++q4) {
          const size_t o = (size_t)(tok0 + bn * 32 + r) * 512 + h * 64 + bm * 32 + 8 * q4 + 4 * h2;
          const uint2 yv = *(const uint2*)(YL + o);
          *(uint2*)(YL + o) = make_uint2(pack2(cY[4 * q4] + lo2f(yv.x), cY[4 * q4 + 1] + hi2f(yv.x)), pack2(cY[4 * q4 + 2] + lo2f(yv.y), cY[4 * q4 + 3] + hi2f(yv.y)));
        }
      }
    }
  }
}

DI void split_hl(float x, bfr& hi, bfr& lo) {
  const unsigned h = pack2(x, 0.f) & 0xffffu;
  hi = (bfr)h;
  lo = (bfr)(pack2(x - __uint_as_float(h << 16), 0.f) & 0xffffu);
}
DI void scanB_phase(const Params& p, char* smem) {
  char* ws = p.ws;
  const int tid = tid_opaque(), lane = tid & 63, wid = tid >> 6, r = lane & 31, h2 = lane >> 5;
  const int bm = wid >> 1, bn = wid & 1;
  Mat SH = (Mat)smem, SL = SH + 64, PH = SL + 64, PL = PH + 64;
  const float* CHP = (const float*)(ws + O_CHP);
  float* CHL = (float*)(ws + O_CHL);
  if (NVB > 128 && VB >= 64) {
    conv_run(p, smem, NC_PREP + (VB - 64), NC_ALL, NVB - 64);
    return;
  }
  const int pk_ = tid >> 4, pj = (tid & 15) * 4;
  for (int chain = VB; chain < 64; chain += NVB) {
    f32x16 S;
    {
      const size_t ub = ((size_t)(chain * NCH)) * 4096;
#pragma unroll
      for (int i = 0; i < 16; ++i) S[i] = CHL[ub + (size_t)(bm * 32 + crow16(i, h2)) * 64 + bn * 32 + r];
    }
    float4 pn[4]; f32x16 ln;
    {
      const size_t ub = ((size_t)(chain * NCH + 1)) * 4096;
#pragma unroll
      for (int u = 0; u < 4; ++u) pn[u] = *(const float4*)(CHP + ub + (size_t)(pk_ + 16 * u) * 64 + pj);
#pragma unroll
      for (int i = 0; i < 16; ++i) ln[i] = CHL[ub + (size_t)(bm * 32 + crow16(i, h2)) * 64 + bn * 32 + r];
    }
#pragma unroll 1
    for (int c = 1; c < NCH - 1; ++c) {
      const size_t ub = ((size_t)(chain * NCH + c)) * 4096;
      __syncthreads();
#pragma unroll
      for (int i = 0; i < 16; ++i) {
        bfr hi, lo; split_hl(S[i], hi, lo);
        SH[bm * 32 + crow16(i, h2)][bn * 32 + r] = hi; SL[bm * 32 + crow16(i, h2)][bn * 32 + r] = lo;
      }
#pragma unroll
      for (int u = 0; u < 4; ++u) {
        const float pv[4] = {pn[u].x, pn[u].y, pn[u].z, pn[u].w};
#pragma unroll
        for (int q = 0; q < 4; ++q) { bfr hi, lo; split_hl(pv[q], hi, lo); PH[pj + q][pk_ + 16 * u] = hi; PL[pj + q][pk_ + 16 * u] = lo; }
      }
      f32x16 acc = ln;
      if (c + 1 < NCH - 1) {
        const size_t ub2 = ub + 4096;
#pragma unroll
        for (int u = 0; u < 4; ++u) pn[u] = *(const float4*)(CHP + ub2 + (size_t)(pk_ + 16 * u) * 64 + pj);
#pragma unroll
        for (int i = 0; i < 16; ++i) ln[i] = CHL[ub2 + (size_t)(bm * 32 + crow16(i, h2)) * 64 + bn * 32 + r];
      }
      __syncthreads();
      acc = mm_nt(SH, PH, bm, bn, r, h2, acc);
      acc = mm_nt(SL, PH, bm, bn, r, h2, acc);
      acc = mm_nt(SH, PL, bm, bn, r, h2, acc);
      S = acc;
#pragma unroll
      for (int i = 0; i < 16; ++i) CHL[ub + (size_t)(bm * 32 + crow16(i, h2)) * 64 + bn * 32 + r] = S[i];
    }
  }
}

DI float half_sum32(float v) {
  v += dpp_mov<0xB1>(v); v += dpp_mov<0x4E>(v); v += dpp_mov<0x141>(v); v += dpp_mov<0x140>(v);
  return v + __shfl_xor(v, 16);
}
DI void scanC_phase(const Params& p, char* smem) {
  char* ws = p.ws;
  const int tid0 = tid_opaque(), wid = __builtin_amdgcn_readfirstlane(tid0 >> 6);
  bfr (*QB)[SR] = (bfr(*)[SR])smem;
  Mat SH = (Mat)(smem + 128 * SR * 2), SL = SH + 64;
  const bfr* PROJ = (const bfr*)(ws + O_PROJ);
  const bfr* Q = (const bfr*)(ws + O_RW_Q); const bfr* YL = (const bfr*)(ws + O_RW_Y);
  const bfr* G = (const bfr*)(ws + O_RW_G);
  const float* RK = (const float*)(ws + O_RK);
  const float* CHL = (const float*)(ws + O_CHL);
  bfr* MIX = (bfr*)(ws + O_MIX);
  for (int unit = VB; unit < 64 * NCH; unit += NVB) {
    int tid = tid0;
    asm volatile("" : "+v"(tid) :: "memory");
    const int lane = tid & 63, r = lane & 31, h2 = lane >> 5;
    const int chain = unit >> 4, chunk = unit & 15, b = chain >> 3, h = chain & 7;
    const int tok0 = b * SEQ + chunk * CHUNK;
    __syncthreads();
#pragma unroll
    for (int u = 0; u < 4; ++u) {
      const int id = tid + u * 256, row = id >> 3, c8 = (id & 7) * 8;
      *(uint4*)&QB[row][c8] = *(const uint4*)(Q + (size_t)(tok0 + row) * 512 + h * 64 + c8);
    }
    if (chunk > 0) {
      const float* s0 = CHL + (size_t)(unit - 1) * 4096;
#pragma unroll
      for (int u = 0; u < 4; ++u) {
        const int id = tid + u * 256, row = id >> 4, c4 = (id & 15) * 4;
        const float4 x = *(const float4*)(s0 + row * 64 + c4);
        bfr h0, l0, h1, l1, h2_, l2, h3, l3;
        split_hl(x.x, h0, l0); split_hl(x.y, h1, l1); split_hl(x.z, h2_, l2); split_hl(x.w, h3, l3);
        *(uint2*)&SH[row][c4] = make_uint2((unsigned)h0 | ((unsigned)h1 << 16), (unsigned)h2_ | ((unsigned)h3 << 16));
        *(uint2*)&SL[row][c4] = make_uint2((unsigned)l0 | ((unsigned)l1 << 16), (unsigned)l2 | ((unsigned)l3 << 16));
      }
    }
    __syncthreads();
    {
      f32x16 a0 = zero16(), a1 = zero16();
      if (chunk > 0) {
        a0 = mm_nt((Mat)QB, SH, wid, 0, r, h2, a0);
        a0 = mm_nt((Mat)QB, SL, wid, 0, r, h2, a0);
        a1 = mm_nt((Mat)QB, SH, wid, 1, r, h2, a1);
        a1 = mm_nt((Mat)QB, SL, wid, 1, r, h2, a1);
      }
      const int c0 = h * 64 + r, c1 = c0 + 32;
      const float lnw0 = p.in[I_LNW][c0], lnb0 = p.in[I_LNB][c0], lnw1 = p.in[I_LNW][c1], lnb1 = p.in[I_LNB][c1];
      const float muv0 = p.in[I_MU][1024 + c0], muv1 = p.in[I_MU][1024 + c1];
#pragma unroll
      for (int i = 0; i < 16; ++i) {
        const int tl = chunk * CHUNK + 32 * wid + crow16(i, h2), tok = b * SEQ + tl;
        const size_t o = (size_t)tok * 512;
        const float y0 = a0[i] + bf2f(YL[o + c0]), y1 = a1[i] + bf2f(YL[o + c1]);
        const float sm = half_sum32(y0 + y1), sq = half_sum32(y0 * y0 + y1 * y1);
        const float mean = sm * (1.f / 64.f);
        const float var = fmaxf(sq * (1.f / 64.f) - mean * mean, 0.f);
        const float rstd = rsqrtf(var + 64e-5f);
        const bfr* pr = PROJ + (size_t)tok * PW1 + 1024;
        const float vc0 = bf2f(pr[c0]), vc1 = bf2f(pr[c1]);
        float vp0 = 0.f, vp1 = 0.f;
        if (tl > 0) { vp0 = bf2f(pr[c0 - PW1]); vp1 = bf2f(pr[c1 - PW1]); }
        const float v0 = vc0 + (vp0 - vc0) * muv0, v1 = vc1 + (vp1 - vc1) * muv1;
        const float rk = RK[tok * 8 + h];
        const float o0 = ((y0 - mean) * rstd * lnw0 + lnb0 + rk * v0) * bf2f(G[o + c0]);
        const float o1 = ((y1 - mean) * rstd * lnw1 + lnb1 + rk * v1) * bf2f(G[o + c1]);
        MIX[(size_t)tok * 1024 + c0] = (bfr)(pack2(o0, 0.f) & 0xffffu);
        MIX[(size_t)tok * 1024 + c1] = (bfr)(pack2(o1, 0.f) & 0xffffu);
      }
    }
  }
}

#ifndef REP_PREP
#define REP_PREP 1
#endif
#ifndef REP_PROJ0
#define REP_PROJ0 1
#endif
#ifndef REP_CMPA
#define REP_CMPA 1
#endif
#ifndef REP_SLC
#define REP_SLC 1
#endif
#ifndef REP_MOE1
#define REP_MOE1 1
#endif
#ifndef REP_MOE2
#define REP_MOE2 1
#endif
#ifndef REP_POST0
#define REP_POST0 1
#endif
#ifndef REP_RPREP
#define REP_RPREP 1
#endif
#ifndef REP_SCANB
#define REP_SCANB 1
#endif
#ifndef POOL_IN_SCANB
#define POOL_IN_SCANB 0
#endif
#ifndef REP_POOLG
#define REP_POOLG 1
#endif
#ifndef REP_SCANA
#define REP_SCANA 1
#endif
#ifndef REP_SCANAB
#define REP_SCANAB 1
#endif
#ifndef REP_SCANC
#define REP_SCANC 1
#endif
#ifndef REP_SYNC
#define REP_SYNC 1
#endif
extern __shared__ __attribute__((aligned(16))) char dyn_smem[];
DI char* smem_half() { int h = __builtin_amdgcn_readfirstlane((int)(threadIdx.x >> 8)); asm volatile("" : "+s"(h) :: "memory"); return dyn_smem + h * 49152; }
__global__ void __launch_bounds__(512, 2) fwd_megakernel(Params p) {
  cg::grid_group grid = cg::this_grid();
  __shared__ uint4 xb_words;
  char* ws = p.ws;
  const float* MOD = (const float*)(ws + O_MOD);
  const float* MOD1 = MOD + 8 * 6144;
  float* X = p.out;
  float* X3 = (float*)(ws + O_F);
  if (threadIdx.x == 0) xb_words = make_uint4(0u, 0u, 0u, 0u);
#ifndef TIMEPH
#define TIMEPH -1
#endif
  unsigned long long t_start = 0, t_mark = 0;
  if (TIMEPH >= 0) t_start = __builtin_amdgcn_s_memrealtime();

  for (int rep = 0; rep < REP_PREP; ++rep)
  {
    for (int item = VB; item < PREP_TOTAL; item += NVB) prep_item(p, smem_half(), item);
    conv_run(p, smem_half(), VB, NVB > 128 ? NC_PREP : NC_ALL, NVB);
  }
  grid.sync();
  const XcdBarrier xb = xcd_barrier_post((unsigned*)(ws + O_BAR), (volatile LAS unsigned*)&xb_words);
#ifndef TIMEPH
#define TIMEPH -1
#endif
  int gs_count = 0;
  if (TIMEPH == 0) t_mark = __builtin_amdgcn_s_memrealtime();
#define GSYNC() do { xcd_barrier(xb); if (TIMEPH >= 0) { ++gs_count; if (gs_count == TIMEPH) t_mark = __builtin_amdgcn_s_memrealtime(); } } while (0)
#ifndef XB_EXTRA_REL
#define XB_EXTRA_REL true
#endif
#ifndef XB_EXTRA_ACQ
#define XB_EXTRA_ACQ true
#endif
  for (int rep = 1; rep < REP_SYNC; ++rep) xcd_barrier<XB_EXTRA_REL, XB_EXTRA_ACQ>(xb);
  norm_phase<0, false>(p, smem_half(), p.in[I_X], nullptr, p.in[I_NMIX], MOD, 0, 1024, 0, 0);
  GSYNC();
  for (int rep = 0; rep < REP_PROJ0; ++rep) gemm_proj_phase<4>(p, dyn_smem, (const bfr*)(ws + O_WEIN), PW0, (bfr*)(ws + O_PROJ));
  GSYNC();
  for (int rep = 0; rep < REP_POST0; ++rep) post0_phase(p, smem_half());
  GSYNC();
  attn_all_phase(p, smem_half());
  GSYNC();
  gemm_out_phase<false>(p, dyn_smem, (const bfr*)(ws + O_WEOUT), p.in[I_X], X, MOD + 2048);
  GSYNC();
  norm_router_phase(p, dyn_smem, X, p.in[I_NFFN], MOD, 3072, 4096, 0);
  GSYNC();
  for (int rep = 0; rep < REP_MOE1; ++rep) moe1_phase(p, dyn_smem, 0);
  GSYNC();
  for (int rep = 0; rep < REP_MOE2; ++rep) moe2_phase(p, dyn_smem, 0);
  GSYNC();
  norm_phase<1, false>(p, smem_half(), X, X, p.in[I_NMIX] + 1024, MOD1, 0, 1024, 5120 - 6144 * 8, 1);
  GSYNC();
  gemm_proj_phase<3>(p, dyn_smem, (const bfr*)(ws + O_WOIN), PW1, (bfr*)(ws + O_PROJ));
  GSYNC();
  for (int rep = 0; rep < REP_RPREP; ++rep) rwkv_lora_pool_phase(p, smem_half());
  GSYNC();
#if SCAN_MASK != 31
  scanA_phase(p, smem_half());
  GSYNC();
#endif
  scanA_mm_phase(p, smem_half());
  GSYNC();
  for (int rep = 0; rep < REP_SCANAB; ++rep) {
    if (rep > 0) { scanA_phase(p, smem_half()); GSYNC(); }
    scanB_phase(p, smem_half());
    GSYNC();
  }
  for (int rep = 0; rep < REP_SCANC; ++rep) scanC_phase(p, smem_half());
#if !POOL_IN_SCANB
  __syncthreads();
  for (int rep = 0; rep < REP_POOLG; ++rep) pool_gemm_tiles(p, smem_half(), VB, NVB);
#endif
  GSYNC();
  gemm_out_phase<true>(p, dyn_smem, (const bfr*)(ws + O_WOOUT), X, X3, MOD1 + 2048);
  GSYNC();
  norm_router_phase(p, dyn_smem, X3, p.in[I_NFFN] + 1024, MOD1, 3072, 4096, 1);
  GSYNC();
  moe1_phase(p, dyn_smem, 1);
  GSYNC();
  moe2_phase(p, dyn_smem, 1);
  GSYNC();
  norm_phase<2, false>(p, smem_half(), X3, X, p.in[I_FN], MOD1, 0, 0, 5120, 1);
  if (TIMEPH >= 0 && blockIdx.x == 0 && threadIdx.x == 0) {
    const unsigned long long dt = t_mark - t_start, t0 = __builtin_amdgcn_s_memrealtime();
    while (__builtin_amdgcn_s_memrealtime() - t0 < dt) __builtin_amdgcn_s_sleep(8);
  }
}

constexpr int DYN_LDS = 2 * 49152;
extern "C" void kernel_launch(void* const* d_in, const int* in_sizes, int n_in,
                              void* d_out, int out_size, void* d_ws, size_t ws_size,
                              hipStream_t stream) {
  static int grid_blocks = 0;
  if (!grid_blocks) {
    int dev = 0, cus = 0, per_cu = 0;
    (void)hipGetDevice(&dev);
    (void)hipDeviceGetAttribute(&cus, hipDeviceAttributeMultiprocessorCount, dev);
    (void)hipFuncSetAttribute((const void*)fwd_megakernel, hipFuncAttributeMaxDynamicSharedMemorySize, DYN_LDS);
    (void)hipOccupancyMaxActiveBlocksPerMultiprocessor(&per_cu, fwd_megakernel, 512, DYN_LDS);
    if (per_cu > 1) per_cu = 1;
    if (per_cu < 1) per_cu = 1;
    grid_blocks = cus * per_cu;
    fprintf(stderr, "cus=%d per_cu=%d grid=%d ws=%zu need=%zu\n", cus, per_cu, grid_blocks, ws_size, (size_t)WS_NEED);
  }
  if (ws_size < WS_NEED || n_in < 33) { fprintf(stderr, "workspace too small\n"); return; }
  Params p{};
  for (int i = 0; i < 33; ++i) p.in[i] = (const float*)d_in[i];
  p.out = (float*)d_out;
  p.ws = (char*)d_ws;
  p.ws_size = (unsigned long long)ws_size;
  void* args[] = {&p};
  hipError_t e = hipLaunchCooperativeKernel((void*)fwd_megakernel, dim3(grid_blocks), dim3(512), args, DYN_LDS, stream);
  if (e != hipSuccess) fprintf(stderr, "cooperative launch failed: %s (grid %d)\n", hipGetErrorString(e), grid_blocks);
}
```
